# Optimizing an MI355X kernel written in HIP

```python
import math
import jax, jax.numpy as jnp
from jax import lax
import numpy as np

D_MODEL = 1024
BATCH = 4
SEQ = 8192
DEPTH = 4

CTX_LEN = 256
GRID_W = 64
HEAD_DIM = 64
D_CONV = 256
CONV_W = 3
H_NA = 6
WIN_R_MAX = 8
WIN_C = 16
H_Q = 6
H_KV = 2
WINDOW = 128
BLK_Q = 128
ROPE_BASE = 10000.0
D_NA = H_NA * HEAD_DIM
D_SW = H_Q * HEAD_DIM
D_KV = H_KV * HEAD_DIM
D_MIX = D_CONV + D_NA + D_SW
N_BRANCH = 3
IN_COLS = 3 * D_CONV + 3 * D_NA + D_SW + 2 * D_KV + N_BRANCH * D_MODEL
N_GROUPS = 4
EXP_PER_GROUP = 8
N_EXPERTS = N_GROUPS * EXP_PER_GROUP
TOP_K = 2
D_EXPERT = 256
MOE_BLK = 256
EPS = 1e-6
NEG_INF = -1e30

kernel_name = "hybrid_conv_natten_swa_hmoe_dit"


def rmsnorm(x, g):
    xf = x.astype(jnp.float32)
    y = xf * lax.rsqrt(jnp.mean(xf * xf, axis=-1, keepdims=True) + EPS)
    return (y * g.astype(jnp.float32)).astype(x.dtype)


def modln(x, g, shift, scale):
    return rmsnorm(x, g) * (1 + scale) + shift


def heads(t, n):
    return t.reshape(t.shape[:-1] + (n, HEAD_DIM))


def split_in(u):
    sizes = (D_CONV, D_CONV, D_CONV, D_NA, D_NA, D_NA, D_SW, D_KV, D_KV, N_BRANCH * D_MODEL)
    idx, acc = [], 0
    for s in sizes[:-1]:
        acc += s
        idx.append(acc)
    return jnp.split(u, idx, axis=-1)


def axial_rope(x, row, col):
    half = HEAD_DIM // 2
    quarter = half // 2
    inv = ROPE_BASE ** (-jnp.arange(quarter, dtype=jnp.float32) / quarter)

    def rot(xa, pos):
        ang = pos[:, None] * inv[None, :]
        cos = jnp.cos(ang)[:, None, :]
        sin = jnp.sin(ang)[:, None, :]
        x1, x2 = jnp.split(xa, 2, axis=-1)
        return jnp.concatenate([x1 * cos - x2 * sin, x1 * sin + x2 * cos], axis=-1)

    xf = x.astype(jnp.float32)
    out = jnp.concatenate([rot(xf[..., :half], row), rot(xf[..., half:], col)], axis=-1)
    return out.astype(x.dtype)


def short_conv(h, b_gate, c_gate, w):
    z = c_gate * h
    pad = CONV_W // 2
    n = z.shape[1]
    zp = jnp.pad(z, ((0, 0), (pad, pad), (0, 0)))
    y = zp[:, 0:n] * w[0]
    for j in range(1, CONV_W):
        y = y + zp[:, j:j + n] * w[j]
    return b_gate * y


def ctx_attn(q, k, v, sink):
    bsz, n, hq, dh = q.shape
    hkv = k.shape[2]
    g = hq // hkv
    qg = q.reshape(bsz, n, hkv, g, dh)
    s = jnp.einsum('bqkgd,bjkd->bkgqj', qg, k).astype(jnp.float32) * (dh ** -0.5)
    if sink is not None:
        sink_col = jnp.broadcast_to(sink.astype(jnp.float32).reshape(1, hkv, g, 1, 1), (bsz, hkv, g, n, 1))
        s = jnp.concatenate([s, sink_col], axis=-1)
    p = jax.nn.softmax(s, axis=-1)[..., :n].astype(v.dtype)
    o = jnp.einsum('bkgqj,bjkd->bqkgd', p, v)
    return o.reshape(bsz, n, hq * dh)


def neighbourhood_attn(q, k, v, kc, vc, rpb):
    bsz, n, h, dh = q.shape
    rows = n // GRID_W
    win_r = min(WIN_R_MAX, rows)
    nw = win_r * WIN_C
    scale = dh ** -0.5
    kg = k.reshape(bsz, rows, GRID_W, h, dh)
    vg = v.reshape(bsz, rows, GRID_W, h, dh)
    qg = q.reshape(bsz, rows, GRID_W, h, dh).transpose(1, 0, 2, 3, 4)
    cols = jnp.arange(GRID_W)
    cstart = jnp.clip(cols - WIN_C // 2, 0, GRID_W - WIN_C)
    col_idx = cstart[:, None] + jnp.arange(WIN_C)[None, :]
    rel_c = col_idx - cols[:, None] + (WIN_C - 1)

    def one_row(args):
        r, q_row = args
        rs = jnp.clip(r - win_r // 2, 0, rows - win_r)
        kb = lax.dynamic_slice_in_dim(kg, rs, win_r, axis=1)
        vb = lax.dynamic_slice_in_dim(vg, rs, win_r, axis=1)
        kw = kb[:, :, col_idx]
        vw = vb[:, :, col_idx]
        rel_r = rs + jnp.arange(win_r) - r + (WIN_R_MAX - 1)
        bias = rpb[:, rel_r[None, :, None], rel_c[:, None, :]]
        s_win = jnp.einsum('bqhd,baqchd->bhqac', q_row, kw).astype(jnp.float32) * scale
        s_win = (s_win + bias.astype(jnp.float32)[None]).reshape(bsz, h, GRID_W, nw)
        s_ctx = jnp.einsum('bqhd,bnhd->bhqn', q_row, kc).astype(jnp.float32) * scale
        p = jax.nn.softmax(jnp.concatenate([s_win, s_ctx], axis=-1), axis=-1).astype(q.dtype)
        p_win = p[..., :nw].reshape(bsz, h, GRID_W, win_r, WIN_C)
        o = jnp.einsum('bhqac,baqchd->bqhd', p_win, vw) + jnp.einsum('bhqn,bnhd->bqhd', p[..., nw:], vc)
        return o

    out = lax.map(one_row, (jnp.arange(rows), qg))
    return out.transpose(1, 0, 2, 3, 4).reshape(bsz, n, h * dh)


def window_attn(q, k, v, kc, vc, sink):
    bsz, n, hq, dh = q.shape
    hkv = k.shape[2]
    g = hq // hkv
    nctx = kc.shape[1]
    nblk = n // BLK_Q
    span = BLK_Q + 2 * WINDOW
    scale = dh ** -0.5
    kp = jnp.pad(k, ((0, 0), (WINDOW, WINDOW), (0, 0), (0, 0)))
    vp = jnp.pad(v, ((0, 0), (WINDOW, WINDOW), (0, 0), (0, 0)))
    qb = q.reshape(bsz, nblk, BLK_Q, hkv, g, dh).transpose(1, 0, 2, 3, 4, 5)
    sink_col = jnp.broadcast_to(sink.astype(jnp.float32).reshape(1, hkv, g, 1, 1), (bsz, hkv, g, BLK_Q, 1))

    def one_block(args):
        b, q_blk = args
        start = b * BLK_Q
        kw = lax.dynamic_slice_in_dim(kp, start, span, axis=1)
        vw = lax.dynamic_slice_in_dim(vp, start, span, axis=1)
        qpos = start + jnp.arange(BLK_Q)
        kpos = start - WINDOW + jnp.arange(span)
        valid = (jnp.abs(qpos[:, None] - kpos[None, :]) <= WINDOW) & (kpos >= 0)[None, :] & (kpos < n)[None, :]
        s_win = jnp.einsum('bqkgd,bjkd->bkgqj', q_blk, kw).astype(jnp.float32) * scale
        s_win = jnp.where(valid, s_win, NEG_INF)
        s_ctx = jnp.einsum('bqkgd,bckd->bkgqc', q_blk, kc).astype(jnp.float32) * scale
        p = jax.nn.softmax(jnp.concatenate([s_win, s_ctx, sink_col], axis=-1), axis=-1).astype(q.dtype)
        o = jnp.einsum('bkgqj,bjkd->bqkgd', p[..., :span], vw) + jnp.einsum('bkgqc,bckd->bqkgd', p[..., span:span + nctx], vc)
        return o.reshape(bsz, BLK_Q, hq * dh)

    out = lax.map(one_block, (jnp.arange(nblk), qb))
    return out.transpose(1, 0, 2, 3).reshape(bsz, n, hq * dh)


def merge_branches(y_a, y_b, y_c, gate_logits, w_branch, w_o):
    g_a, g_b, g_c = jnp.split(jax.nn.sigmoid(gate_logits), N_BRANCH, axis=-1)
    o1 = D_CONV
    o2 = D_CONV + D_NA
    m = g_a * (y_a @ w_branch[:o1]) + g_b * (y_b @ w_branch[o1:o2]) + g_c * (y_c @ w_branch[o2:])
    return m @ w_o


def token_mixers(h, hc, w_in, conv_w, rpb, sink, w_branch, w_o, row, col, need_ctx):
    a_h, a_b, a_c, nq, nk, nv, wq, wk, wv, gates = split_in(h @ w_in)
    ca_h, ca_b, ca_c, cnq, cnk, cnv, cwq, cwk, cwv, cgates = split_in(hc @ w_in)
    cnk, cnv = heads(cnk, H_NA), heads(cnv, H_NA)
    cwk, cwv = heads(cwk, H_KV), heads(cwv, H_KV)
    y_a = short_conv(a_h, a_b, a_c, conv_w)
    y_b = neighbourhood_attn(heads(nq, H_NA), heads(nk, H_NA), heads(nv, H_NA), cnk, cnv, rpb)
    y_c = window_attn(axial_rope(heads(wq, H_Q), row, col), axial_rope(heads(wk, H_KV), row, col),
                      heads(wv, H_KV), cwk, cwv, sink)
    y = merge_branches(y_a, y_b, y_c, gates, w_branch, w_o)
    if not need_ctx:
        return y, None
    yc_a = short_conv(ca_h, ca_b, ca_c, conv_w)
    yc_b = ctx_attn(heads(cnq, H_NA), cnk, cnv, None)
    yc_c = ctx_attn(heads(cwq, H_Q), cwk, cwv, sink)
    yc = merge_branches(yc_a, yc_b, yc_c, cgates, w_branch, w_o)
    return y, yc


def hier_moe(xt, w_rg, b_rg, w_re, b_re, w_g, w_u, w_d):
    n, d = xt.shape
    lg = (xt @ w_rg + b_rg).astype(jnp.float32)
    pg = jax.nn.softmax(lg, axis=-1)
    gi = jnp.argmax(lg, axis=-1)
    pg_top = jnp.take_along_axis(pg, gi[:, None], axis=-1)[:, 0]
    le = (xt @ w_re + b_re).astype(jnp.float32).reshape(n, N_GROUPS, EXP_PER_GROUP)
    le_g = jnp.take_along_axis(le, gi[:, None, None], axis=1)[:, 0]
    top_v, top_i = lax.top_k(le_g, TOP_K)
    wts = (pg_top[:, None] * jax.nn.softmax(top_v, axis=-1)).reshape(-1)
    eid = (gi[:, None] * EXP_PER_GROUP + top_i).reshape(-1).astype(jnp.int32)
    tok = jnp.repeat(jnp.arange(n), TOP_K)
    a = n * TOP_K
    order = jnp.argsort(eid)
    e_s, t_s, w_s = eid[order], tok[order], wts[order]
    counts = jnp.bincount(eid, length=N_EXPERTS)
    padded = ((counts + MOE_BLK - 1) // MOE_BLK) * MOE_BLK
    seg_start = jnp.cumsum(counts) - counts
    pad_end = jnp.cumsum(padded)
    pad_start = pad_end - padded
    dest = pad_start[e_s] + jnp.arange(a) - seg_start[e_s]
    nb = (a + N_EXPERTS * (MOE_BLK - 1) + MOE_BLK - 1) // MOE_BLK
    xd = jnp.zeros((nb * MOE_BLK, d), xt.dtype).at[dest].set(xt[t_s])
    blk_start = jnp.arange(nb) * MOE_BLK
    blk_e = jnp.clip(jnp.sum(pad_end[None, :] <= blk_start[:, None], axis=1), 0, N_EXPERTS - 1)

    def expert_block(args):
        xb, e = args
        hid = jax.nn.silu(xb @ w_g[e]) * (xb @ w_u[e])
        return hid @ w_d[e]

    yd = lax.map(expert_block, (xd.reshape(nb, MOE_BLK, d), blk_e)).reshape(nb * MOE_BLK, d)
    return jnp.zeros((n, d), xt.dtype).at[t_s].add(yd[dest] * w_s[:, None].astype(xt.dtype))


def setup_inputs(seed: int = 0) -> dict:
    key = jax.random.key(seed)
    ks = jax.random.split(key, 26)
    f32 = jnp.float32

    def nrm(k, shape, scale):
        return jax.random.normal(k, shape, f32) * scale

    w_branch = jnp.concatenate([
        nrm(ks[12], (DEPTH, D_CONV, D_MODEL), D_CONV ** -0.5),
        nrm(ks[13], (DEPTH, D_NA, D_MODEL), D_NA ** -0.5),
        nrm(ks[14], (DEPTH, D_SW, D_MODEL), D_SW ** -0.5)], axis=1)
    return {
        "x": nrm(ks[0], (BATCH, SEQ, D_MODEL), 1.0),
        "c": nrm(ks[1], (BATCH, D_MODEL), 1.0),
        "ctx": nrm(ks[2], (BATCH, CTX_LEN, D_MODEL), 1.0),
        "c_ctx": nrm(ks[3], (D_MODEL,), 1.0),
        "w_mod": nrm(ks[4], (DEPTH, D_MODEL, 6 * D_MODEL), 0.5 * D_MODEL ** -0.5),
        "b_mod": nrm(ks[5], (DEPTH, 6 * D_MODEL), 0.02),
        "g_attn": 1.0 + nrm(ks[6], (DEPTH, D_MODEL), 0.05),
        "g_ffn": 1.0 + nrm(ks[7], (DEPTH, D_MODEL), 0.05),
        "w_in": nrm(ks[8], (DEPTH, D_MODEL, IN_COLS), D_MODEL ** -0.5),
        "conv_w": nrm(ks[9], (DEPTH, CONV_W, D_CONV), CONV_W ** -0.5),
        "rpb": nrm(ks[10], (DEPTH, H_NA, 2 * WIN_R_MAX - 1, 2 * WIN_C - 1), 0.1),
        "sinks": nrm(ks[11], (DEPTH, H_Q), 0.5),
        "w_branch": w_branch,
        "w_o": nrm(ks[15], (DEPTH, D_MODEL, D_MODEL), D_MODEL ** -0.5),
        "w_rg": nrm(ks[16], (DEPTH, D_MODEL, N_GROUPS), D_MODEL ** -0.5),
        "b_rg": nrm(ks[17], (DEPTH, N_GROUPS), 0.01),
        "w_re": nrm(ks[18], (DEPTH, D_MODEL, N_EXPERTS), D_MODEL ** -0.5),
        "b_re": nrm(ks[19], (DEPTH, N_EXPERTS), 0.01),
        "w_e_gate": nrm(ks[20], (DEPTH, N_EXPERTS, D_MODEL, D_EXPERT), D_MODEL ** -0.5),
        "w_e_up": nrm(ks[21], (DEPTH, N_EXPERTS, D_MODEL, D_EXPERT), D_MODEL ** -0.5),
        "w_e_down": nrm(ks[22], (DEPTH, N_EXPERTS, D_EXPERT, D_MODEL), D_EXPERT ** -0.5),
        "g_final": 1.0 + nrm(ks[23], (D_MODEL,), 0.05),
    }


def reference(x, c, ctx, c_ctx, w_mod, b_mod, g_attn, g_ffn, w_in, conv_w, rpb, sinks,
              w_branch, w_o, w_rg, b_rg, w_re, b_re, w_e_gate, w_e_up, w_e_down, g_final):
    bsz, n, d = x.shape
    t = jnp.arange(n)
    row = (t // GRID_W).astype(jnp.float32)
    col = (t % GRID_W).astype(jnp.float32)
    silu_c = jax.nn.silu(c)
    silu_cc = jax.nn.silu(c_ctx)
    xc = ctx
    for l in range(DEPTH):
        need_ctx = l < DEPTH - 1
        mod = (silu_c @ w_mod[l] + b_mod[l])[:, None, :]
        modc = silu_cc @ w_mod[l] + b_mod[l]
        sh_a, sc_a, gt_a, sh_f, sc_f, gt_f = jnp.split(mod, 6, axis=-1)
        csh_a, csc_a, cgt_a, csh_f, csc_f, cgt_f = jnp.split(modc, 6, axis=-1)
        h = modln(x, g_attn[l], sh_a, sc_a)
        hc = modln(xc, g_attn[l], csh_a, csc_a)
        y, yc = token_mixers(h, hc, w_in[l], conv_w[l], rpb[l], sinks[l], w_branch[l], w_o[l], row, col, need_ctx)
        x = x + gt_a * y
        h2 = modln(x, g_ffn[l], sh_f, sc_f)
        if need_ctx:
            xc = xc + cgt_a * yc
            h2c = modln(xc, g_ffn[l], csh_f, csc_f)
            toks = jnp.concatenate([h2.reshape(-1, d), h2c.reshape(-1, d)], axis=0)
            yt = hier_moe(toks, w_rg[l], b_rg[l], w_re[l], b_re[l], w_e_gate[l], w_e_up[l], w_e_down[l])
            nl = bsz * n
            x = x + gt_f * yt[:nl].reshape(x.shape)
            xc = xc + cgt_f * yt[nl:].reshape(xc.shape)
        else:
            yt = hier_moe(h2.reshape(-1, d), w_rg[l], b_rg[l], w_re[l], b_re[l], w_e_gate[l], w_e_up[l], w_e_down[l])
            x = x + gt_f * yt.reshape(x.shape)
    return rmsnorm(x, g_final)
```

```cpp
#include <hip/hip_runtime.h>
#include <stdint.h>

typedef unsigned short bf16_t;
typedef short bf16x8 __attribute__((ext_vector_type(8)));
typedef float f32x4 __attribute__((ext_vector_type(4)));

#define D_MODEL 1024
#define NB 4
#define SEQ 8192
#define DEPTH 4
#define CTXL 256
#define T_LAT 32768
#define T_CTX 1024
#define T_ALL 33792
#define UA_LD 2560
#define UG_LD 3072
#define IN_COLS 5632
#define MAXBLK 296
#define NTHR 512

struct Params {
    const float *x, *c, *ctx, *c_ctx, *w_mod, *b_mod, *g_attn, *g_ffn, *w_in, *conv_w, *rpb, *sinks, *w_branch, *w_o, *w_rg, *b_rg, *w_re, *b_re, *w_eg, *w_eu, *w_ed, *g_final;
    float* out;
    unsigned* bar; int* cnt; int* blk_e; int* nbu;
    float* modv; float* ropet; float* xs;
    bf16_t *h, *wt_in, *wt_br, *wt_o, *wt_gu, *wt_d, *uA, *uG, *ycat, *mbuf, *xd, *hid, *Y;
    int* eid; int* epos; float* ewt; int* slot;
};

__device__ __forceinline__ bf16_t f2bf(float f) { unsigned u = __float_as_uint(f); u += 0x7FFFu + ((u >> 16) & 1u); return (bf16_t)(u >> 16); }
__device__ __forceinline__ float bf2f(bf16_t b) { return __uint_as_float(((unsigned)b) << 16); }
__device__ __forceinline__ unsigned pack2(float a, float b) { return (unsigned)f2bf(a) | ((unsigned)f2bf(b) << 16); }
__device__ __forceinline__ float wave_sum(float v) { for (int o = 32; o > 0; o >>= 1) v += __shfl_xor(v, o); return v; }
__device__ __forceinline__ float wave_max(float v) { for (int o = 32; o > 0; o >>= 1) v = fmaxf(v, __shfl_xor(v, o)); return v; }
__device__ __forceinline__ int tok_variant(int t) { return t < T_LAT ? (t >> 13) : 4; }

__device__ void phase_mod(const Params& p, float* smem) {
    const int tid = threadIdx.x, lane = tid & 63, wid = tid >> 6;
    float* s_silu = smem;
    float* s_part = smem + 5 * 1024;
    for (int i = tid; i < 5 * 1024; i += NTHR) { const int v = i >> 10, k = i & 1023; const float cv = v < 4 ? p.c[v * 1024 + k] : p.c_ctx[k]; s_silu[i] = cv / (1.0f + expf(-cv)); }
    __syncthreads();
    for (int item = blockIdx.x; item < DEPTH * 96; item += gridDim.x) {
        const int l = item / 96, cb = item % 96, col = cb * 64 + lane;
        const float* w = p.w_mod + (size_t)l * 1024 * 6144 + col;
        float a0 = 0.f, a1 = 0.f, a2 = 0.f, a3 = 0.f, a4 = 0.f;
#pragma unroll 8
        for (int kk = 0; kk < 128; ++kk) { const int k = wid * 128 + kk; const float wv = w[(size_t)k * 6144];
            a0 += s_silu[k] * wv; a1 += s_silu[1024 + k] * wv; a2 += s_silu[2048 + k] * wv; a3 += s_silu[3072 + k] * wv; a4 += s_silu[4096 + k] * wv; }
        s_part[(wid * 5 + 0) * 64 + lane] = a0; s_part[(wid * 5 + 1) * 64 + lane] = a1; s_part[(wid * 5 + 2) * 64 + lane] = a2; s_part[(wid * 5 + 3) * 64 + lane] = a3; s_part[(wid * 5 + 4) * 64 + lane] = a4;
        __syncthreads();
        if (tid < 320) { const int v = tid >> 6, ln = tid & 63; float s = p.b_mod[l * 6144 + cb * 64 + ln];
            for (int w8 = 0; w8 < 8; ++w8) s += s_part[(w8 * 5 + v) * 64 + ln];
            p.modv[(size_t)(l * 5 + v) * 6144 + cb * 64 + ln] = s; }
        __syncthreads();
    }
    for (int i = blockIdx.x * NTHR + tid; i < 128 * 16; i += gridDim.x * NTHR) { const int pos = i >> 4, f = i & 15;
        const float inv = powf(10000.0f, -(float)f / 16.0f); const float ang = (float)pos * inv; p.ropet[i * 2] = cosf(ang); p.ropet[i * 2 + 1] = sinf(ang); }
    for (int i = blockIdx.x * NTHR + tid; i < DEPTH * 32; i += gridDim.x * NTHR) p.cnt[i] = 0;
}

#define GU_IG 32
__device__ void phase_wconv(const Params& p, int l, float* smem) {
    const int tid = threadIdx.x;
    float* tile = smem;
    const int n1 = 16 * 88, n2 = 256, n3 = 256, n4 = 2048, n5 = 2048, n6 = 2048;
    const int total = n1 + n2 + n3 + n4 + n5 + n6;
    for (int it = blockIdx.x; it < total; it += gridDim.x) {
        const float* src; int ldN; bf16_t* dst; int ldK; int kt, nt; int kind = 0, e = 0; int i = it;
        if (i < n1) { src = p.w_in + (size_t)l * 1024 * IN_COLS; ldN = IN_COLS; dst = p.wt_in; ldK = 1024; kt = i / 88; nt = i % 88; }
        else if ((i -= n1) < n2) { src = p.w_branch + (size_t)l * 1024 * 1024; ldN = 1024; dst = p.wt_br; ldK = 1024; kt = i / 16; nt = i % 16; }
        else if ((i -= n2) < n3) { src = p.w_o + (size_t)l * 1024 * 1024; ldN = 1024; dst = p.wt_o; ldK = 1024; kt = i / 16; nt = i % 16; }
        else if ((i -= n3) < n4) { e = i / 64; i %= 64; src = p.w_eg + ((size_t)l * 32 + e) * 1024 * 256; ldN = 256; dst = p.wt_gu; ldK = 1024; kt = i / 4; nt = i % 4; kind = 1; }
        else if ((i -= n4) < n5) { e = i / 64; i %= 64; src = p.w_eu + ((size_t)l * 32 + e) * 1024 * 256; ldN = 256; dst = p.wt_gu; ldK = 1024; kt = i / 4; nt = i % 4; kind = 2; }
        else { i -= n5; e = i / 64; i %= 64; src = p.w_ed + ((size_t)l * 32 + e) * 256 * 1024; ldN = 1024; dst = p.wt_d + (size_t)e * 1024 * 256; ldK = 256; kt = i / 16; nt = i % 16; }
        {   const int r = tid >> 4, c4 = tid & 15;
#pragma unroll
            for (int hh = 0; hh < 2; ++hh) { const int rr = r + hh * 32; const float4 v = *(const float4*)(src + (size_t)(kt * 64 + rr) * ldN + nt * 64 + c4 * 4);
                tile[rr * 65 + c4 * 4 + 0] = v.x; tile[rr * 65 + c4 * 4 + 1] = v.y; tile[rr * 65 + c4 * 4 + 2] = v.z; tile[rr * 65 + c4 * 4 + 3] = v.w; }
        }
        __syncthreads();
        {   const int n = tid >> 3, kc = tid & 7; const int ncol = nt * 64 + n; int drow = ncol;
            if (kind) drow = e * 512 + (ncol / GU_IG) * (2 * GU_IG) + (kind == 2 ? GU_IG : 0) + (ncol % GU_IG);
            uint4 o; o.x = pack2(tile[(kc * 8 + 0) * 65 + n], tile[(kc * 8 + 1) * 65 + n]); o.y = pack2(tile[(kc * 8 + 2) * 65 + n], tile[(kc * 8 + 3) * 65 + n]);
            o.z = pack2(tile[(kc * 8 + 4) * 65 + n], tile[(kc * 8 + 5) * 65 + n]); o.w = pack2(tile[(kc * 8 + 6) * 65 + n], tile[(kc * 8 + 7) * 65 + n]);
            *(uint4*)(dst + (size_t)drow * ldK + kt * 64 + kc * 8) = o;
        }
        __syncthreads();
    }
}

__device__ void phase_norm1(const Params& p, int l) {
    const int tid = threadIdx.x, lane = tid & 63, wid = tid >> 6;
    const int ntok = (l == DEPTH) ? T_LAT : T_ALL;
    for (int t = blockIdx.x * 8 + wid; t < ntok; t += gridDim.x * 8) {
        const int v = tok_variant(t);
        float4 xv[4];
        if (l == 0) {
            const float* src = t < T_LAT ? p.x + (size_t)t * 1024 : p.ctx + (size_t)(t - T_LAT) * 1024;
#pragma unroll
            for (int i = 0; i < 4; ++i) xv[i] = *(const float4*)(src + i * 256 + lane * 4);
        } else {
            const float* src = p.xs + (size_t)t * 1024;
#pragma unroll
            for (int i = 0; i < 4; ++i) xv[i] = *(const float4*)(src + i * 256 + lane * 4);
            const bool had_moe = (l - 1 < DEPTH - 1) || t < T_LAT;
            if (had_moe) {
                const int s0 = p.slot[t * 2], s1 = p.slot[t * 2 + 1]; const float w0 = p.ewt[t * 2], w1 = p.ewt[t * 2 + 1];
                const float* gt = p.modv + (size_t)((l - 1) * 5 + v) * 6144 + 5120;
#pragma unroll
                for (int i = 0; i < 4; ++i) { const int c = i * 256 + lane * 4;
                    const uint2 y0 = *(const uint2*)(p.Y + (size_t)s0 * 1024 + c), y1 = *(const uint2*)(p.Y + (size_t)s1 * 1024 + c);
                    const float4 g = *(const float4*)(gt + c);
                    xv[i].x += g.x * (w0 * bf2f((bf16_t)(y0.x & 0xffff)) + w1 * bf2f((bf16_t)(y1.x & 0xffff)));
                    xv[i].y += g.y * (w0 * bf2f((bf16_t)(y0.x >> 16)) + w1 * bf2f((bf16_t)(y1.x >> 16)));
                    xv[i].z += g.z * (w0 * bf2f((bf16_t)(y0.y & 0xffff)) + w1 * bf2f((bf16_t)(y1.y & 0xffff)));
                    xv[i].w += g.w * (w0 * bf2f((bf16_t)(y0.y >> 16)) + w1 * bf2f((bf16_t)(y1.y >> 16))); }
            }
        }
        float ss = 0.f;
#pragma unroll
        for (int i = 0; i < 4; ++i) ss += xv[i].x * xv[i].x + xv[i].y * xv[i].y + xv[i].z * xv[i].z + xv[i].w * xv[i].w;
        ss = wave_sum(ss);
        const float rstd = rsqrtf(ss * (1.0f / 1024.0f) + 1e-6f);
        if (l == DEPTH) {
#pragma unroll
            for (int i = 0; i < 4; ++i) { const int c = i * 256 + lane * 4; const float4 g = *(const float4*)(p.g_final + c);
                float4 o; o.x = xv[i].x * rstd * g.x; o.y = xv[i].y * rstd * g.y; o.z = xv[i].z * rstd * g.z; o.w = xv[i].w * rstd * g.w;
                *(float4*)(p.out + (size_t)t * 1024 + c) = o; }
        } else {
            const float* mv = p.modv + (size_t)(l * 5 + v) * 6144;
#pragma unroll
            for (int i = 0; i < 4; ++i) { const int c = i * 256 + lane * 4;
                *(float4*)(p.xs + (size_t)t * 1024 + c) = xv[i];
                const float4 g = *(const float4*)(p.g_attn + l * 1024 + c), sh = *(const float4*)(mv + c), sc = *(const float4*)(mv + 1024 + c);
                uint2 o; o.x = pack2(xv[i].x * rstd * g.x * (1.f + sc.x) + sh.x, xv[i].y * rstd * g.y * (1.f + sc.y) + sh.y);
                o.y = pack2(xv[i].z * rstd * g.z * (1.f + sc.z) + sh.z, xv[i].w * rstd * g.w * (1.f + sc.w) + sh.w);
                *(uint2*)(p.h + (size_t)t * 1024 + c) = o; }
        }
    }
}

#define SG_STRIDE 144
#define SG_BOFF (128 * SG_STRIDE)
struct RowsLinear { const bf16_t* base; size_t ld; __device__ __forceinline__ const bf16_t* operator()(int r) const { return base + (size_t)r * ld; } };
template <class ARow>
__device__ __forceinline__ void gemm_core(unsigned char* smem, const ARow& arow, const bf16_t* Bt, size_t ldb, int k0, int k1, f32x4 (&acc)[2][4]) {
    const int tid = threadIdx.x, lane = tid & 63, wid = tid >> 6, wm = wid >> 1, wn = wid & 1;
    const int row0 = tid >> 3, kc = tid & 7;
    const bf16_t* pa0 = arow(row0) + kc * 8; const bf16_t* pa1 = arow(row0 + 64) + kc * 8;
    const bf16_t* pb0 = Bt + (size_t)row0 * ldb + kc * 8; const bf16_t* pb1 = Bt + (size_t)(row0 + 64) * ldb + kc * 8;
    const int soff0 = row0 * SG_STRIDE + kc * 16, soff1 = soff0 + 64 * SG_STRIDE;
    uint4 ra0 = *(const uint4*)(pa0 + k0), ra1 = *(const uint4*)(pa1 + k0), rb0 = *(const uint4*)(pb0 + k0), rb1 = *(const uint4*)(pb1 + k0);
    const int fa = (wm * 32 + (lane & 15)) * SG_STRIDE + (lane >> 4) * 16, fb = SG_BOFF + (wn * 64 + (lane & 15)) * SG_STRIDE + (lane >> 4) * 16;
    for (int k = k0; k < k1; k += 64) {
        __syncthreads();
        *(uint4*)(smem + soff0) = ra0; *(uint4*)(smem + soff1) = ra1; *(uint4*)(smem + SG_BOFF + soff0) = rb0; *(uint4*)(smem + SG_BOFF + soff1) = rb1;
        __syncthreads();
        if (k + 64 < k1) { ra0 = *(const uint4*)(pa0 + k + 64); ra1 = *(const uint4*)(pa1 + k + 64); rb0 = *(const uint4*)(pb0 + k + 64); rb1 = *(const uint4*)(pb1 + k + 64); }
#pragma unroll
        for (int ks = 0; ks < 2; ++ks) {
            const bf16x8 af0 = *(const bf16x8*)(smem + fa + ks * 64), af1 = *(const bf16x8*)(smem + fa + 16 * SG_STRIDE + ks * 64);
            const bf16x8 b0 = *(const bf16x8*)(smem + fb + ks * 64), b1 = *(const bf16x8*)(smem + fb + 16 * SG_STRIDE + ks * 64);
            const bf16x8 b2 = *(const bf16x8*)(smem + fb + 32 * SG_STRIDE + ks * 64), b3 = *(const bf16x8*)(smem + fb + 48 * SG_STRIDE + ks * 64);
            acc[0][0] = __builtin_amdgcn_mfma_f32_16x16x32_bf16(b0, af0, acc[0][0], 0, 0, 0); acc[0][1] = __builtin_amdgcn_mfma_f32_16x16x32_bf16(b1, af0, acc[0][1], 0, 0, 0);
            acc[0][2] = __builtin_amdgcn_mfma_f32_16x16x32_bf16(b2, af0, acc[0][2], 0, 0, 0); acc[0][3] = __builtin_amdgcn_mfma_f32_16x16x32_bf16(b3, af0, acc[0][3], 0, 0, 0);
            acc[1][0] = __builtin_amdgcn_mfma_f32_16x16x32_bf16(b0, af1, acc[1][0], 0, 0, 0); acc[1][1] = __builtin_amdgcn_mfma_f32_16x16x32_bf16(b1, af1, acc[1][1], 0, 0, 0);
            acc[1][2] = __builtin_amdgcn_mfma_f32_16x16x32_bf16(b2, af1, acc[1][2], 0, 0, 0); acc[1][3] = __builtin_amdgcn_mfma_f32_16x16x32_bf16(b3, af1, acc[1][3], 0, 0, 0);
        }
    }
}
__device__ __forceinline__ void zero_acc(f32x4 (&acc)[2][4]) {
#pragma unroll
    for (int a = 0; a < 2; ++a)
#pragma unroll
        for (int b = 0; b < 4; ++b) acc[a][b] = (f32x4){0.f, 0.f, 0.f, 0.f};
}
__device__ __forceinline__ void store4bf(bf16_t* dst, f32x4 v) { uint2 o; o.x = pack2(v[0], v[1]); o.y = pack2(v[2], v[3]); *(uint2*)dst = o; }

__device__ void phase_gemm_in(const Params& p, int l, unsigned char* smem) {
    const int tid = threadIdx.x, lane = tid & 63, wid = tid >> 6, wm = wid >> 1, wn = wid & 1, q4 = (lane >> 4) * 4;
    const int nM = T_ALL / 128, nN = IN_COLS / 128;
    for (int tile = blockIdx.x; tile < nM * nN; tile += gridDim.x) {
        const int tm = tile / nN, tn = tile % nN, m0 = tm * 128, n0 = tn * 128;
        f32x4 acc[2][4]; zero_acc(acc);
        RowsLinear ar{p.h + (size_t)m0 * 1024, 1024};
        gemm_core(smem, ar, p.wt_in + (size_t)n0 * 1024, 1024, 0, 1024, acc);
        const int cb = n0 + wn * 64;
#pragma unroll
        for (int mi = 0; mi < 2; ++mi) {
            const int t = m0 + wm * 32 + mi * 16 + (lane & 15);
            f32x4 v0 = acc[mi][0], v1 = acc[mi][1], v2 = acc[mi][2], v3 = acc[mi][3];
            if (cb >= 2560) {
                bf16_t* dst = p.uG + (size_t)t * UG_LD + (cb - 2560) + q4;
#pragma unroll
                for (int e = 0; e < 4; ++e) { v0[e] = 1.f / (1.f + __expf(-v0[e])); v1[e] = 1.f / (1.f + __expf(-v1[e])); v2[e] = 1.f / (1.f + __expf(-v2[e])); v3[e] = 1.f / (1.f + __expf(-v3[e])); }
                store4bf(dst, v0); store4bf(dst + 16, v1); store4bf(dst + 32, v2); store4bf(dst + 48, v3);
            } else {
                const bool isq = (cb >= 768 && cb < 1152) || (cb >= 1920 && cb < 2304);
                const bool rope = (cb >= 1920 && cb < 2432) && (t < T_LAT);
                if (rope) { const int pos = t & 8191, r = pos >> 6, cc = pos & 63;
#pragma unroll
                    for (int e = 0; e < 4; ++e) {
                        const float2 csr = *(const float2*)(p.ropet + (r * 16 + q4 + e) * 2), csc = *(const float2*)(p.ropet + (cc * 16 + q4 + e) * 2);
                        const float a1 = v0[e], a2 = v1[e]; v0[e] = a1 * csr.x - a2 * csr.y; v1[e] = a1 * csr.y + a2 * csr.x;
                        const float b1 = v2[e], b2 = v3[e]; v2[e] = b1 * csc.x - b2 * csc.y; v3[e] = b1 * csc.y + b2 * csc.x; } }
                if (isq) { v0 = v0 * 0.125f; v1 = v1 * 0.125f; v2 = v2 * 0.125f; v3 = v3 * 0.125f; }
                bf16_t* dst = p.uA + (size_t)t * UA_LD + cb + q4;
                store4bf(dst, v0); store4bf(dst + 16, v1); store4bf(dst + 32, v2); store4bf(dst + 48, v3);
            }
        }
    }
}

struct KmNA { int b, r, c, rs, cs; const float* rpb;
    __device__ __forceinline__ int tok(int kk) const { if (kk < 128) return b * SEQ + (rs + (kk >> 4)) * 64 + cs + (kk & 15); return T_LAT + b * CTXL + (kk - 128); }
    __device__ __forceinline__ float bias(int kk) const { if (kk < 128) return rpb[(rs + (kk >> 4) - r + 7) * 31 + (cs + (kk & 15) - c + 15)]; return 0.f; } };
struct KmSWA { int b, i;
    __device__ __forceinline__ int tok(int kk) const { if (kk < 257) { const int j = i - 128 + kk; return (j >= 0 && j < SEQ) ? b * SEQ + j : -1; } if (kk < 513) return T_LAT + b * CTXL + (kk - 257); return -1; }
    __device__ __forceinline__ float bias(int) const { return 0.f; } };
struct KmCtx { int b;
    __device__ __forceinline__ int tok(int kk) const { return T_LAT + b * CTXL + kk; }
    __device__ __forceinline__ float bias(int) const { return 0.f; } };

template <int NI, class KM>
__device__ __forceinline__ void attn_item(const bf16_t* uA, int tq, int qcol, int kcol, int vcol, const KM& km, bool has_sink, float sink, bf16_t* outp, int lane) {
    float q[64];
    {   const uint4* qp = (const uint4*)(uA + (size_t)tq * UA_LD + qcol);
#pragma unroll
        for (int c = 0; c < 8; ++c) { const uint4 v = qp[c];
            q[c * 8 + 0] = bf2f((bf16_t)(v.x & 0xffff)); q[c * 8 + 1] = bf2f((bf16_t)(v.x >> 16)); q[c * 8 + 2] = bf2f((bf16_t)(v.y & 0xffff)); q[c * 8 + 3] = bf2f((bf16_t)(v.y >> 16));
            q[c * 8 + 4] = bf2f((bf16_t)(v.z & 0xffff)); q[c * 8 + 5] = bf2f((bf16_t)(v.z >> 16)); q[c * 8 + 6] = bf2f((bf16_t)(v.w & 0xffff)); q[c * 8 + 7] = bf2f((bf16_t)(v.w >> 16)); } }
    float s[NI]; float mx = -3.0e38f;
#pragma unroll
    for (int i = 0; i < NI; ++i) { const int kk = i * 64 + lane; const int tk = km.tok(kk);
        float d = -3.0e38f;
        if (tk >= 0) { const uint4* kp = (const uint4*)(uA + (size_t)tk * UA_LD + kcol); d = 0.f;
#pragma unroll
            for (int c = 0; c < 8; ++c) { const uint4 v = kp[c];
                d += q[c * 8 + 0] * bf2f((bf16_t)(v.x & 0xffff)) + q[c * 8 + 1] * bf2f((bf16_t)(v.x >> 16)) + q[c * 8 + 2] * bf2f((bf16_t)(v.y & 0xffff)) + q[c * 8 + 3] * bf2f((bf16_t)(v.y >> 16))
                   + q[c * 8 + 4] * bf2f((bf16_t)(v.z & 0xffff)) + q[c * 8 + 5] * bf2f((bf16_t)(v.z >> 16)) + q[c * 8 + 6] * bf2f((bf16_t)(v.w & 0xffff)) + q[c * 8 + 7] * bf2f((bf16_t)(v.w >> 16)); }
            d += km.bias(kk); }
        s[i] = d; mx = fmaxf(mx, d); }
    mx = wave_max(mx); if (has_sink) mx = fmaxf(mx, sink);
    float sum = 0.f;
#pragma unroll
    for (int i = 0; i < NI; ++i) { const float pv = s[i] > -1.0e38f ? __expf(s[i] - mx) : 0.f; s[i] = pv; sum += pv; }
    sum = wave_sum(sum); if (has_sink) sum += __expf(sink - mx);
    const float inv = 1.0f / sum;
    float o = 0.f;
#pragma unroll
    for (int i = 0; i < NI; ++i) {
        for (int sl = 0; sl < 64; ++sl) { const int tk = km.tok(i * 64 + sl); const float pv = __shfl(s[i], sl);
            if (tk >= 0) o += pv * bf2f(uA[(size_t)tk * UA_LD + vcol + lane]); } }
    outp[lane] = f2bf(o * inv);
}

__device__ void phase_mix(const Params& p, int l) {
    const int tid = threadIdx.x, lane = tid & 63, wid = tid >> 6;
    const bool need_ctx = l < DEPTH - 1;
    {   const int ntok = need_ctx ? T_ALL : T_LAT; const float* cw = p.conv_w + l * 3 * 256;
        for (int idx = blockIdx.x * NTHR + tid; idx < ntok * 256; idx += gridDim.x * NTHR) { const int t = idx >> 8, c = idx & 255;
            int pos, len; if (t < T_LAT) { pos = t & 8191; len = SEQ; } else { pos = (t - T_LAT) & 255; len = CTXL; }
            const bf16_t* u = p.uA + (size_t)t * UA_LD + c;
            const float z1 = bf2f(u[512]) * bf2f(u[0]);
            const float z0 = pos > 0 ? bf2f(u[512 - UA_LD]) * bf2f(u[-UA_LD]) : 0.f;
            const float z2 = pos + 1 < len ? bf2f(u[512 + UA_LD]) * bf2f(u[UA_LD]) : 0.f;
            const float y = bf2f(u[256]) * (z0 * cw[c] + z1 * cw[256 + c] + z2 * cw[512 + c]);
            p.ycat[(size_t)t * 1024 + c] = f2bf(y); } }
    const int n_lat = T_LAT * 12, n_all = n_lat + (need_ctx ? T_CTX * 12 : 0);
    for (int it = blockIdx.x * 8 + wid; it < n_all; it += gridDim.x * 8) {
        if (it < n_lat) { const int t = it / 12, hh = it % 12; const int b = t >> 13, pos = t & 8191;
            if (hh < 6) { KmNA km; km.b = b; km.r = pos >> 6; km.c = pos & 63; km.rs = min(max(km.r - 4, 0), 120); km.cs = min(max(km.c - 8, 0), 48); km.rpb = p.rpb + ((size_t)l * 6 + hh) * 15 * 31;
                attn_item<6>(p.uA, t, 768 + hh * 64, 1152 + hh * 64, 1536 + hh * 64, km, false, 0.f, p.ycat + (size_t)t * 1024 + 256 + hh * 64, lane); }
            else { const int hq = hh - 6, kh = hq / 3; KmSWA km; km.b = b; km.i = pos;
                attn_item<9>(p.uA, t, 1920 + hq * 64, 2304 + kh * 64, 2432 + kh * 64, km, true, p.sinks[l * 6 + hq], p.ycat + (size_t)t * 1024 + 640 + hq * 64, lane); }
        } else { const int it2 = it - n_lat; const int tc = it2 / 12, hh = it2 % 12; const int t = T_LAT + tc; KmCtx km; km.b = tc >> 8;
            if (hh < 6) attn_item<4>(p.uA, t, 768 + hh * 64, 1152 + hh * 64, 1536 + hh * 64, km, false, 0.f, p.ycat + (size_t)t * 1024 + 256 + hh * 64, lane);
            else { const int hq = hh - 6, kh = hq / 3; attn_item<4>(p.uA, t, 1920 + hq * 64, 2304 + kh * 64, 2432 + kh * 64, km, true, p.sinks[l * 6 + hq], p.ycat + (size_t)t * 1024 + 640 + hq * 64, lane); }
        }
    }
}

__device__ void phase_gemm_merge(const Params& p, int l, unsigned char* smem) {
    const int tid = threadIdx.x, lane = tid & 63, wid = tid >> 6, wm = wid >> 1, wn = wid & 1, q4 = (lane >> 4) * 4;
    const int ntok = (l < DEPTH - 1) ? T_ALL : T_LAT; const int nM = ntok / 128, nN = 8;
    for (int tile = blockIdx.x; tile < nM * nN; tile += gridDim.x) {
        const int tm = tile / nN, tn = tile % nN, m0 = tm * 128, n0 = tn * 128;
        f32x4 macc[2][4]; zero_acc(macc);
        RowsLinear ar{p.ycat + (size_t)m0 * 1024, 1024};
#pragma unroll
        for (int seg = 0; seg < 3; ++seg) {
            const int k0 = seg == 0 ? 0 : (seg == 1 ? 256 : 640), k1 = seg == 0 ? 256 : (seg == 1 ? 640 : 1024);
            f32x4 acc[2][4]; zero_acc(acc);
            gemm_core(smem, ar, p.wt_br + (size_t)n0 * 1024, 1024, k0, k1, acc);
#pragma unroll
            for (int mi = 0; mi < 2; ++mi) { const int t = m0 + wm * 32 + mi * 16 + (lane & 15);
#pragma unroll
                for (int nj = 0; nj < 4; ++nj) { const uint2 g = *(const uint2*)(p.uG + (size_t)t * UG_LD + seg * 1024 + n0 + wn * 64 + nj * 16 + q4);
                    macc[mi][nj][0] += bf2f((bf16_t)(g.x & 0xffff)) * acc[mi][nj][0]; macc[mi][nj][1] += bf2f((bf16_t)(g.x >> 16)) * acc[mi][nj][1];
                    macc[mi][nj][2] += bf2f((bf16_t)(g.y & 0xffff)) * acc[mi][nj][2]; macc[mi][nj][3] += bf2f((bf16_t)(g.y >> 16)) * acc[mi][nj][3]; } }
        }
#pragma unroll
        for (int mi = 0; mi < 2; ++mi) { const int t = m0 + wm * 32 + mi * 16 + (lane & 15);
#pragma unroll
            for (int nj = 0; nj < 4; ++nj) store4bf(p.mbuf + (size_t)t * 1024 + n0 + wn * 64 + nj * 16 + q4, macc[mi][nj]); }
    }
}

__device__ void phase_gemm_o(const Params& p, int l, unsigned char* smem) {
    const int tid = threadIdx.x, lane = tid & 63, wid = tid >> 6, wm = wid >> 1, wn = wid & 1, q4 = (lane >> 4) * 4;
    const int ntok = (l < DEPTH - 1) ? T_ALL : T_LAT; const int nM = ntok / 128, nN = 8;
    for (int tile = blockIdx.x; tile < nM * nN; tile += gridDim.x) {
        const int tm = tile / nN, tn = tile % nN, m0 = tm * 128, n0 = tn * 128;
        f32x4 acc[2][4]; zero_acc(acc);
        RowsLinear ar{p.mbuf + (size_t)m0 * 1024, 1024};
        gemm_core(smem, ar, p.wt_o + (size_t)n0 * 1024, 1024, 0, 1024, acc);
#pragma unroll
        for (int mi = 0; mi < 2; ++mi) { const int t = m0 + wm * 32 + mi * 16 + (lane & 15); const float* gt = p.modv + (size_t)(l * 5 + tok_variant(t)) * 6144 + 2048;
#pragma unroll
            for (int nj = 0; nj < 4; ++nj) { const int c = n0 + wn * 64 + nj * 16 + q4; float4* xp = (float4*)(p.xs + (size_t)t * 1024 + c); float4 xv = *xp; const float4 g = *(const float4*)(gt + c);
                xv.x += g.x * acc[mi][nj][0]; xv.y += g.y * acc[mi][nj][1]; xv.z += g.z * acc[mi][nj][2]; xv.w += g.w * acc[mi][nj][3]; *xp = xv; } }
    }
}

__device__ void phase_router(const Params& p, int l, float* smem) {
    const int tid = threadIdx.x, lane = tid & 63, wid = tid >> 6;
    float* sh2 = smem;
    float* slg = smem + 16 * 1024;
    const int ntok = (l < DEPTH - 1) ? T_ALL : T_LAT;
    const float* wre = p.w_re + (size_t)l * 1024 * 32; const float* wrg = p.w_rg + (size_t)l * 1024 * 4;
    for (int tb = blockIdx.x; tb < ntok / 16; tb += gridDim.x) {
#pragma unroll
        for (int j = 0; j < 2; ++j) { const int tt = wid * 2 + j, t = tb * 16 + tt; const int v = tok_variant(t);
            float4 xv[4]; float ss = 0.f;
#pragma unroll
            for (int i = 0; i < 4; ++i) { xv[i] = *(const float4*)(p.xs + (size_t)t * 1024 + i * 256 + lane * 4); ss += xv[i].x * xv[i].x + xv[i].y * xv[i].y + xv[i].z * xv[i].z + xv[i].w * xv[i].w; }
            ss = wave_sum(ss); const float rstd = rsqrtf(ss * (1.0f / 1024.0f) + 1e-6f);
            const float* mv = p.modv + (size_t)(l * 5 + v) * 6144 + 3072;
#pragma unroll
            for (int i = 0; i < 4; ++i) { const int c = i * 256 + lane * 4;
                const float4 g = *(const float4*)(p.g_ffn + l * 1024 + c), sh = *(const float4*)(mv + c), sc = *(const float4*)(mv + 1024 + c);
                float4 o; o.x = xv[i].x * rstd * g.x * (1.f + sc.x) + sh.x; o.y = xv[i].y * rstd * g.y * (1.f + sc.y) + sh.y; o.z = xv[i].z * rstd * g.z * (1.f + sc.z) + sh.z; o.w = xv[i].w * rstd * g.w * (1.f + sc.w) + sh.w;
                *(float4*)(sh2 + tt * 1024 + c) = o; uint2 ob; ob.x = pack2(o.x, o.y); ob.y = pack2(o.z, o.w); *(uint2*)(p.h + (size_t)t * 1024 + c) = ob; } }
        __syncthreads();
        {   const int tt = tid >> 5, j = tid & 31; float a = 0.f; const float* hp = sh2 + tt * 1024;
#pragma unroll 8
            for (int k = 0; k < 1024; ++k) a += hp[k] * wre[k * 32 + j];
            slg[tt * 36 + 4 + j] = a + p.b_re[l * 32 + j];
            if (tid < 64) { const int t2 = tid >> 2, j2 = tid & 3; float a2 = 0.f; const float* hp2 = sh2 + t2 * 1024;
#pragma unroll 8
                for (int k = 0; k < 1024; ++k) a2 += hp2[k] * wrg[k * 4 + j2];
                slg[t2 * 36 + j2] = a2 + p.b_rg[l * 4 + j2]; } }
        __syncthreads();
        if (tid < 16) { const int t = tb * 16 + tid; const float* lg = slg + tid * 36;
            int gi = 0; float gm = lg[0];
            for (int j = 1; j < 4; ++j) if (lg[j] > gm) { gm = lg[j]; gi = j; }
            float den = 0.f; for (int j = 0; j < 4; ++j) den += expf(lg[j] - gm);
            const float pg = 1.0f / den;
            const float* le = lg + 4 + gi * 8;
            int i1 = 0; float v1 = le[0]; for (int j = 1; j < 8; ++j) if (le[j] > v1) { v1 = le[j]; i1 = j; }
            int i2 = -1; float v2 = -3.0e38f; for (int j = 0; j < 8; ++j) if (j != i1 && le[j] > v2) { v2 = le[j]; i2 = j; }
            const float e2 = expf(v2 - v1); const float wa = 1.0f / (1.0f + e2), wb = e2 / (1.0f + e2);
            const int ea = gi * 8 + i1, eb = gi * 8 + i2;
            p.eid[t * 2] = ea; p.eid[t * 2 + 1] = eb; p.ewt[t * 2] = pg * wa; p.ewt[t * 2 + 1] = pg * wb;
            p.epos[t * 2] = atomicAdd(p.cnt + l * 32 + ea, 1); p.epos[t * 2 + 1] = atomicAdd(p.cnt + l * 32 + eb, 1); }
        __syncthreads();
    }
}

__device__ void phase_dispatch(const Params& p, int l, int* smem) {
    const int tid = threadIdx.x, lane = tid & 63, wid = tid >> 6;
    int* pstart = smem;
    if (tid == 0) { int acc = 0; for (int e = 0; e < 32; ++e) { pstart[e] = acc; acc += ((p.cnt[l * 32 + e] + 255) >> 8) << 8; } pstart[32] = acc; }
    __syncthreads();
    if (blockIdx.x == 0) { const int nb = pstart[32] >> 8;
        for (int rb = tid; rb < nb; rb += NTHR) { int e = 0; while (e < 31 && pstart[e + 1] <= rb * 256) ++e; p.blk_e[rb] = e; }
        if (tid == 0) p.nbu[0] = nb; }
    const int ntok = (l < DEPTH - 1) ? T_ALL : T_LAT;
    for (int a = blockIdx.x * 8 + wid; a < ntok * 2; a += gridDim.x * 8) {
        const int t = a >> 1; const int sl = pstart[p.eid[a]] + p.epos[a];
        if (lane == 0) p.slot[a] = sl;
        const uint4* src = (const uint4*)(p.h + (size_t)t * 1024); uint4* dst = (uint4*)(p.xd + (size_t)sl * 1024);
        dst[lane] = src[lane]; dst[lane + 64] = src[lane + 64];
    }
}

__device__ void phase_gemm_e1(const Params& p, unsigned char* smem) {
    const int tid = threadIdx.x, lane = tid & 63, wid = tid >> 6, wm = wid >> 1, wn = wid & 1, q4 = (lane >> 4) * 4;
    const int nb = p.nbu[0]; const int ntiles = nb * 2 * 4;
    for (int tile = blockIdx.x; tile < ntiles; tile += gridDim.x) {
        const int rb = tile >> 2, tn = tile & 3, m0 = rb * 128, e = p.blk_e[rb >> 1];
        f32x4 acc[2][4]; zero_acc(acc);
        RowsLinear ar{p.xd + (size_t)m0 * 1024, 1024};
        gemm_core(smem, ar, p.wt_gu + ((size_t)e * 512 + tn * 128) * 1024, 1024, 0, 1024, acc);
        const int pg = tn * 2 + wn;
#pragma unroll
        for (int mi = 0; mi < 2; ++mi) { const int sl = m0 + wm * 32 + mi * 16 + (lane & 15);
#pragma unroll
            for (int nj = 0; nj < 2; ++nj) { f32x4 g = acc[mi][nj], u = acc[mi][nj + 2], o;
#pragma unroll
                for (int e4 = 0; e4 < 4; ++e4) o[e4] = g[e4] / (1.f + __expf(-g[e4])) * u[e4];
                store4bf(p.hid + (size_t)sl * 256 + pg * 32 + nj * 16 + q4, o); } }
    }
}
__device__ void phase_gemm_e2(const Params& p, unsigned char* smem) {
    const int tid = threadIdx.x, lane = tid & 63, wid = tid >> 6, wm = wid >> 1, wn = wid & 1, q4 = (lane >> 4) * 4;
    const int nb = p.nbu[0]; const int ntiles = nb * 2 * 8;
    for (int tile = blockIdx.x; tile < ntiles; tile += gridDim.x) {
        const int rb = tile >> 3, tn = tile & 7, m0 = rb * 128, n0 = tn * 128, e = p.blk_e[rb >> 1];
        f32x4 acc[2][4]; zero_acc(acc);
        RowsLinear ar{p.hid + (size_t)m0 * 256, 256};
        gemm_core(smem, ar, p.wt_d + ((size_t)e * 1024 + n0) * 256, 256, 0, 256, acc);
#pragma unroll
        for (int mi = 0; mi < 2; ++mi) { const int sl = m0 + wm * 32 + mi * 16 + (lane & 15);
#pragma unroll
            for (int nj = 0; nj < 4; ++nj) store4bf(p.Y + (size_t)sl * 1024 + n0 + wn * 64 + nj * 16 + q4, acc[mi][nj]); }
    }
}

#define SMEM_BYTES 73728
__global__ void __launch_bounds__(NTHR, 2) k_prep(Params p) { extern __shared__ __attribute__((aligned(16))) unsigned char smem[]; phase_mod(p, (float*)smem); }
__global__ void __launch_bounds__(NTHR, 2) k_norm1(Params p, int l) { extern __shared__ __attribute__((aligned(16))) unsigned char smem[]; phase_norm1(p, l); if (l < DEPTH) phase_wconv(p, l, (float*)smem); }
__global__ void __launch_bounds__(NTHR, 2) k_gemm_in(Params p, int l) { extern __shared__ __attribute__((aligned(16))) unsigned char smem[]; phase_gemm_in(p, l, smem); }
__global__ void __launch_bounds__(NTHR, 2) k_mix(Params p, int l) { phase_mix(p, l); }
__global__ void __launch_bounds__(NTHR, 2) k_merge(Params p, int l) { extern __shared__ __attribute__((aligned(16))) unsigned char smem[]; phase_gemm_merge(p, l, smem); }
__global__ void __launch_bounds__(NTHR, 2) k_o(Params p, int l) { extern __shared__ __attribute__((aligned(16))) unsigned char smem[]; phase_gemm_o(p, l, smem); }
__global__ void __launch_bounds__(NTHR, 2) k_router(Params p, int l) { extern __shared__ __attribute__((aligned(16))) unsigned char smem[]; phase_router(p, l, (float*)smem); }
__global__ void __launch_bounds__(NTHR, 2) k_dispatch(Params p, int l) { extern __shared__ __attribute__((aligned(16))) unsigned char smem[]; phase_dispatch(p, l, (int*)smem); }
__global__ void __launch_bounds__(NTHR, 2) k_e1(Params p) { extern __shared__ __attribute__((aligned(16))) unsigned char smem[]; phase_gemm_e1(p, smem); }
__global__ void __launch_bounds__(NTHR, 2) k_e2(Params p) { extern __shared__ __attribute__((aligned(16))) unsigned char smem[]; phase_gemm_e2(p, smem); }

extern "C" void kernel_launch(void* const* d_in, const int* in_sizes, int n_in, void* d_out, int out_size, void* d_ws, size_t ws_size, hipStream_t stream) {
    Params p{};
    p.x = (const float*)d_in[0]; p.c = (const float*)d_in[1]; p.ctx = (const float*)d_in[2]; p.c_ctx = (const float*)d_in[3]; p.w_mod = (const float*)d_in[4]; p.b_mod = (const float*)d_in[5];
    p.g_attn = (const float*)d_in[6]; p.g_ffn = (const float*)d_in[7]; p.w_in = (const float*)d_in[8]; p.conv_w = (const float*)d_in[9]; p.rpb = (const float*)d_in[10]; p.sinks = (const float*)d_in[11];
    p.w_branch = (const float*)d_in[12]; p.w_o = (const float*)d_in[13]; p.w_rg = (const float*)d_in[14]; p.b_rg = (const float*)d_in[15]; p.w_re = (const float*)d_in[16]; p.b_re = (const float*)d_in[17];
    p.w_eg = (const float*)d_in[18]; p.w_eu = (const float*)d_in[19]; p.w_ed = (const float*)d_in[20]; p.g_final = (const float*)d_in[21];
    p.out = (float*)d_out;
    unsigned char* w = (unsigned char*)d_ws; size_t off = 0;
    auto take = [&](size_t bytes) { unsigned char* r = w + off; off += (bytes + 255) & ~(size_t)255; return r; };
    p.bar = (unsigned*)take(16384); p.cnt = (int*)take(DEPTH * 32 * 4); p.blk_e = (int*)take(MAXBLK * 4); p.nbu = (int*)take(256);
    p.modv = (float*)take((size_t)DEPTH * 5 * 6144 * 4); p.ropet = (float*)take(128 * 16 * 2 * 4);
    p.eid = (int*)take((size_t)T_ALL * 2 * 4); p.epos = (int*)take((size_t)T_ALL * 2 * 4); p.ewt = (float*)take((size_t)T_ALL * 2 * 4); p.slot = (int*)take((size_t)T_ALL * 2 * 4);
    p.xs = (float*)take((size_t)T_ALL * 1024 * 4);
    p.h = (bf16_t*)take((size_t)T_ALL * 1024 * 2);
    p.wt_in = (bf16_t*)take((size_t)IN_COLS * 1024 * 2); p.wt_br = (bf16_t*)take((size_t)1024 * 1024 * 2); p.wt_o = (bf16_t*)take((size_t)1024 * 1024 * 2);
    p.wt_gu = (bf16_t*)take((size_t)32 * 512 * 1024 * 2); p.wt_d = (bf16_t*)take((size_t)32 * 1024 * 256 * 2);
    p.uA = (bf16_t*)take((size_t)T_ALL * UA_LD * 2); p.uG = (bf16_t*)take((size_t)T_ALL * UG_LD * 2); p.ycat = (bf16_t*)take((size_t)T_ALL * 1024 * 2);
    p.mbuf = p.uA; p.xd = p.uA; p.hid = p.ycat; p.Y = p.uG;
    if (off > ws_size) return;
    const int G = 1024; const dim3 blk(NTHR);
    static bool attr_done = false;
    if (!attr_done) { attr_done = true;
        hipFuncSetAttribute((const void*)k_prep, hipFuncAttributeMaxDynamicSharedMemorySize, SMEM_BYTES); hipFuncSetAttribute((const void*)k_norm1, hipFuncAttributeMaxDynamicSharedMemorySize, SMEM_BYTES);
        hipFuncSetAttribute((const void*)k_gemm_in, hipFuncAttributeMaxDynamicSharedMemorySize, SMEM_BYTES); hipFuncSetAttribute((const void*)k_merge, hipFuncAttributeMaxDynamicSharedMemorySize, SMEM_BYTES);
        hipFuncSetAttribute((const void*)k_o, hipFuncAttributeMaxDynamicSharedMemorySize, SMEM_BYTES); hipFuncSetAttribute((const void*)k_router, hipFuncAttributeMaxDynamicSharedMemorySize, SMEM_BYTES);
        hipFuncSetAttribute((const void*)k_dispatch, hipFuncAttributeMaxDynamicSharedMemorySize, SMEM_BYTES); hipFuncSetAttribute((const void*)k_e1, hipFuncAttributeMaxDynamicSharedMemorySize, SMEM_BYTES);
        hipFuncSetAttribute((const void*)k_e2, hipFuncAttributeMaxDynamicSharedMemorySize, SMEM_BYTES); }
    hipLaunchKernelGGL(k_prep, dim3(384), blk, SMEM_BYTES, stream, p);
    for (int l = 0; l < DEPTH; ++l) {
        hipLaunchKernelGGL(k_norm1, dim3(G), blk, SMEM_BYTES, stream, p, l);
        hipLaunchKernelGGL(k_gemm_in, dim3(G), blk, SMEM_BYTES, stream, p, l);
        hipLaunchKernelGGL(k_mix, dim3(2048), blk, 0, stream, p, l);
        hipLaunchKernelGGL(k_merge, dim3(G), blk, SMEM_BYTES, stream, p, l);
        hipLaunchKernelGGL(k_o, dim3(G), blk, SMEM_BYTES, stream, p, l);
        hipLaunchKernelGGL(k_router, dim3(G), blk, SMEM_BYTES, stream, p, l);
        hipLaunchKernelGGL(k_dispatch, dim3(G), blk, SMEM_BYTES, stream, p, l);
        hipLaunchKernelGGL(k_e1, dim3(G), blk, SMEM_BYTES, stream, p);
        hipLaunchKernelGGL(k_e2, dim3(G), blk, SMEM_BYTES, stream, p);
    }
    hipLaunchKernelGGL(k_norm1, dim3(G), blk, SMEM_BYTES, stream, p, DEPTH);
}
```

```cpp
#include <hip/hip_runtime.h>
#include <stdint.h>

typedef unsigned short bf16_t;
typedef short bf16x8 __attribute__((ext_vector_type(8)));
typedef float f32x4 __attribute__((ext_vector_type(4)));

#define D_MODEL 1024
#define NB 4
#define SEQ 8192
#define DEPTH 4
#define CTXL 256
#define T_LAT 32768
#define T_CTX 1024
#define T_ALL 33792
#define UA_LD 2560
#define UG_LD 3072
#define IN_COLS 5632
#define MAXBLK 296
#define NTHR 512

struct Params {
    const float *x, *c, *ctx, *c_ctx, *w_mod, *b_mod, *g_attn, *g_ffn, *w_in, *conv_w, *rpb, *sinks, *w_branch, *w_o, *w_rg, *b_rg, *w_re, *b_re, *w_eg, *w_eu, *w_ed, *g_final;
    float* out;
    unsigned* bar; int* cnt; int* blk_e; int* nbu;
    float* modv; float* ropet; float* xs;
    bf16_t *h, *wt_in, *wt_br, *wt_o, *wt_gu, *wt_d, *uA, *uG, *ycat, *mbuf, *xd, *hid, *Y;
    int* eid; int* epos; float* ewt; int* slot;
};

__device__ __forceinline__ int ltid() { int t = threadIdx.x; asm volatile("" : "+v"(t)); return t; }
__device__ __forceinline__ bf16_t f2bf(float f) { unsigned u = __float_as_uint(f); u += 0x7FFFu + ((u >> 16) & 1u); return (bf16_t)(u >> 16); }
__device__ __forceinline__ float bf2f(bf16_t b) { return __uint_as_float(((unsigned)b) << 16); }
__device__ __forceinline__ unsigned pack2(float a, float b) { return (unsigned)f2bf(a) | ((unsigned)f2bf(b) << 16); }
__device__ __forceinline__ float wave_sum(float v) { for (int o = 32; o > 0; o >>= 1) v += __shfl_xor(v, o); return v; }
__device__ __forceinline__ float wave_max(float v) { for (int o = 32; o > 0; o >>= 1) v = fmaxf(v, __shfl_xor(v, o)); return v; }
__device__ __forceinline__ int tok_variant(int t) { return t < T_LAT ? (t >> 13) : 4; }

__device__ __forceinline__ void phase_mod(const Params& p, float* smem) {
    const int tid = ltid(), lane = tid & 63, wid = tid >> 6;
    float* s_silu = smem;
    float* s_part = smem + 5 * 1024;
    for (int i = tid; i < 5 * 1024; i += NTHR) { const int v = i >> 10, k = i & 1023; const float cv = v < 4 ? p.c[v * 1024 + k] : p.c_ctx[k]; s_silu[i] = cv / (1.0f + expf(-cv)); }
    __syncthreads();
    for (int item = blockIdx.x; item < DEPTH * 96; item += gridDim.x) {
        const int l = item / 96, cb = item % 96, col = cb * 64 + lane;
        const float* w = p.w_mod + (size_t)l * 1024 * 6144 + col;
        float a0 = 0.f, a1 = 0.f, a2 = 0.f, a3 = 0.f, a4 = 0.f;
#pragma unroll 8
        for (int kk = 0; kk < 128; ++kk) { const int k = wid * 128 + kk; const float wv = w[(size_t)k * 6144];
            a0 += s_silu[k] * wv; a1 += s_silu[1024 + k] * wv; a2 += s_silu[2048 + k] * wv; a3 += s_silu[3072 + k] * wv; a4 += s_silu[4096 + k] * wv; }
        s_part[(wid * 5 + 0) * 64 + lane] = a0; s_part[(wid * 5 + 1) * 64 + lane] = a1; s_part[(wid * 5 + 2) * 64 + lane] = a2; s_part[(wid * 5 + 3) * 64 + lane] = a3; s_part[(wid * 5 + 4) * 64 + lane] = a4;
        __syncthreads();
        if (tid < 320) { const int v = tid >> 6, ln = tid & 63; float s = p.b_mod[l * 6144 + cb * 64 + ln];
            for (int w8 = 0; w8 < 8; ++w8) s += s_part[(w8 * 5 + v) * 64 + ln];
            p.modv[(size_t)(l * 5 + v) * 6144 + cb * 64 + ln] = s; }
        __syncthreads();
    }
    for (int i = blockIdx.x * NTHR + tid; i < 128 * 16; i += gridDim.x * NTHR) { const int pos = i >> 4, f = i & 15;
        const float inv = powf(10000.0f, -(float)f / 16.0f); const float ang = (float)pos * inv; p.ropet[i * 2] = cosf(ang); p.ropet[i * 2 + 1] = sinf(ang); }
    for (int i = blockIdx.x * NTHR + tid; i < DEPTH * 32; i += gridDim.x * NTHR) p.cnt[i] = 0;
}

#define GU_IG 32
__device__ __forceinline__ void phase_wconv(const Params& p, int l, float* smem) {
    const int tid = ltid();
    float* tile = smem;
    const int n1 = 16 * 88, n2 = 256, n3 = 256, n4 = 2048, n5 = 2048, n6 = 2048;
    const int total = n1 + n2 + n3 + n4 + n5 + n6;
    for (int it = blockIdx.x; it < total; it += gridDim.x) {
        const float* src; int ldN; bf16_t* dst; int ldK; int kt, nt; int kind = 0, e = 0; int i = it;
        if (i < n1) { src = p.w_in + (size_t)l * 1024 * IN_COLS; ldN = IN_COLS; dst = p.wt_in; ldK = 1024; kt = i / 88; nt = i % 88; }
        else if ((i -= n1) < n2) { src = p.w_branch + (size_t)l * 1024 * 1024; ldN = 1024; dst = p.wt_br; ldK = 1024; kt = i / 16; nt = i % 16; }
        else if ((i -= n2) < n3) { src = p.w_o + (size_t)l * 1024 * 1024; ldN = 1024; dst = p.wt_o; ldK = 1024; kt = i / 16; nt = i % 16; }
        else if ((i -= n3) < n4) { e = i / 64; i %= 64; src = p.w_eg + ((size_t)l * 32 + e) * 1024 * 256; ldN = 256; dst = p.wt_gu; ldK = 1024; kt = i / 4; nt = i % 4; kind = 1; }
        else if ((i -= n4) < n5) { e = i / 64; i %= 64; src = p.w_eu + ((size_t)l * 32 + e) * 1024 * 256; ldN = 256; dst = p.wt_gu; ldK = 1024; kt = i / 4; nt = i % 4; kind = 2; }
        else { i -= n5; e = i / 64; i %= 64; src = p.w_ed + ((size_t)l * 32 + e) * 256 * 1024; ldN = 1024; dst = p.wt_d + (size_t)e * 1024 * 256; ldK = 256; kt = i / 16; nt = i % 16; }
        {   const int r = tid >> 4, c4 = tid & 15;
#pragma unroll
            for (int hh = 0; hh < 2; ++hh) { const int rr = r + hh * 32; const float4 v = *(const float4*)(src + (size_t)(kt * 64 + rr) * ldN + nt * 64 + c4 * 4);
                tile[rr * 65 + c4 * 4 + 0] = v.x; tile[rr * 65 + c4 * 4 + 1] = v.y; tile[rr * 65 + c4 * 4 + 2] = v.z; tile[rr * 65 + c4 * 4 + 3] = v.w; }
        }
        __syncthreads();
        {   const int n = tid >> 3, kc = tid & 7; const int ncol = nt * 64 + n; int drow = ncol;
            if (kind) drow = e * 512 + (ncol / GU_IG) * (2 * GU_IG) + (kind == 2 ? GU_IG : 0) + (ncol % GU_IG);
            uint4 o; o.x = pack2(tile[(kc * 8 + 0) * 65 + n], tile[(kc * 8 + 1) * 65 + n]); o.y = pack2(tile[(kc * 8 + 2) * 65 + n], tile[(kc * 8 + 3) * 65 + n]);
            o.z = pack2(tile[(kc * 8 + 4) * 65 + n], tile[(kc * 8 + 5) * 65 + n]); o.w = pack2(tile[(kc * 8 + 6) * 65 + n], tile[(kc * 8 + 7) * 65 + n]);
            *(uint4*)(dst + (size_t)drow * ldK + kt * 64 + kc * 8) = o;
        }
        __syncthreads();
    }
}

__device__ __forceinline__ void phase_norm1(const Params& p, int l) {
    const int tid = ltid(), lane = tid & 63, wid = tid >> 6;
    const int ntok = (l == DEPTH) ? T_LAT : T_ALL;
    for (int t = blockIdx.x * 8 + wid; t < ntok; t += gridDim.x * 8) {
        const int v = tok_variant(t);
        float4 xv[4];
        if (l == 0) {
            const float* src = t < T_LAT ? p.x + (size_t)t * 1024 : p.ctx + (size_t)(t - T_LAT) * 1024;
#pragma unroll
            for (int i = 0; i < 4; ++i) xv[i] = *(const float4*)(src + i * 256 + lane * 4);
        } else {
            const float* src = p.xs + (size_t)t * 1024;
#pragma unroll
            for (int i = 0; i < 4; ++i) xv[i] = *(const float4*)(src + i * 256 + lane * 4);
            const bool had_moe = (l - 1 < DEPTH - 1) || t < T_LAT;
            if (had_moe) {
                const int s0 = p.slot[t * 2], s1 = p.slot[t * 2 + 1]; const float w0 = p.ewt[t * 2], w1 = p.ewt[t * 2 + 1];
                const float* gt = p.modv + (size_t)((l - 1) * 5 + v) * 6144 + 5120;
#pragma unroll
                for (int i = 0; i < 4; ++i) { const int c = i * 256 + lane * 4;
                    const uint2 y0 = *(const uint2*)(p.Y + (size_t)s0 * 1024 + c), y1 = *(const uint2*)(p.Y + (size_t)s1 * 1024 + c);
                    const float4 g = *(const float4*)(gt + c);
                    xv[i].x += g.x * (w0 * bf2f((bf16_t)(y0.x & 0xffff)) + w1 * bf2f((bf16_t)(y1.x & 0xffff)));
                    xv[i].y += g.y * (w0 * bf2f((bf16_t)(y0.x >> 16)) + w1 * bf2f((bf16_t)(y1.x >> 16)));
                    xv[i].z += g.z * (w0 * bf2f((bf16_t)(y0.y & 0xffff)) + w1 * bf2f((bf16_t)(y1.y & 0xffff)));
                    xv[i].w += g.w * (w0 * bf2f((bf16_t)(y0.y >> 16)) + w1 * bf2f((bf16_t)(y1.y >> 16))); }
            }
        }
        float ss = 0.f;
#pragma unroll
        for (int i = 0; i < 4; ++i) ss += xv[i].x * xv[i].x + xv[i].y * xv[i].y + xv[i].z * xv[i].z + xv[i].w * xv[i].w;
        ss = wave_sum(ss);
        const float rstd = rsqrtf(ss * (1.0f / 1024.0f) + 1e-6f);
        if (l == DEPTH) {
#pragma unroll
            for (int i = 0; i < 4; ++i) { const int c = i * 256 + lane * 4; const float4 g = *(const float4*)(p.g_final + c);
                float4 o; o.x = xv[i].x * rstd * g.x; o.y = xv[i].y * rstd * g.y; o.z = xv[i].z * rstd * g.z; o.w = xv[i].w * rstd * g.w;
                *(float4*)(p.out + (size_t)t * 1024 + c) = o; }
        } else {
            const float* mv = p.modv + (size_t)(l * 5 + v) * 6144;
#pragma unroll
            for (int i = 0; i < 4; ++i) { const int c = i * 256 + lane * 4;
                *(float4*)(p.xs + (size_t)t * 1024 + c) = xv[i];
                const float4 g = *(const float4*)(p.g_attn + l * 1024 + c), sh = *(const float4*)(mv + c), sc = *(const float4*)(mv + 1024 + c);
                uint2 o; o.x = pack2(xv[i].x * rstd * g.x * (1.f + sc.x) + sh.x, xv[i].y * rstd * g.y * (1.f + sc.y) + sh.y);
                o.y = pack2(xv[i].z * rstd * g.z * (1.f + sc.z) + sh.z, xv[i].w * rstd * g.w * (1.f + sc.w) + sh.w);
                *(uint2*)(p.h + (size_t)t * 1024 + c) = o; }
        }
    }
}

#define SG_STRIDE 144
#define SG_BOFF (128 * SG_STRIDE)
struct RowsLinear { const bf16_t* base; size_t ld; __device__ __forceinline__ const bf16_t* operator()(int r) const { return base + (size_t)r * ld; } };
template <class ARow>
__device__ __forceinline__ void gemm_core(unsigned char* smem, const ARow& arow, const bf16_t* Bt, size_t ldb, int k0, int k1, f32x4 (&acc)[2][4]) {
    const int tid = ltid(), lane = tid & 63, wid = tid >> 6, wm = wid >> 1, wn = wid & 1;
    const int row0 = tid >> 3, kc = tid & 7;
    const bf16_t* pa0 = arow(row0) + kc * 8; const bf16_t* pa1 = arow(row0 + 64) + kc * 8;
    const bf16_t* pb0 = Bt + (size_t)row0 * ldb + kc * 8; const bf16_t* pb1 = Bt + (size_t)(row0 + 64) * ldb + kc * 8;
    const int soff0 = row0 * SG_STRIDE + kc * 16, soff1 = soff0 + 64 * SG_STRIDE;
    uint4 ra0 = *(const uint4*)(pa0 + k0), ra1 = *(const uint4*)(pa1 + k0), rb0 = *(const uint4*)(pb0 + k0), rb1 = *(const uint4*)(pb1 + k0);
    const int fa = (wm * 32 + (lane & 15)) * SG_STRIDE + (lane >> 4) * 16, fb = SG_BOFF + (wn * 64 + (lane & 15)) * SG_STRIDE + (lane >> 4) * 16;
    for (int k = k0; k < k1; k += 64) {
        __syncthreads();
        *(uint4*)(smem + soff0) = ra0; *(uint4*)(smem + soff1) = ra1; *(uint4*)(smem + SG_BOFF + soff0) = rb0; *(uint4*)(smem + SG_BOFF + soff1) = rb1;
        __syncthreads();
        if (k + 64 < k1) { ra0 = *(const uint4*)(pa0 + k + 64); ra1 = *(const uint4*)(pa1 + k + 64); rb0 = *(const uint4*)(pb0 + k + 64); rb1 = *(const uint4*)(pb1 + k + 64); }
#pragma unroll
        for (int ks = 0; ks < 2; ++ks) {
            const bf16x8 af0 = *(const bf16x8*)(smem + fa + ks * 64), af1 = *(const bf16x8*)(smem + fa + 16 * SG_STRIDE + ks * 64);
            const bf16x8 b0 = *(const bf16x8*)(smem + fb + ks * 64), b1 = *(const bf16x8*)(smem + fb + 16 * SG_STRIDE + ks * 64);
            const bf16x8 b2 = *(const bf16x8*)(smem + fb + 32 * SG_STRIDE + ks * 64), b3 = *(const bf16x8*)(smem + fb + 48 * SG_STRIDE + ks * 64);
            acc[0][0] = __builtin_amdgcn_mfma_f32_16x16x32_bf16(b0, af0, acc[0][0], 0, 0, 0); acc[0][1] = __builtin_amdgcn_mfma_f32_16x16x32_bf16(b1, af0, acc[0][1], 0, 0, 0);
            acc[0][2] = __builtin_amdgcn_mfma_f32_16x16x32_bf16(b2, af0, acc[0][2], 0, 0, 0); acc[0][3] = __builtin_amdgcn_mfma_f32_16x16x32_bf16(b3, af0, acc[0][3], 0, 0, 0);
            acc[1][0] = __builtin_amdgcn_mfma_f32_16x16x32_bf16(b0, af1, acc[1][0], 0, 0, 0); acc[1][1] = __builtin_amdgcn_mfma_f32_16x16x32_bf16(b1, af1, acc[1][1], 0, 0, 0);
            acc[1][2] = __builtin_amdgcn_mfma_f32_16x16x32_bf16(b2, af1, acc[1][2], 0, 0, 0); acc[1][3] = __builtin_amdgcn_mfma_f32_16x16x32_bf16(b3, af1, acc[1][3], 0, 0, 0);
        }
    }
}
__device__ __forceinline__ void zero_acc(f32x4 (&acc)[2][4]) {
#pragma unroll
    for (int a = 0; a < 2; ++a)
#pragma unroll
        for (int b = 0; b < 4; ++b) acc[a][b] = (f32x4){0.f, 0.f, 0.f, 0.f};
}
__device__ __forceinline__ void store4bf(bf16_t* dst, f32x4 v) { uint2 o; o.x = pack2(v[0], v[1]); o.y = pack2(v[2], v[3]); *(uint2*)dst = o; }

__device__ __forceinline__ void phase_gemm_in(const Params& p, int l, unsigned char* smem) {
    const int tid = ltid(), lane = tid & 63, wid = tid >> 6, wm = wid >> 1, wn = wid & 1, q4 = (lane >> 4) * 4;
    const int nM = T_ALL / 128, nN = IN_COLS / 128;
    for (int tile = blockIdx.x; tile < nM * nN; tile += gridDim.x) {
        const int tm = tile / nN, tn = tile % nN, m0 = tm * 128, n0 = tn * 128;
        f32x4 acc[2][4]; zero_acc(acc);
        RowsLinear ar{p.h + (size_t)m0 * 1024, 1024};
        gemm_core(smem, ar, p.wt_in + (size_t)n0 * 1024, 1024, 0, 1024, acc);
        const int cb = n0 + wn * 64;
#pragma unroll
        for (int mi = 0; mi < 2; ++mi) {
            const int t = m0 + wm * 32 + mi * 16 + (lane & 15);
            f32x4 v0 = acc[mi][0], v1 = acc[mi][1], v2 = acc[mi][2], v3 = acc[mi][3];
            if (cb >= 2560) {
                bf16_t* dst = p.uG + (size_t)t * UG_LD + (cb - 2560) + q4;
#pragma unroll
                for (int e = 0; e < 4; ++e) { v0[e] = 1.f / (1.f + __expf(-v0[e])); v1[e] = 1.f / (1.f + __expf(-v1[e])); v2[e] = 1.f / (1.f + __expf(-v2[e])); v3[e] = 1.f / (1.f + __expf(-v3[e])); }
                store4bf(dst, v0); store4bf(dst + 16, v1); store4bf(dst + 32, v2); store4bf(dst + 48, v3);
            } else {
                const bool isq = (cb >= 768 && cb < 1152) || (cb >= 1920 && cb < 2304);
                const bool rope = (cb >= 1920 && cb < 2432) && (t < T_LAT);
                if (rope) { const int pos = t & 8191, r = pos >> 6, cc = pos & 63;
#pragma unroll
                    for (int e = 0; e < 4; ++e) {
                        const float2 csr = *(const float2*)(p.ropet + (r * 16 + q4 + e) * 2), csc = *(const float2*)(p.ropet + (cc * 16 + q4 + e) * 2);
                        const float a1 = v0[e], a2 = v1[e]; v0[e] = a1 * csr.x - a2 * csr.y; v1[e] = a1 * csr.y + a2 * csr.x;
                        const float b1 = v2[e], b2 = v3[e]; v2[e] = b1 * csc.x - b2 * csc.y; v3[e] = b1 * csc.y + b2 * csc.x; } }
                if (isq) { v0 = v0 * 0.125f; v1 = v1 * 0.125f; v2 = v2 * 0.125f; v3 = v3 * 0.125f; }
                bf16_t* dst = p.uA + (size_t)t * UA_LD + cb + q4;
                store4bf(dst, v0); store4bf(dst + 16, v1); store4bf(dst + 32, v2); store4bf(dst + 48, v3);
            }
        }
    }
}

struct KmNA { int b, r, c, rs, cs; const float* rpb;
    __device__ __forceinline__ int tok(int kk) const { if (kk < 128) return b * SEQ + (rs + (kk >> 4)) * 64 + cs + (kk & 15); return T_LAT + b * CTXL + (kk - 128); }
    __device__ __forceinline__ float bias(int kk) const { if (kk < 128) return rpb[(rs + (kk >> 4) - r + 7) * 31 + (cs + (kk & 15) - c + 15)]; return 0.f; } };
struct KmSWA { int b, i;
    __device__ __forceinline__ int tok(int kk) const { if (kk < 257) { const int j = i - 128 + kk; return (j >= 0 && j < SEQ) ? b * SEQ + j : -1; } if (kk < 513) return T_LAT + b * CTXL + (kk - 257); return -1; }
    __device__ __forceinline__ float bias(int) const { return 0.f; } };
struct KmCtx { int b;
    __device__ __forceinline__ int tok(int kk) const { return T_LAT + b * CTXL + kk; }
    __device__ __forceinline__ float bias(int) const { return 0.f; } };

template <int NI, class KM>
__device__ __forceinline__ void attn_item(const bf16_t* uA, int tq, int qcol, int kcol, int vcol, const KM& km, bool has_sink, float sink, bf16_t* outp, int lane) {
    float q[64];
    {   const uint4* qp = (const uint4*)(uA + (size_t)tq * UA_LD + qcol);
#pragma unroll
        for (int c = 0; c < 8; ++c) { const uint4 v = qp[c];
            q[c * 8 + 0] = bf2f((bf16_t)(v.x & 0xffff)); q[c * 8 + 1] = bf2f((bf16_t)(v.x >> 16)); q[c * 8 + 2] = bf2f((bf16_t)(v.y & 0xffff)); q[c * 8 + 3] = bf2f((bf16_t)(v.y >> 16));
            q[c * 8 + 4] = bf2f((bf16_t)(v.z & 0xffff)); q[c * 8 + 5] = bf2f((bf16_t)(v.z >> 16)); q[c * 8 + 6] = bf2f((bf16_t)(v.w & 0xffff)); q[c * 8 + 7] = bf2f((bf16_t)(v.w >> 16)); } }
    float s[NI]; float mx = -3.0e38f;
#pragma unroll
    for (int i = 0; i < NI; ++i) { const int kk = i * 64 + lane; const int tk = km.tok(kk);
        float d = -3.0e38f;
        if (tk >= 0) { const uint4* kp = (const uint4*)(uA + (size_t)tk * UA_LD + kcol); d = 0.f;
#pragma unroll
            for (int c = 0; c < 8; ++c) { const uint4 v = kp[c];
                d += q[c * 8 + 0] * bf2f((bf16_t)(v.x & 0xffff)) + q[c * 8 + 1] * bf2f((bf16_t)(v.x >> 16)) + q[c * 8 + 2] * bf2f((bf16_t)(v.y & 0xffff)) + q[c * 8 + 3] * bf2f((bf16_t)(v.y >> 16))
                   + q[c * 8 + 4] * bf2f((bf16_t)(v.z & 0xffff)) + q[c * 8 + 5] * bf2f((bf16_t)(v.z >> 16)) + q[c * 8 + 6] * bf2f((bf16_t)(v.w & 0xffff)) + q[c * 8 + 7] * bf2f((bf16_t)(v.w >> 16)); }
            d += km.bias(kk); }
        s[i] = d; mx = fmaxf(mx, d); }
    mx = wave_max(mx); if (has_sink) mx = fmaxf(mx, sink);
    float sum = 0.f;
#pragma unroll
    for (int i = 0; i < NI; ++i) { const float pv = s[i] > -1.0e38f ? __expf(s[i] - mx) : 0.f; s[i] = pv; sum += pv; }
    sum = wave_sum(sum); if (has_sink) sum += __expf(sink - mx);
    const float inv = 1.0f / sum;
    float o = 0.f;
#pragma unroll
    for (int i = 0; i < NI; ++i) {
        for (int sl = 0; sl < 64; ++sl) { const int tk = km.tok(i * 64 + sl); const float pv = __shfl(s[i], sl);
            if (tk >= 0) o += pv * bf2f(uA[(size_t)tk * UA_LD + vcol + lane]); } }
    outp[lane] = f2bf(o * inv);
}

__device__ __forceinline__ void phase_mix(const Params& p, int l) {
    const int tid = ltid(), lane = tid & 63, wid = tid >> 6;
    const bool need_ctx = l < DEPTH - 1;
    {   const int ntok = need_ctx ? T_ALL : T_LAT; const float* cw = p.conv_w + l * 3 * 256;
        for (int idx = blockIdx.x * NTHR + tid; idx < ntok * 256; idx += gridDim.x * NTHR) { const int t = idx >> 8, c = idx & 255;
            int pos, len; if (t < T_LAT) { pos = t & 8191; len = SEQ; } else { pos = (t - T_LAT) & 255; len = CTXL; }
            const bf16_t* u = p.uA + (size_t)t * UA_LD + c;
            const float z1 = bf2f(u[512]) * bf2f(u[0]);
            const float z0 = pos > 0 ? bf2f(u[512 - UA_LD]) * bf2f(u[-UA_LD]) : 0.f;
            const float z2 = pos + 1 < len ? bf2f(u[512 + UA_LD]) * bf2f(u[UA_LD]) : 0.f;
            const float y = bf2f(u[256]) * (z0 * cw[c] + z1 * cw[256 + c] + z2 * cw[512 + c]);
            p.ycat[(size_t)t * 1024 + c] = f2bf(y); } }
    const int n_lat = T_LAT * 12, n_all = n_lat + (need_ctx ? T_CTX * 12 : 0);
    for (int it = blockIdx.x * 8 + wid; it < n_all; it += gridDim.x * 8) {
        if (it < n_lat) { const int t = it / 12, hh = it % 12; const int b = t >> 13, pos = t & 8191;
            if (hh < 6) { KmNA km; km.b = b; km.r = pos >> 6; km.c = pos & 63; km.rs = min(max(km.r - 4, 0), 120); km.cs = min(max(km.c - 8, 0), 48); km.rpb = p.rpb + ((size_t)l * 6 + hh) * 15 * 31;
                attn_item<6>(p.uA, t, 768 + hh * 64, 1152 + hh * 64, 1536 + hh * 64, km, false, 0.f, p.ycat + (size_t)t * 1024 + 256 + hh * 64, lane); }
            else { const int hq = hh - 6, kh = hq / 3; KmSWA km; km.b = b; km.i = pos;
                attn_item<9>(p.uA, t, 1920 + hq * 64, 2304 + kh * 64, 2432 + kh * 64, km, true, p.sinks[l * 6 + hq], p.ycat + (size_t)t * 1024 + 640 + hq * 64, lane); }
        } else { const int it2 = it - n_lat; const int tc = it2 / 12, hh = it2 % 12; const int t = T_LAT + tc; KmCtx km; km.b = tc >> 8;
            if (hh < 6) attn_item<4>(p.uA, t, 768 + hh * 64, 1152 + hh * 64, 1536 + hh * 64, km, false, 0.f, p.ycat + (size_t)t * 1024 + 256 + hh * 64, lane);
            else { const int hq = hh - 6, kh = hq / 3; attn_item<4>(p.uA, t, 1920 + hq * 64, 2304 + kh * 64, 2432 + kh * 64, km, true, p.sinks[l * 6 + hq], p.ycat + (size_t)t * 1024 + 640 + hq * 64, lane); }
        }
    }
}

__device__ __forceinline__ void phase_gemm_merge(const Params& p, int l, unsigned char* smem) {
    const int tid = ltid(), lane = tid & 63, wid = tid >> 6, wm = wid >> 1, wn = wid & 1, q4 = (lane >> 4) * 4;
    const int ntok = (l < DEPTH - 1) ? T_ALL : T_LAT; const int nM = ntok / 128, nN = 8;
    for (int tile = blockIdx.x; tile < nM * nN; tile += gridDim.x) {
        const int tm = tile / nN, tn = tile % nN, m0 = tm * 128, n0 = tn * 128;
        f32x4 macc[2][4]; zero_acc(macc);
        RowsLinear ar{p.ycat + (size_t)m0 * 1024, 1024};
#pragma unroll
        for (int seg = 0; seg < 3; ++seg) {
            const int k0 = seg == 0 ? 0 : (seg == 1 ? 256 : 640), k1 = seg == 0 ? 256 : (seg == 1 ? 640 : 1024);
            f32x4 acc[2][4]; zero_acc(acc);
            gemm_core(smem, ar, p.wt_br + (size_t)n0 * 1024, 1024, k0, k1, acc);
#pragma unroll
            for (int mi = 0; mi < 2; ++mi) { const int t = m0 + wm * 32 + mi * 16 + (lane & 15);
#pragma unroll
                for (int nj = 0; nj < 4; ++nj) { const uint2 g = *(const uint2*)(p.uG + (size_t)t * UG_LD + seg * 1024 + n0 + wn * 64 + nj * 16 + q4);
                    macc[mi][nj][0] += bf2f((bf16_t)(g.x & 0xffff)) * acc[mi][nj][0]; macc[mi][nj][1] += bf2f((bf16_t)(g.x >> 16)) * acc[mi][nj][1];
                    macc[mi][nj][2] += bf2f((bf16_t)(g.y & 0xffff)) * acc[mi][nj][2]; macc[mi][nj][3] += bf2f((bf16_t)(g.y >> 16)) * acc[mi][nj][3]; } }
        }
#pragma unroll
        for (int mi = 0; mi < 2; ++mi) { const int t = m0 + wm * 32 + mi * 16 + (lane & 15);
#pragma unroll
            for (int nj = 0; nj < 4; ++nj) store4bf(p.mbuf + (size_t)t * 1024 + n0 + wn * 64 + nj * 16 + q4, macc[mi][nj]); }
    }
}

__device__ __forceinline__ void phase_gemm_o(const Params& p, int l, unsigned char* smem) {
    const int tid = ltid(), lane = tid & 63, wid = tid >> 6, wm = wid >> 1, wn = wid & 1, q4 = (lane >> 4) * 4;
    const int ntok = (l < DEPTH - 1) ? T_ALL : T_LAT; const int nM = ntok / 128, nN = 8;
    for (int tile = blockIdx.x; tile < nM * nN; tile += gridDim.x) {
        const int tm = tile / nN, tn = tile % nN, m0 = tm * 128, n0 = tn * 128;
        f32x4 acc[2][4]; zero_acc(acc);
        RowsLinear ar{p.mbuf + (size_t)m0 * 1024, 1024};
        gemm_core(smem, ar, p.wt_o + (size_t)n0 * 1024, 1024, 0, 1024, acc);
#pragma unroll
        for (int mi = 0; mi < 2; ++mi) { const int t = m0 + wm * 32 + mi * 16 + (lane & 15); const float* gt = p.modv + (size_t)(l * 5 + tok_variant(t)) * 6144 + 2048;
#pragma unroll
            for (int nj = 0; nj < 4; ++nj) { const int c = n0 + wn * 64 + nj * 16 + q4; float4* xp = (float4*)(p.xs + (size_t)t * 1024 + c); float4 xv = *xp; const float4 g = *(const float4*)(gt + c);
                xv.x += g.x * acc[mi][nj][0]; xv.y += g.y * acc[mi][nj][1]; xv.z += g.z * acc[mi][nj][2]; xv.w += g.w * acc[mi][nj][3]; *xp = xv; } }
    }
}

__device__ __forceinline__ void phase_router(const Params& p, int l, float* smem) {
    const int tid = ltid(), lane = tid & 63, wid = tid >> 6;
    float* sh2 = smem;
    float* slg = smem + 16 * 1024;
    const int ntok = (l < DEPTH - 1) ? T_ALL : T_LAT;
    const float* wre = p.w_re + (size_t)l * 1024 * 32; const float* wrg = p.w_rg + (size_t)l * 1024 * 4;
    for (int tb = blockIdx.x; tb < ntok / 16; tb += gridDim.x) {
#pragma unroll
        for (int j = 0; j < 2; ++j) { const int tt = wid * 2 + j, t = tb * 16 + tt; const int v = tok_variant(t);
            float4 xv[4]; float ss = 0.f;
#pragma unroll
            for (int i = 0; i < 4; ++i) { xv[i] = *(const float4*)(p.xs + (size_t)t * 1024 + i * 256 + lane * 4); ss += xv[i].x * xv[i].x + xv[i].y * xv[i].y + xv[i].z * xv[i].z + xv[i].w * xv[i].w; }
            ss = wave_sum(ss); const float rstd = rsqrtf(ss * (1.0f / 1024.0f) + 1e-6f);
            const float* mv = p.modv + (size_t)(l * 5 + v) * 6144 + 3072;
#pragma unroll
            for (int i = 0; i < 4; ++i) { const int c = i * 256 + lane * 4;
                const float4 g = *(const float4*)(p.g_ffn + l * 1024 + c), sh = *(const float4*)(mv + c), sc = *(const float4*)(mv + 1024 + c);
                float4 o; o.x = xv[i].x * rstd * g.x * (1.f + sc.x) + sh.x; o.y = xv[i].y * rstd * g.y * (1.f + sc.y) + sh.y; o.z = xv[i].z * rstd * g.z * (1.f + sc.z) + sh.z; o.w = xv[i].w * rstd * g.w * (1.f + sc.w) + sh.w;
                *(float4*)(sh2 + tt * 1024 + c) = o; uint2 ob; ob.x = pack2(o.x, o.y); ob.y = pack2(o.z, o.w); *(uint2*)(p.h + (size_t)t * 1024 + c) = ob; } }
        __syncthreads();
        {   const int tt = tid >> 5, j = tid & 31; float a = 0.f; const float* hp = sh2 + tt * 1024;
#pragma unroll 8
            for (int k = 0; k < 1024; ++k) a += hp[k] * wre[k * 32 + j];
            slg[tt * 36 + 4 + j] = a + p.b_re[l * 32 + j];
            if (tid < 64) { const int t2 = tid >> 2, j2 = tid & 3; float a2 = 0.f; const float* hp2 = sh2 + t2 * 1024;
#pragma unroll 8
                for (int k = 0; k < 1024; ++k) a2 += hp2[k] * wrg[k * 4 + j2];
                slg[t2 * 36 + j2] = a2 + p.b_rg[l * 4 + j2]; } }
        __syncthreads();
        if (tid < 16) { const int t = tb * 16 + tid; const float* lg = slg + tid * 36;
            int gi = 0; float gm = lg[0];
            for (int j = 1; j < 4; ++j) if (lg[j] > gm) { gm = lg[j]; gi = j; }
            float den = 0.f; for (int j = 0; j < 4; ++j) den += expf(lg[j] - gm);
            const float pg = 1.0f / den;
            const float* le = lg + 4 + gi * 8;
            int i1 = 0; float v1 = le[0]; for (int j = 1; j < 8; ++j) if (le[j] > v1) { v1 = le[j]; i1 = j; }
            int i2 = -1; float v2 = -3.0e38f; for (int j = 0; j < 8; ++j) if (j != i1 && le[j] > v2) { v2 = le[j]; i2 = j; }
            const float e2 = expf(v2 - v1); const float wa = 1.0f / (1.0f + e2), wb = e2 / (1.0f + e2);
            const int ea = gi * 8 + i1, eb = gi * 8 + i2;
            p.eid[t * 2] = ea; p.eid[t * 2 + 1] = eb; p.ewt[t * 2] = pg * wa; p.ewt[t * 2 + 1] = pg * wb;
            p.epos[t * 2] = atomicAdd(p.cnt + l * 32 + ea, 1); p.epos[t * 2 + 1] = atomicAdd(p.cnt + l * 32 + eb, 1); }
        __syncthreads();
    }
}

__device__ __forceinline__ void phase_dispatch(const Params& p, int l, int* smem) {
    const int tid = ltid(), lane = tid & 63, wid = tid >> 6;
    int* pstart = smem;
    if (tid == 0) { int acc = 0; for (int e = 0; e < 32; ++e) { pstart[e] = acc; acc += ((p.cnt[l * 32 + e] + 255) >> 8) << 8; } pstart[32] = acc; }
    __syncthreads();
    if (blockIdx.x == 0) { const int nb = pstart[32] >> 8;
        for (int rb = tid; rb < nb; rb += NTHR) { int e = 0; while (e < 31 && pstart[e + 1] <= rb * 256) ++e; p.blk_e[rb] = e; }
        if (tid == 0) p.nbu[0] = nb; }
    const int ntok = (l < DEPTH - 1) ? T_ALL : T_LAT;
    for (int a = blockIdx.x * 8 + wid; a < ntok * 2; a += gridDim.x * 8) {
        const int t = a >> 1; const int sl = pstart[p.eid[a]] + p.epos[a];
        if (lane == 0) p.slot[a] = sl;
        const uint4* src = (const uint4*)(p.h + (size_t)t * 1024); uint4* dst = (uint4*)(p.xd + (size_t)sl * 1024);
        dst[lane] = src[lane]; dst[lane + 64] = src[lane + 64];
    }
}

__device__ __forceinline__ void phase_gemm_e1(const Params& p, unsigned char* smem) {
    const int tid = ltid(), lane = tid & 63, wid = tid >> 6, wm = wid >> 1, wn = wid & 1, q4 = (lane >> 4) * 4;
    const int nb = p.nbu[0]; const int ntiles = nb * 2 * 4;
    for (int tile = blockIdx.x; tile < ntiles; tile += gridDim.x) {
        const int rb = tile >> 2, tn = tile & 3, m0 = rb * 128, e = p.blk_e[rb >> 1];
        f32x4 acc[2][4]; zero_acc(acc);
        RowsLinear ar{p.xd + (size_t)m0 * 1024, 1024};
        gemm_core(smem, ar, p.wt_gu + ((size_t)e * 512 + tn * 128) * 1024, 1024, 0, 1024, acc);
        const int pg = tn * 2 + wn;
#pragma unroll
        for (int mi = 0; mi < 2; ++mi) { const int sl = m0 + wm * 32 + mi * 16 + (lane & 15);
#pragma unroll
            for (int nj = 0; nj < 2; ++nj) { f32x4 g = acc[mi][nj], u = acc[mi][nj + 2], o;
#pragma unroll
                for (int e4 = 0; e4 < 4; ++e4) o[e4] = g[e4] / (1.f + __expf(-g[e4])) * u[e4];
                store4bf(p.hid + (size_t)sl * 256 + pg * 32 + nj * 16 + q4, o); } }
    }
}
__device__ __forceinline__ void phase_gemm_e2(const Params& p, unsigned char* smem) {
    const int tid = ltid(), lane = tid & 63, wid = tid >> 6, wm = wid >> 1, wn = wid & 1, q4 = (lane >> 4) * 4;
    const int nb = p.nbu[0]; const int ntiles = nb * 2 * 8;
    for (int tile = blockIdx.x; tile < ntiles; tile += gridDim.x) {
        const int rb = tile >> 3, tn = tile & 7, m0 = rb * 128, n0 = tn * 128, e = p.blk_e[rb >> 1];
        f32x4 acc[2][4]; zero_acc(acc);
        RowsLinear ar{p.hid + (size_t)m0 * 256, 256};
        gemm_core(smem, ar, p.wt_d + ((size_t)e * 1024 + n0) * 256, 256, 0, 256, acc);
#pragma unroll
        for (int mi = 0; mi < 2; ++mi) { const int sl = m0 + wm * 32 + mi * 16 + (lane & 15);
#pragma unroll
            for (int nj = 0; nj < 4; ++nj) store4bf(p.Y + (size_t)sl * 1024 + n0 + wn * 64 + nj * 16 + q4, acc[mi][nj]); }
    }
}


#define XB_TMO      128
#define XB_XCNT(j)  (256  + 64 * (j))
#define XB_XSUB(j)  (1280 + 64 * (j))
#define XB_XGEN(j)  (2304 + 64 * (j))
#define XB_TOP      3328
#define XB_TOPGEN   3392
#define XCD_BAR_WORDS 3456
#define XB_SPIN_CAP (1u << 18)
#define LAS __attribute__((address_space(3)))
__device__ __forceinline__ unsigned xb_ld(unsigned* p)              { return __hip_atomic_load(p, __ATOMIC_RELAXED, __HIP_MEMORY_SCOPE_AGENT); }
__device__ __forceinline__ unsigned xb_add(unsigned* p, unsigned v) { return __hip_atomic_fetch_add(p, v, __ATOMIC_RELAXED, __HIP_MEMORY_SCOPE_AGENT); }
__device__ __forceinline__ unsigned xb_xcc_id() { return (unsigned)__builtin_amdgcn_s_getreg((3 << 11) | 20) & 0xFu; }
#define XB_SPIN(cond, bar) do { unsigned _sp = 0; while (cond) { __builtin_amdgcn_s_sleep(1); \
    if ((++_sp & 255u) == 0u) { if (xb_ld(&(bar)[XB_TMO])) break; if (_sp > XB_SPIN_CAP) { atomicAdd(&(bar)[XB_TMO], 1u); break; } } } } while (0)
struct XcdBarrier { unsigned* bar; unsigned x; volatile LAS unsigned* st; };
__device__ __forceinline__ XcdBarrier xcd_barrier_post(unsigned* bar, volatile LAS unsigned* st) {
    XcdBarrier b; b.bar = bar; b.x = xb_xcc_id(); b.st = st;
    if (threadIdx.x == 0) (void)xb_add(&bar[XB_XCNT(b.x)], 1u);
    return b;
}
__device__ __forceinline__ void xcd_barrier_complete(unsigned* bar, unsigned x, unsigned& nloc, unsigned& nx) {
    const unsigned G = gridDim.x * gridDim.y * gridDim.z;
    unsigned sum, cnt, mine, sp = 0u;
    for (;;) {
        sum = 0u; cnt = 0u; mine = 0u;
#pragma unroll
        for (unsigned j = 0; j < 16; ++j) { const unsigned c = xb_ld(&bar[XB_XCNT(j)]); sum += c; cnt += (c > 0u) ? 1u : 0u; mine = (j == x) ? c : mine; }
        if (sum == G) break;
        __builtin_amdgcn_s_sleep(1);
        if ((++sp & 255u) == 0u) { if (xb_ld(&bar[XB_TMO])) break; if (sp > XB_SPIN_CAP) { atomicAdd(&bar[XB_TMO], 1u); break; } }
    }
    nloc = mine > 0u ? mine : 1u; nx = cnt > 0u ? cnt : 1u;
}
__device__ __forceinline__ void xcd_barrier(const XcdBarrier& b) {
    asm volatile("s_waitcnt vmcnt(0)" ::: "memory");
    __syncthreads();
    if (threadIdx.x == 0) {
        unsigned* bar = b.bar;
        __builtin_amdgcn_s_waitcnt(0);
        unsigned nloc = b.st[0], nx = b.st[1];
        if (nloc == 0u) { xcd_barrier_complete(bar, b.x, nloc, nx); b.st[0] = nloc; b.st[1] = nx; }
        const unsigned old = xb_add(&bar[XB_XSUB(b.x)], 1u);
        const unsigned gen = old / nloc;
        if (old + 1u == (gen + 1u) * nloc) {
            __builtin_amdgcn_fence(__ATOMIC_RELEASE, "agent");
            asm volatile("s_waitcnt vmcnt(0)" ::: "memory");
            const unsigned og = xb_add(&bar[XB_TOP], 1u);
            const unsigned tg = og / nx;
            if (og + 1u == (tg + 1u) * nx) xb_add(&bar[XB_TOPGEN], 1u);
            else XB_SPIN(xb_ld(&bar[XB_TOPGEN]) == tg, bar);
            __builtin_amdgcn_fence(__ATOMIC_ACQUIRE, "agent");
            xb_add(&bar[XB_XGEN(b.x)], 1u);
            asm volatile("s_waitcnt vmcnt(0)" ::: "memory");
        } else {
            XB_SPIN(xb_ld(&bar[XB_XGEN(b.x)]) == gen, bar);
            __builtin_amdgcn_fence(__ATOMIC_ACQUIRE, "agent");
            asm volatile("s_waitcnt vmcnt(0)" ::: "memory");
        }
    }
    __syncthreads();
}

#define SMEM_BYTES 73728
__global__ void __launch_bounds__(NTHR, 2) k_mega(Params p) {
    extern __shared__ __attribute__((aligned(16))) unsigned char smem[];
    volatile LAS unsigned* xbw = (volatile LAS unsigned*)(smem + SMEM_BYTES);
    if (threadIdx.x == 0) { xbw[0] = 0u; xbw[1] = 0u; xbw[2] = 0u; xbw[3] = 0u; }
    __syncthreads();
    XcdBarrier bar = xcd_barrier_post(p.bar, xbw);
    phase_mod(p, (float*)smem);
    xcd_barrier(bar);
    for (int l = 0; l < DEPTH; ++l) {
        phase_norm1(p, l); phase_wconv(p, l, (float*)smem);
        xcd_barrier(bar);
        phase_gemm_in(p, l, smem);
        xcd_barrier(bar);
        phase_mix(p, l);
        xcd_barrier(bar);
        phase_gemm_merge(p, l, smem);
        xcd_barrier(bar);
        phase_gemm_o(p, l, smem);
        xcd_barrier(bar);
        phase_router(p, l, (float*)smem);
        xcd_barrier(bar);
        phase_dispatch(p, l, (int*)smem);
        xcd_barrier(bar);
        phase_gemm_e1(p, smem);
        xcd_barrier(bar);
        phase_gemm_e2(p, smem);
        xcd_barrier(bar);
    }
    phase_norm1(p, DEPTH);
}

extern "C" void kernel_launch(void* const* d_in, const int* in_sizes, int n_in, void* d_out, int out_size, void* d_ws, size_t ws_size, hipStream_t stream) {
    Params p{};
    p.x = (const float*)d_in[0]; p.c = (const float*)d_in[1]; p.ctx = (const float*)d_in[2]; p.c_ctx = (const float*)d_in[3]; p.w_mod = (const float*)d_in[4]; p.b_mod = (const float*)d_in[5];
    p.g_attn = (const float*)d_in[6]; p.g_ffn = (const float*)d_in[7]; p.w_in = (const float*)d_in[8]; p.conv_w = (const float*)d_in[9]; p.rpb = (const float*)d_in[10]; p.sinks = (const float*)d_in[11];
    p.w_branch = (const float*)d_in[12]; p.w_o = (const float*)d_in[13]; p.w_rg = (const float*)d_in[14]; p.b_rg = (const float*)d_in[15]; p.w_re = (const float*)d_in[16]; p.b_re = (const float*)d_in[17];
    p.w_eg = (const float*)d_in[18]; p.w_eu = (const float*)d_in[19]; p.w_ed = (const float*)d_in[20]; p.g_final = (const float*)d_in[21];
    p.out = (float*)d_out;
    unsigned char* w = (unsigned char*)d_ws; size_t off = 0;
    auto take = [&](size_t bytes) { unsigned char* r = w + off; off += (bytes + 255) & ~(size_t)255; return r; };
    p.bar = (unsigned*)take(16384); p.cnt = (int*)take(DEPTH * 32 * 4); p.blk_e = (int*)take(MAXBLK * 4); p.nbu = (int*)take(256);
    p.modv = (float*)take((size_t)DEPTH * 5 * 6144 * 4); p.ropet = (float*)take(128 * 16 * 2 * 4);
    p.eid = (int*)take((size_t)T_ALL * 2 * 4); p.epos = (int*)take((size_t)T_ALL * 2 * 4); p.ewt = (float*)take((size_t)T_ALL * 2 * 4); p.slot = (int*)take((size_t)T_ALL * 2 * 4);
    p.xs = (float*)take((size_t)T_ALL * 1024 * 4);
    p.h = (bf16_t*)take((size_t)T_ALL * 1024 * 2);
    p.wt_in = (bf16_t*)take((size_t)IN_COLS * 1024 * 2); p.wt_br = (bf16_t*)take((size_t)1024 * 1024 * 2); p.wt_o = (bf16_t*)take((size_t)1024 * 1024 * 2);
    p.wt_gu = (bf16_t*)take((size_t)32 * 512 * 1024 * 2); p.wt_d = (bf16_t*)take((size_t)32 * 1024 * 256 * 2);
    p.uA = (bf16_t*)take((size_t)T_ALL * UA_LD * 2); p.uG = (bf16_t*)take((size_t)T_ALL * UG_LD * 2); p.ycat = (bf16_t*)take((size_t)T_ALL * 1024 * 2);
    p.mbuf = p.uA; p.xd = p.uA; p.hid = p.ycat; p.Y = p.uG;
    if (off > ws_size) return;
    constexpr size_t kDynLds = SMEM_BYTES + 16;
    static int grid = 0;
    if (!grid) {
        (void)hipFuncSetAttribute((const void*)k_mega, hipFuncAttributeMaxDynamicSharedMemorySize, (int)kDynLds);
        int dev = 0, cus = 0, per_cu = 0;
        (void)hipGetDevice(&dev);
        (void)hipDeviceGetAttribute(&cus, hipDeviceAttributeMultiprocessorCount, dev);
        (void)hipOccupancyMaxActiveBlocksPerMultiprocessor(&per_cu, (const void*)k_mega, NTHR, kDynLds);
        grid = cus * (per_cu < 1 ? per_cu : 1);
        if (grid <= 0) grid = 0;
    }
    if (!grid) return;
    (void)hipMemsetAsync(p.bar, 0, XCD_BAR_WORDS * sizeof(unsigned), stream);
    hipLaunchKernelGGL(k_mega, dim3(grid), dim3(NTHR), kDynLds, stream, p);
}
```

```cpp
#include <hip/hip_runtime.h>
#include <stdint.h>

typedef unsigned short bf16_t;
typedef short bf16x8 __attribute__((ext_vector_type(8)));
typedef float f32x4 __attribute__((ext_vector_type(4)));

#define D_MODEL 1024
#define NB 4
#define SEQ 8192
#define DEPTH 4
#define CTXL 256
#define T_LAT 32768
#define T_CTX 1024
#define T_ALL 33792
#define UA_LD 2560
#define UG_LD 3072
#define IN_COLS 5632
#define MAXBLK 296
#define NTHR 512
#define LAS __attribute__((address_space(3)))

struct Params {
    const float *x, *c, *ctx, *c_ctx, *w_mod, *b_mod, *g_attn, *g_ffn, *w_in, *conv_w, *rpb, *sinks, *w_branch, *w_o, *w_rg, *b_rg, *w_re, *b_re, *w_eg, *w_eu, *w_ed, *g_final;
    float* out;
    unsigned* bar; int* cnt; int* blk_e; int* nbu;
    float* modv; float* ropet; float* xs;
    bf16_t *h, *wt_in, *wt_br, *wt_o, *wt_gu, *wt_d, *uA, *uG, *ycat, *mbuf, *xd, *hid, *Y;
    int* eid; int* epos; float* ewt; int* slot;
};

__device__ __forceinline__ int ltid() { int t = threadIdx.x; asm volatile("" : "+v"(t)); return t; }
__device__ __forceinline__ bf16_t f2bf(float f) { unsigned u = __float_as_uint(f); u += 0x7FFFu + ((u >> 16) & 1u); return (bf16_t)(u >> 16); }
__device__ __forceinline__ float bf2f(bf16_t b) { return __uint_as_float(((unsigned)b) << 16); }
__device__ __forceinline__ unsigned pack2(float a, float b) { return (unsigned)f2bf(a) | ((unsigned)f2bf(b) << 16); }
__device__ __forceinline__ float wave_sum(float v) { for (int o = 32; o > 0; o >>= 1) v += __shfl_xor(v, o); return v; }
__device__ __forceinline__ float wave_max(float v) { for (int o = 32; o > 0; o >>= 1) v = fmaxf(v, __shfl_xor(v, o)); return v; }
__device__ __forceinline__ int tok_variant(int t) { return t < T_LAT ? (t >> 13) : 4; }

__device__ __forceinline__ void phase_mod(const Params& p, float* smem) {
    const int tid = ltid(), lane = tid & 63, wid = tid >> 6;
    float* s_silu = smem;
    float* s_part = smem + 5 * 1024;
    for (int i = tid; i < 5 * 1024; i += NTHR) { const int v = i >> 10, k = i & 1023; const float cv = v < 4 ? p.c[v * 1024 + k] : p.c_ctx[k]; s_silu[i] = cv / (1.0f + expf(-cv)); }
    __syncthreads();
    for (int item = blockIdx.x; item < DEPTH * 96; item += gridDim.x) {
        const int l = item / 96, cb = item % 96, col = cb * 64 + lane;
        const float* w = p.w_mod + (size_t)l * 1024 * 6144 + col;
        float a0 = 0.f, a1 = 0.f, a2 = 0.f, a3 = 0.f, a4 = 0.f;
#pragma unroll 8
        for (int kk = 0; kk < 128; ++kk) { const int k = wid * 128 + kk; const float wv = w[(size_t)k * 6144];
            a0 += s_silu[k] * wv; a1 += s_silu[1024 + k] * wv; a2 += s_silu[2048 + k] * wv; a3 += s_silu[3072 + k] * wv; a4 += s_silu[4096 + k] * wv; }
        s_part[(wid * 5 + 0) * 64 + lane] = a0; s_part[(wid * 5 + 1) * 64 + lane] = a1; s_part[(wid * 5 + 2) * 64 + lane] = a2; s_part[(wid * 5 + 3) * 64 + lane] = a3; s_part[(wid * 5 + 4) * 64 + lane] = a4;
        __syncthreads();
        if (tid < 320) { const int v = tid >> 6, ln = tid & 63; float s = p.b_mod[l * 6144 + cb * 64 + ln];
            for (int w8 = 0; w8 < 8; ++w8) s += s_part[(w8 * 5 + v) * 64 + ln];
            p.modv[(size_t)(l * 5 + v) * 6144 + cb * 64 + ln] = s; }
        __syncthreads();
    }
    for (int i = blockIdx.x * NTHR + tid; i < 128 * 16; i += gridDim.x * NTHR) { const int pos = i >> 4, f = i & 15;
        const float inv = powf(10000.0f, -(float)f / 16.0f); const float ang = (float)pos * inv; p.ropet[i * 2] = cosf(ang); p.ropet[i * 2 + 1] = sinf(ang); }
    for (int i = blockIdx.x * NTHR + tid; i < DEPTH * 32; i += gridDim.x * NTHR) p.cnt[i] = 0;
}

#define GU_IG 32
__device__ __forceinline__ void phase_wconv(const Params& p, int l, float* smem) {
    const int tid = ltid();
    float* tile = smem;
    const int n1 = 16 * 88, n2 = 256, n3 = 256, n4 = 2048, n5 = 2048, n6 = 2048;
    const int total = n1 + n2 + n3 + n4 + n5 + n6;
    for (int it = blockIdx.x; it < total; it += gridDim.x) {
        const float* src; int ldN; bf16_t* dst; int ldK; int kt, nt; int kind = 0, e = 0; int i = it;
        if (i < n1) { src = p.w_in + (size_t)l * 1024 * IN_COLS; ldN = IN_COLS; dst = p.wt_in; ldK = 1024; kt = i / 88; nt = i % 88; }
        else if ((i -= n1) < n2) { src = p.w_branch + (size_t)l * 1024 * 1024; ldN = 1024; dst = p.wt_br; ldK = 1024; kt = i / 16; nt = i % 16; }
        else if ((i -= n2) < n3) { src = p.w_o + (size_t)l * 1024 * 1024; ldN = 1024; dst = p.wt_o; ldK = 1024; kt = i / 16; nt = i % 16; }
        else if ((i -= n3) < n4) { e = i / 64; i %= 64; src = p.w_eg + ((size_t)l * 32 + e) * 1024 * 256; ldN = 256; dst = p.wt_gu; ldK = 1024; kt = i / 4; nt = i % 4; kind = 1; }
        else if ((i -= n4) < n5) { e = i / 64; i %= 64; src = p.w_eu + ((size_t)l * 32 + e) * 1024 * 256; ldN = 256; dst = p.wt_gu; ldK = 1024; kt = i / 4; nt = i % 4; kind = 2; }
        else { i -= n5; e = i / 64; i %= 64; src = p.w_ed + ((size_t)l * 32 + e) * 256 * 1024; ldN = 1024; dst = p.wt_d + (size_t)e * 1024 * 256; ldK = 256; kt = i / 16; nt = i % 16; }
        {   const int r = tid >> 4, c4 = tid & 15;
#pragma unroll
            for (int hh = 0; hh < 2; ++hh) { const int rr = r + hh * 32; const float4 v = *(const float4*)(src + (size_t)(kt * 64 + rr) * ldN + nt * 64 + c4 * 4);
                tile[rr * 65 + c4 * 4 + 0] = v.x; tile[rr * 65 + c4 * 4 + 1] = v.y; tile[rr * 65 + c4 * 4 + 2] = v.z; tile[rr * 65 + c4 * 4 + 3] = v.w; }
        }
        __syncthreads();
        {   const int n = tid >> 3, kc = tid & 7; const int ncol = nt * 64 + n; int drow = ncol;
            if (kind) drow = e * 512 + (ncol / GU_IG) * (2 * GU_IG) + (kind == 2 ? GU_IG : 0) + (ncol % GU_IG);
            uint4 o; o.x = pack2(tile[(kc * 8 + 0) * 65 + n], tile[(kc * 8 + 1) * 65 + n]); o.y = pack2(tile[(kc * 8 + 2) * 65 + n], tile[(kc * 8 + 3) * 65 + n]);
            o.z = pack2(tile[(kc * 8 + 4) * 65 + n], tile[(kc * 8 + 5) * 65 + n]); o.w = pack2(tile[(kc * 8 + 6) * 65 + n], tile[(kc * 8 + 7) * 65 + n]);
            *(uint4*)(dst + (size_t)drow * ldK + kt * 64 + kc * 8) = o;
        }
        __syncthreads();
    }
}

__device__ __forceinline__ void phase_norm1(const Params& p, int l) {
    const int tid = ltid(), lane = tid & 63, wid = tid >> 6;
    const int ntok = (l == DEPTH) ? T_LAT : T_ALL;
    for (int t = blockIdx.x * 8 + wid; t < ntok; t += gridDim.x * 8) {
        const int v = tok_variant(t);
        float4 xv[4];
        if (l == 0) {
            const float* src = t < T_LAT ? p.x + (size_t)t * 1024 : p.ctx + (size_t)(t - T_LAT) * 1024;
#pragma unroll
            for (int i = 0; i < 4; ++i) xv[i] = *(const float4*)(src + i * 256 + lane * 4);
        } else {
            const float* src = p.xs + (size_t)t * 1024;
#pragma unroll
            for (int i = 0; i < 4; ++i) xv[i] = *(const float4*)(src + i * 256 + lane * 4);
            const bool had_moe = (l - 1 < DEPTH - 1) || t < T_LAT;
            if (had_moe) {
                const int s0 = p.slot[t * 2], s1 = p.slot[t * 2 + 1]; const float w0 = p.ewt[t * 2], w1 = p.ewt[t * 2 + 1];
                const float* gt = p.modv + (size_t)((l - 1) * 5 + v) * 6144 + 5120;
#pragma unroll
                for (int i = 0; i < 4; ++i) { const int c = i * 256 + lane * 4;
                    const uint2 y0 = *(const uint2*)(p.Y + (size_t)s0 * 1024 + c), y1 = *(const uint2*)(p.Y + (size_t)s1 * 1024 + c);
                    const float4 g = *(const float4*)(gt + c);
                    xv[i].x += g.x * (w0 * bf2f((bf16_t)(y0.x & 0xffff)) + w1 * bf2f((bf16_t)(y1.x & 0xffff)));
                    xv[i].y += g.y * (w0 * bf2f((bf16_t)(y0.x >> 16)) + w1 * bf2f((bf16_t)(y1.x >> 16)));
                    xv[i].z += g.z * (w0 * bf2f((bf16_t)(y0.y & 0xffff)) + w1 * bf2f((bf16_t)(y1.y & 0xffff)));
                    xv[i].w += g.w * (w0 * bf2f((bf16_t)(y0.y >> 16)) + w1 * bf2f((bf16_t)(y1.y >> 16))); }
            }
        }
        float ss = 0.f;
#pragma unroll
        for (int i = 0; i < 4; ++i) ss += xv[i].x * xv[i].x + xv[i].y * xv[i].y + xv[i].z * xv[i].z + xv[i].w * xv[i].w;
        ss = wave_sum(ss);
        const float rstd = rsqrtf(ss * (1.0f / 1024.0f) + 1e-6f);
        if (l == DEPTH) {
#pragma unroll
            for (int i = 0; i < 4; ++i) { const int c = i * 256 + lane * 4; const float4 g = *(const float4*)(p.g_final + c);
                float4 o; o.x = xv[i].x * rstd * g.x; o.y = xv[i].y * rstd * g.y; o.z = xv[i].z * rstd * g.z; o.w = xv[i].w * rstd * g.w;
                *(float4*)(p.out + (size_t)t * 1024 + c) = o; }
        } else {
            const float* mv = p.modv + (size_t)(l * 5 + v) * 6144;
#pragma unroll
            for (int i = 0; i < 4; ++i) { const int c = i * 256 + lane * 4;
                *(float4*)(p.xs + (size_t)t * 1024 + c) = xv[i];
                const float4 g = *(const float4*)(p.g_attn + l * 1024 + c), sh = *(const float4*)(mv + c), sc = *(const float4*)(mv + 1024 + c);
                uint2 o; o.x = pack2(xv[i].x * rstd * g.x * (1.f + sc.x) + sh.x, xv[i].y * rstd * g.y * (1.f + sc.y) + sh.y);
                o.y = pack2(xv[i].z * rstd * g.z * (1.f + sc.z) + sh.z, xv[i].w * rstd * g.w * (1.f + sc.w) + sh.w);
                *(uint2*)(p.h + (size_t)t * 1024 + c) = o; }
        }
    }
}

#define SG_STRIDE 144
#define SG_BOFF (128 * SG_STRIDE)
struct RowsLinear { const bf16_t* base; size_t ld; __device__ __forceinline__ const bf16_t* operator()(int r) const { return base + (size_t)r * ld; } };
template <class ARow>
__device__ __forceinline__ void gemm_core(unsigned char* smem, const ARow& arow, const bf16_t* Bt, size_t ldb, int k0, int k1, f32x4 (&acc)[2][4]) {
    const int tid = ltid(), lane = tid & 63, wid = tid >> 6, wm = wid >> 1, wn = wid & 1;
    const int row0 = tid >> 3, kc = tid & 7;
    const bf16_t* pa0 = arow(row0) + kc * 8; const bf16_t* pa1 = arow(row0 + 64) + kc * 8;
    const bf16_t* pb0 = Bt + (size_t)row0 * ldb + kc * 8; const bf16_t* pb1 = Bt + (size_t)(row0 + 64) * ldb + kc * 8;
    const int soff0 = row0 * SG_STRIDE + kc * 16, soff1 = soff0 + 64 * SG_STRIDE;
    uint4 ra0 = *(const uint4*)(pa0 + k0), ra1 = *(const uint4*)(pa1 + k0), rb0 = *(const uint4*)(pb0 + k0), rb1 = *(const uint4*)(pb1 + k0);
    const int fa = (wm * 32 + (lane & 15)) * SG_STRIDE + (lane >> 4) * 16, fb = SG_BOFF + (wn * 64 + (lane & 15)) * SG_STRIDE + (lane >> 4) * 16;
    for (int k = k0; k < k1; k += 64) {
        __syncthreads();
        *(uint4*)(smem + soff0) = ra0; *(uint4*)(smem + soff1) = ra1; *(uint4*)(smem + SG_BOFF + soff0) = rb0; *(uint4*)(smem + SG_BOFF + soff1) = rb1;
        __syncthreads();
        if (k + 64 < k1) { ra0 = *(const uint4*)(pa0 + k + 64); ra1 = *(const uint4*)(pa1 + k + 64); rb0 = *(const uint4*)(pb0 + k + 64); rb1 = *(const uint4*)(pb1 + k + 64); }
#pragma unroll
        for (int ks = 0; ks < 2; ++ks) {
            const bf16x8 af0 = *(const bf16x8*)(smem + fa + ks * 64), af1 = *(const bf16x8*)(smem + fa + 16 * SG_STRIDE + ks * 64);
            const bf16x8 b0 = *(const bf16x8*)(smem + fb + ks * 64), b1 = *(const bf16x8*)(smem + fb + 16 * SG_STRIDE + ks * 64);
            const bf16x8 b2 = *(const bf16x8*)(smem + fb + 32 * SG_STRIDE + ks * 64), b3 = *(const bf16x8*)(smem + fb + 48 * SG_STRIDE + ks * 64);
            acc[0][0] = __builtin_amdgcn_mfma_f32_16x16x32_bf16(b0, af0, acc[0][0], 0, 0, 0); acc[0][1] = __builtin_amdgcn_mfma_f32_16x16x32_bf16(b1, af0, acc[0][1], 0, 0, 0);
            acc[0][2] = __builtin_amdgcn_mfma_f32_16x16x32_bf16(b2, af0, acc[0][2], 0, 0, 0); acc[0][3] = __builtin_amdgcn_mfma_f32_16x16x32_bf16(b3, af0, acc[0][3], 0, 0, 0);
            acc[1][0] = __builtin_amdgcn_mfma_f32_16x16x32_bf16(b0, af1, acc[1][0], 0, 0, 0); acc[1][1] = __builtin_amdgcn_mfma_f32_16x16x32_bf16(b1, af1, acc[1][1], 0, 0, 0);
            acc[1][2] = __builtin_amdgcn_mfma_f32_16x16x32_bf16(b2, af1, acc[1][2], 0, 0, 0); acc[1][3] = __builtin_amdgcn_mfma_f32_16x16x32_bf16(b3, af1, acc[1][3], 0, 0, 0);
        }
    }
}
__device__ __forceinline__ void zero_acc(f32x4 (&acc)[2][4]) {
#pragma unroll
    for (int a = 0; a < 2; ++a)
#pragma unroll
        for (int b = 0; b < 4; ++b) acc[a][b] = (f32x4){0.f, 0.f, 0.f, 0.f};
}
__device__ __forceinline__ void store4bf(bf16_t* dst, f32x4 v) { uint2 o; o.x = pack2(v[0], v[1]); o.y = pack2(v[2], v[3]); *(uint2*)dst = o; }

__device__ __forceinline__ void phase_gemm_in(const Params& p, int l, unsigned char* smem) {
    const int tid = ltid(), lane = tid & 63, wid = tid >> 6, wm = wid >> 1, wn = wid & 1, q4 = (lane >> 4) * 4;
    const int nM = T_ALL / 128, nN = IN_COLS / 128;
    for (int tile = blockIdx.x; tile < nM * nN; tile += gridDim.x) {
        const int tm = tile / nN, tn = tile % nN, m0 = tm * 128, n0 = tn * 128;
        f32x4 acc[2][4]; zero_acc(acc);
        RowsLinear ar{p.h + (size_t)m0 * 1024, 1024};
        gemm_core(smem, ar, p.wt_in + (size_t)n0 * 1024, 1024, 0, 1024, acc);
        const int cb = n0 + wn * 64;
#pragma unroll
        for (int mi = 0; mi < 2; ++mi) {
            const int t = m0 + wm * 32 + mi * 16 + (lane & 15);
            f32x4 v0 = acc[mi][0], v1 = acc[mi][1], v2 = acc[mi][2], v3 = acc[mi][3];
            if (cb >= 2560) {
                bf16_t* dst = p.uG + (size_t)t * UG_LD + (cb - 2560) + q4;
#pragma unroll
                for (int e = 0; e < 4; ++e) { v0[e] = 1.f / (1.f + __expf(-v0[e])); v1[e] = 1.f / (1.f + __expf(-v1[e])); v2[e] = 1.f / (1.f + __expf(-v2[e])); v3[e] = 1.f / (1.f + __expf(-v3[e])); }
                store4bf(dst, v0); store4bf(dst + 16, v1); store4bf(dst + 32, v2); store4bf(dst + 48, v3);
            } else {
                const bool isq = (cb >= 768 && cb < 1152) || (cb >= 1920 && cb < 2304);
                const bool rope = (cb >= 1920 && cb < 2432) && (t < T_LAT);
                if (rope) { const int pos = t & 8191, r = pos >> 6, cc = pos & 63;
#pragma unroll
                    for (int e = 0; e < 4; ++e) {
                        const float2 csr = *(const float2*)(p.ropet + (r * 16 + q4 + e) * 2), csc = *(const float2*)(p.ropet + (cc * 16 + q4 + e) * 2);
                        const float a1 = v0[e], a2 = v1[e]; v0[e] = a1 * csr.x - a2 * csr.y; v1[e] = a1 * csr.y + a2 * csr.x;
                        const float b1 = v2[e], b2 = v3[e]; v2[e] = b1 * csc.x - b2 * csc.y; v3[e] = b1 * csc.y + b2 * csc.x; } }
                if (isq) { v0 = v0 * 0.125f; v1 = v1 * 0.125f; v2 = v2 * 0.125f; v3 = v3 * 0.125f; }
                bf16_t* dst = p.uA + (size_t)t * UA_LD + cb + q4;
                store4bf(dst, v0); store4bf(dst + 16, v1); store4bf(dst + 32, v2); store4bf(dst + 48, v3);
            }
        }
    }
}

struct KmNA { int b, r, c, rs, cs; const float* rpb;
    __device__ __forceinline__ int tok(int kk) const { if (kk < 128) return b * SEQ + (rs + (kk >> 4)) * 64 + cs + (kk & 15); return T_LAT + b * CTXL + (kk - 128); }
    __device__ __forceinline__ float bias(int kk) const { if (kk < 128) return rpb[(rs + (kk >> 4) - r + 7) * 31 + (cs + (kk & 15) - c + 15)]; return 0.f; } };
struct KmSWA { int b, i;
    __device__ __forceinline__ int tok(int kk) const { if (kk < 257) { const int j = i - 128 + kk; return (j >= 0 && j < SEQ) ? b * SEQ + j : -1; } if (kk < 513) return T_LAT + b * CTXL + (kk - 257); return -1; }
    __device__ __forceinline__ float bias(int) const { return 0.f; } };
struct KmCtx { int b;
    __device__ __forceinline__ int tok(int kk) const { return T_LAT + b * CTXL + kk; }
    __device__ __forceinline__ float bias(int) const { return 0.f; } };

template <int NI, class KM>
__device__ __forceinline__ void attn_item(const bf16_t* uA, int tq, int qcol, int kcol, int vcol, const KM& km, bool has_sink, float sink, bf16_t* outp, int lane) {
    float q[64];
    {   const uint4* qp = (const uint4*)(uA + (size_t)tq * UA_LD + qcol);
#pragma unroll
        for (int c = 0; c < 8; ++c) { const uint4 v = qp[c];
            q[c * 8 + 0] = bf2f((bf16_t)(v.x & 0xffff)); q[c * 8 + 1] = bf2f((bf16_t)(v.x >> 16)); q[c * 8 + 2] = bf2f((bf16_t)(v.y & 0xffff)); q[c * 8 + 3] = bf2f((bf16_t)(v.y >> 16));
            q[c * 8 + 4] = bf2f((bf16_t)(v.z & 0xffff)); q[c * 8 + 5] = bf2f((bf16_t)(v.z >> 16)); q[c * 8 + 6] = bf2f((bf16_t)(v.w & 0xffff)); q[c * 8 + 7] = bf2f((bf16_t)(v.w >> 16)); } }
    float s[NI]; float mx = -3.0e38f;
#pragma unroll
    for (int i = 0; i < NI; ++i) { const int kk = i * 64 + lane; const int tk = km.tok(kk);
        float d = -3.0e38f;
        if (tk >= 0) { const uint4* kp = (const uint4*)(uA + (size_t)tk * UA_LD + kcol); d = 0.f;
#pragma unroll
            for (int c = 0; c < 8; ++c) { const uint4 v = kp[c];
                d += q[c * 8 + 0] * bf2f((bf16_t)(v.x & 0xffff)) + q[c * 8 + 1] * bf2f((bf16_t)(v.x >> 16)) + q[c * 8 + 2] * bf2f((bf16_t)(v.y & 0xffff)) + q[c * 8 + 3] * bf2f((bf16_t)(v.y >> 16))
                   + q[c * 8 + 4] * bf2f((bf16_t)(v.z & 0xffff)) + q[c * 8 + 5] * bf2f((bf16_t)(v.z >> 16)) + q[c * 8 + 6] * bf2f((bf16_t)(v.w & 0xffff)) + q[c * 8 + 7] * bf2f((bf16_t)(v.w >> 16)); }
            d += km.bias(kk); }
        s[i] = d; mx = fmaxf(mx, d); }
    mx = wave_max(mx); if (has_sink) mx = fmaxf(mx, sink);
    float sum = 0.f;
#pragma unroll
    for (int i = 0; i < NI; ++i) { const float pv = s[i] > -1.0e38f ? __expf(s[i] - mx) : 0.f; s[i] = pv; sum += pv; }
    sum = wave_sum(sum); if (has_sink) sum += __expf(sink - mx);
    const float inv = 1.0f / sum;
    float o = 0.f;
#pragma unroll
    for (int i = 0; i < NI; ++i) {
        for (int sl = 0; sl < 64; ++sl) { const int tk = km.tok(i * 64 + sl); const float pv = __shfl(s[i], sl);
            if (tk >= 0) o += pv * bf2f(uA[(size_t)tk * UA_LD + vcol + lane]); } }
    outp[lane] = f2bf(o * inv);
}

__device__ __forceinline__ void phase_mix(const Params& p, int l) {
    const int tid = ltid(), lane = tid & 63, wid = tid >> 6;
    const bool need_ctx = l < DEPTH - 1;
    {   const int ntok = need_ctx ? T_ALL : T_LAT; const float* cw = p.conv_w + l * 3 * 256;
        for (int idx = blockIdx.x * NTHR + tid; idx < ntok * 256; idx += gridDim.x * NTHR) { const int t = idx >> 8, c = idx & 255;
            int pos, len; if (t < T_LAT) { pos = t & 8191; len = SEQ; } else { pos = (t - T_LAT) & 255; len = CTXL; }
            const bf16_t* u = p.uA + (size_t)t * UA_LD + c;
            const float z1 = bf2f(u[512]) * bf2f(u[0]);
            const float z0 = pos > 0 ? bf2f(u[512 - UA_LD]) * bf2f(u[-UA_LD]) : 0.f;
            const float z2 = pos + 1 < len ? bf2f(u[512 + UA_LD]) * bf2f(u[UA_LD]) : 0.f;
            const float y = bf2f(u[256]) * (z0 * cw[c] + z1 * cw[256 + c] + z2 * cw[512 + c]);
            p.ycat[(size_t)t * 1024 + c] = f2bf(y); } }
    const int n_lat = T_LAT * 12, n_all = n_lat + (need_ctx ? T_CTX * 12 : 0);
    for (int it = blockIdx.x * 8 + wid; it < n_all; it += gridDim.x * 8) {
        if (it < n_lat) { const int t = it / 12, hh = it % 12; const int b = t >> 13, pos = t & 8191;
            if (hh < 6) { KmNA km; km.b = b; km.r = pos >> 6; km.c = pos & 63; km.rs = min(max(km.r - 4, 0), 120); km.cs = min(max(km.c - 8, 0), 48); km.rpb = p.rpb + ((size_t)l * 6 + hh) * 15 * 31;
                attn_item<6>(p.uA, t, 768 + hh * 64, 1152 + hh * 64, 1536 + hh * 64, km, false, 0.f, p.ycat + (size_t)t * 1024 + 256 + hh * 64, lane); }
            else { const int hq = hh - 6, kh = hq / 3; KmSWA km; km.b = b; km.i = pos;
                attn_item<9>(p.uA, t, 1920 + hq * 64, 2304 + kh * 64, 2432 + kh * 64, km, true, p.sinks[l * 6 + hq], p.ycat + (size_t)t * 1024 + 640 + hq * 64, lane); }
        } else { const int it2 = it - n_lat; const int tc = it2 / 12, hh = it2 % 12; const int t = T_LAT + tc; KmCtx km; km.b = tc >> 8;
            if (hh < 6) attn_item<4>(p.uA, t, 768 + hh * 64, 1152 + hh * 64, 1536 + hh * 64, km, false, 0.f, p.ycat + (size_t)t * 1024 + 256 + hh * 64, lane);
            else { const int hq = hh - 6, kh = hq / 3; attn_item<4>(p.uA, t, 1920 + hq * 64, 2304 + kh * 64, 2432 + kh * 64, km, true, p.sinks[l * 6 + hq], p.ycat + (size_t)t * 1024 + 640 + hq * 64, lane); }
        }
    }
}


typedef float f32x16 __attribute__((ext_vector_type(16)));
typedef short s16x4 __attribute__((ext_vector_type(4)));
#define AT_STRIDE 144
#define AT_KBUF(b) ((b) * 9216)
#define AT_VBUF(b) (18432 + (b) * 9216)
#define AT_RPB 36864
#define LOG2E 1.4426950408889634f
#define AT_NEG (-1.0e30f)

template <int MK>
__device__ __forceinline__ void attn_tile(const unsigned char* kt, const unsigned char* vlane, const bf16x8 (&qf)[4], f32x16 (&oacc)[2], float& m, float& lsum,
                                          const float* rpb_row, int relc0  , int lo0  , int lane) {
    const int n = lane & 31, hh = lane >> 5;
    f32x16 sc;
#pragma unroll
    for (int r = 0; r < 16; ++r) sc[r] = 0.f;
#pragma unroll
    for (int sp = 0; sp < 4; ++sp) { const bf16x8 kf = *(const bf16x8*)(kt + n * AT_STRIDE + sp * 32 + hh * 16); sc = __builtin_amdgcn_mfma_f32_32x32x16_bf16(kf, qf[sp], sc, 0, 0, 0); }
    float mx = AT_NEG;
#pragma unroll
    for (int r = 0; r < 16; ++r) { const int i = (r & 3) + 8 * (r >> 2) + 4 * hh; float v = sc[r];
        if (MK == 1) { const bool ok = (i >= lo0) && (i < lo0 + 16); const int ridx = ok ? (relc0 + i) : 0; v = ok ? (v + rpb_row[ridx]) * LOG2E : AT_NEG; }
        else if (MK == 2) v = (i >= n) ? v * LOG2E : AT_NEG;
        else if (MK == 3) v = (i <= n) ? v * LOG2E : AT_NEG;
        else v = v * LOG2E;
        sc[r] = v; mx = fmaxf(mx, v); }
    mx = fmaxf(mx, __shfl_xor(mx, 32));
    const float mn = fmaxf(m, mx); const float alpha = __builtin_amdgcn_exp2f(m - mn); m = mn;
    float ps = 0.f;
#pragma unroll
    for (int r = 0; r < 16; ++r) { const float pv = __builtin_amdgcn_exp2f(sc[r] - mn); sc[r] = pv; ps += pv; }
    lsum = lsum * alpha + ps;
#pragma unroll
    for (int r = 0; r < 16; ++r) { oacc[0][r] *= alpha; oacc[1][r] *= alpha; }
    bf16x8 pf[2];
#pragma unroll
    for (int s2 = 0; s2 < 2; ++s2)
#pragma unroll
        for (int j = 0; j < 8; ++j) pf[s2][j] = (short)f2bf(sc[s2 * 8 + j]);
#pragma unroll
    for (int c = 0; c < 2; ++c)
#pragma unroll
        for (int s2 = 0; s2 < 2; ++s2) {
            const s16x4 v0 = __builtin_amdgcn_ds_read_tr16_b64_v4i16((LAS s16x4*)(vlane + (16 * s2) * AT_STRIDE + 64 * c));
            const s16x4 v1 = __builtin_amdgcn_ds_read_tr16_b64_v4i16((LAS s16x4*)(vlane + (16 * s2 + 8) * AT_STRIDE + 64 * c));
            bf16x8 vf; vf[0] = v0[0]; vf[1] = v0[1]; vf[2] = v0[2]; vf[3] = v0[3]; vf[4] = v1[0]; vf[5] = v1[1]; vf[6] = v1[2]; vf[7] = v1[3];
            oacc[c] = __builtin_amdgcn_mfma_f32_32x32x16_bf16(vf, pf[s2], oacc[c], 0, 0, 0);
        }
}

template <int MODE>
__device__ __forceinline__ void attn_unit(const Params& p, int l, int u, unsigned char* smem) {
    const int tid = ltid(), lane = tid & 63, wid = tid >> 6;
    int b, qcol, kcol, vcol, ocol, qtok; bool has_sink = false; float sinkv = 0.f;
    int nsteps, krlo = 0, r = 0, rs = 0, c = 0, cs = 0, q0 = 0, jwlo = 0;
    if (MODE == 0) { b = u / 192; const int rem = u % 192, h = rem / 32, rg = rem % 32; qcol = 768 + h * 64; kcol = 1152 + h * 64; vcol = 1536 + h * 64; ocol = 256 + h * 64;
        r = rg * 4 + (wid >> 1); rs = min(max(r - 4, 0), 120); c = 32 * (wid & 1) + (lane & 31); cs = min(max(c - 8, 0), 48);
        krlo = min(max(rg * 4 - 4, 0), 120); const int krhi = min(max(rg * 4 + 3 - 4, 0), 120) + 7; nsteps = 4 + (krhi - krlo + 1);
        qtok = b * SEQ + r * 64 + 32 * (wid & 1);
        for (int i = tid; i < 15 * 31; i += NTHR) ((float*)(smem + AT_RPB))[i] = p.rpb[((size_t)l * 6 + h) * 465 + i];
    } else if (MODE == 1) { b = u / 192; const int rem = u % 192, hq = rem / 32, qb = rem % 32, kh = hq / 3; qcol = 1920 + hq * 64; kcol = 2304 + kh * 64; vcol = 2432 + kh * 64; ocol = 640 + hq * 64;
        q0 = qb * 256; jwlo = (q0 == 0) ? 2 : 0; const int jwhi = min(8, (SEQ - q0 + 128) / 64); nsteps = 4 + (jwhi - jwlo);
        qtok = b * SEQ + q0 + 32 * wid; has_sink = true; sinkv = p.sinks[l * 6 + hq];
    } else { b = u / 12; const int hh = u % 12;
        if (hh < 6) { qcol = 768 + hh * 64; kcol = 1152 + hh * 64; vcol = 1536 + hh * 64; ocol = 256 + hh * 64; }
        else { const int hq = hh - 6, kh = hq / 3; qcol = 1920 + hq * 64; kcol = 2304 + kh * 64; vcol = 2432 + kh * 64; ocol = 640 + hq * 64; has_sink = true; sinkv = p.sinks[l * 6 + hq]; }
        nsteps = 4; qtok = T_LAT + b * CTXL + 32 * wid;
    }
    const bf16_t* uA = p.uA;
    bf16x8 qf[4];
    {   const bf16_t* qp = uA + (size_t)(qtok + (lane & 31)) * UA_LD + qcol + (lane >> 5) * 8;
#pragma unroll
        for (int sp = 0; sp < 4; ++sp) qf[sp] = *(const bf16x8*)(qp + sp * 16); }
    f32x16 oacc[2];
#pragma unroll
    for (int r16 = 0; r16 < 16; ++r16) { oacc[0][r16] = 0.f; oacc[1][r16] = 0.f; }
    float m = has_sink ? sinkv * LOG2E : AT_NEG, lsum = (has_sink && lane < 32) ? 1.f : 0.f;
    const int skey = tid >> 3, sch = tid & 7; const int soff = skey * AT_STRIDE + sch * 16;
    auto chunk_tok = [&](int j) -> int {
        if (j < 4) return T_LAT + b * CTXL + 64 * j;
        if (MODE == 0) return b * SEQ + (krlo + (j - 4)) * 64;
        return b * SEQ + q0 - 128 + 64 * (jwlo + (j - 4)); };
    uint4 rk, rv;
    {   const bf16_t* src = uA + (size_t)(chunk_tok(0) + skey) * UA_LD + sch * 8; rk = *(const uint4*)(src + kcol); rv = *(const uint4*)(src + vcol); }
    *(uint4*)(smem + AT_KBUF(0) + soff) = rk; *(uint4*)(smem + AT_VBUF(0) + soff) = rv;
    __syncthreads();
    const int vl_off = (4 * (lane >> 5) + ((lane & 15) >> 2)) * AT_STRIDE + (16 * ((lane >> 4) & 1) + 4 * (lane & 3)) * 2;
    const float* rpb_s = (const float*)(smem + AT_RPB);
    for (int j = 0; j < nsteps; ++j) {
        const int buf = j & 1;
        if (j + 1 < nsteps) { const bf16_t* src = uA + (size_t)(chunk_tok(j + 1) + skey) * UA_LD + sch * 8; rk = *(const uint4*)(src + kcol); rv = *(const uint4*)(src + vcol); }
        const unsigned char* kb = smem + AT_KBUF(buf); const unsigned char* vb = smem + AT_VBUF(buf) + vl_off;
        if (j < 4) {
            attn_tile<0>(kb, vb, qf, oacc, m, lsum, rpb_s, 0, 0, lane);
            attn_tile<0>(kb + 32 * AT_STRIDE, vb + 32 * AT_STRIDE, qf, oacc, m, lsum, rpb_s, 0, 0, lane);
        } else if (MODE == 0) {
            const int kr = krlo + (j - 4);
            if (kr >= rs && kr < rs + 8) { const float* rrow = rpb_s + (kr - r + 7) * 31;
                attn_tile<1>(kb, vb, qf, oacc, m, lsum, rrow, 0 - c + 15, cs, lane);
                attn_tile<1>(kb + 32 * AT_STRIDE, vb + 32 * AT_STRIDE, qf, oacc, m, lsum, rrow, 32 - c + 15, cs - 32, lane); }
        } else if (MODE == 1) {
            const int qp0 = q0 + 32 * wid;
#pragma unroll
            for (int tl = 0; tl < 2; ++tl) { const int kp0 = q0 - 128 + 64 * (jwlo + (j - 4)) + 32 * tl; const int d = kp0 - qp0;
                const unsigned char* kt = kb + tl * 32 * AT_STRIDE; const unsigned char* vt = vb + tl * 32 * AT_STRIDE;
                if (d == -128) attn_tile<2>(kt, vt, qf, oacc, m, lsum, rpb_s, 0, 0, lane);
                else if (d == 128) attn_tile<3>(kt, vt, qf, oacc, m, lsum, rpb_s, 0, 0, lane);
                else if (d > -128 && d < 128) attn_tile<0>(kt, vt, qf, oacc, m, lsum, rpb_s, 0, 0, lane); }
        }
        if (j + 1 < nsteps) { *(uint4*)(smem + AT_KBUF(buf ^ 1) + soff) = rk; *(uint4*)(smem + AT_VBUF(buf ^ 1) + soff) = rv; }
        __syncthreads();
    }
    const float ltot = lsum + __shfl_xor(lsum, 32); const float inv = 1.0f / ltot;
    bf16_t* op = p.ycat + (size_t)(qtok + (lane & 31)) * 1024 + ocol + 4 * (lane >> 5);
#pragma unroll
    for (int cc = 0; cc < 2; ++cc)
#pragma unroll
        for (int g = 0; g < 4; ++g) { f32x4 v; v[0] = oacc[cc][4 * g] * inv; v[1] = oacc[cc][4 * g + 1] * inv; v[2] = oacc[cc][4 * g + 2] * inv; v[3] = oacc[cc][4 * g + 3] * inv;
            store4bf(op + 32 * cc + 8 * g, v); }
}

__device__ __forceinline__ void phase_mix2(const Params& p, int l, unsigned char* smem) {
    const int tid = ltid();
    const bool need_ctx = l < DEPTH - 1;
    {   const int ntok = need_ctx ? T_ALL : T_LAT; const float* cw = p.conv_w + l * 3 * 256;
        for (int idx = blockIdx.x * NTHR + tid; idx < ntok * 256; idx += gridDim.x * NTHR) { const int t = idx >> 8, c = idx & 255;
            int pos, len; if (t < T_LAT) { pos = t & 8191; len = SEQ; } else { pos = (t - T_LAT) & 255; len = CTXL; }
            const bf16_t* u = p.uA + (size_t)t * UA_LD + c;
            const float z1 = bf2f(u[512]) * bf2f(u[0]);
            const float z0 = pos > 0 ? bf2f(u[512 - UA_LD]) * bf2f(u[-UA_LD]) : 0.f;
            const float z2 = pos + 1 < len ? bf2f(u[512 + UA_LD]) * bf2f(u[UA_LD]) : 0.f;
            const float y = bf2f(u[256]) * (z0 * cw[c] + z1 * cw[256 + c] + z2 * cw[512 + c]);
            p.ycat[(size_t)t * 1024 + c] = f2bf(y); } }
    for (int u = blockIdx.x; u < 768; u += gridDim.x) attn_unit<0>(p, l, u, smem);
    for (int u = blockIdx.x; u < 768; u += gridDim.x) attn_unit<1>(p, l, u, smem);
    if (need_ctx) for (int u = blockIdx.x; u < 48; u += gridDim.x) attn_unit<2>(p, l, u, smem);
}

__device__ __forceinline__ void phase_gemm_merge(const Params& p, int l, unsigned char* smem) {
    const int tid = ltid(), lane = tid & 63, wid = tid >> 6, wm = wid >> 1, wn = wid & 1, q4 = (lane >> 4) * 4;
    const int ntok = (l < DEPTH - 1) ? T_ALL : T_LAT; const int nM = ntok / 128, nN = 8;
    for (int tile = blockIdx.x; tile < nM * nN; tile += gridDim.x) {
        const int tm = tile / nN, tn = tile % nN, m0 = tm * 128, n0 = tn * 128;
        f32x4 macc[2][4]; zero_acc(macc);
        RowsLinear ar{p.ycat + (size_t)m0 * 1024, 1024};
#pragma unroll
        for (int seg = 0; seg < 3; ++seg) {
            const int k0 = seg == 0 ? 0 : (seg == 1 ? 256 : 640), k1 = seg == 0 ? 256 : (seg == 1 ? 640 : 1024);
            f32x4 acc[2][4]; zero_acc(acc);
            gemm_core(smem, ar, p.wt_br + (size_t)n0 * 1024, 1024, k0, k1, acc);
#pragma unroll
            for (int mi = 0; mi < 2; ++mi) { const int t = m0 + wm * 32 + mi * 16 + (lane & 15);
#pragma unroll
                for (int nj = 0; nj < 4; ++nj) { const uint2 g = *(const uint2*)(p.uG + (size_t)t * UG_LD + seg * 1024 + n0 + wn * 64 + nj * 16 + q4);
                    macc[mi][nj][0] += bf2f((bf16_t)(g.x & 0xffff)) * acc[mi][nj][0]; macc[mi][nj][1] += bf2f((bf16_t)(g.x >> 16)) * acc[mi][nj][1];
                    macc[mi][nj][2] += bf2f((bf16_t)(g.y & 0xffff)) * acc[mi][nj][2]; macc[mi][nj][3] += bf2f((bf16_t)(g.y >> 16)) * acc[mi][nj][3]; } }
        }
#pragma unroll
        for (int mi = 0; mi < 2; ++mi) { const int t = m0 + wm * 32 + mi * 16 + (lane & 15);
#pragma unroll
            for (int nj = 0; nj < 4; ++nj) store4bf(p.mbuf + (size_t)t * 1024 + n0 + wn * 64 + nj * 16 + q4, macc[mi][nj]); }
    }
}

__device__ __forceinline__ void phase_gemm_o(const Params& p, int l, unsigned char* smem) {
    const int tid = ltid(), lane = tid & 63, wid = tid >> 6, wm = wid >> 1, wn = wid & 1, q4 = (lane >> 4) * 4;
    const int ntok = (l < DEPTH - 1) ? T_ALL : T_LAT; const int nM = ntok / 128, nN = 8;
    for (int tile = blockIdx.x; tile < nM * nN; tile += gridDim.x) {
        const int tm = tile / nN, tn = tile % nN, m0 = tm * 128, n0 = tn * 128;
        f32x4 acc[2][4]; zero_acc(acc);
        RowsLinear ar{p.mbuf + (size_t)m0 * 1024, 1024};
        gemm_core(smem, ar, p.wt_o + (size_t)n0 * 1024, 1024, 0, 1024, acc);
#pragma unroll
        for (int mi = 0; mi < 2; ++mi) { const int t = m0 + wm * 32 + mi * 16 + (lane & 15); const float* gt = p.modv + (size_t)(l * 5 + tok_variant(t)) * 6144 + 2048;
#pragma unroll
            for (int nj = 0; nj < 4; ++nj) { const int c = n0 + wn * 64 + nj * 16 + q4; float4* xp = (float4*)(p.xs + (size_t)t * 1024 + c); float4 xv = *xp; const float4 g = *(const float4*)(gt + c);
                xv.x += g.x * acc[mi][nj][0]; xv.y += g.y * acc[mi][nj][1]; xv.z += g.z * acc[mi][nj][2]; xv.w += g.w * acc[mi][nj][3]; *xp = xv; } }
    }
}

__device__ __forceinline__ void phase_router(const Params& p, int l, float* smem) {
    const int tid = ltid(), lane = tid & 63, wid = tid >> 6;
    float* sh2 = smem;
    float* slg = smem + 16 * 1024;
    const int ntok = (l < DEPTH - 1) ? T_ALL : T_LAT;
    const float* wre = p.w_re + (size_t)l * 1024 * 32; const float* wrg = p.w_rg + (size_t)l * 1024 * 4;
    for (int tb = blockIdx.x; tb < ntok / 16; tb += gridDim.x) {
#pragma unroll
        for (int j = 0; j < 2; ++j) { const int tt = wid * 2 + j, t = tb * 16 + tt; const int v = tok_variant(t);
            float4 xv[4]; float ss = 0.f;
#pragma unroll
            for (int i = 0; i < 4; ++i) { xv[i] = *(const float4*)(p.xs + (size_t)t * 1024 + i * 256 + lane * 4); ss += xv[i].x * xv[i].x + xv[i].y * xv[i].y + xv[i].z * xv[i].z + xv[i].w * xv[i].w; }
            ss = wave_sum(ss); const float rstd = rsqrtf(ss * (1.0f / 1024.0f) + 1e-6f);
            const float* mv = p.modv + (size_t)(l * 5 + v) * 6144 + 3072;
#pragma unroll
            for (int i = 0; i < 4; ++i) { const int c = i * 256 + lane * 4;
                const float4 g = *(const float4*)(p.g_ffn + l * 1024 + c), sh = *(const float4*)(mv + c), sc = *(const float4*)(mv + 1024 + c);
                float4 o; o.x = xv[i].x * rstd * g.x * (1.f + sc.x) + sh.x; o.y = xv[i].y * rstd * g.y * (1.f + sc.y) + sh.y; o.z = xv[i].z * rstd * g.z * (1.f + sc.z) + sh.z; o.w = xv[i].w * rstd * g.w * (1.f + sc.w) + sh.w;
                *(float4*)(sh2 + tt * 1024 + c) = o; uint2 ob; ob.x = pack2(o.x, o.y); ob.y = pack2(o.z, o.w); *(uint2*)(p.h + (size_t)t * 1024 + c) = ob; } }
        __syncthreads();
        {   const int tt = tid >> 5, j = tid & 31; float a = 0.f; const float* hp = sh2 + tt * 1024;
#pragma unroll 8
            for (int k = 0; k < 1024; ++k) a += hp[k] * wre[k * 32 + j];
            slg[tt * 36 + 4 + j] = a + p.b_re[l * 32 + j];
            if (tid < 64) { const int t2 = tid >> 2, j2 = tid & 3; float a2 = 0.f; const float* hp2 = sh2 + t2 * 1024;
#pragma unroll 8
                for (int k = 0; k < 1024; ++k) a2 += hp2[k] * wrg[k * 4 + j2];
                slg[t2 * 36 + j2] = a2 + p.b_rg[l * 4 + j2]; } }
        __syncthreads();
        if (tid < 16) { const int t = tb * 16 + tid; const float* lg = slg + tid * 36;
            int gi = 0; float gm = lg[0];
            for (int j = 1; j < 4; ++j) if (lg[j] > gm) { gm = lg[j]; gi = j; }
            float den = 0.f; for (int j = 0; j < 4; ++j) den += expf(lg[j] - gm);
            const float pg = 1.0f / den;
            const float* le = lg + 4 + gi * 8;
            int i1 = 0; float v1 = le[0]; for (int j = 1; j < 8; ++j) if (le[j] > v1) { v1 = le[j]; i1 = j; }
            int i2 = -1; float v2 = -3.0e38f; for (int j = 0; j < 8; ++j) if (j != i1 && le[j] > v2) { v2 = le[j]; i2 = j; }
            const float e2 = expf(v2 - v1); const float wa = 1.0f / (1.0f + e2), wb = e2 / (1.0f + e2);
            const int ea = gi * 8 + i1, eb = gi * 8 + i2;
            p.eid[t * 2] = ea; p.eid[t * 2 + 1] = eb; p.ewt[t * 2] = pg * wa; p.ewt[t * 2 + 1] = pg * wb;
            p.epos[t * 2] = atomicAdd(p.cnt + l * 32 + ea, 1); p.epos[t * 2 + 1] = atomicAdd(p.cnt + l * 32 + eb, 1); }
        __syncthreads();
    }
}

__device__ __forceinline__ void phase_dispatch(const Params& p, int l, int* smem) {
    const int tid = ltid(), lane = tid & 63, wid = tid >> 6;
    int* pstart = smem;
    if (tid == 0) { int acc = 0; for (int e = 0; e < 32; ++e) { pstart[e] = acc; acc += ((p.cnt[l * 32 + e] + 255) >> 8) << 8; } pstart[32] = acc; }
    __syncthreads();
    if (blockIdx.x == 0) { const int nb = pstart[32] >> 8;
        for (int rb = tid; rb < nb; rb += NTHR) { int e = 0; while (e < 31 && pstart[e + 1] <= rb * 256) ++e; p.blk_e[rb] = e; }
        if (tid == 0) p.nbu[0] = nb; }
    const int ntok = (l < DEPTH - 1) ? T_ALL : T_LAT;
    for (int a = blockIdx.x * 8 + wid; a < ntok * 2; a += gridDim.x * 8) {
        const int t = a >> 1; const int sl = pstart[p.eid[a]] + p.epos[a];
        if (lane == 0) p.slot[a] = sl;
        const uint4* src = (const uint4*)(p.h + (size_t)t * 1024); uint4* dst = (uint4*)(p.xd + (size_t)sl * 1024);
        dst[lane] = src[lane]; dst[lane + 64] = src[lane + 64];
    }
}

__device__ __forceinline__ void phase_gemm_e1(const Params& p, unsigned char* smem) {
    const int tid = ltid(), lane = tid & 63, wid = tid >> 6, wm = wid >> 1, wn = wid & 1, q4 = (lane >> 4) * 4;
    const int nb = p.nbu[0]; const int ntiles = nb * 2 * 4;
    for (int tile = blockIdx.x; tile < ntiles; tile += gridDim.x) {
        const int rb = tile >> 2, tn = tile & 3, m0 = rb * 128, e = p.blk_e[rb >> 1];
        f32x4 acc[2][4]; zero_acc(acc);
        RowsLinear ar{p.xd + (size_t)m0 * 1024, 1024};
        gemm_core(smem, ar, p.wt_gu + ((size_t)e * 512 + tn * 128) * 1024, 1024, 0, 1024, acc);
        const int pg = tn * 2 + wn;
#pragma unroll
        for (int mi = 0; mi < 2; ++mi) { const int sl = m0 + wm * 32 + mi * 16 + (lane & 15);
#pragma unroll
            for (int nj = 0; nj < 2; ++nj) { f32x4 g = acc[mi][nj], u = acc[mi][nj + 2], o;
#pragma unroll
                for (int e4 = 0; e4 < 4; ++e4) o[e4] = g[e4] / (1.f + __expf(-g[e4])) * u[e4];
                store4bf(p.hid + (size_t)sl * 256 + pg * 32 + nj * 16 + q4, o); } }
    }
}
__device__ __forceinline__ void phase_gemm_e2(const Params& p, unsigned char* smem) {
    const int tid = ltid(), lane = tid & 63, wid = tid >> 6, wm = wid >> 1, wn = wid & 1, q4 = (lane >> 4) * 4;
    const int nb = p.nbu[0]; const int ntiles = nb * 2 * 8;
    for (int tile = blockIdx.x; tile < ntiles; tile += gridDim.x) {
        const int rb = tile >> 3, tn = tile & 7, m0 = rb * 128, n0 = tn * 128, e = p.blk_e[rb >> 1];
        f32x4 acc[2][4]; zero_acc(acc);
        RowsLinear ar{p.hid + (size_t)m0 * 256, 256};
        gemm_core(smem, ar, p.wt_d + ((size_t)e * 1024 + n0) * 256, 256, 0, 256, acc);
#pragma unroll
        for (int mi = 0; mi < 2; ++mi) { const int sl = m0 + wm * 32 + mi * 16 + (lane & 15);
#pragma unroll
            for (int nj = 0; nj < 4; ++nj) store4bf(p.Y + (size_t)sl * 1024 + n0 + wn * 64 + nj * 16 + q4, acc[mi][nj]); }
    }
}


#define XB_TMO      128
#define XB_XCNT(j)  (256  + 64 * (j))
#define XB_XSUB(j)  (1280 + 64 * (j))
#define XB_XGEN(j)  (2304 + 64 * (j))
#define XB_TOP      3328
#define XB_TOPGEN   3392
#define XCD_BAR_WORDS 3456
#define XB_SPIN_CAP (1u << 18)
__device__ __forceinline__ unsigned xb_ld(unsigned* p)              { return __hip_atomic_load(p, __ATOMIC_RELAXED, __HIP_MEMORY_SCOPE_AGENT); }
__device__ __forceinline__ unsigned xb_add(unsigned* p, unsigned v) { return __hip_atomic_fetch_add(p, v, __ATOMIC_RELAXED, __HIP_MEMORY_SCOPE_AGENT); }
__device__ __forceinline__ unsigned xb_xcc_id() { return (unsigned)__builtin_amdgcn_s_getreg((3 << 11) | 20) & 0xFu; }
#define XB_SPIN(cond, bar) do { unsigned _sp = 0; while (cond) { __builtin_amdgcn_s_sleep(1); \
    if ((++_sp & 255u) == 0u) { if (xb_ld(&(bar)[XB_TMO])) break; if (_sp > XB_SPIN_CAP) { atomicAdd(&(bar)[XB_TMO], 1u); break; } } } } while (0)
struct XcdBarrier { unsigned* bar; unsigned x; volatile LAS unsigned* st; };
__device__ __forceinline__ XcdBarrier xcd_barrier_post(unsigned* bar, volatile LAS unsigned* st) {
    XcdBarrier b; b.bar = bar; b.x = xb_xcc_id(); b.st = st;
    if (threadIdx.x == 0) (void)xb_add(&bar[XB_XCNT(b.x)], 1u);
    return b;
}
__device__ __forceinline__ void xcd_barrier_complete(unsigned* bar, unsigned x, unsigned& nloc, unsigned& nx) {
    const unsigned G = gridDim.x * gridDim.y * gridDim.z;
    unsigned sum, cnt, mine, sp = 0u;
    for (;;) {
        sum = 0u; cnt = 0u; mine = 0u;
#pragma unroll
        for (unsigned j = 0; j < 16; ++j) { const unsigned c = xb_ld(&bar[XB_XCNT(j)]); sum += c; cnt += (c > 0u) ? 1u : 0u; mine = (j == x) ? c : mine; }
        if (sum == G) break;
        __builtin_amdgcn_s_sleep(1);
        if ((++sp & 255u) == 0u) { if (xb_ld(&bar[XB_TMO])) break; if (sp > XB_SPIN_CAP) { atomicAdd(&bar[XB_TMO], 1u); break; } }
    }
    nloc = mine > 0u ? mine : 1u; nx = cnt > 0u ? cnt : 1u;
}
__device__ __forceinline__ void xcd_barrier(const XcdBarrier& b) {
    asm volatile("s_waitcnt vmcnt(0)" ::: "memory");
    __syncthreads();
    if (threadIdx.x == 0) {
        unsigned* bar = b.bar;
        __builtin_amdgcn_s_waitcnt(0);
        unsigned nloc = b.st[0], nx = b.st[1];
        if (nloc == 0u) { xcd_barrier_complete(bar, b.x, nloc, nx); b.st[0] = nloc; b.st[1] = nx; }
        const unsigned old = xb_add(&bar[XB_XSUB(b.x)], 1u);
        const unsigned gen = old / nloc;
        if (old + 1u == (gen + 1u) * nloc) {
            __builtin_amdgcn_fence(__ATOMIC_RELEASE, "agent");
            asm volatile("s_waitcnt vmcnt(0)" ::: "memory");
            const unsigned og = xb_add(&bar[XB_TOP], 1u);
            const unsigned tg = og / nx;
            if (og + 1u == (tg + 1u) * nx) xb_add(&bar[XB_TOPGEN], 1u);
            else XB_SPIN(xb_ld(&bar[XB_TOPGEN]) == tg, bar);
            __builtin_amdgcn_fence(__ATOMIC_ACQUIRE, "agent");
            xb_add(&bar[XB_XGEN(b.x)], 1u);
            asm volatile("s_waitcnt vmcnt(0)" ::: "memory");
        } else {
            XB_SPIN(xb_ld(&bar[XB_XGEN(b.x)]) == gen, bar);
            __builtin_amdgcn_fence(__ATOMIC_ACQUIRE, "agent");
            asm volatile("s_waitcnt vmcnt(0)" ::: "memory");
        }
    }
    __syncthreads();
}

#define SMEM_BYTES 73728
__global__ void __launch_bounds__(NTHR, 2) k_mega(Params p) {
    extern __shared__ __attribute__((aligned(16))) unsigned char smem[];
    volatile LAS unsigned* xbw = (volatile LAS unsigned*)(smem + SMEM_BYTES);
    if (threadIdx.x == 0) { xbw[0] = 0u; xbw[1] = 0u; xbw[2] = 0u; xbw[3] = 0u; }
    __syncthreads();
    XcdBarrier bar = xcd_barrier_post(p.bar, xbw);
    phase_mod(p, (float*)smem);
    xcd_barrier(bar);
    for (int l = 0; l < DEPTH; ++l) {
        phase_norm1(p, l); phase_wconv(p, l, (float*)smem);
        xcd_barrier(bar);
        phase_gemm_in(p, l, smem);
        xcd_barrier(bar);
        phase_mix2(p, l, smem);
        xcd_barrier(bar);
        phase_gemm_merge(p, l, smem);
        xcd_barrier(bar);
        phase_gemm_o(p, l, smem);
        xcd_barrier(bar);
        phase_router(p, l, (float*)smem);
        xcd_barrier(bar);
        phase_dispatch(p, l, (int*)smem);
        xcd_barrier(bar);
        phase_gemm_e1(p, smem);
        xcd_barrier(bar);
        phase_gemm_e2(p, smem);
        xcd_barrier(bar);
    }
    phase_norm1(p, DEPTH);
}

extern "C" void kernel_launch(void* const* d_in, const int* in_sizes, int n_in, void* d_out, int out_size, void* d_ws, size_t ws_size, hipStream_t stream) {
    Params p{};
    p.x = (const float*)d_in[0]; p.c = (const float*)d_in[1]; p.ctx = (const float*)d_in[2]; p.c_ctx = (const float*)d_in[3]; p.w_mod = (const float*)d_in[4]; p.b_mod = (const float*)d_in[5];
    p.g_attn = (const float*)d_in[6]; p.g_ffn = (const float*)d_in[7]; p.w_in = (const float*)d_in[8]; p.conv_w = (const float*)d_in[9]; p.rpb = (const float*)d_in[10]; p.sinks = (const float*)d_in[11];
    p.w_branch = (const float*)d_in[12]; p.w_o = (const float*)d_in[13]; p.w_rg = (const float*)d_in[14]; p.b_rg = (const float*)d_in[15]; p.w_re = (const float*)d_in[16]; p.b_re = (const float*)d_in[17];
    p.w_eg = (const float*)d_in[18]; p.w_eu = (const float*)d_in[19]; p.w_ed = (const float*)d_in[20]; p.g_final = (const float*)d_in[21];
    p.out = (float*)d_out;
    unsigned char* w = (unsigned char*)d_ws; size_t off = 0;
    auto take = [&](size_t bytes) { unsigned char* r = w + off; off += (bytes + 255) & ~(size_t)255; return r; };
    p.bar = (unsigned*)take(16384); p.cnt = (int*)take(DEPTH * 32 * 4); p.blk_e = (int*)take(MAXBLK * 4); p.nbu = (int*)take(256);
    p.modv = (float*)take((size_t)DEPTH * 5 * 6144 * 4); p.ropet = (float*)take(128 * 16 * 2 * 4);
    p.eid = (int*)take((size_t)T_ALL * 2 * 4); p.epos = (int*)take((size_t)T_ALL * 2 * 4); p.ewt = (float*)take((size_t)T_ALL * 2 * 4); p.slot = (int*)take((size_t)T_ALL * 2 * 4);
    p.xs = (float*)take((size_t)T_ALL * 1024 * 4);
    p.h = (bf16_t*)take((size_t)T_ALL * 1024 * 2);
    p.wt_in = (bf16_t*)take((size_t)IN_COLS * 1024 * 2); p.wt_br = (bf16_t*)take((size_t)1024 * 1024 * 2); p.wt_o = (bf16_t*)take((size_t)1024 * 1024 * 2);
    p.wt_gu = (bf16_t*)take((size_t)32 * 512 * 1024 * 2); p.wt_d = (bf16_t*)take((size_t)32 * 1024 * 256 * 2);
    p.uA = (bf16_t*)take((size_t)T_ALL * UA_LD * 2); p.uG = (bf16_t*)take((size_t)T_ALL * UG_LD * 2); p.ycat = (bf16_t*)take((size_t)T_ALL * 1024 * 2);
    p.mbuf = p.uA; p.xd = p.uA; p.hid = p.ycat; p.Y = p.uG;
    if (off > ws_size) return;
    constexpr size_t kDynLds = SMEM_BYTES + 16;
    static int grid = 0;
    if (!grid) {
        (void)hipFuncSetAttribute((const void*)k_mega, hipFuncAttributeMaxDynamicSharedMemorySize, (int)kDynLds);
        int dev = 0, cus = 0, per_cu = 0;
        (void)hipGetDevice(&dev);
        (void)hipDeviceGetAttribute(&cus, hipDeviceAttributeMultiprocessorCount, dev);
        (void)hipOccupancyMaxActiveBlocksPerMultiprocessor(&per_cu, (const void*)k_mega, NTHR, kDynLds);
        grid = cus * (per_cu < 1 ? per_cu : 1);
        if (grid <= 0) grid = 0;
    }
    if (!grid) return;
    (void)hipMemsetAsync(p.bar, 0, XCD_BAR_WORDS * sizeof(unsigned), stream);
    hipLaunchKernelGGL(k_mega, dim3(grid), dim3(NTHR), kDynLds, stream, p);
}
```

```cpp
#include <hip/hip_runtime.h>
#include <stdint.h>

typedef unsigned short bf16_t;
typedef short bf16x8 __attribute__((ext_vector_type(8)));
typedef float f32x4 __attribute__((ext_vector_type(4)));

#define D_MODEL 1024
#define NB 4
#define SEQ 8192
#define DEPTH 4
#define CTXL 256
#define T_LAT 32768
#define T_CTX 1024
#define T_ALL 33792
#define UA_LD 2560
#define UG_LD 3072
#define IN_COLS 5632
#define MAXBLK 296
#define NTHR 512
#ifndef PGM
#define PGM 31
#endif
#define LAS __attribute__((address_space(3)))

struct Params {
    const float *x, *c, *ctx, *c_ctx, *w_mod, *b_mod, *g_attn, *g_ffn, *w_in, *conv_w, *rpb, *sinks, *w_branch, *w_o, *w_rg, *b_rg, *w_re, *b_re, *w_eg, *w_eu, *w_ed, *g_final;
    float* out;
    unsigned* bar; int* cnt; int* blk_e; int* nbu;
    float* modv; float* ropet; float* xs;
    bf16_t *h, *wt_in, *wt_br, *wt_o, *wt_gu, *wt_d, *uA, *uG, *ycat, *mbuf, *xd, *hid, *Y;
    int* eid; int* epos; float* ewt; int* slot;
};

__device__ __forceinline__ int ltid() { int t = threadIdx.x; asm volatile("" : "+v"(t)); return t; }
__device__ __forceinline__ bf16_t f2bf(float f) { unsigned u = __float_as_uint(f); u += 0x7FFFu + ((u >> 16) & 1u); return (bf16_t)(u >> 16); }
__device__ __forceinline__ float bf2f(bf16_t b) { return __uint_as_float(((unsigned)b) << 16); }
__device__ __forceinline__ unsigned pack2(float a, float b) { return (unsigned)f2bf(a) | ((unsigned)f2bf(b) << 16); }
__device__ __forceinline__ float wave_sum(float v) { for (int o = 32; o > 0; o >>= 1) v += __shfl_xor(v, o); return v; }
__device__ __forceinline__ float wave_max(float v) { for (int o = 32; o > 0; o >>= 1) v = fmaxf(v, __shfl_xor(v, o)); return v; }
__device__ __forceinline__ int tok_variant(int t) { return t < T_LAT ? (t >> 13) : 4; }

__device__ __forceinline__ void phase_mod(const Params& p, float* smem) {
    const int tid = ltid(), lane = tid & 63, wid = tid >> 6;
    float* s_silu = smem;
    float* s_part = smem + 5 * 1024;
    for (int i = tid; i < 5 * 1024; i += NTHR) { const int v = i >> 10, k = i & 1023; const float cv = v < 4 ? p.c[v * 1024 + k] : p.c_ctx[k]; s_silu[i] = cv / (1.0f + expf(-cv)); }
    __syncthreads();
    for (int item = blockIdx.x; item < DEPTH * 96; item += gridDim.x) {
        const int l = item / 96, cb = item % 96, col = cb * 64 + lane;
        const float* w = p.w_mod + (size_t)l * 1024 * 6144 + col;
        float a0 = 0.f, a1 = 0.f, a2 = 0.f, a3 = 0.f, a4 = 0.f;
#pragma unroll 8
        for (int kk = 0; kk < 128; ++kk) { const int k = wid * 128 + kk; const float wv = w[(size_t)k * 6144];
            a0 += s_silu[k] * wv; a1 += s_silu[1024 + k] * wv; a2 += s_silu[2048 + k] * wv; a3 += s_silu[3072 + k] * wv; a4 += s_silu[4096 + k] * wv; }
        s_part[(wid * 5 + 0) * 64 + lane] = a0; s_part[(wid * 5 + 1) * 64 + lane] = a1; s_part[(wid * 5 + 2) * 64 + lane] = a2; s_part[(wid * 5 + 3) * 64 + lane] = a3; s_part[(wid * 5 + 4) * 64 + lane] = a4;
        __syncthreads();
        if (tid < 320) { const int v = tid >> 6, ln = tid & 63; float s = p.b_mod[l * 6144 + cb * 64 + ln];
            for (int w8 = 0; w8 < 8; ++w8) s += s_part[(w8 * 5 + v) * 64 + ln];
            p.modv[(size_t)(l * 5 + v) * 6144 + cb * 64 + ln] = s; }
        __syncthreads();
    }
    for (int i = blockIdx.x * NTHR + tid; i < 128 * 16; i += gridDim.x * NTHR) { const int pos = i >> 4, f = i & 15;
        const float inv = powf(10000.0f, -(float)f / 16.0f); const float ang = (float)pos * inv; p.ropet[i * 2] = cosf(ang); p.ropet[i * 2 + 1] = sinf(ang); }
    for (int i = blockIdx.x * NTHR + tid; i < DEPTH * 32; i += gridDim.x * NTHR) p.cnt[i] = 0;
}

#define GU_IG 128
__device__ __forceinline__ void phase_wconv(const Params& p, int l, float* smem) {
    const int tid = ltid();
    float* tile = smem;
    const int n1 = 16 * 88, n2 = 256, n3 = 256, n4 = 2048, n5 = 2048, n6 = 2048;
    const int total = n1 + n2 + n3 + n4 + n5 + n6;
    for (int it = blockIdx.x; it < total; it += gridDim.x) {
        const float* src; int ldN; bf16_t* dst; int ldK; int kt, nt; int kind = 0, e = 0; int i = it;
        if (i < n1) { src = p.w_in + (size_t)l * 1024 * IN_COLS; ldN = IN_COLS; dst = p.wt_in; ldK = 1024; kt = i / 88; nt = i % 88; }
        else if ((i -= n1) < n2) { src = p.w_branch + (size_t)l * 1024 * 1024; ldN = 1024; dst = p.wt_br; ldK = 1024; kt = i / 16; nt = i % 16; }
        else if ((i -= n2) < n3) { src = p.w_o + (size_t)l * 1024 * 1024; ldN = 1024; dst = p.wt_o; ldK = 1024; kt = i / 16; nt = i % 16; }
        else if ((i -= n3) < n4) { e = i / 64; i %= 64; src = p.w_eg + ((size_t)l * 32 + e) * 1024 * 256; ldN = 256; dst = p.wt_gu; ldK = 1024; kt = i / 4; nt = i % 4; kind = 1; }
        else if ((i -= n4) < n5) { e = i / 64; i %= 64; src = p.w_eu + ((size_t)l * 32 + e) * 1024 * 256; ldN = 256; dst = p.wt_gu; ldK = 1024; kt = i / 4; nt = i % 4; kind = 2; }
        else { i -= n5; e = i / 64; i %= 64; src = p.w_ed + ((size_t)l * 32 + e) * 256 * 1024; ldN = 1024; dst = p.wt_d + (size_t)e * 1024 * 256; ldK = 256; kt = i / 16; nt = i % 16; }
        {   const int r = tid >> 4, c4 = tid & 15;
#pragma unroll
            for (int hh = 0; hh < 2; ++hh) { const int rr = r + hh * 32; const float4 v = *(const float4*)(src + (size_t)(kt * 64 + rr) * ldN + nt * 64 + c4 * 4);
                tile[rr * 65 + c4 * 4 + 0] = v.x; tile[rr * 65 + c4 * 4 + 1] = v.y; tile[rr * 65 + c4 * 4 + 2] = v.z; tile[rr * 65 + c4 * 4 + 3] = v.w; }
        }
        __syncthreads();
        {   const int n = tid >> 3, kc = tid & 7; const int ncol = nt * 64 + n; int drow = ncol;
            if (kind) drow = e * 512 + (ncol / GU_IG) * (2 * GU_IG) + (kind == 2 ? GU_IG : 0) + (ncol % GU_IG);
            uint4 o; o.x = pack2(tile[(kc * 8 + 0) * 65 + n], tile[(kc * 8 + 1) * 65 + n]); o.y = pack2(tile[(kc * 8 + 2) * 65 + n], tile[(kc * 8 + 3) * 65 + n]);
            o.z = pack2(tile[(kc * 8 + 4) * 65 + n], tile[(kc * 8 + 5) * 65 + n]); o.w = pack2(tile[(kc * 8 + 6) * 65 + n], tile[(kc * 8 + 7) * 65 + n]);
            *(uint4*)(dst + (size_t)drow * ldK + kt * 64 + kc * 8) = o;
        }
        __syncthreads();
    }
}

__device__ __forceinline__ void phase_norm1(const Params& p, int l) {
    const int tid = ltid(), lane = tid & 63, wid = tid >> 6;
    const int ntok = (l == DEPTH) ? T_LAT : T_ALL;
    for (int t = blockIdx.x * 8 + wid; t < ntok; t += gridDim.x * 8) {
        const int v = tok_variant(t);
        float4 xv[4];
        if (l == 0) {
            const float* src = t < T_LAT ? p.x + (size_t)t * 1024 : p.ctx + (size_t)(t - T_LAT) * 1024;
#pragma unroll
            for (int i = 0; i < 4; ++i) xv[i] = *(const float4*)(src + i * 256 + lane * 4);
        } else {
            const float* src = p.xs + (size_t)t * 1024;
#pragma unroll
            for (int i = 0; i < 4; ++i) xv[i] = *(const float4*)(src + i * 256 + lane * 4);
            const bool had_moe = (l - 1 < DEPTH - 1) || t < T_LAT;
            if (had_moe) {
                const int s0 = p.slot[t * 2], s1 = p.slot[t * 2 + 1]; const float w0 = p.ewt[t * 2], w1 = p.ewt[t * 2 + 1];
                const float* gt = p.modv + (size_t)((l - 1) * 5 + v) * 6144 + 5120;
#pragma unroll
                for (int i = 0; i < 4; ++i) { const int c = i * 256 + lane * 4;
                    const uint2 y0 = *(const uint2*)(p.Y + (size_t)s0 * 1024 + c), y1 = *(const uint2*)(p.Y + (size_t)s1 * 1024 + c);
                    const float4 g = *(const float4*)(gt + c);
                    xv[i].x += g.x * (w0 * bf2f((bf16_t)(y0.x & 0xffff)) + w1 * bf2f((bf16_t)(y1.x & 0xffff)));
                    xv[i].y += g.y * (w0 * bf2f((bf16_t)(y0.x >> 16)) + w1 * bf2f((bf16_t)(y1.x >> 16)));
                    xv[i].z += g.z * (w0 * bf2f((bf16_t)(y0.y & 0xffff)) + w1 * bf2f((bf16_t)(y1.y & 0xffff)));
                    xv[i].w += g.w * (w0 * bf2f((bf16_t)(y0.y >> 16)) + w1 * bf2f((bf16_t)(y1.y >> 16))); }
            }
        }
        float ss = 0.f;
#pragma unroll
        for (int i = 0; i < 4; ++i) ss += xv[i].x * xv[i].x + xv[i].y * xv[i].y + xv[i].z * xv[i].z + xv[i].w * xv[i].w;
        ss = wave_sum(ss);
        const float rstd = rsqrtf(ss * (1.0f / 1024.0f) + 1e-6f);
        if (l == DEPTH) {
#pragma unroll
            for (int i = 0; i < 4; ++i) { const int c = i * 256 + lane * 4; const float4 g = *(const float4*)(p.g_final + c);
                float4 o; o.x = xv[i].x * rstd * g.x; o.y = xv[i].y * rstd * g.y; o.z = xv[i].z * rstd * g.z; o.w = xv[i].w * rstd * g.w;
                *(float4*)(p.out + (size_t)t * 1024 + c) = o; }
        } else {
            const float* mv = p.modv + (size_t)(l * 5 + v) * 6144;
#pragma unroll
            for (int i = 0; i < 4; ++i) { const int c = i * 256 + lane * 4;
                *(float4*)(p.xs + (size_t)t * 1024 + c) = xv[i];
                const float4 g = *(const float4*)(p.g_attn + l * 1024 + c), sh = *(const float4*)(mv + c), sc = *(const float4*)(mv + 1024 + c);
                uint2 o; o.x = pack2(xv[i].x * rstd * g.x * (1.f + sc.x) + sh.x, xv[i].y * rstd * g.y * (1.f + sc.y) + sh.y);
                o.y = pack2(xv[i].z * rstd * g.z * (1.f + sc.z) + sh.z, xv[i].w * rstd * g.w * (1.f + sc.w) + sh.w);
                *(uint2*)(p.h + (size_t)t * 1024 + c) = o; }
        }
    }
}

#define SG_STRIDE 144
#define SG_BOFF (128 * SG_STRIDE)
struct RowsLinear { const bf16_t* base; size_t ld; __device__ __forceinline__ const bf16_t* operator()(int r) const { return base + (size_t)r * ld; } };
template <class ARow>
__device__ __forceinline__ void gemm_core(unsigned char* smem, const ARow& arow, const bf16_t* Bt, size_t ldb, int k0, int k1, f32x4 (&acc)[2][4]) {
    const int tid = ltid(), lane = tid & 63, wid = tid >> 6, wm = wid >> 1, wn = wid & 1;
    const int row0 = tid >> 3, kc = tid & 7;
    const bf16_t* pa0 = arow(row0) + kc * 8; const bf16_t* pa1 = arow(row0 + 64) + kc * 8;
    const bf16_t* pb0 = Bt + (size_t)row0 * ldb + kc * 8; const bf16_t* pb1 = Bt + (size_t)(row0 + 64) * ldb + kc * 8;
    const int soff0 = row0 * SG_STRIDE + kc * 16, soff1 = soff0 + 64 * SG_STRIDE;
    uint4 ra0 = *(const uint4*)(pa0 + k0), ra1 = *(const uint4*)(pa1 + k0), rb0 = *(const uint4*)(pb0 + k0), rb1 = *(const uint4*)(pb1 + k0);
    const int fa = (wm * 32 + (lane & 15)) * SG_STRIDE + (lane >> 4) * 16, fb = SG_BOFF + (wn * 64 + (lane & 15)) * SG_STRIDE + (lane >> 4) * 16;
    for (int k = k0; k < k1; k += 64) {
        __syncthreads();
        *(uint4*)(smem + soff0) = ra0; *(uint4*)(smem + soff1) = ra1; *(uint4*)(smem + SG_BOFF + soff0) = rb0; *(uint4*)(smem + SG_BOFF + soff1) = rb1;
        __syncthreads();
        if (k + 64 < k1) { ra0 = *(const uint4*)(pa0 + k + 64); ra1 = *(const uint4*)(pa1 + k + 64); rb0 = *(const uint4*)(pb0 + k + 64); rb1 = *(const uint4*)(pb1 + k + 64); }
#pragma unroll
        for (int ks = 0; ks < 2; ++ks) {
            const bf16x8 af0 = *(const bf16x8*)(smem + fa + ks * 64), af1 = *(const bf16x8*)(smem + fa + 16 * SG_STRIDE + ks * 64);
            const bf16x8 b0 = *(const bf16x8*)(smem + fb + ks * 64), b1 = *(const bf16x8*)(smem + fb + 16 * SG_STRIDE + ks * 64);
            const bf16x8 b2 = *(const bf16x8*)(smem + fb + 32 * SG_STRIDE + ks * 64), b3 = *(const bf16x8*)(smem + fb + 48 * SG_STRIDE + ks * 64);
            acc[0][0] = __builtin_amdgcn_mfma_f32_16x16x32_bf16(b0, af0, acc[0][0], 0, 0, 0); acc[0][1] = __builtin_amdgcn_mfma_f32_16x16x32_bf16(b1, af0, acc[0][1], 0, 0, 0);
            acc[0][2] = __builtin_amdgcn_mfma_f32_16x16x32_bf16(b2, af0, acc[0][2], 0, 0, 0); acc[0][3] = __builtin_amdgcn_mfma_f32_16x16x32_bf16(b3, af0, acc[0][3], 0, 0, 0);
            acc[1][0] = __builtin_amdgcn_mfma_f32_16x16x32_bf16(b0, af1, acc[1][0], 0, 0, 0); acc[1][1] = __builtin_amdgcn_mfma_f32_16x16x32_bf16(b1, af1, acc[1][1], 0, 0, 0);
            acc[1][2] = __builtin_amdgcn_mfma_f32_16x16x32_bf16(b2, af1, acc[1][2], 0, 0, 0); acc[1][3] = __builtin_amdgcn_mfma_f32_16x16x32_bf16(b3, af1, acc[1][3], 0, 0, 0);
        }
    }
}
__device__ __forceinline__ void zero_acc(f32x4 (&acc)[2][4]) {
#pragma unroll
    for (int a = 0; a < 2; ++a)
#pragma unroll
        for (int b = 0; b < 4; ++b) acc[a][b] = (f32x4){0.f, 0.f, 0.f, 0.f};
}
__device__ __forceinline__ void store4bf(bf16_t* dst, f32x4 v) { uint2 o; o.x = pack2(v[0], v[1]); o.y = pack2(v[2], v[3]); *(uint2*)dst = o; }


namespace pg8 {
#define PG8_LAS __attribute__((address_space(3)))
typedef unsigned u32x4 __attribute__((ext_vector_type(4)));
constexpr int BM = 256, BK = 64, HALF = 128, HTB = HALF * BK * 2, STAGE_BYTES = 8 * HTB, NXCD = 8, WGM = 8;
__host__ __device__ __forceinline__ int lds_byte(int r, int c) { const int st = (r >> 4) * 2 + (c >> 5), rr = r & 15, cc = c & 31, ob = rr * 64 + cc * 2; return st * 1024 + (ob ^ (((ob >> 9) & 1) << 5)); }
__host__ __device__ __forceinline__ void stage_rc(int b, int& R, int& C) { const int st = b / 1024, sb = b % 1024, swz = sb ^ (((sb >> 9) & 1) << 5); R = (st >> 1) * 16 + swz / 64; C = (st & 1) * 32 + (swz % 64) / 2; }
__host__ __device__ __forceinline__ int perm32(int rho) { const int n = rho >> 4, i = rho & 15; return 8 * (i >> 2) + 4 * n + (i & 3); }
struct Unit { int pm, pn; };
struct Gemm { const bf16_t* A; const bf16_t* Bt; int M, N, K; };
struct StaticOrder {
    int nM, nN, nwg, G, c;
    __device__ void init(int M, int N, int G_, int c_) { nM = M / BM; nN = N / BM; nwg = nM * nN; G = G_; c = c_; }
    __device__ bool next(int i, Unit& u) const {
        const long L = (long)i * G + c; if (L >= nwg) return false;
        int wgid = (int)L; { const int q = nwg / NXCD, r = nwg % NXCD, xcd = wgid % NXCD, off = wgid / NXCD; wgid = (xcd < r ? xcd * (q + 1) : r * (q + 1) + (xcd - r) * q) + off; }
        const int nig = WGM * nN, gid = wgid / nig, fm = gid * WGM, gsz = (nM - fm) < WGM ? (nM - fm) : WGM;
        u.pm = fm + ((wgid % nig) % gsz); u.pn = (wgid % nig) / gsz; return true;
    }
    __device__ __forceinline__ void a_ready(const Unit&) const {}
    __device__ __forceinline__ void done(const Unit&) const {}
};
template <int NT> struct GroupedOrder {
    const int* blk_e; int nunits, G, c;
    __device__ bool next(int i, Unit& u) const { const long L = (long)i * G + c; if (L >= nunits) return false; const int rb = (int)L / NT; u.pm = rb; u.pn = blk_e[rb] * NT + (int)L % NT; return true; }
    __device__ __forceinline__ void a_ready(const Unit&) const {}
    __device__ __forceinline__ void done(const Unit&) const {}
};
template <class Epi, class Sched, bool ALIGN_EPI = false, bool SP2 = false>
__device__ __forceinline__ void gemm_phase(PG8_LAS unsigned char* lds, const Gemm g, const Sched& S, const Epi& E) {
    const int tid = ltid(), wid = __builtin_amdgcn_readfirstlane(tid >> 6), lane = tid & 63, wr = wid >> 2, wc = wid & 3, fr = lane & 15, fq = lane >> 4;
    int K = g.K; asm volatile("" : "+s"(K)); const int nt = K / BK;
    unsigned voffA[2], voffB[2];
#pragma unroll
    for (int i = 0; i < 2; ++i) { int R, C; stage_rc(tid * 16 + i * 8192, R, C); const int Rb = Epi::PERM ? ((R & ~31) + perm32(R & 31)) : R;
        voffA[i] = (unsigned)(R * K + C) * 2u; voffB[i] = (unsigned)(Rb * K + C) * 2u; }
    const size_t kstep = (size_t)(BK * 2);
    const size_t hstep = (size_t)HALF * K * 2;
    const size_t tstep = 2 * hstep;
    const unsigned ldsw = (unsigned)wid * 1024u;
    const int aoff = lds_byte(wr * 64 + fr, fq * 8), boff = lds_byte(wc * 32 + fr, fq * 8);
#define PG8_SA(b, h) (((b) * 2 + (h)) * HTB)
#define PG8_SB(b, h) ((4 + (b) * 2 + (h)) * HTB)
#define PG8_STAGE(bufoff, gbase, voff) do { _Pragma("unroll") for (int _i = 0; _i < 2; ++_i) \
        __builtin_amdgcn_global_load_lds((const unsigned*)((const char*)(gbase) + (voff)[_i]), (PG8_LAS unsigned*)(lds + (bufoff) + ldsw + _i * 8192), 16, 0, 0); } while (0)
#define PG8_LDA(dst, b, h) do { _Pragma("unroll") for (int m = 0; m < 4; ++m) _Pragma("unroll") for (int k = 0; k < 2; ++k) dst[m][k] = *(const PG8_LAS bf16x8*)(lds + PG8_SA(b, h) + aoff + m * 2048 + k * 1024); } while (0)
#define PG8_LDB(dst, b, h) do { _Pragma("unroll") for (int n = 0; n < 2; ++n) _Pragma("unroll") for (int k = 0; k < 2; ++k) dst[n][k] = *(const PG8_LAS bf16x8*)(lds + PG8_SB(b, h) + boff + n * 2048 + k * 1024); } while (0)
#define PG8_MMA(ai, bj, At, Bt) do { __builtin_amdgcn_s_setprio(1); _Pragma("unroll") for (int m = 0; m < 4; ++m) _Pragma("unroll") for (int n = 0; n < 2; ++n) _Pragma("unroll") for (int k = 0; k < 2; ++k) \
        acc[ai][bj][m][n] = __builtin_amdgcn_mfma_f32_16x16x32_bf16(Bt[n][k], At[m][k], acc[ai][bj][m][n], 0, 0, 0); __builtin_amdgcn_s_setprio(0); } while (0)
#define PG8_WAIT_V(n) asm volatile("s_waitcnt vmcnt(" #n ")" ::: "memory")
#define PG8_WAIT_L(n) asm volatile("s_waitcnt lgkmcnt(" #n ")" ::: "memory")
#define PG8_BAR __builtin_amdgcn_s_barrier()
#define PG8_SCHED __builtin_amdgcn_sched_barrier(0)
    Unit cur, nxt; int ui = 0;
    if (!S.next(0, cur)) return;
    f32x4 acc[2][2][4][2];
#pragma unroll
    for (int a = 0; a < 2; ++a)
#pragma unroll
        for (int b = 0; b < 2; ++b)
#pragma unroll
            for (int m = 0; m < 4; ++m)
#pragma unroll
                for (int n = 0; n < 2; ++n) acc[a][b][m][n] = (f32x4){0.f, 0.f, 0.f, 0.f};
    bf16x8 At[4][2], B0[2][2], B1[2][2];
    const char* cA = (const char*)g.A + (size_t)cur.pm * tstep; const char* cB = (const char*)g.Bt + (size_t)cur.pn * tstep;
    S.a_ready(cur);
    if constexpr (SP2) {
        PG8_STAGE(PG8_SB(0, 0), cB, voffB); PG8_STAGE(PG8_SB(0, 1), cB + hstep, voffB); PG8_STAGE(PG8_SA(0, 0), cA, voffA); PG8_STAGE(PG8_SA(0, 1), cA + hstep, voffA);
        if (wr == 1) PG8_BAR;
        PG8_WAIT_V(2); PG8_BAR;
        PG8_STAGE(PG8_SB(1, 0), cB + kstep, voffB); PG8_STAGE(PG8_SA(1, 0), cA + kstep, voffA); PG8_STAGE(PG8_SB(1, 1), cB + hstep + kstep, voffB);
        PG8_WAIT_V(6); PG8_BAR;
    } else {
        PG8_STAGE(PG8_SB(0, 0), cB, voffB); PG8_STAGE(PG8_SA(0, 0), cA, voffA); PG8_STAGE(PG8_SB(0, 1), cB + hstep, voffB); PG8_STAGE(PG8_SA(0, 1), cA + hstep, voffA);
        if (wr == 1) PG8_BAR;
        PG8_WAIT_V(4); PG8_BAR;
        PG8_STAGE(PG8_SB(1, 0), cB + kstep, voffB); PG8_STAGE(PG8_SA(1, 0), cA + kstep, voffA); PG8_STAGE(PG8_SB(1, 1), cB + hstep + kstep, voffB);
        PG8_WAIT_V(6); PG8_BAR;
    }
    for (;;) {
        const bool has_next = S.next(ui + 1, nxt);
        const char* nA = has_next ? (const char*)g.A + (size_t)nxt.pm * tstep : cA; const char* nB = has_next ? (const char*)g.Bt + (size_t)nxt.pn * tstep : cB;
        for (int t = 0; t < nt; t += 2) {
            const bool last = (t == nt - 2);
            const char* a1 = cA + (size_t)(t + 1) * kstep;
            const char* a2 = last ? nA : cA + (size_t)(t + 2) * kstep; const char* b2 = last ? nB : cB + (size_t)(t + 2) * kstep;
            const char* a3 = a2 + kstep; const char* b3 = b2 + kstep;
            if (last && has_next) S.a_ready(nxt);
            if constexpr (SP2) {
            PG8_LDB(B0, 0, 0); PG8_LDB(B1, 0, 1); PG8_SCHED; PG8_LDA(At, 0, 0); PG8_STAGE(PG8_SA(1, 1), a1 + hstep, voffA);
            PG8_WAIT_V(8); PG8_WAIT_L(0); PG8_BAR; PG8_MMA(0, 0, At, B0); PG8_MMA(0, 1, At, B1); PG8_BAR; PG8_SCHED;
            PG8_LDA(At, 0, 1); PG8_STAGE(PG8_SB(0, 0), b2, voffB); PG8_STAGE(PG8_SB(0, 1), b2 + hstep, voffB); PG8_STAGE(PG8_SA(0, 0), a2, voffA);
            PG8_WAIT_V(8); PG8_WAIT_L(0); PG8_BAR; PG8_MMA(1, 0, At, B0); PG8_MMA(1, 1, At, B1); PG8_BAR; PG8_SCHED;
            PG8_LDB(B0, 1, 0); PG8_LDB(B1, 1, 1); PG8_SCHED; PG8_LDA(At, 1, 0); PG8_STAGE(PG8_SA(0, 1), a2 + hstep, voffA);
            PG8_WAIT_V(8); PG8_WAIT_L(0); PG8_BAR; PG8_MMA(0, 0, At, B0); PG8_MMA(0, 1, At, B1); PG8_BAR; PG8_SCHED;
            PG8_LDA(At, 1, 1); PG8_STAGE(PG8_SB(1, 0), b3, voffB); PG8_STAGE(PG8_SB(1, 1), b3 + hstep, voffB); PG8_STAGE(PG8_SA(1, 0), a3, voffA);
            PG8_WAIT_V(8); PG8_WAIT_L(0); PG8_BAR; PG8_MMA(1, 0, At, B0); PG8_MMA(1, 1, At, B1); PG8_BAR; PG8_SCHED;
            } else {
            PG8_LDB(B0, 0, 0); PG8_SCHED; PG8_LDA(At, 0, 0); PG8_STAGE(PG8_SA(1, 1), a1 + hstep, voffA);
            PG8_WAIT_L(8); PG8_BAR; PG8_WAIT_L(0); PG8_MMA(0, 0, At, B0); PG8_BAR; PG8_SCHED;
            PG8_LDB(B1, 0, 1); PG8_STAGE(PG8_SB(0, 0), b2, voffB);
            PG8_BAR; PG8_WAIT_L(0); PG8_MMA(0, 1, At, B1); PG8_BAR;
            PG8_LDA(At, 0, 1); PG8_STAGE(PG8_SA(0, 0), a2, voffA);
            PG8_BAR; PG8_WAIT_L(0); PG8_MMA(1, 0, At, B0); PG8_BAR; PG8_SCHED;
            PG8_STAGE(PG8_SB(0, 1), b2 + hstep, voffB);
            PG8_WAIT_V(6); PG8_BAR; PG8_MMA(1, 1, At, B1); PG8_BAR;
            PG8_LDB(B0, 1, 0); PG8_SCHED; PG8_LDA(At, 1, 0); PG8_STAGE(PG8_SA(0, 1), a2 + hstep, voffA);
            PG8_WAIT_L(8); PG8_BAR; PG8_WAIT_L(0); PG8_MMA(0, 0, At, B0); PG8_BAR; PG8_SCHED;
            PG8_LDB(B1, 1, 1); PG8_STAGE(PG8_SB(1, 0), b3, voffB);
            PG8_BAR; PG8_WAIT_L(0); PG8_MMA(0, 1, At, B1); PG8_BAR;
            PG8_LDA(At, 1, 1); PG8_STAGE(PG8_SA(1, 0), a3, voffA);
            PG8_BAR; PG8_WAIT_L(0); PG8_MMA(1, 0, At, B0); PG8_BAR; PG8_SCHED;
            PG8_STAGE(PG8_SB(1, 1), b3 + hstep, voffB);
            PG8_WAIT_V(6); PG8_BAR; PG8_MMA(1, 1, At, B1); PG8_BAR;
            }
            if constexpr (Epi::HOOK) { if (t == 2 || t == 8) E.hook(acc, cur, t, wr, wc, fr, fq); }
        }
        if constexpr (ALIGN_EPI) { if (wr == 0) PG8_BAR; }
        if constexpr (!Epi::AFTER_DRAIN) { E(acc, cur, wr, wc, fr, fq); S.done(cur); }
        if (!has_next) break;
#pragma unroll
        for (int a = 0; a < 2; ++a)
#pragma unroll
            for (int b = 0; b < 2; ++b)
#pragma unroll
                for (int m = 0; m < 4; ++m)
#pragma unroll
                    for (int n = 0; n < 2; ++n) acc[a][b][m][n] = (f32x4){0.f, 0.f, 0.f, 0.f};
        cur = nxt; cA = nA; cB = nB; ++ui;
        if constexpr (ALIGN_EPI) { if (wr == 1) PG8_BAR; }
    }
    PG8_WAIT_V(0);
    if constexpr (!ALIGN_EPI) { if (wr == 0) PG8_BAR; }
    PG8_BAR;
    if constexpr (Epi::AFTER_DRAIN) { E.fused(acc, cur, wr, wc, fr, fq, lds, wid, lane); S.done(cur); }
#undef PG8_SA
#undef PG8_SB
#undef PG8_STAGE
#undef PG8_LDA
#undef PG8_LDB
#undef PG8_MMA
#undef PG8_WAIT_V
#undef PG8_WAIT_L
#undef PG8_BAR
#undef PG8_SCHED
}

}

__device__ __forceinline__ void phase_gemm_in(const Params& p, int l, unsigned char* smem) {
    const int tid = ltid(), lane = tid & 63, wid = tid >> 6, wm = wid >> 1, wn = wid & 1, q4 = (lane >> 4) * 4;
    const int nM = T_ALL / 128, nN = IN_COLS / 128;
    for (int tile = blockIdx.x; tile < nM * nN; tile += gridDim.x) {
        const int tm = tile / nN, tn = tile % nN, m0 = tm * 128, n0 = tn * 128;
        f32x4 acc[2][4]; zero_acc(acc);
        RowsLinear ar{p.h + (size_t)m0 * 1024, 1024};
        gemm_core(smem, ar, p.wt_in + (size_t)n0 * 1024, 1024, 0, 1024, acc);
        const int cb = n0 + wn * 64;
#pragma unroll
        for (int mi = 0; mi < 2; ++mi) {
            const int t = m0 + wm * 32 + mi * 16 + (lane & 15);
            f32x4 v0 = acc[mi][0], v1 = acc[mi][1], v2 = acc[mi][2], v3 = acc[mi][3];
            if (cb >= 2560) {
                bf16_t* dst = p.uG + (size_t)t * UG_LD + (cb - 2560) + q4;
#pragma unroll
                for (int e = 0; e < 4; ++e) { v0[e] = 1.f / (1.f + __expf(-v0[e])); v1[e] = 1.f / (1.f + __expf(-v1[e])); v2[e] = 1.f / (1.f + __expf(-v2[e])); v3[e] = 1.f / (1.f + __expf(-v3[e])); }
                store4bf(dst, v0); store4bf(dst + 16, v1); store4bf(dst + 32, v2); store4bf(dst + 48, v3);
            } else {
                const bool isq = (cb >= 768 && cb < 1152) || (cb >= 1920 && cb < 2304);
                const bool rope = (cb >= 1920 && cb < 2432) && (t < T_LAT);
                if (rope) { const int pos = t & 8191, r = pos >> 6, cc = pos & 63;
#pragma unroll
                    for (int e = 0; e < 4; ++e) {
                        const float2 csr = *(const float2*)(p.ropet + (r * 16 + q4 + e) * 2), csc = *(const float2*)(p.ropet + (cc * 16 + q4 + e) * 2);
                        const float a1 = v0[e], a2 = v1[e]; v0[e] = a1 * csr.x - a2 * csr.y; v1[e] = a1 * csr.y + a2 * csr.x;
                        const float b1 = v2[e], b2 = v3[e]; v2[e] = b1 * csc.x - b2 * csc.y; v3[e] = b1 * csc.y + b2 * csc.x; } }
                if (isq) { v0 = v0 * 0.125f; v1 = v1 * 0.125f; v2 = v2 * 0.125f; v3 = v3 * 0.125f; }
                bf16_t* dst = p.uA + (size_t)t * UA_LD + cb + q4;
                store4bf(dst, v0); store4bf(dst + 16, v1); store4bf(dst + 32, v2); store4bf(dst + 48, v3);
            }
        }
    }
}

struct KmNA { int b, r, c, rs, cs; const float* rpb;
    __device__ __forceinline__ int tok(int kk) const { if (kk < 128) return b * SEQ + (rs + (kk >> 4)) * 64 + cs + (kk & 15); return T_LAT + b * CTXL + (kk - 128); }
    __device__ __forceinline__ float bias(int kk) const { if (kk < 128) return rpb[(rs + (kk >> 4) - r + 7) * 31 + (cs + (kk & 15) - c + 15)]; return 0.f; } };
struct KmSWA { int b, i;
    __device__ __forceinline__ int tok(int kk) const { if (kk < 257) { const int j = i - 128 + kk; return (j >= 0 && j < SEQ) ? b * SEQ + j : -1; } if (kk < 513) return T_LAT + b * CTXL + (kk - 257); return -1; }
    __device__ __forceinline__ float bias(int) const { return 0.f; } };
struct KmCtx { int b;
    __device__ __forceinline__ int tok(int kk) const { return T_LAT + b * CTXL + kk; }
    __device__ __forceinline__ float bias(int) const { return 0.f; } };

template <int NI, class KM>
__device__ __forceinline__ void attn_item(const bf16_t* uA, int tq, int qcol, int kcol, int vcol, const KM& km, bool has_sink, float sink, bf16_t* outp, int lane) {
    float q[64];
    {   const uint4* qp = (const uint4*)(uA + (size_t)tq * UA_LD + qcol);
#pragma unroll
        for (int c = 0; c < 8; ++c) { const uint4 v = qp[c];
            q[c * 8 + 0] = bf2f((bf16_t)(v.x & 0xffff)); q[c * 8 + 1] = bf2f((bf16_t)(v.x >> 16)); q[c * 8 + 2] = bf2f((bf16_t)(v.y & 0xffff)); q[c * 8 + 3] = bf2f((bf16_t)(v.y >> 16));
            q[c * 8 + 4] = bf2f((bf16_t)(v.z & 0xffff)); q[c * 8 + 5] = bf2f((bf16_t)(v.z >> 16)); q[c * 8 + 6] = bf2f((bf16_t)(v.w & 0xffff)); q[c * 8 + 7] = bf2f((bf16_t)(v.w >> 16)); } }
    float s[NI]; float mx = -3.0e38f;
#pragma unroll
    for (int i = 0; i < NI; ++i) { const int kk = i * 64 + lane; const int tk = km.tok(kk);
        float d = -3.0e38f;
        if (tk >= 0) { const uint4* kp = (const uint4*)(uA + (size_t)tk * UA_LD + kcol); d = 0.f;
#pragma unroll
            for (int c = 0; c < 8; ++c) { const uint4 v = kp[c];
                d += q[c * 8 + 0] * bf2f((bf16_t)(v.x & 0xffff)) + q[c * 8 + 1] * bf2f((bf16_t)(v.x >> 16)) + q[c * 8 + 2] * bf2f((bf16_t)(v.y & 0xffff)) + q[c * 8 + 3] * bf2f((bf16_t)(v.y >> 16))
                   + q[c * 8 + 4] * bf2f((bf16_t)(v.z & 0xffff)) + q[c * 8 + 5] * bf2f((bf16_t)(v.z >> 16)) + q[c * 8 + 6] * bf2f((bf16_t)(v.w & 0xffff)) + q[c * 8 + 7] * bf2f((bf16_t)(v.w >> 16)); }
            d += km.bias(kk); }
        s[i] = d; mx = fmaxf(mx, d); }
    mx = wave_max(mx); if (has_sink) mx = fmaxf(mx, sink);
    float sum = 0.f;
#pragma unroll
    for (int i = 0; i < NI; ++i) { const float pv = s[i] > -1.0e38f ? __expf(s[i] - mx) : 0.f; s[i] = pv; sum += pv; }
    sum = wave_sum(sum); if (has_sink) sum += __expf(sink - mx);
    const float inv = 1.0f / sum;
    float o = 0.f;
#pragma unroll
    for (int i = 0; i < NI; ++i) {
        for (int sl = 0; sl < 64; ++sl) { const int tk = km.tok(i * 64 + sl); const float pv = __shfl(s[i], sl);
            if (tk >= 0) o += pv * bf2f(uA[(size_t)tk * UA_LD + vcol + lane]); } }
    outp[lane] = f2bf(o * inv);
}

__device__ __forceinline__ void phase_mix(const Params& p, int l) {
    const int tid = ltid(), lane = tid & 63, wid = tid >> 6;
    const bool need_ctx = l < DEPTH - 1;
    {   const int ntok = need_ctx ? T_ALL : T_LAT; const float* cw = p.conv_w + l * 3 * 256;
        for (int idx = blockIdx.x * NTHR + tid; idx < ntok * 256; idx += gridDim.x * NTHR) { const int t = idx >> 8, c = idx & 255;
            int pos, len; if (t < T_LAT) { pos = t & 8191; len = SEQ; } else { pos = (t - T_LAT) & 255; len = CTXL; }
            const bf16_t* u = p.uA + (size_t)t * UA_LD + c;
            const float z1 = bf2f(u[512]) * bf2f(u[0]);
            const float z0 = pos > 0 ? bf2f(u[512 - UA_LD]) * bf2f(u[-UA_LD]) : 0.f;
            const float z2 = pos + 1 < len ? bf2f(u[512 + UA_LD]) * bf2f(u[UA_LD]) : 0.f;
            const float y = bf2f(u[256]) * (z0 * cw[c] + z1 * cw[256 + c] + z2 * cw[512 + c]);
            p.ycat[(size_t)t * 1024 + c] = f2bf(y); } }
    const int n_lat = T_LAT * 12, n_all = n_lat + (need_ctx ? T_CTX * 12 : 0);
    for (int it = blockIdx.x * 8 + wid; it < n_all; it += gridDim.x * 8) {
        if (it < n_lat) { const int t = it / 12, hh = it % 12; const int b = t >> 13, pos = t & 8191;
            if (hh < 6) { KmNA km; km.b = b; km.r = pos >> 6; km.c = pos & 63; km.rs = min(max(km.r - 4, 0), 120); km.cs = min(max(km.c - 8, 0), 48); km.rpb = p.rpb + ((size_t)l * 6 + hh) * 15 * 31;
                attn_item<6>(p.uA, t, 768 + hh * 64, 1152 + hh * 64, 1536 + hh * 64, km, false, 0.f, p.ycat + (size_t)t * 1024 + 256 + hh * 64, lane); }
            else { const int hq = hh - 6, kh = hq / 3; KmSWA km; km.b = b; km.i = pos;
                attn_item<9>(p.uA, t, 1920 + hq * 64, 2304 + kh * 64, 2432 + kh * 64, km, true, p.sinks[l * 6 + hq], p.ycat + (size_t)t * 1024 + 640 + hq * 64, lane); }
        } else { const int it2 = it - n_lat; const int tc = it2 / 12, hh = it2 % 12; const int t = T_LAT + tc; KmCtx km; km.b = tc >> 8;
            if (hh < 6) attn_item<4>(p.uA, t, 768 + hh * 64, 1152 + hh * 64, 1536 + hh * 64, km, false, 0.f, p.ycat + (size_t)t * 1024 + 256 + hh * 64, lane);
            else { const int hq = hh - 6, kh = hq / 3; attn_item<4>(p.uA, t, 1920 + hq * 64, 2304 + kh * 64, 2432 + kh * 64, km, true, p.sinks[l * 6 + hq], p.ycat + (size_t)t * 1024 + 640 + hq * 64, lane); }
        }
    }
}


typedef float f32x16 __attribute__((ext_vector_type(16)));
typedef short s16x4 __attribute__((ext_vector_type(4)));
#define AT_STRIDE 144
#define AT_KBUF(b) ((b) * 9216)
#define AT_VBUF(b) (18432 + (b) * 9216)
#define AT_RPB 36864
#define LOG2E 1.4426950408889634f
#define AT_NEG (-1.0e30f)

template <int MK>
__device__ __forceinline__ void attn_tile(const unsigned char* kt, const unsigned char* vlane, const bf16x8 (&qf)[4], f32x16 (&oacc)[2], float& m, float& lsum,
                                          const float* rpb_row, int relc0  , int lo0  , int lane) {
    const int n = lane & 31, hh = lane >> 5;
    f32x16 sc;
#pragma unroll
    for (int r = 0; r < 16; ++r) sc[r] = 0.f;
#pragma unroll
    for (int sp = 0; sp < 4; ++sp) { const bf16x8 kf = *(const bf16x8*)(kt + n * AT_STRIDE + sp * 32 + hh * 16); sc = __builtin_amdgcn_mfma_f32_32x32x16_bf16(kf, qf[sp], sc, 0, 0, 0); }
    float mx = AT_NEG;
#pragma unroll
    for (int r = 0; r < 16; ++r) { const int i = (r & 3) + 8 * (r >> 2) + 4 * hh; float v = sc[r];
        if (MK == 1) { const bool ok = (i >= lo0) && (i < lo0 + 16); const int ridx = ok ? (relc0 + i) : 0; v = ok ? (v + rpb_row[ridx]) * LOG2E : AT_NEG; }
        else if (MK == 2) v = (i >= n) ? v * LOG2E : AT_NEG;
        else if (MK == 3) v = (i <= n) ? v * LOG2E : AT_NEG;
        else v = v * LOG2E;
        sc[r] = v; mx = fmaxf(mx, v); }
    mx = fmaxf(mx, __shfl_xor(mx, 32));
    const float mn = fmaxf(m, mx); const float alpha = __builtin_amdgcn_exp2f(m - mn); m = mn;
    float ps = 0.f;
#pragma unroll
    for (int r = 0; r < 16; ++r) { const float pv = __builtin_amdgcn_exp2f(sc[r] - mn); sc[r] = pv; ps += pv; }
    lsum = lsum * alpha + ps;
#pragma unroll
    for (int r = 0; r < 16; ++r) { oacc[0][r] *= alpha; oacc[1][r] *= alpha; }
    bf16x8 pf[2];
#pragma unroll
    for (int s2 = 0; s2 < 2; ++s2)
#pragma unroll
        for (int j = 0; j < 8; ++j) pf[s2][j] = (short)f2bf(sc[s2 * 8 + j]);
#pragma unroll
    for (int c = 0; c < 2; ++c)
#pragma unroll
        for (int s2 = 0; s2 < 2; ++s2) {
            const s16x4 v0 = __builtin_amdgcn_ds_read_tr16_b64_v4i16((LAS s16x4*)(vlane + (16 * s2) * AT_STRIDE + 64 * c));
            const s16x4 v1 = __builtin_amdgcn_ds_read_tr16_b64_v4i16((LAS s16x4*)(vlane + (16 * s2 + 8) * AT_STRIDE + 64 * c));
            bf16x8 vf; vf[0] = v0[0]; vf[1] = v0[1]; vf[2] = v0[2]; vf[3] = v0[3]; vf[4] = v1[0]; vf[5] = v1[1]; vf[6] = v1[2]; vf[7] = v1[3];
            oacc[c] = __builtin_amdgcn_mfma_f32_32x32x16_bf16(vf, pf[s2], oacc[c], 0, 0, 0);
        }
}

template <int MODE>
__device__ __forceinline__ void attn_unit(const Params& p, int l, int u, unsigned char* smem) {
    const int tid = ltid(), lane = tid & 63, wid = tid >> 6;
    int b, qcol, kcol, vcol, ocol, qtok; bool has_sink = false; float sinkv = 0.f;
    int nsteps, krlo = 0, r = 0, rs = 0, c = 0, cs = 0, q0 = 0, jwlo = 0;
    if (MODE == 0) { b = u / 192; const int rem = u % 192, h = rem / 32, rg = rem % 32; qcol = 768 + h * 64; kcol = 1152 + h * 64; vcol = 1536 + h * 64; ocol = 256 + h * 64;
        r = rg * 4 + (wid >> 1); rs = min(max(r - 4, 0), 120); c = 32 * (wid & 1) + (lane & 31); cs = min(max(c - 8, 0), 48);
        krlo = min(max(rg * 4 - 4, 0), 120); const int krhi = min(max(rg * 4 + 3 - 4, 0), 120) + 7; nsteps = 4 + (krhi - krlo + 1);
        qtok = b * SEQ + r * 64 + 32 * (wid & 1);
        for (int i = tid; i < 15 * 31; i += NTHR) ((float*)(smem + AT_RPB))[i] = p.rpb[((size_t)l * 6 + h) * 465 + i];
    } else if (MODE == 1) { b = u / 192; const int rem = u % 192, hq = rem / 32, qb = rem % 32, kh = hq / 3; qcol = 1920 + hq * 64; kcol = 2304 + kh * 64; vcol = 2432 + kh * 64; ocol = 640 + hq * 64;
        q0 = qb * 256; jwlo = (q0 == 0) ? 2 : 0; const int jwhi = min(8, (SEQ - q0 + 128) / 64); nsteps = 4 + (jwhi - jwlo);
        qtok = b * SEQ + q0 + 32 * wid; has_sink = true; sinkv = p.sinks[l * 6 + hq];
    } else { b = u / 12; const int hh = u % 12;
        if (hh < 6) { qcol = 768 + hh * 64; kcol = 1152 + hh * 64; vcol = 1536 + hh * 64; ocol = 256 + hh * 64; }
        else { const int hq = hh - 6, kh = hq / 3; qcol = 1920 + hq * 64; kcol = 2304 + kh * 64; vcol = 2432 + kh * 64; ocol = 640 + hq * 64; has_sink = true; sinkv = p.sinks[l * 6 + hq]; }
        nsteps = 4; qtok = T_LAT + b * CTXL + 32 * wid;
    }
    const bf16_t* uA = p.uA;
    bf16x8 qf[4];
    {   const bf16_t* qp = uA + (size_t)(qtok + (lane & 31)) * UA_LD + qcol + (lane >> 5) * 8;
#pragma unroll
        for (int sp = 0; sp < 4; ++sp) qf[sp] = *(const bf16x8*)(qp + sp * 16); }
    f32x16 oacc[2];
#pragma unroll
    for (int r16 = 0; r16 < 16; ++r16) { oacc[0][r16] = 0.f; oacc[1][r16] = 0.f; }
    float m = has_sink ? sinkv * LOG2E : AT_NEG, lsum = (has_sink && lane < 32) ? 1.f : 0.f;
    const int skey = tid >> 3, sch = tid & 7; const int soff = skey * AT_STRIDE + sch * 16;
    auto chunk_tok = [&](int j) -> int {
        if (j < 4) return T_LAT + b * CTXL + 64 * j;
        if (MODE == 0) return b * SEQ + (krlo + (j - 4)) * 64;
        return b * SEQ + q0 - 128 + 64 * (jwlo + (j - 4)); };
    uint4 rk, rv;
    {   const bf16_t* src = uA + (size_t)(chunk_tok(0) + skey) * UA_LD + sch * 8; rk = *(const uint4*)(src + kcol); rv = *(const uint4*)(src + vcol); }
    *(uint4*)(smem + AT_KBUF(0) + soff) = rk; *(uint4*)(smem + AT_VBUF(0) + soff) = rv;
    __syncthreads();
    const int vl_off = (4 * (lane >> 5) + ((lane & 15) >> 2)) * AT_STRIDE + (16 * ((lane >> 4) & 1) + 4 * (lane & 3)) * 2;
    const float* rpb_s = (const float*)(smem + AT_RPB);
    for (int j = 0; j < nsteps; ++j) {
        const int buf = j & 1;
        if (j + 1 < nsteps) { const bf16_t* src = uA + (size_t)(chunk_tok(j + 1) + skey) * UA_LD + sch * 8; rk = *(const uint4*)(src + kcol); rv = *(const uint4*)(src + vcol); }
        const unsigned char* kb = smem + AT_KBUF(buf); const unsigned char* vb = smem + AT_VBUF(buf) + vl_off;
        if (j < 4) {
            attn_tile<0>(kb, vb, qf, oacc, m, lsum, rpb_s, 0, 0, lane);
            attn_tile<0>(kb + 32 * AT_STRIDE, vb + 32 * AT_STRIDE, qf, oacc, m, lsum, rpb_s, 0, 0, lane);
        } else if (MODE == 0) {
            const int kr = krlo + (j - 4);
            if (kr >= rs && kr < rs + 8) { const float* rrow = rpb_s + (kr - r + 7) * 31;
                attn_tile<1>(kb, vb, qf, oacc, m, lsum, rrow, 0 - c + 15, cs, lane);
                attn_tile<1>(kb + 32 * AT_STRIDE, vb + 32 * AT_STRIDE, qf, oacc, m, lsum, rrow, 32 - c + 15, cs - 32, lane); }
        } else if (MODE == 1) {
            const int qp0 = q0 + 32 * wid;
#pragma unroll
            for (int tl = 0; tl < 2; ++tl) { const int kp0 = q0 - 128 + 64 * (jwlo + (j - 4)) + 32 * tl; const int d = kp0 - qp0;
                const unsigned char* kt = kb + tl * 32 * AT_STRIDE; const unsigned char* vt = vb + tl * 32 * AT_STRIDE;
                if (d == -128) attn_tile<2>(kt, vt, qf, oacc, m, lsum, rpb_s, 0, 0, lane);
                else if (d == 128) attn_tile<3>(kt, vt, qf, oacc, m, lsum, rpb_s, 0, 0, lane);
                else if (d > -128 && d < 128) attn_tile<0>(kt, vt, qf, oacc, m, lsum, rpb_s, 0, 0, lane); }
        }
        if (j + 1 < nsteps) { *(uint4*)(smem + AT_KBUF(buf ^ 1) + soff) = rk; *(uint4*)(smem + AT_VBUF(buf ^ 1) + soff) = rv; }
        __syncthreads();
    }
    const float ltot = lsum + __shfl_xor(lsum, 32); const float inv = 1.0f / ltot;
    bf16_t* op = p.ycat + (size_t)(qtok + (lane & 31)) * 1024 + ocol + 4 * (lane >> 5);
#pragma unroll
    for (int cc = 0; cc < 2; ++cc)
#pragma unroll
        for (int g = 0; g < 4; ++g) { f32x4 v; v[0] = oacc[cc][4 * g] * inv; v[1] = oacc[cc][4 * g + 1] * inv; v[2] = oacc[cc][4 * g + 2] * inv; v[3] = oacc[cc][4 * g + 3] * inv;
            store4bf(op + 32 * cc + 8 * g, v); }
}

__device__ __forceinline__ void phase_mix2(const Params& p, int l, unsigned char* smem) {
    const int tid = ltid();
    const bool need_ctx = l < DEPTH - 1;
    {   const int ntok = need_ctx ? T_ALL : T_LAT; const float* cw = p.conv_w + l * 3 * 256;
        for (int idx = blockIdx.x * NTHR + tid; idx < ntok * 256; idx += gridDim.x * NTHR) { const int t = idx >> 8, c = idx & 255;
            int pos, len; if (t < T_LAT) { pos = t & 8191; len = SEQ; } else { pos = (t - T_LAT) & 255; len = CTXL; }
            const bf16_t* u = p.uA + (size_t)t * UA_LD + c;
            const float z1 = bf2f(u[512]) * bf2f(u[0]);
            const float z0 = pos > 0 ? bf2f(u[512 - UA_LD]) * bf2f(u[-UA_LD]) : 0.f;
            const float z2 = pos + 1 < len ? bf2f(u[512 + UA_LD]) * bf2f(u[UA_LD]) : 0.f;
            const float y = bf2f(u[256]) * (z0 * cw[c] + z1 * cw[256 + c] + z2 * cw[512 + c]);
            p.ycat[(size_t)t * 1024 + c] = f2bf(y); } }
    for (int u = blockIdx.x; u < 768; u += gridDim.x) attn_unit<0>(p, l, u, smem);
    for (int u = blockIdx.x; u < 768; u += gridDim.x) attn_unit<1>(p, l, u, smem);
    if (need_ctx) for (int u = blockIdx.x; u < 48; u += gridDim.x) attn_unit<2>(p, l, u, smem);
}

__device__ __forceinline__ void phase_gemm_merge(const Params& p, int l, unsigned char* smem) {
    const int tid = ltid(), lane = tid & 63, wid = tid >> 6, wm = wid >> 1, wn = wid & 1, q4 = (lane >> 4) * 4;
    const int ntok = (l < DEPTH - 1) ? T_ALL : T_LAT; const int nM = ntok / 128, nN = 8;
    for (int tile = blockIdx.x; tile < nM * nN; tile += gridDim.x) {
        const int tm = tile / nN, tn = tile % nN, m0 = tm * 128, n0 = tn * 128;
        f32x4 macc[2][4]; zero_acc(macc);
        RowsLinear ar{p.ycat + (size_t)m0 * 1024, 1024};
#pragma unroll
        for (int seg = 0; seg < 3; ++seg) {
            const int k0 = seg == 0 ? 0 : (seg == 1 ? 256 : 640), k1 = seg == 0 ? 256 : (seg == 1 ? 640 : 1024);
            f32x4 acc[2][4]; zero_acc(acc);
            gemm_core(smem, ar, p.wt_br + (size_t)n0 * 1024, 1024, k0, k1, acc);
#pragma unroll
            for (int mi = 0; mi < 2; ++mi) { const int t = m0 + wm * 32 + mi * 16 + (lane & 15);
#pragma unroll
                for (int nj = 0; nj < 4; ++nj) { const uint2 g = *(const uint2*)(p.uG + (size_t)t * UG_LD + seg * 1024 + n0 + wn * 64 + nj * 16 + q4);
                    macc[mi][nj][0] += bf2f((bf16_t)(g.x & 0xffff)) * acc[mi][nj][0]; macc[mi][nj][1] += bf2f((bf16_t)(g.x >> 16)) * acc[mi][nj][1];
                    macc[mi][nj][2] += bf2f((bf16_t)(g.y & 0xffff)) * acc[mi][nj][2]; macc[mi][nj][3] += bf2f((bf16_t)(g.y >> 16)) * acc[mi][nj][3]; } }
        }
#pragma unroll
        for (int mi = 0; mi < 2; ++mi) { const int t = m0 + wm * 32 + mi * 16 + (lane & 15);
#pragma unroll
            for (int nj = 0; nj < 4; ++nj) store4bf(p.mbuf + (size_t)t * 1024 + n0 + wn * 64 + nj * 16 + q4, macc[mi][nj]); }
    }
}

__device__ __forceinline__ void phase_gemm_o(const Params& p, int l, unsigned char* smem) {
    const int tid = ltid(), lane = tid & 63, wid = tid >> 6, wm = wid >> 1, wn = wid & 1, q4 = (lane >> 4) * 4;
    const int ntok = (l < DEPTH - 1) ? T_ALL : T_LAT; const int nM = ntok / 128, nN = 8;
    for (int tile = blockIdx.x; tile < nM * nN; tile += gridDim.x) {
        const int tm = tile / nN, tn = tile % nN, m0 = tm * 128, n0 = tn * 128;
        f32x4 acc[2][4]; zero_acc(acc);
        RowsLinear ar{p.mbuf + (size_t)m0 * 1024, 1024};
        gemm_core(smem, ar, p.wt_o + (size_t)n0 * 1024, 1024, 0, 1024, acc);
#pragma unroll
        for (int mi = 0; mi < 2; ++mi) { const int t = m0 + wm * 32 + mi * 16 + (lane & 15); const float* gt = p.modv + (size_t)(l * 5 + tok_variant(t)) * 6144 + 2048;
#pragma unroll
            for (int nj = 0; nj < 4; ++nj) { const int c = n0 + wn * 64 + nj * 16 + q4; float4* xp = (float4*)(p.xs + (size_t)t * 1024 + c); float4 xv = *xp; const float4 g = *(const float4*)(gt + c);
                xv.x += g.x * acc[mi][nj][0]; xv.y += g.y * acc[mi][nj][1]; xv.z += g.z * acc[mi][nj][2]; xv.w += g.w * acc[mi][nj][3]; *xp = xv; } }
    }
}

__device__ __forceinline__ void phase_router(const Params& p, int l, float* smem) {
    const int tid = ltid(), lane = tid & 63, wid = tid >> 6;
    float* sh2 = smem;
    float* slg = smem + 16 * 1024;
    const int ntok = (l < DEPTH - 1) ? T_ALL : T_LAT;
    const float* wre = p.w_re + (size_t)l * 1024 * 32; const float* wrg = p.w_rg + (size_t)l * 1024 * 4;
    for (int tb = blockIdx.x; tb < ntok / 16; tb += gridDim.x) {
#pragma unroll
        for (int j = 0; j < 2; ++j) { const int tt = wid * 2 + j, t = tb * 16 + tt; const int v = tok_variant(t);
            float4 xv[4]; float ss = 0.f;
#pragma unroll
            for (int i = 0; i < 4; ++i) { xv[i] = *(const float4*)(p.xs + (size_t)t * 1024 + i * 256 + lane * 4); ss += xv[i].x * xv[i].x + xv[i].y * xv[i].y + xv[i].z * xv[i].z + xv[i].w * xv[i].w; }
            ss = wave_sum(ss); const float rstd = rsqrtf(ss * (1.0f / 1024.0f) + 1e-6f);
            const float* mv = p.modv + (size_t)(l * 5 + v) * 6144 + 3072;
#pragma unroll
            for (int i = 0; i < 4; ++i) { const int c = i * 256 + lane * 4;
                const float4 g = *(const float4*)(p.g_ffn + l * 1024 + c), sh = *(const float4*)(mv + c), sc = *(const float4*)(mv + 1024 + c);
                float4 o; o.x = xv[i].x * rstd * g.x * (1.f + sc.x) + sh.x; o.y = xv[i].y * rstd * g.y * (1.f + sc.y) + sh.y; o.z = xv[i].z * rstd * g.z * (1.f + sc.z) + sh.z; o.w = xv[i].w * rstd * g.w * (1.f + sc.w) + sh.w;
                *(float4*)(sh2 + tt * 1024 + c) = o; uint2 ob; ob.x = pack2(o.x, o.y); ob.y = pack2(o.z, o.w); *(uint2*)(p.h + (size_t)t * 1024 + c) = ob; } }
        __syncthreads();
        {   const int tt = tid >> 5, j = tid & 31; float a = 0.f; const float* hp = sh2 + tt * 1024;
#pragma unroll 8
            for (int k = 0; k < 1024; ++k) a += hp[k] * wre[k * 32 + j];
            slg[tt * 36 + 4 + j] = a + p.b_re[l * 32 + j];
            if (tid < 64) { const int t2 = tid >> 2, j2 = tid & 3; float a2 = 0.f; const float* hp2 = sh2 + t2 * 1024;
#pragma unroll 8
                for (int k = 0; k < 1024; ++k) a2 += hp2[k] * wrg[k * 4 + j2];
                slg[t2 * 36 + j2] = a2 + p.b_rg[l * 4 + j2]; } }
        __syncthreads();
        if (tid < 16) { const int t = tb * 16 + tid; const float* lg = slg + tid * 36;
            int gi = 0; float gm = lg[0];
            for (int j = 1; j < 4; ++j) if (lg[j] > gm) { gm = lg[j]; gi = j; }
            float den = 0.f; for (int j = 0; j < 4; ++j) den += expf(lg[j] - gm);
            const float pg = 1.0f / den;
            const float* le = lg + 4 + gi * 8;
            int i1 = 0; float v1 = le[0]; for (int j = 1; j < 8; ++j) if (le[j] > v1) { v1 = le[j]; i1 = j; }
            int i2 = -1; float v2 = -3.0e38f; for (int j = 0; j < 8; ++j) if (j != i1 && le[j] > v2) { v2 = le[j]; i2 = j; }
            const float e2 = expf(v2 - v1); const float wa = 1.0f / (1.0f + e2), wb = e2 / (1.0f + e2);
            const int ea = gi * 8 + i1, eb = gi * 8 + i2;
            p.eid[t * 2] = ea; p.eid[t * 2 + 1] = eb; p.ewt[t * 2] = pg * wa; p.ewt[t * 2 + 1] = pg * wb;
            p.epos[t * 2] = atomicAdd(p.cnt + l * 32 + ea, 1); p.epos[t * 2 + 1] = atomicAdd(p.cnt + l * 32 + eb, 1); }
        __syncthreads();
    }
}

__device__ __forceinline__ void phase_dispatch(const Params& p, int l, int* smem) {
    const int tid = ltid(), lane = tid & 63, wid = tid >> 6;
    int* pstart = smem;
    if (tid == 0) { int acc = 0; for (int e = 0; e < 32; ++e) { pstart[e] = acc; acc += ((p.cnt[l * 32 + e] + 255) >> 8) << 8; } pstart[32] = acc; }
    __syncthreads();
    if (blockIdx.x == 0) { const int nb = pstart[32] >> 8;
        for (int rb = tid; rb < nb; rb += NTHR) { int e = 0; while (e < 31 && pstart[e + 1] <= rb * 256) ++e; p.blk_e[rb] = e; }
        if (tid == 0) p.nbu[0] = nb; }
    const int ntok = (l < DEPTH - 1) ? T_ALL : T_LAT;
    for (int a = blockIdx.x * 8 + wid; a < ntok * 2; a += gridDim.x * 8) {
        const int t = a >> 1; const int sl = pstart[p.eid[a]] + p.epos[a];
        if (lane == 0) p.slot[a] = sl;
        const uint4* src = (const uint4*)(p.h + (size_t)t * 1024); uint4* dst = (uint4*)(p.xd + (size_t)sl * 1024);
        dst[lane] = src[lane]; dst[lane + 64] = src[lane + 64];
    }
}

__device__ __forceinline__ void phase_gemm_e1(const Params& p, unsigned char* smem) {
    const int tid = ltid(), lane = tid & 63, wid = tid >> 6, wm = wid >> 1, wn = wid & 1, q4 = (lane >> 4) * 4;
    const int nb = p.nbu[0]; const int ntiles = nb * 2 * 4;
    for (int tile = blockIdx.x; tile < ntiles; tile += gridDim.x) {
        const int rb = tile >> 2, tn = tile & 3, m0 = rb * 128, e = p.blk_e[rb >> 1];
        f32x4 acc[2][4]; zero_acc(acc);
        RowsLinear ar{p.xd + (size_t)m0 * 1024, 1024};
        gemm_core(smem, ar, p.wt_gu + ((size_t)e * 512 + tn * 128) * 1024, 1024, 0, 1024, acc);
        const int pg = tn * 2 + wn;
#pragma unroll
        for (int mi = 0; mi < 2; ++mi) { const int sl = m0 + wm * 32 + mi * 16 + (lane & 15);
#pragma unroll
            for (int nj = 0; nj < 2; ++nj) { f32x4 g = acc[mi][nj], u = acc[mi][nj + 2], o;
#pragma unroll
                for (int e4 = 0; e4 < 4; ++e4) o[e4] = g[e4] / (1.f + __expf(-g[e4])) * u[e4];
                store4bf(p.hid + (size_t)sl * 256 + pg * 32 + nj * 16 + q4, o); } }
    }
}
__device__ __forceinline__ void phase_gemm_e2(const Params& p, unsigned char* smem) {
    const int tid = ltid(), lane = tid & 63, wid = tid >> 6, wm = wid >> 1, wn = wid & 1, q4 = (lane >> 4) * 4;
    const int nb = p.nbu[0]; const int ntiles = nb * 2 * 8;
    for (int tile = blockIdx.x; tile < ntiles; tile += gridDim.x) {
        const int rb = tile >> 3, tn = tile & 7, m0 = rb * 128, n0 = tn * 128, e = p.blk_e[rb >> 1];
        f32x4 acc[2][4]; zero_acc(acc);
        RowsLinear ar{p.hid + (size_t)m0 * 256, 256};
        gemm_core(smem, ar, p.wt_d + ((size_t)e * 1024 + n0) * 256, 256, 0, 256, acc);
#pragma unroll
        for (int mi = 0; mi < 2; ++mi) { const int sl = m0 + wm * 32 + mi * 16 + (lane & 15);
#pragma unroll
            for (int nj = 0; nj < 4; ++nj) store4bf(p.Y + (size_t)sl * 1024 + n0 + wn * 64 + nj * 16 + q4, acc[mi][nj]); }
    }
}


__device__ __forceinline__ pg8::u32x4 pack8(const f32x4& a, const f32x4& b) { pg8::u32x4 w; w.x = pack2(a[0], a[1]); w.y = pack2(a[2], a[3]); w.z = pack2(b[0], b[1]); w.w = pack2(b[2], b[3]); return w; }
__device__ __forceinline__ void unpack8(const pg8::u32x4& w, f32x4& a, f32x4& b) {
    a[0] = __uint_as_float(w.x << 16); a[1] = __uint_as_float(w.x & 0xffff0000u); a[2] = __uint_as_float(w.y << 16); a[3] = __uint_as_float(w.y & 0xffff0000u);
    b[0] = __uint_as_float(w.z << 16); b[1] = __uint_as_float(w.z & 0xffff0000u); b[2] = __uint_as_float(w.w << 16); b[3] = __uint_as_float(w.w & 0xffff0000u); }

struct EpiIn { static constexpr bool PERM = true, AFTER_DRAIN = false, HOOK = false;
    bf16_t* uA; bf16_t* uG; const float* ropet;
    __device__ __forceinline__ void operator()(const f32x4 (&acc)[2][2][4][2], const pg8::Unit& u, int wr, int wc, int fr, int fq) const {
        const int row0 = u.pm * 256 + wr * 64 + fr; const bool latent = u.pm < 128;
#pragma unroll
        for (int bj = 0; bj < 2; ++bj) {
            const int cb32 = u.pn * 256 + bj * 128 + wc * 32, c0 = cb32 + 8 * fq;
            if (cb32 >= 2560) {
#pragma unroll
                for (int ai = 0; ai < 2; ++ai)
#pragma unroll
                    for (int m = 0; m < 4; ++m) { const int t = row0 + ai * 128 + m * 16; f32x4 v0 = acc[ai][bj][m][0], v1 = acc[ai][bj][m][1];
#pragma unroll
                        for (int e = 0; e < 4; ++e) { v0[e] = __builtin_amdgcn_rcpf(1.f + __expf(-v0[e])); v1[e] = __builtin_amdgcn_rcpf(1.f + __expf(-v1[e])); }
                        *(pg8::u32x4*)(uG + (size_t)t * UG_LD + (c0 - 2560)) = pack8(v0, v1); }
            } else {
                const bool isq = (cb32 >= 768 && cb32 < 1152) || (cb32 >= 1920 && cb32 < 2304);
                const bool rope = (cb32 >= 1920 && cb32 < 2432) && latent;
#pragma unroll
                for (int ai = 0; ai < 2; ++ai)
#pragma unroll
                    for (int m = 0; m < 4; ++m) { const int t = row0 + ai * 128 + m * 16; f32x4 v0 = acc[ai][bj][m][0], v1 = acc[ai][bj][m][1];
                        if (rope) { const int pos = t & 8191; const int posv = (wc & 1) ? (pos & 63) : (pos >> 6);
                            const float4* cs = (const float4*)(ropet + (posv * 16 + 8 * (fq & 1)) * 2);
                            const float4 c01 = cs[0], c23 = cs[1], c45 = cs[2], c67 = cs[3];
                            f32x4 p0, p1;
#pragma unroll
                            for (int e = 0; e < 4; ++e) { p0[e] = __shfl_xor(v0[e], 32); p1[e] = __shfl_xor(v1[e], 32); }
                            const float co0[4] = {c01.x, c01.z, c23.x, c23.z}, si0[4] = {c01.y, c01.w, c23.y, c23.w}, co1[4] = {c45.x, c45.z, c67.x, c67.z}, si1[4] = {c45.y, c45.w, c67.y, c67.w};
#pragma unroll
                            for (int e = 0; e < 4; ++e) {
                                if (fq < 2) { v0[e] = v0[e] * co0[e] - p0[e] * si0[e]; v1[e] = v1[e] * co1[e] - p1[e] * si1[e]; }
                                else { v0[e] = p0[e] * si0[e] + v0[e] * co0[e]; v1[e] = p1[e] * si1[e] + v1[e] * co1[e]; } } }
                        if (isq) { v0 = v0 * 0.125f; v1 = v1 * 0.125f; }
                        *(pg8::u32x4*)(uA + (size_t)t * UA_LD + c0) = pack8(v0, v1); }
            }
        }
    }
};

struct EpiMerge { static constexpr bool PERM = true, AFTER_DRAIN = false, HOOK = true;
    const bf16_t* uG; bf16_t* mo;
    __device__ __forceinline__ void hook(f32x4 (&acc)[2][2][4][2], const pg8::Unit& u, int t, int wr, int wc, int fr, int fq) const {
        int row0 = u.pm * 256 + wr * 64 + fr; asm volatile("" : "+v"(row0)); const int seg = (t == 2) ? 0 : 1;
#pragma unroll
        for (int ai = 0; ai < 2; ++ai)
#pragma unroll
            for (int m = 0; m < 4; ++m)
#pragma unroll
                for (int bj = 0; bj < 2; ++bj) { const int tr = row0 + ai * 128 + m * 16; const int c0 = u.pn * 256 + bj * 128 + wc * 32 + 8 * fq;
                    const bf16_t* gp = uG + (size_t)tr * UG_LD + seg * 1024 + c0;
                    const pg8::u32x4 wn = *(const pg8::u32x4*)gp, wd = *(const pg8::u32x4*)(gp + 1024);
                    f32x4 n0, n1, d0, d1; unpack8(wn, n0, n1); unpack8(wd, d0, d1);
#pragma unroll
                    for (int e = 0; e < 4; ++e) { acc[ai][bj][m][0][e] *= n0[e] * __builtin_amdgcn_rcpf(fmaxf(d0[e], 1e-20f)); acc[ai][bj][m][1][e] *= n1[e] * __builtin_amdgcn_rcpf(fmaxf(d1[e], 1e-20f)); }
                    if (bj == 1) asm volatile("" ::: "memory"); }
    }
    __device__ __forceinline__ void operator()(const f32x4 (&acc)[2][2][4][2], const pg8::Unit& u, int wr, int wc, int fr, int fq) const {
        const int row0 = u.pm * 256 + wr * 64 + fr;
#pragma unroll
        for (int ai = 0; ai < 2; ++ai)
#pragma unroll
            for (int m = 0; m < 4; ++m)
#pragma unroll
                for (int bj = 0; bj < 2; ++bj) { const int tr = row0 + ai * 128 + m * 16; const int c0 = u.pn * 256 + bj * 128 + wc * 32 + 8 * fq;
                    const pg8::u32x4 wg = *(const pg8::u32x4*)(uG + (size_t)tr * UG_LD + 2048 + c0); f32x4 g0, g1; unpack8(wg, g0, g1);
                    f32x4 v0 = acc[ai][bj][m][0], v1 = acc[ai][bj][m][1];
#pragma unroll
                    for (int e = 0; e < 4; ++e) { v0[e] *= fmaxf(g0[e], 1e-20f); v1[e] *= fmaxf(g1[e], 1e-20f); }
                    *(pg8::u32x4*)(mo + (size_t)tr * 1024 + c0) = pack8(v0, v1);
                    if (bj == 1) asm volatile("" ::: "memory"); }
    }
};

struct EpiO { static constexpr bool PERM = false, AFTER_DRAIN = false, HOOK = false;
    float* xs; const float* modv_l;
    __device__ __forceinline__ void operator()(const f32x4 (&acc)[2][2][4][2], const pg8::Unit& u, int wr, int wc, int fr, int fq) const {
        const int row0 = u.pm * 256 + wr * 64 + fr; const int v = u.pm < 128 ? (u.pm >> 5) : 4; const float* gt = modv_l + (size_t)v * 6144 + 2048;
        const int col0 = u.pn * 256 + wc * 32 + 4 * fq;
        f32x4 gv[2][2];
#pragma unroll
        for (int bj = 0; bj < 2; ++bj)
#pragma unroll
            for (int n = 0; n < 2; ++n) gv[bj][n] = *(const f32x4*)(gt + col0 + bj * 128 + n * 16);
#pragma unroll
        for (int ai = 0; ai < 2; ++ai)
#pragma unroll
            for (int m = 0; m < 4; ++m) { float* rowp = xs + (size_t)(row0 + ai * 128 + m * 16) * 1024 + col0;
#pragma unroll
                for (int bj = 0; bj < 2; ++bj)
#pragma unroll
                    for (int n = 0; n < 2; ++n) { f32x4* xp = (f32x4*)(rowp + bj * 128 + n * 16); *xp = *xp + gv[bj][n] * acc[ai][bj][m][n]; } }
    }
};

struct EpiE1 { static constexpr bool PERM = true, AFTER_DRAIN = false, HOOK = false;
    bf16_t* hid;
    __device__ __forceinline__ void operator()(const f32x4 (&acc)[2][2][4][2], const pg8::Unit& u, int wr, int wc, int fr, int fq) const {
        const int row0 = u.pm * 256 + wr * 64 + fr; const int c0 = (u.pn & 1) * 128 + wc * 32 + 8 * fq;
#pragma unroll
        for (int ai = 0; ai < 2; ++ai)
#pragma unroll
            for (int m = 0; m < 4; ++m) { f32x4 o0, o1;
#pragma unroll
                for (int e = 0; e < 4; ++e) { const float g0 = acc[ai][0][m][0][e], g1 = acc[ai][0][m][1][e];
                    o0[e] = g0 * __builtin_amdgcn_rcpf(1.f + __expf(-g0)) * acc[ai][1][m][0][e]; o1[e] = g1 * __builtin_amdgcn_rcpf(1.f + __expf(-g1)) * acc[ai][1][m][1][e]; }
                *(pg8::u32x4*)(hid + (size_t)(row0 + ai * 128 + m * 16) * 256 + c0) = pack8(o0, o1); }
    }
};

struct EpiE2 { static constexpr bool PERM = true, AFTER_DRAIN = false, HOOK = false;
    bf16_t* Y;
    __device__ __forceinline__ void operator()(const f32x4 (&acc)[2][2][4][2], const pg8::Unit& u, int wr, int wc, int fr, int fq) const {
        const int row0 = u.pm * 256 + wr * 64 + fr; const int c0 = (u.pn & 3) * 256 + wc * 32 + 8 * fq;
#pragma unroll
        for (int ai = 0; ai < 2; ++ai)
#pragma unroll
            for (int m = 0; m < 4; ++m)
#pragma unroll
                for (int bj = 0; bj < 2; ++bj) *(pg8::u32x4*)(Y + (size_t)(row0 + ai * 128 + m * 16) * 1024 + c0 + bj * 128) = pack8(acc[ai][bj][m][0], acc[ai][bj][m][1]);
    }
};

__device__ __forceinline__ void phase_pg_in(const Params& p, int l, unsigned char* smem) {
    pg8::Gemm g{p.h, p.wt_in, T_ALL, IN_COLS, 1024}; pg8::StaticOrder S; S.init(T_ALL, IN_COLS, (int)gridDim.x, (int)blockIdx.x);
    EpiIn E{p.uA, p.uG, p.ropet};
    pg8::gemm_phase<EpiIn, pg8::StaticOrder, true, true>((PG8_LAS unsigned char*)smem, g, S, E);
}
__device__ __forceinline__ void phase_pg_merge(const Params& p, int l, unsigned char* smem) {
    const int M = (l < DEPTH - 1) ? T_ALL : T_LAT;
    pg8::Gemm g{p.ycat, p.wt_br, M, 1024, 1024}; pg8::StaticOrder S; S.init(M, 1024, (int)gridDim.x, (int)blockIdx.x);
    EpiMerge E{p.uG, p.mbuf};
    pg8::gemm_phase<EpiMerge, pg8::StaticOrder, true, true>((PG8_LAS unsigned char*)smem, g, S, E);
}
__device__ __forceinline__ void phase_pg_o(const Params& p, int l, unsigned char* smem) {
    const int M = (l < DEPTH - 1) ? T_ALL : T_LAT;
    pg8::Gemm g{p.mbuf, p.wt_o, M, 1024, 1024}; pg8::StaticOrder S; S.init(M, 1024, (int)gridDim.x, (int)blockIdx.x);
    EpiO E{p.xs, p.modv + (size_t)l * 5 * 6144};
    pg8::gemm_phase<EpiO, pg8::StaticOrder, true, true>((PG8_LAS unsigned char*)smem, g, S, E);
}
__device__ __forceinline__ void phase_pg_e1(const Params& p, unsigned char* smem) {
    const int nb = p.nbu[0];
    pg8::Gemm g{p.xd, p.wt_gu, nb * 256, 512, 1024}; pg8::GroupedOrder<2> S{p.blk_e, nb * 2, (int)gridDim.x, (int)blockIdx.x};
    EpiE1 E{p.hid};
    pg8::gemm_phase<EpiE1, pg8::GroupedOrder<2>, true, true>((PG8_LAS unsigned char*)smem, g, S, E);
}
__device__ __forceinline__ void phase_pg_e2(const Params& p, unsigned char* smem) {
    const int nb = p.nbu[0];
    pg8::Gemm g{p.hid, p.wt_d, nb * 256, 1024, 256}; pg8::GroupedOrder<4> S{p.blk_e, nb * 4, (int)gridDim.x, (int)blockIdx.x};
    EpiE2 E{p.Y};
    pg8::gemm_phase<EpiE2, pg8::GroupedOrder<4>, true, true>((PG8_LAS unsigned char*)smem, g, S, E);
}

#define XB_TMO      128
#define XB_XCNT(j)  (256  + 64 * (j))
#define XB_XSUB(j)  (1280 + 64 * (j))
#define XB_XGEN(j)  (2304 + 64 * (j))
#define XB_TOP      3328
#define XB_TOPGEN   3392
#define XCD_BAR_WORDS 3456
#define XB_SPIN_CAP (1u << 18)
__device__ __forceinline__ unsigned xb_ld(unsigned* p)              { return __hip_atomic_load(p, __ATOMIC_RELAXED, __HIP_MEMORY_SCOPE_AGENT); }
__device__ __forceinline__ unsigned xb_add(unsigned* p, unsigned v) { return __hip_atomic_fetch_add(p, v, __ATOMIC_RELAXED, __HIP_MEMORY_SCOPE_AGENT); }
__device__ __forceinline__ unsigned xb_xcc_id() { return (unsigned)__builtin_amdgcn_s_getreg((3 << 11) | 20) & 0xFu; }
#define XB_SPIN(cond, bar) do { unsigned _sp = 0; while (cond) { __builtin_amdgcn_s_sleep(1); \
    if ((++_sp & 255u) == 0u) { if (xb_ld(&(bar)[XB_TMO])) break; if (_sp > XB_SPIN_CAP) { atomicAdd(&(bar)[XB_TMO], 1u); break; } } } } while (0)
struct XcdBarrier { unsigned* bar; unsigned x; volatile LAS unsigned* st; };
__device__ __forceinline__ XcdBarrier xcd_barrier_post(unsigned* bar, volatile LAS unsigned* st) {
    XcdBarrier b; b.bar = bar; b.x = xb_xcc_id(); b.st = st;
    if (threadIdx.x == 0) (void)xb_add(&bar[XB_XCNT(b.x)], 1u);
    return b;
}
__device__ __forceinline__ void xcd_barrier_complete(unsigned* bar, unsigned x, unsigned& nloc, unsigned& nx) {
    const unsigned G = gridDim.x * gridDim.y * gridDim.z;
    unsigned sum, cnt, mine, sp = 0u;
    for (;;) {
        sum = 0u; cnt = 0u; mine = 0u;
#pragma unroll
        for (unsigned j = 0; j < 16; ++j) { const unsigned c = xb_ld(&bar[XB_XCNT(j)]); sum += c; cnt += (c > 0u) ? 1u : 0u; mine = (j == x) ? c : mine; }
        if (sum == G) break;
        __builtin_amdgcn_s_sleep(1);
        if ((++sp & 255u) == 0u) { if (xb_ld(&bar[XB_TMO])) break; if (sp > XB_SPIN_CAP) { atomicAdd(&bar[XB_TMO], 1u); break; } }
    }
    nloc = mine > 0u ? mine : 1u; nx = cnt > 0u ? cnt : 1u;
}
__device__ __forceinline__ void xcd_barrier(const XcdBarrier& b) {
    asm volatile("s_waitcnt vmcnt(0)" ::: "memory");
    __syncthreads();
    if (threadIdx.x == 0) {
        unsigned* bar = b.bar;
        __builtin_amdgcn_s_waitcnt(0);
        unsigned nloc = b.st[0], nx = b.st[1];
        if (nloc == 0u) { xcd_barrier_complete(bar, b.x, nloc, nx); b.st[0] = nloc; b.st[1] = nx; }
        const unsigned old = xb_add(&bar[XB_XSUB(b.x)], 1u);
        const unsigned gen = old / nloc;
        if (old + 1u == (gen + 1u) * nloc) {
            __builtin_amdgcn_fence(__ATOMIC_RELEASE, "agent");
            asm volatile("s_waitcnt vmcnt(0)" ::: "memory");
            const unsigned og = xb_add(&bar[XB_TOP], 1u);
            const unsigned tg = og / nx;
            if (og + 1u == (tg + 1u) * nx) xb_add(&bar[XB_TOPGEN], 1u);
            else XB_SPIN(xb_ld(&bar[XB_TOPGEN]) == tg, bar);
            __builtin_amdgcn_fence(__ATOMIC_ACQUIRE, "agent");
            xb_add(&bar[XB_XGEN(b.x)], 1u);
            asm volatile("s_waitcnt vmcnt(0)" ::: "memory");
        } else {
            XB_SPIN(xb_ld(&bar[XB_XGEN(b.x)]) == gen, bar);
            __builtin_amdgcn_fence(__ATOMIC_ACQUIRE, "agent");
            asm volatile("s_waitcnt vmcnt(0)" ::: "memory");
        }
    }
    __syncthreads();
}

#define SMEM_BYTES 131072
__global__ void __launch_bounds__(NTHR, 2) k_mega(Params p) {
    extern __shared__ __attribute__((aligned(16))) unsigned char smem[];
    volatile LAS unsigned* xbw = (volatile LAS unsigned*)(smem + SMEM_BYTES);
    if (threadIdx.x == 0) { xbw[0] = 0u; xbw[1] = 0u; xbw[2] = 0u; xbw[3] = 0u; }
    __syncthreads();
    XcdBarrier bar = xcd_barrier_post(p.bar, xbw);
    phase_mod(p, (float*)smem);
    xcd_barrier(bar);
    for (int l = 0; l < DEPTH; ++l) {
        phase_norm1(p, l); phase_wconv(p, l, (float*)smem);
        xcd_barrier(bar);
#if PGM & 1
        phase_pg_in(p, l, smem);
#else
        phase_gemm_in(p, l, smem);
#endif
        xcd_barrier(bar);
        phase_mix2(p, l, smem);
        xcd_barrier(bar);
#if PGM & 2
        phase_pg_merge(p, l, smem);
#else
        phase_gemm_merge(p, l, smem);
#endif
        xcd_barrier(bar);
#if PGM & 4
        phase_pg_o(p, l, smem);
#else
        phase_gemm_o(p, l, smem);
#endif
        xcd_barrier(bar);
        phase_router(p, l, (float*)smem);
        xcd_barrier(bar);
        phase_dispatch(p, l, (int*)smem);
        xcd_barrier(bar);
#if PGM & 8
        phase_pg_e1(p, smem);
#else
        phase_gemm_e1(p, smem);
#endif
        xcd_barrier(bar);
#if PGM & 16
        phase_pg_e2(p, smem);
#else
        phase_gemm_e2(p, smem);
#endif
        xcd_barrier(bar);
    }
    phase_norm1(p, DEPTH);
}

extern "C" void kernel_launch(void* const* d_in, const int* in_sizes, int n_in, void* d_out, int out_size, void* d_ws, size_t ws_size, hipStream_t stream) {
    Params p{};
    p.x = (const float*)d_in[0]; p.c = (const float*)d_in[1]; p.ctx = (const float*)d_in[2]; p.c_ctx = (const float*)d_in[3]; p.w_mod = (const float*)d_in[4]; p.b_mod = (const float*)d_in[5];
    p.g_attn = (const float*)d_in[6]; p.g_ffn = (const float*)d_in[7]; p.w_in = (const float*)d_in[8]; p.conv_w = (const float*)d_in[9]; p.rpb = (const float*)d_in[10]; p.sinks = (const float*)d_in[11];
    p.w_branch = (const float*)d_in[12]; p.w_o = (const float*)d_in[13]; p.w_rg = (const float*)d_in[14]; p.b_rg = (const float*)d_in[15]; p.w_re = (const float*)d_in[16]; p.b_re = (const float*)d_in[17];
    p.w_eg = (const float*)d_in[18]; p.w_eu = (const float*)d_in[19]; p.w_ed = (const float*)d_in[20]; p.g_final = (const float*)d_in[21];
    p.out = (float*)d_out;
    unsigned char* w = (unsigned char*)d_ws; size_t off = 0;
    auto take = [&](size_t bytes) { unsigned char* r = w + off; off += (bytes + 255) & ~(size_t)255; return r; };
    p.bar = (unsigned*)take(16384); p.cnt = (int*)take(DEPTH * 32 * 4); p.blk_e = (int*)take(MAXBLK * 4); p.nbu = (int*)take(256);
    p.modv = (float*)take((size_t)DEPTH * 5 * 6144 * 4); p.ropet = (float*)take(128 * 16 * 2 * 4);
    p.eid = (int*)take((size_t)T_ALL * 2 * 4); p.epos = (int*)take((size_t)T_ALL * 2 * 4); p.ewt = (float*)take((size_t)T_ALL * 2 * 4); p.slot = (int*)take((size_t)T_ALL * 2 * 4);
    p.xs = (float*)take((size_t)T_ALL * 1024 * 4);
    p.h = (bf16_t*)take((size_t)T_ALL * 1024 * 2);
    p.wt_in = (bf16_t*)take((size_t)IN_COLS * 1024 * 2); p.wt_br = (bf16_t*)take((size_t)1024 * 1024 * 2); p.wt_o = (bf16_t*)take((size_t)1024 * 1024 * 2);
    p.wt_gu = (bf16_t*)take((size_t)32 * 512 * 1024 * 2); p.wt_d = (bf16_t*)take((size_t)32 * 1024 * 256 * 2);
    p.uA = (bf16_t*)take((size_t)T_ALL * UA_LD * 2); p.uG = (bf16_t*)take((size_t)T_ALL * UG_LD * 2); p.ycat = (bf16_t*)take((size_t)T_ALL * 1024 * 2);
    p.mbuf = p.uA; p.xd = p.uA; p.hid = p.ycat; p.Y = p.uG;
    if (off > ws_size) return;
    constexpr size_t kDynLds = SMEM_BYTES + 16;
    static int grid = 0;
    if (!grid) {
        (void)hipFuncSetAttribute((const void*)k_mega, hipFuncAttributeMaxDynamicSharedMemorySize, (int)kDynLds);
        int dev = 0, cus = 0, per_cu = 0;
        (void)hipGetDevice(&dev);
        (void)hipDeviceGetAttribute(&cus, hipDeviceAttributeMultiprocessorCount, dev);
        (void)hipOccupancyMaxActiveBlocksPerMultiprocessor(&per_cu, (const void*)k_mega, NTHR, kDynLds);
        grid = cus * (per_cu < 1 ? per_cu : 1);
        if (grid <= 0) grid = 0;
    }
    if (!grid) return;
    (void)hipMemsetAsync(p.bar, 0, XCD_BAR_WORDS * sizeof(unsigned), stream);
    hipLaunchKernelGGL(k_mega, dim3(grid), dim3(NTHR), kDynLds, stream, p);
}
```

```cpp
#include <hip/hip_runtime.h>
#include <stdint.h>

typedef unsigned short bf16_t;
typedef short bf16x8 __attribute__((ext_vector_type(8)));
typedef float f32x4 __attribute__((ext_vector_type(4)));

#define D_MODEL 1024
#define NB 4
#define SEQ 8192
#define DEPTH 4
#define CTXL 256
#define T_LAT 32768
#define T_CTX 1024
#define T_ALL 33792
#define UA_LD 2560
#define UG_LD 3072
#define IN_COLS 5632
#define MAXBLK 296
#define NTHR 512
#ifndef PGM
#define PGM 31
#endif
#define LAS __attribute__((address_space(3)))

struct Params {
    const float *x, *c, *ctx, *c_ctx, *w_mod, *b_mod, *g_attn, *g_ffn, *w_in, *conv_w, *rpb, *sinks, *w_branch, *w_o, *w_rg, *b_rg, *w_re, *b_re, *w_eg, *w_eu, *w_ed, *g_final;
    float* out;
    unsigned* bar; int* cnt; int* blk_e; int* nbu;
    float* modv; float* ropet; float* xs;
    bf16_t *h, *wt_in, *wt_br, *wt_o, *wt_gu, *wt_d, *uA, *uG, *ycat, *mbuf, *xd, *hid, *Y;
    int* eid; int* epos; float* ewt; int* slot;
};

__device__ __forceinline__ int ltid() { int t = threadIdx.x; asm volatile("" : "+v"(t)); return t; }
__device__ __forceinline__ bf16_t f2bf(float f) { unsigned u = __float_as_uint(f); u += 0x7FFFu + ((u >> 16) & 1u); return (bf16_t)(u >> 16); }
__device__ __forceinline__ float bf2f(bf16_t b) { return __uint_as_float(((unsigned)b) << 16); }
__device__ __forceinline__ unsigned pack2(float a, float b) { return (unsigned)f2bf(a) | ((unsigned)f2bf(b) << 16); }
__device__ __forceinline__ float wave_sum(float v) { for (int o = 32; o > 0; o >>= 1) v += __shfl_xor(v, o); return v; }
__device__ __forceinline__ float wave_max(float v) { for (int o = 32; o > 0; o >>= 1) v = fmaxf(v, __shfl_xor(v, o)); return v; }
__device__ __forceinline__ int tok_variant(int t) { return t < T_LAT ? (t >> 13) : 4; }

__device__ __forceinline__ void phase_mod(const Params& p, float* smem) {
    const int tid = ltid(), lane = tid & 63, wid = tid >> 6;
    float* s_silu = smem;
    float* s_part = smem + 5 * 1024;
    for (int i = tid; i < 5 * 1024; i += NTHR) { const int v = i >> 10, k = i & 1023; const float cv = v < 4 ? p.c[v * 1024 + k] : p.c_ctx[k]; s_silu[i] = cv / (1.0f + expf(-cv)); }
    __syncthreads();
    for (int item = blockIdx.x; item < DEPTH * 96; item += gridDim.x) {
        const int l = item / 96, cb = item % 96, col = cb * 64 + lane;
        const float* w = p.w_mod + (size_t)l * 1024 * 6144 + col;
        float a0 = 0.f, a1 = 0.f, a2 = 0.f, a3 = 0.f, a4 = 0.f;
#pragma unroll 8
        for (int kk = 0; kk < 128; ++kk) { const int k = wid * 128 + kk; const float wv = w[(size_t)k * 6144];
            a0 += s_silu[k] * wv; a1 += s_silu[1024 + k] * wv; a2 += s_silu[2048 + k] * wv; a3 += s_silu[3072 + k] * wv; a4 += s_silu[4096 + k] * wv; }
        s_part[(wid * 5 + 0) * 64 + lane] = a0; s_part[(wid * 5 + 1) * 64 + lane] = a1; s_part[(wid * 5 + 2) * 64 + lane] = a2; s_part[(wid * 5 + 3) * 64 + lane] = a3; s_part[(wid * 5 + 4) * 64 + lane] = a4;
        __syncthreads();
        if (tid < 320) { const int v = tid >> 6, ln = tid & 63; float s = p.b_mod[l * 6144 + cb * 64 + ln];
            for (int w8 = 0; w8 < 8; ++w8) s += s_part[(w8 * 5 + v) * 64 + ln];
            p.modv[(size_t)(l * 5 + v) * 6144 + cb * 64 + ln] = s; }
        __syncthreads();
    }
    for (int i = blockIdx.x * NTHR + tid; i < 128 * 16; i += gridDim.x * NTHR) { const int pos = i >> 4, f = i & 15;
        const float inv = powf(10000.0f, -(float)f / 16.0f); const float ang = (float)pos * inv; p.ropet[i * 2] = cosf(ang); p.ropet[i * 2 + 1] = sinf(ang); }
}

#define GU_IG 128
__device__ __forceinline__ void phase_wconv(const Params& p, int l, float* smem) {
    const int tid = ltid();
    float* tile = smem;
    const int n1 = 16 * 88, n2 = 256, n3 = 256, n4 = 2048, n5 = 2048, n6 = 2048;
    const int total = n1 + n2 + n3 + n4 + n5 + n6;
    for (int it = blockIdx.x; it < total; it += gridDim.x) {
        const float* src; int ldN; bf16_t* dst; int ldK; int kt, nt; int kind = 0, e = 0; int i = it;
        if (i < n1) { src = p.w_in + (size_t)l * 1024 * IN_COLS; ldN = IN_COLS; dst = p.wt_in; ldK = 1024; kt = i / 88; nt = i % 88; }
        else if ((i -= n1) < n2) { src = p.w_branch + (size_t)l * 1024 * 1024; ldN = 1024; dst = p.wt_br; ldK = 1024; kt = i / 16; nt = i % 16; }
        else if ((i -= n2) < n3) { src = p.w_o + (size_t)l * 1024 * 1024; ldN = 1024; dst = p.wt_o; ldK = 1024; kt = i / 16; nt = i % 16; }
        else if ((i -= n3) < n4) { e = i / 64; i %= 64; src = p.w_eg + ((size_t)l * 32 + e) * 1024 * 256; ldN = 256; dst = p.wt_gu; ldK = 1024; kt = i / 4; nt = i % 4; kind = 1; }
        else if ((i -= n4) < n5) { e = i / 64; i %= 64; src = p.w_eu + ((size_t)l * 32 + e) * 1024 * 256; ldN = 256; dst = p.wt_gu; ldK = 1024; kt = i / 4; nt = i % 4; kind = 2; }
        else { i -= n5; e = i / 64; i %= 64; src = p.w_ed + ((size_t)l * 32 + e) * 256 * 1024; ldN = 1024; dst = p.wt_d + (size_t)e * 1024 * 256; ldK = 256; kt = i / 16; nt = i % 16; }
        {   const int r = tid >> 4, c4 = tid & 15;
#pragma unroll
            for (int hh = 0; hh < 2; ++hh) { const int rr = r + hh * 32; const float4 v = *(const float4*)(src + (size_t)(kt * 64 + rr) * ldN + nt * 64 + c4 * 4);
                tile[rr * 65 + c4 * 4 + 0] = v.x; tile[rr * 65 + c4 * 4 + 1] = v.y; tile[rr * 65 + c4 * 4 + 2] = v.z; tile[rr * 65 + c4 * 4 + 3] = v.w; }
        }
        __syncthreads();
        {   const int n = tid >> 3, kc = tid & 7; const int ncol = nt * 64 + n; int drow = ncol;
            if (kind) drow = e * 512 + (ncol / GU_IG) * (2 * GU_IG) + (kind == 2 ? GU_IG : 0) + (ncol % GU_IG);
            uint4 o; o.x = pack2(tile[(kc * 8 + 0) * 65 + n], tile[(kc * 8 + 1) * 65 + n]); o.y = pack2(tile[(kc * 8 + 2) * 65 + n], tile[(kc * 8 + 3) * 65 + n]);
            o.z = pack2(tile[(kc * 8 + 4) * 65 + n], tile[(kc * 8 + 5) * 65 + n]); o.w = pack2(tile[(kc * 8 + 6) * 65 + n], tile[(kc * 8 + 7) * 65 + n]);
            *(uint4*)(dst + (size_t)drow * ldK + kt * 64 + kc * 8) = o;
        }
        __syncthreads();
    }
}

__device__ __forceinline__ void phase_norm1(const Params& p, int l) {
    const int tid = ltid(), lane = tid & 63, wid = tid >> 6;
    const int ntok = (l == DEPTH) ? T_LAT : T_ALL;
    for (int t = blockIdx.x * 8 + wid; t < ntok; t += gridDim.x * 8) {
        const int v = tok_variant(t);
        float4 xv[4];
        if (l == 0) {
            const float* src = t < T_LAT ? p.x + (size_t)t * 1024 : p.ctx + (size_t)(t - T_LAT) * 1024;
#pragma unroll
            for (int i = 0; i < 4; ++i) xv[i] = *(const float4*)(src + i * 256 + lane * 4);
        } else {
            const float* src = p.xs + (size_t)t * 1024;
#pragma unroll
            for (int i = 0; i < 4; ++i) xv[i] = *(const float4*)(src + i * 256 + lane * 4);
            const bool had_moe = (l - 1 < DEPTH - 1) || t < T_LAT;
            if (had_moe) {
                const int s0 = p.slot[t * 2], s1 = p.slot[t * 2 + 1]; const float w0 = p.ewt[t * 2], w1 = p.ewt[t * 2 + 1];
                const float* gt = p.modv + (size_t)((l - 1) * 5 + v) * 6144 + 5120;
#pragma unroll
                for (int i = 0; i < 4; ++i) { const int c = i * 256 + lane * 4;
                    const uint2 y0 = *(const uint2*)(p.Y + (size_t)s0 * 1024 + c), y1 = *(const uint2*)(p.Y + (size_t)s1 * 1024 + c);
                    const float4 g = *(const float4*)(gt + c);
                    xv[i].x += g.x * (w0 * bf2f((bf16_t)(y0.x & 0xffff)) + w1 * bf2f((bf16_t)(y1.x & 0xffff)));
                    xv[i].y += g.y * (w0 * bf2f((bf16_t)(y0.x >> 16)) + w1 * bf2f((bf16_t)(y1.x >> 16)));
                    xv[i].z += g.z * (w0 * bf2f((bf16_t)(y0.y & 0xffff)) + w1 * bf2f((bf16_t)(y1.y & 0xffff)));
                    xv[i].w += g.w * (w0 * bf2f((bf16_t)(y0.y >> 16)) + w1 * bf2f((bf16_t)(y1.y >> 16))); }
            }
        }
        float ss = 0.f;
#pragma unroll
        for (int i = 0; i < 4; ++i) ss += xv[i].x * xv[i].x + xv[i].y * xv[i].y + xv[i].z * xv[i].z + xv[i].w * xv[i].w;
        ss = wave_sum(ss);
        const float rstd = rsqrtf(ss * (1.0f / 1024.0f) + 1e-6f);
        if (l == DEPTH) {
#pragma unroll
            for (int i = 0; i < 4; ++i) { const int c = i * 256 + lane * 4; const float4 g = *(const float4*)(p.g_final + c);
                float4 o; o.x = xv[i].x * rstd * g.x; o.y = xv[i].y * rstd * g.y; o.z = xv[i].z * rstd * g.z; o.w = xv[i].w * rstd * g.w;
                *(float4*)(p.out + (size_t)t * 1024 + c) = o; }
        } else {
            const float* mv = p.modv + (size_t)(l * 5 + v) * 6144;
#pragma unroll
            for (int i = 0; i < 4; ++i) { const int c = i * 256 + lane * 4;
                *(float4*)(p.xs + (size_t)t * 1024 + c) = xv[i];
                const float4 g = *(const float4*)(p.g_attn + l * 1024 + c), sh = *(const float4*)(mv + c), sc = *(const float4*)(mv + 1024 + c);
                uint2 o; o.x = pack2(xv[i].x * rstd * g.x * (1.f + sc.x) + sh.x, xv[i].y * rstd * g.y * (1.f + sc.y) + sh.y);
                o.y = pack2(xv[i].z * rstd * g.z * (1.f + sc.z) + sh.z, xv[i].w * rstd * g.w * (1.f + sc.w) + sh.w);
                *(uint2*)(p.h + (size_t)t * 1024 + c) = o; }
        }
    }
}

#define SG_STRIDE 144
#define SG_BOFF (128 * SG_STRIDE)
struct RowsLinear { const bf16_t* base; size_t ld; __device__ __forceinline__ const bf16_t* operator()(int r) const { return base + (size_t)r * ld; } };
template <class ARow>
__device__ __forceinline__ void gemm_core(unsigned char* smem, const ARow& arow, const bf16_t* Bt, size_t ldb, int k0, int k1, f32x4 (&acc)[2][4]) {
    const int tid = ltid(), lane = tid & 63, wid = tid >> 6, wm = wid >> 1, wn = wid & 1;
    const int row0 = tid >> 3, kc = tid & 7;
    const bf16_t* pa0 = arow(row0) + kc * 8; const bf16_t* pa1 = arow(row0 + 64) + kc * 8;
    const bf16_t* pb0 = Bt + (size_t)row0 * ldb + kc * 8; const bf16_t* pb1 = Bt + (size_t)(row0 + 64) * ldb + kc * 8;
    const int soff0 = row0 * SG_STRIDE + kc * 16, soff1 = soff0 + 64 * SG_STRIDE;
    uint4 ra0 = *(const uint4*)(pa0 + k0), ra1 = *(const uint4*)(pa1 + k0), rb0 = *(const uint4*)(pb0 + k0), rb1 = *(const uint4*)(pb1 + k0);
    const int fa = (wm * 32 + (lane & 15)) * SG_STRIDE + (lane >> 4) * 16, fb = SG_BOFF + (wn * 64 + (lane & 15)) * SG_STRIDE + (lane >> 4) * 16;
    for (int k = k0; k < k1; k += 64) {
        __syncthreads();
        *(uint4*)(smem + soff0) = ra0; *(uint4*)(smem + soff1) = ra1; *(uint4*)(smem + SG_BOFF + soff0) = rb0; *(uint4*)(smem + SG_BOFF + soff1) = rb1;
        __syncthreads();
        if (k + 64 < k1) { ra0 = *(const uint4*)(pa0 + k + 64); ra1 = *(const uint4*)(pa1 + k + 64); rb0 = *(const uint4*)(pb0 + k + 64); rb1 = *(const uint4*)(pb1 + k + 64); }
#pragma unroll
        for (int ks = 0; ks < 2; ++ks) {
            const bf16x8 af0 = *(const bf16x8*)(smem + fa + ks * 64), af1 = *(const bf16x8*)(smem + fa + 16 * SG_STRIDE + ks * 64);
            const bf16x8 b0 = *(const bf16x8*)(smem + fb + ks * 64), b1 = *(const bf16x8*)(smem + fb + 16 * SG_STRIDE + ks * 64);
            const bf16x8 b2 = *(const bf16x8*)(smem + fb + 32 * SG_STRIDE + ks * 64), b3 = *(const bf16x8*)(smem + fb + 48 * SG_STRIDE + ks * 64);
            acc[0][0] = __builtin_amdgcn_mfma_f32_16x16x32_bf16(b0, af0, acc[0][0], 0, 0, 0); acc[0][1] = __builtin_amdgcn_mfma_f32_16x16x32_bf16(b1, af0, acc[0][1], 0, 0, 0);
            acc[0][2] = __builtin_amdgcn_mfma_f32_16x16x32_bf16(b2, af0, acc[0][2], 0, 0, 0); acc[0][3] = __builtin_amdgcn_mfma_f32_16x16x32_bf16(b3, af0, acc[0][3], 0, 0, 0);
            acc[1][0] = __builtin_amdgcn_mfma_f32_16x16x32_bf16(b0, af1, acc[1][0], 0, 0, 0); acc[1][1] = __builtin_amdgcn_mfma_f32_16x16x32_bf16(b1, af1, acc[1][1], 0, 0, 0);
            acc[1][2] = __builtin_amdgcn_mfma_f32_16x16x32_bf16(b2, af1, acc[1][2], 0, 0, 0); acc[1][3] = __builtin_amdgcn_mfma_f32_16x16x32_bf16(b3, af1, acc[1][3], 0, 0, 0);
        }
    }
}
__device__ __forceinline__ void zero_acc(f32x4 (&acc)[2][4]) {
#pragma unroll
    for (int a = 0; a < 2; ++a)
#pragma unroll
        for (int b = 0; b < 4; ++b) acc[a][b] = (f32x4){0.f, 0.f, 0.f, 0.f};
}
__device__ __forceinline__ void store4bf(bf16_t* dst, f32x4 v) { uint2 o; o.x = pack2(v[0], v[1]); o.y = pack2(v[2], v[3]); *(uint2*)dst = o; }


namespace pg8 {
#define PG8_LAS __attribute__((address_space(3)))
typedef unsigned u32x4 __attribute__((ext_vector_type(4)));
constexpr int BM = 256, BK = 64, HALF = 128, HTB = HALF * BK * 2, STAGE_BYTES = 8 * HTB, NXCD = 8, WGM = 8;
__host__ __device__ __forceinline__ int lds_byte(int r, int c) { const int st = (r >> 4) * 2 + (c >> 5), rr = r & 15, cc = c & 31, ob = rr * 64 + cc * 2; return st * 1024 + (ob ^ (((ob >> 9) & 1) << 5)); }
__host__ __device__ __forceinline__ void stage_rc(int b, int& R, int& C) { const int st = b / 1024, sb = b % 1024, swz = sb ^ (((sb >> 9) & 1) << 5); R = (st >> 1) * 16 + swz / 64; C = (st & 1) * 32 + (swz % 64) / 2; }
__host__ __device__ __forceinline__ int perm32(int rho) { const int n = rho >> 4, i = rho & 15; return 8 * (i >> 2) + 4 * n + (i & 3); }
struct Unit { int pm, pn; };
struct Gemm { const bf16_t* A; const bf16_t* Bt; int M, N, K; };
struct StaticOrder {
    int nM, nN, nwg, G, c;
    __device__ void init(int M, int N, int G_, int c_) { nM = M / BM; nN = N / BM; nwg = nM * nN; G = G_; c = c_; }
    __device__ bool next(int i, Unit& u) const {
        const long L = (long)i * G + c; if (L >= nwg) return false;
        int wgid = (int)L; { const int q = nwg / NXCD, r = nwg % NXCD, xcd = wgid % NXCD, off = wgid / NXCD; wgid = (xcd < r ? xcd * (q + 1) : r * (q + 1) + (xcd - r) * q) + off; }
        const int nig = WGM * nN, gid = wgid / nig, fm = gid * WGM, gsz = (nM - fm) < WGM ? (nM - fm) : WGM;
        u.pm = fm + ((wgid % nig) % gsz); u.pn = (wgid % nig) / gsz; return true;
    }
    __device__ __forceinline__ void a_ready(const Unit&) const {}
    __device__ __forceinline__ void done(const Unit&) const {}
};
template <int NT> struct GroupedOrder {
    const int* blk_e; int nunits, G, c;
    __device__ bool next(int i, Unit& u) const { const long L = (long)i * G + c; if (L >= nunits) return false; const int rb = (int)L / NT; u.pm = rb; u.pn = blk_e[rb] * NT + (int)L % NT; return true; }
    __device__ __forceinline__ void a_ready(const Unit&) const {}
    __device__ __forceinline__ void done(const Unit&) const {}
};
template <class Epi, class Sched, bool ALIGN_EPI = false, bool SP2 = false>
__device__ __forceinline__ void gemm_phase(PG8_LAS unsigned char* lds, const Gemm g, const Sched& S, const Epi& E) {
    const int tid = ltid(), wid = __builtin_amdgcn_readfirstlane(tid >> 6), lane = tid & 63, wr = wid >> 2, wc = wid & 3, fr = lane & 15, fq = lane >> 4;
    int K = g.K; asm volatile("" : "+s"(K)); const int nt = K / BK;
    unsigned voffA[2], voffB[2];
#pragma unroll
    for (int i = 0; i < 2; ++i) { int R, C; stage_rc(tid * 16 + i * 8192, R, C); const int Rb = Epi::PERM ? ((R & ~31) + perm32(R & 31)) : R;
        voffA[i] = (unsigned)(R * K + C) * 2u; voffB[i] = (unsigned)(Rb * K + C) * 2u; }
    const size_t kstep = (size_t)(BK * 2);
    const size_t hstep = (size_t)HALF * K * 2;
    const size_t tstep = 2 * hstep;
    const unsigned ldsw = (unsigned)wid * 1024u;
    const int aoff = lds_byte(wr * 64 + fr, fq * 8), boff = lds_byte(wc * 32 + fr, fq * 8);
#define PG8_SA(b, h) (((b) * 2 + (h)) * HTB)
#define PG8_SB(b, h) ((4 + (b) * 2 + (h)) * HTB)
#define PG8_STAGE(bufoff, gbase, voff) do { _Pragma("unroll") for (int _i = 0; _i < 2; ++_i) \
        __builtin_amdgcn_global_load_lds((const unsigned*)((const char*)(gbase) + (voff)[_i]), (PG8_LAS unsigned*)(lds + (bufoff) + ldsw + _i * 8192), 16, 0, 0); } while (0)
#define PG8_LDA(dst, b, h) do { _Pragma("unroll") for (int m = 0; m < 4; ++m) _Pragma("unroll") for (int k = 0; k < 2; ++k) dst[m][k] = *(const PG8_LAS bf16x8*)(lds + PG8_SA(b, h) + aoff + m * 2048 + k * 1024); } while (0)
#define PG8_LDB(dst, b, h) do { _Pragma("unroll") for (int n = 0; n < 2; ++n) _Pragma("unroll") for (int k = 0; k < 2; ++k) dst[n][k] = *(const PG8_LAS bf16x8*)(lds + PG8_SB(b, h) + boff + n * 2048 + k * 1024); } while (0)
#define PG8_MMA(ai, bj, At, Bt) do { __builtin_amdgcn_s_setprio(1); _Pragma("unroll") for (int m = 0; m < 4; ++m) _Pragma("unroll") for (int n = 0; n < 2; ++n) _Pragma("unroll") for (int k = 0; k < 2; ++k) \
        acc[ai][bj][m][n] = __builtin_amdgcn_mfma_f32_16x16x32_bf16(Bt[n][k], At[m][k], acc[ai][bj][m][n], 0, 0, 0); __builtin_amdgcn_s_setprio(0); } while (0)
#define PG8_WAIT_V(n) asm volatile("s_waitcnt vmcnt(" #n ")" ::: "memory")
#define PG8_WAIT_L(n) asm volatile("s_waitcnt lgkmcnt(" #n ")" ::: "memory")
#define PG8_BAR __builtin_amdgcn_s_barrier()
#define PG8_SCHED __builtin_amdgcn_sched_barrier(0)
    Unit cur, nxt; int ui = 0;
    if (!S.next(0, cur)) return;
    f32x4 acc[2][2][4][2];
#pragma unroll
    for (int a = 0; a < 2; ++a)
#pragma unroll
        for (int b = 0; b < 2; ++b)
#pragma unroll
            for (int m = 0; m < 4; ++m)
#pragma unroll
                for (int n = 0; n < 2; ++n) acc[a][b][m][n] = (f32x4){0.f, 0.f, 0.f, 0.f};
    bf16x8 At[4][2], B0[2][2], B1[2][2];
    const char* cA = (const char*)g.A + (size_t)cur.pm * tstep; const char* cB = (const char*)g.Bt + (size_t)cur.pn * tstep;
    S.a_ready(cur);
    if constexpr (SP2) {
        PG8_STAGE(PG8_SB(0, 0), cB, voffB); PG8_STAGE(PG8_SB(0, 1), cB + hstep, voffB); PG8_STAGE(PG8_SA(0, 0), cA, voffA); PG8_STAGE(PG8_SA(0, 1), cA + hstep, voffA);
        if (wr == 1) PG8_BAR;
        PG8_WAIT_V(2); PG8_BAR;
        PG8_STAGE(PG8_SB(1, 0), cB + kstep, voffB); PG8_STAGE(PG8_SA(1, 0), cA + kstep, voffA); PG8_STAGE(PG8_SB(1, 1), cB + hstep + kstep, voffB);
        PG8_WAIT_V(6); PG8_BAR;
    } else {
        PG8_STAGE(PG8_SB(0, 0), cB, voffB); PG8_STAGE(PG8_SA(0, 0), cA, voffA); PG8_STAGE(PG8_SB(0, 1), cB + hstep, voffB); PG8_STAGE(PG8_SA(0, 1), cA + hstep, voffA);
        if (wr == 1) PG8_BAR;
        PG8_WAIT_V(4); PG8_BAR;
        PG8_STAGE(PG8_SB(1, 0), cB + kstep, voffB); PG8_STAGE(PG8_SA(1, 0), cA + kstep, voffA); PG8_STAGE(PG8_SB(1, 1), cB + hstep + kstep, voffB);
        PG8_WAIT_V(6); PG8_BAR;
    }
    for (;;) {
        const bool has_next = S.next(ui + 1, nxt);
        const char* nA = has_next ? (const char*)g.A + (size_t)nxt.pm * tstep : cA; const char* nB = has_next ? (const char*)g.Bt + (size_t)nxt.pn * tstep : cB;
        for (int t = 0; t < nt; t += 2) {
            const bool last = (t == nt - 2);
            const char* a1 = cA + (size_t)(t + 1) * kstep;
            const char* a2 = last ? nA : cA + (size_t)(t + 2) * kstep; const char* b2 = last ? nB : cB + (size_t)(t + 2) * kstep;
            const char* a3 = a2 + kstep; const char* b3 = b2 + kstep;
            if (last && has_next) S.a_ready(nxt);
            if constexpr (SP2) {
            PG8_LDB(B0, 0, 0); PG8_LDB(B1, 0, 1); PG8_SCHED; PG8_LDA(At, 0, 0); PG8_STAGE(PG8_SA(1, 1), a1 + hstep, voffA);
            PG8_WAIT_V(8); PG8_WAIT_L(0); PG8_BAR; PG8_MMA(0, 0, At, B0); PG8_MMA(0, 1, At, B1); PG8_BAR; PG8_SCHED;
            PG8_LDA(At, 0, 1); PG8_STAGE(PG8_SB(0, 0), b2, voffB); PG8_STAGE(PG8_SB(0, 1), b2 + hstep, voffB); PG8_STAGE(PG8_SA(0, 0), a2, voffA);
            PG8_WAIT_V(8); PG8_WAIT_L(0); PG8_BAR; PG8_MMA(1, 0, At, B0); PG8_MMA(1, 1, At, B1); PG8_BAR; PG8_SCHED;
            PG8_LDB(B0, 1, 0); PG8_LDB(B1, 1, 1); PG8_SCHED; PG8_LDA(At, 1, 0); PG8_STAGE(PG8_SA(0, 1), a2 + hstep, voffA);
            PG8_WAIT_V(8); PG8_WAIT_L(0); PG8_BAR; PG8_MMA(0, 0, At, B0); PG8_MMA(0, 1, At, B1); PG8_BAR; PG8_SCHED;
            PG8_LDA(At, 1, 1); PG8_STAGE(PG8_SB(1, 0), b3, voffB); PG8_STAGE(PG8_SB(1, 1), b3 + hstep, voffB); PG8_STAGE(PG8_SA(1, 0), a3, voffA);
            PG8_WAIT_V(8); PG8_WAIT_L(0); PG8_BAR; PG8_MMA(1, 0, At, B0); PG8_MMA(1, 1, At, B1); PG8_BAR; PG8_SCHED;
            } else {
            PG8_LDB(B0, 0, 0); PG8_SCHED; PG8_LDA(At, 0, 0); PG8_STAGE(PG8_SA(1, 1), a1 + hstep, voffA);
            PG8_WAIT_L(8); PG8_BAR; PG8_WAIT_L(0); PG8_MMA(0, 0, At, B0); PG8_BAR; PG8_SCHED;
            PG8_LDB(B1, 0, 1); PG8_STAGE(PG8_SB(0, 0), b2, voffB);
            PG8_BAR; PG8_WAIT_L(0); PG8_MMA(0, 1, At, B1); PG8_BAR;
            PG8_LDA(At, 0, 1); PG8_STAGE(PG8_SA(0, 0), a2, voffA);
            PG8_BAR; PG8_WAIT_L(0); PG8_MMA(1, 0, At, B0); PG8_BAR; PG8_SCHED;
            PG8_STAGE(PG8_SB(0, 1), b2 + hstep, voffB);
            PG8_WAIT_V(6); PG8_BAR; PG8_MMA(1, 1, At, B1); PG8_BAR;
            PG8_LDB(B0, 1, 0); PG8_SCHED; PG8_LDA(At, 1, 0); PG8_STAGE(PG8_SA(0, 1), a2 + hstep, voffA);
            PG8_WAIT_L(8); PG8_BAR; PG8_WAIT_L(0); PG8_MMA(0, 0, At, B0); PG8_BAR; PG8_SCHED;
            PG8_LDB(B1, 1, 1); PG8_STAGE(PG8_SB(1, 0), b3, voffB);
            PG8_BAR; PG8_WAIT_L(0); PG8_MMA(0, 1, At, B1); PG8_BAR;
            PG8_LDA(At, 1, 1); PG8_STAGE(PG8_SA(1, 0), a3, voffA);
            PG8_BAR; PG8_WAIT_L(0); PG8_MMA(1, 0, At, B0); PG8_BAR; PG8_SCHED;
            PG8_STAGE(PG8_SB(1, 1), b3 + hstep, voffB);
            PG8_WAIT_V(6); PG8_BAR; PG8_MMA(1, 1, At, B1); PG8_BAR;
            }
            if constexpr (Epi::HOOK) { if (t == 2 || t == 8) E.hook(acc, cur, t, wr, wc, fr, fq); }
        }
        if constexpr (ALIGN_EPI) { if (wr == 0) PG8_BAR; }
        if constexpr (!Epi::AFTER_DRAIN) { E(acc, cur, wr, wc, fr, fq); S.done(cur); }
        if (!has_next) break;
#pragma unroll
        for (int a = 0; a < 2; ++a)
#pragma unroll
            for (int b = 0; b < 2; ++b)
#pragma unroll
                for (int m = 0; m < 4; ++m)
#pragma unroll
                    for (int n = 0; n < 2; ++n) acc[a][b][m][n] = (f32x4){0.f, 0.f, 0.f, 0.f};
        cur = nxt; cA = nA; cB = nB; ++ui;
        if constexpr (ALIGN_EPI) { if (wr == 1) PG8_BAR; }
    }
    PG8_WAIT_V(0);
    if constexpr (!ALIGN_EPI) { if (wr == 0) PG8_BAR; }
    PG8_BAR;
    if constexpr (Epi::AFTER_DRAIN) { E.fused(acc, cur, wr, wc, fr, fq, lds, wid, lane); S.done(cur); }
#undef PG8_SA
#undef PG8_SB
#undef PG8_STAGE
#undef PG8_LDA
#undef PG8_LDB
#undef PG8_MMA
#undef PG8_WAIT_V
#undef PG8_WAIT_L
#undef PG8_BAR
#undef PG8_SCHED
}

}
__device__ __forceinline__ pg8::u32x4 pack8(const f32x4& a, const f32x4& b) { pg8::u32x4 w; w.x = pack2(a[0], a[1]); w.y = pack2(a[2], a[3]); w.z = pack2(b[0], b[1]); w.w = pack2(b[2], b[3]); return w; }
__device__ __forceinline__ void unpack8(const pg8::u32x4& w, f32x4& a, f32x4& b) {
    a[0] = __uint_as_float(w.x << 16); a[1] = __uint_as_float(w.x & 0xffff0000u); a[2] = __uint_as_float(w.y << 16); a[3] = __uint_as_float(w.y & 0xffff0000u);
    b[0] = __uint_as_float(w.z << 16); b[1] = __uint_as_float(w.z & 0xffff0000u); b[2] = __uint_as_float(w.w << 16); b[3] = __uint_as_float(w.w & 0xffff0000u); }


__device__ __forceinline__ void phase_gemm_in(const Params& p, int l, unsigned char* smem) {
    const int tid = ltid(), lane = tid & 63, wid = tid >> 6, wm = wid >> 1, wn = wid & 1, q4 = (lane >> 4) * 4;
    const int nM = T_ALL / 128, nN = IN_COLS / 128;
    for (int tile = blockIdx.x; tile < nM * nN; tile += gridDim.x) {
        const int tm = tile / nN, tn = tile % nN, m0 = tm * 128, n0 = tn * 128;
        f32x4 acc[2][4]; zero_acc(acc);
        RowsLinear ar{p.h + (size_t)m0 * 1024, 1024};
        gemm_core(smem, ar, p.wt_in + (size_t)n0 * 1024, 1024, 0, 1024, acc);
        const int cb = n0 + wn * 64;
#pragma unroll
        for (int mi = 0; mi < 2; ++mi) {
            const int t = m0 + wm * 32 + mi * 16 + (lane & 15);
            f32x4 v0 = acc[mi][0], v1 = acc[mi][1], v2 = acc[mi][2], v3 = acc[mi][3];
            if (cb >= 2560) {
                bf16_t* dst = p.uG + (size_t)t * UG_LD + (cb - 2560) + q4;
#pragma unroll
                for (int e = 0; e < 4; ++e) { v0[e] = 1.f / (1.f + __expf(-v0[e])); v1[e] = 1.f / (1.f + __expf(-v1[e])); v2[e] = 1.f / (1.f + __expf(-v2[e])); v3[e] = 1.f / (1.f + __expf(-v3[e])); }
                store4bf(dst, v0); store4bf(dst + 16, v1); store4bf(dst + 32, v2); store4bf(dst + 48, v3);
            } else {
                const bool isq = (cb >= 768 && cb < 1152) || (cb >= 1920 && cb < 2304);
                const bool rope = (cb >= 1920 && cb < 2432) && (t < T_LAT);
                if (rope) { const int pos = t & 8191, r = pos >> 6, cc = pos & 63;
#pragma unroll
                    for (int e = 0; e < 4; ++e) {
                        const float2 csr = *(const float2*)(p.ropet + (r * 16 + q4 + e) * 2), csc = *(const float2*)(p.ropet + (cc * 16 + q4 + e) * 2);
                        const float a1 = v0[e], a2 = v1[e]; v0[e] = a1 * csr.x - a2 * csr.y; v1[e] = a1 * csr.y + a2 * csr.x;
                        const float b1 = v2[e], b2 = v3[e]; v2[e] = b1 * csc.x - b2 * csc.y; v3[e] = b1 * csc.y + b2 * csc.x; } }
                if (isq) { v0 = v0 * 0.125f; v1 = v1 * 0.125f; v2 = v2 * 0.125f; v3 = v3 * 0.125f; }
                bf16_t* dst = p.uA + (size_t)t * UA_LD + cb + q4;
                store4bf(dst, v0); store4bf(dst + 16, v1); store4bf(dst + 32, v2); store4bf(dst + 48, v3);
            }
        }
    }
}

struct KmNA { int b, r, c, rs, cs; const float* rpb;
    __device__ __forceinline__ int tok(int kk) const { if (kk < 128) return b * SEQ + (rs + (kk >> 4)) * 64 + cs + (kk & 15); return T_LAT + b * CTXL + (kk - 128); }
    __device__ __forceinline__ float bias(int kk) const { if (kk < 128) return rpb[(rs + (kk >> 4) - r + 7) * 31 + (cs + (kk & 15) - c + 15)]; return 0.f; } };
struct KmSWA { int b, i;
    __device__ __forceinline__ int tok(int kk) const { if (kk < 257) { const int j = i - 128 + kk; return (j >= 0 && j < SEQ) ? b * SEQ + j : -1; } if (kk < 513) return T_LAT + b * CTXL + (kk - 257); return -1; }
    __device__ __forceinline__ float bias(int) const { return 0.f; } };
struct KmCtx { int b;
    __device__ __forceinline__ int tok(int kk) const { return T_LAT + b * CTXL + kk; }
    __device__ __forceinline__ float bias(int) const { return 0.f; } };

template <int NI, class KM>
__device__ __forceinline__ void attn_item(const bf16_t* uA, int tq, int qcol, int kcol, int vcol, const KM& km, bool has_sink, float sink, bf16_t* outp, int lane) {
    float q[64];
    {   const uint4* qp = (const uint4*)(uA + (size_t)tq * UA_LD + qcol);
#pragma unroll
        for (int c = 0; c < 8; ++c) { const uint4 v = qp[c];
            q[c * 8 + 0] = bf2f((bf16_t)(v.x & 0xffff)); q[c * 8 + 1] = bf2f((bf16_t)(v.x >> 16)); q[c * 8 + 2] = bf2f((bf16_t)(v.y & 0xffff)); q[c * 8 + 3] = bf2f((bf16_t)(v.y >> 16));
            q[c * 8 + 4] = bf2f((bf16_t)(v.z & 0xffff)); q[c * 8 + 5] = bf2f((bf16_t)(v.z >> 16)); q[c * 8 + 6] = bf2f((bf16_t)(v.w & 0xffff)); q[c * 8 + 7] = bf2f((bf16_t)(v.w >> 16)); } }
    float s[NI]; float mx = -3.0e38f;
#pragma unroll
    for (int i = 0; i < NI; ++i) { const int kk = i * 64 + lane; const int tk = km.tok(kk);
        float d = -3.0e38f;
        if (tk >= 0) { const uint4* kp = (const uint4*)(uA + (size_t)tk * UA_LD + kcol); d = 0.f;
#pragma unroll
            for (int c = 0; c < 8; ++c) { const uint4 v = kp[c];
                d += q[c * 8 + 0] * bf2f((bf16_t)(v.x & 0xffff)) + q[c * 8 + 1] * bf2f((bf16_t)(v.x >> 16)) + q[c * 8 + 2] * bf2f((bf16_t)(v.y & 0xffff)) + q[c * 8 + 3] * bf2f((bf16_t)(v.y >> 16))
                   + q[c * 8 + 4] * bf2f((bf16_t)(v.z & 0xffff)) + q[c * 8 + 5] * bf2f((bf16_t)(v.z >> 16)) + q[c * 8 + 6] * bf2f((bf16_t)(v.w & 0xffff)) + q[c * 8 + 7] * bf2f((bf16_t)(v.w >> 16)); }
            d += km.bias(kk); }
        s[i] = d; mx = fmaxf(mx, d); }
    mx = wave_max(mx); if (has_sink) mx = fmaxf(mx, sink);
    float sum = 0.f;
#pragma unroll
    for (int i = 0; i < NI; ++i) { const float pv = s[i] > -1.0e38f ? __expf(s[i] - mx) : 0.f; s[i] = pv; sum += pv; }
    sum = wave_sum(sum); if (has_sink) sum += __expf(sink - mx);
    const float inv = 1.0f / sum;
    float o = 0.f;
#pragma unroll
    for (int i = 0; i < NI; ++i) {
        for (int sl = 0; sl < 64; ++sl) { const int tk = km.tok(i * 64 + sl); const float pv = __shfl(s[i], sl);
            if (tk >= 0) o += pv * bf2f(uA[(size_t)tk * UA_LD + vcol + lane]); } }
    outp[lane] = f2bf(o * inv);
}

__device__ __forceinline__ void phase_mix(const Params& p, int l) {
    const int tid = ltid(), lane = tid & 63, wid = tid >> 6;
    const bool need_ctx = l < DEPTH - 1;
    {   const int ntok = need_ctx ? T_ALL : T_LAT; const float* cw = p.conv_w + l * 3 * 256;
        for (int idx = blockIdx.x * NTHR + tid; idx < ntok * 256; idx += gridDim.x * NTHR) { const int t = idx >> 8, c = idx & 255;
            int pos, len; if (t < T_LAT) { pos = t & 8191; len = SEQ; } else { pos = (t - T_LAT) & 255; len = CTXL; }
            const bf16_t* u = p.uA + (size_t)t * UA_LD + c;
            const float z1 = bf2f(u[512]) * bf2f(u[0]);
            const float z0 = pos > 0 ? bf2f(u[512 - UA_LD]) * bf2f(u[-UA_LD]) : 0.f;
            const float z2 = pos + 1 < len ? bf2f(u[512 + UA_LD]) * bf2f(u[UA_LD]) : 0.f;
            const float y = bf2f(u[256]) * (z0 * cw[c] + z1 * cw[256 + c] + z2 * cw[512 + c]);
            p.ycat[(size_t)t * 1024 + c] = f2bf(y); } }
    const int n_lat = T_LAT * 12, n_all = n_lat + (need_ctx ? T_CTX * 12 : 0);
    for (int it = blockIdx.x * 8 + wid; it < n_all; it += gridDim.x * 8) {
        if (it < n_lat) { const int t = it / 12, hh = it % 12; const int b = t >> 13, pos = t & 8191;
            if (hh < 6) { KmNA km; km.b = b; km.r = pos >> 6; km.c = pos & 63; km.rs = min(max(km.r - 4, 0), 120); km.cs = min(max(km.c - 8, 0), 48); km.rpb = p.rpb + ((size_t)l * 6 + hh) * 15 * 31;
                attn_item<6>(p.uA, t, 768 + hh * 64, 1152 + hh * 64, 1536 + hh * 64, km, false, 0.f, p.ycat + (size_t)t * 1024 + 256 + hh * 64, lane); }
            else { const int hq = hh - 6, kh = hq / 3; KmSWA km; km.b = b; km.i = pos;
                attn_item<9>(p.uA, t, 1920 + hq * 64, 2304 + kh * 64, 2432 + kh * 64, km, true, p.sinks[l * 6 + hq], p.ycat + (size_t)t * 1024 + 640 + hq * 64, lane); }
        } else { const int it2 = it - n_lat; const int tc = it2 / 12, hh = it2 % 12; const int t = T_LAT + tc; KmCtx km; km.b = tc >> 8;
            if (hh < 6) attn_item<4>(p.uA, t, 768 + hh * 64, 1152 + hh * 64, 1536 + hh * 64, km, false, 0.f, p.ycat + (size_t)t * 1024 + 256 + hh * 64, lane);
            else { const int hq = hh - 6, kh = hq / 3; attn_item<4>(p.uA, t, 1920 + hq * 64, 2304 + kh * 64, 2432 + kh * 64, km, true, p.sinks[l * 6 + hq], p.ycat + (size_t)t * 1024 + 640 + hq * 64, lane); }
        }
    }
}


typedef float f32x16 __attribute__((ext_vector_type(16)));
typedef short s16x4 __attribute__((ext_vector_type(4)));
#define AT_STRIDE 144
#define AT_KBUF(b) ((b) * 9216)
#define AT_VBUF(b) (18432 + (b) * 9216)
#define AT_RPB 36864
#define LOG2E 1.4426950408889634f
#define AT_NEG (-1.0e30f)

template <int MK>
__device__ __forceinline__ void attn_tile(const unsigned char* kt, const unsigned char* vlane, const bf16x8 (&qf)[4], f32x16 (&oacc)[2], float& m, float& lsum,
                                          const float* rpb_row, int relc0  , int lo0  , int lane) {
    const int n = lane & 31, hh = lane >> 5;
    f32x16 sc;
#pragma unroll
    for (int r = 0; r < 16; ++r) sc[r] = 0.f;
#pragma unroll
    for (int sp = 0; sp < 4; ++sp) { const bf16x8 kf = *(const bf16x8*)(kt + n * AT_STRIDE + sp * 32 + hh * 16); sc = __builtin_amdgcn_mfma_f32_32x32x16_bf16(kf, qf[sp], sc, 0, 0, 0); }
    float mx = AT_NEG;
#pragma unroll
    for (int r = 0; r < 16; ++r) { const int i = (r & 3) + 8 * (r >> 2) + 4 * hh; float v = sc[r];
        if (MK == 1) { const bool ok = (i >= lo0) && (i < lo0 + 16); const int ridx = ok ? (relc0 + i) : 0; v = ok ? (v + rpb_row[ridx]) * LOG2E : AT_NEG; }
        else if (MK == 2) v = (i >= n) ? v * LOG2E : AT_NEG;
        else if (MK == 3) v = (i <= n) ? v * LOG2E : AT_NEG;
        else v = v * LOG2E;
        sc[r] = v; mx = fmaxf(mx, v); }
    mx = fmaxf(mx, __shfl_xor(mx, 32));
    const float mn = fmaxf(m, mx); const float alpha = __builtin_amdgcn_exp2f(m - mn); m = mn;
    float ps = 0.f;
#pragma unroll
    for (int r = 0; r < 16; ++r) { const float pv = __builtin_amdgcn_exp2f(sc[r] - mn); sc[r] = pv; ps += pv; }
    lsum = lsum * alpha + ps;
#pragma unroll
    for (int r = 0; r < 16; ++r) { oacc[0][r] *= alpha; oacc[1][r] *= alpha; }
    bf16x8 pf[2];
#pragma unroll
    for (int s2 = 0; s2 < 2; ++s2)
#pragma unroll
        for (int j = 0; j < 8; ++j) pf[s2][j] = (short)f2bf(sc[s2 * 8 + j]);
#pragma unroll
    for (int c = 0; c < 2; ++c)
#pragma unroll
        for (int s2 = 0; s2 < 2; ++s2) {
            const s16x4 v0 = __builtin_amdgcn_ds_read_tr16_b64_v4i16((LAS s16x4*)(vlane + (16 * s2) * AT_STRIDE + 64 * c));
            const s16x4 v1 = __builtin_amdgcn_ds_read_tr16_b64_v4i16((LAS s16x4*)(vlane + (16 * s2 + 8) * AT_STRIDE + 64 * c));
            bf16x8 vf; vf[0] = v0[0]; vf[1] = v0[1]; vf[2] = v0[2]; vf[3] = v0[3]; vf[4] = v1[0]; vf[5] = v1[1]; vf[6] = v1[2]; vf[7] = v1[3];
            oacc[c] = __builtin_amdgcn_mfma_f32_32x32x16_bf16(vf, pf[s2], oacc[c], 0, 0, 0);
        }
}

template <int MODE>
__device__ __forceinline__ void attn_unit(const Params& p, int l, int u, unsigned char* smem) {
    const int tid = ltid(), lane = tid & 63, wid = tid >> 6;
    int b, qcol, kcol, vcol, ocol, qtok; bool has_sink = false; float sinkv = 0.f;
    int nsteps, krlo = 0, r = 0, rs = 0, c = 0, cs = 0, q0 = 0, jwlo = 0;
    if (MODE == 0) { b = u / 192; const int rem = u % 192, h = rem / 32, rg = rem % 32; qcol = 768 + h * 64; kcol = 1152 + h * 64; vcol = 1536 + h * 64; ocol = 256 + h * 64;
        r = rg * 4 + (wid >> 1); rs = min(max(r - 4, 0), 120); c = 32 * (wid & 1) + (lane & 31); cs = min(max(c - 8, 0), 48);
        krlo = min(max(rg * 4 - 4, 0), 120); const int krhi = min(max(rg * 4 + 3 - 4, 0), 120) + 7; nsteps = 4 + (krhi - krlo + 1);
        qtok = b * SEQ + r * 64 + 32 * (wid & 1);
        for (int i = tid; i < 15 * 31; i += NTHR) ((float*)(smem + AT_RPB))[i] = p.rpb[((size_t)l * 6 + h) * 465 + i];
    } else if (MODE == 1) { b = u / 192; const int rem = u % 192, hq = rem / 32, qb = rem % 32, kh = hq / 3; qcol = 1920 + hq * 64; kcol = 2304 + kh * 64; vcol = 2432 + kh * 64; ocol = 640 + hq * 64;
        q0 = qb * 256; jwlo = (q0 == 0) ? 2 : 0; const int jwhi = min(8, (SEQ - q0 + 128) / 64); nsteps = 4 + (jwhi - jwlo);
        qtok = b * SEQ + q0 + 32 * wid; has_sink = true; sinkv = p.sinks[l * 6 + hq];
    } else { b = u / 12; const int hh = u % 12;
        if (hh < 6) { qcol = 768 + hh * 64; kcol = 1152 + hh * 64; vcol = 1536 + hh * 64; ocol = 256 + hh * 64; }
        else { const int hq = hh - 6, kh = hq / 3; qcol = 1920 + hq * 64; kcol = 2304 + kh * 64; vcol = 2432 + kh * 64; ocol = 640 + hq * 64; has_sink = true; sinkv = p.sinks[l * 6 + hq]; }
        nsteps = 4; qtok = T_LAT + b * CTXL + 32 * wid;
    }
    const bf16_t* uA = p.uA;
    bf16x8 qf[4];
    {   const bf16_t* qp = uA + (size_t)(qtok + (lane & 31)) * UA_LD + qcol + (lane >> 5) * 8;
#pragma unroll
        for (int sp = 0; sp < 4; ++sp) qf[sp] = *(const bf16x8*)(qp + sp * 16); }
    f32x16 oacc[2];
#pragma unroll
    for (int r16 = 0; r16 < 16; ++r16) { oacc[0][r16] = 0.f; oacc[1][r16] = 0.f; }
    float m = has_sink ? sinkv * LOG2E : AT_NEG, lsum = (has_sink && lane < 32) ? 1.f : 0.f;
    const int skey = tid >> 3, sch = tid & 7; const int soff = skey * AT_STRIDE + sch * 16;
    auto chunk_tok = [&](int j) -> int {
        if (j < 4) return T_LAT + b * CTXL + 64 * j;
        if (MODE == 0) return b * SEQ + (krlo + (j - 4)) * 64;
        return b * SEQ + q0 - 128 + 64 * (jwlo + (j - 4)); };
    uint4 rk, rv;
    {   const bf16_t* src = uA + (size_t)(chunk_tok(0) + skey) * UA_LD + sch * 8; rk = *(const uint4*)(src + kcol); rv = *(const uint4*)(src + vcol); }
    *(uint4*)(smem + AT_KBUF(0) + soff) = rk; *(uint4*)(smem + AT_VBUF(0) + soff) = rv;
    __syncthreads();
    const int vl_off = (4 * (lane >> 5) + ((lane & 15) >> 2)) * AT_STRIDE + (16 * ((lane >> 4) & 1) + 4 * (lane & 3)) * 2;
    const float* rpb_s = (const float*)(smem + AT_RPB);
    for (int j = 0; j < nsteps; ++j) {
        const int buf = j & 1;
        if (j + 1 < nsteps) { const bf16_t* src = uA + (size_t)(chunk_tok(j + 1) + skey) * UA_LD + sch * 8; rk = *(const uint4*)(src + kcol); rv = *(const uint4*)(src + vcol); }
        const unsigned char* kb = smem + AT_KBUF(buf); const unsigned char* vb = smem + AT_VBUF(buf) + vl_off;
        if (j < 4) {
            attn_tile<0>(kb, vb, qf, oacc, m, lsum, rpb_s, 0, 0, lane);
            attn_tile<0>(kb + 32 * AT_STRIDE, vb + 32 * AT_STRIDE, qf, oacc, m, lsum, rpb_s, 0, 0, lane);
        } else if (MODE == 0) {
            const int kr = krlo + (j - 4);
            if (kr >= rs && kr < rs + 8) { const float* rrow = rpb_s + (kr - r + 7) * 31;
                attn_tile<1>(kb, vb, qf, oacc, m, lsum, rrow, 0 - c + 15, cs, lane);
                attn_tile<1>(kb + 32 * AT_STRIDE, vb + 32 * AT_STRIDE, qf, oacc, m, lsum, rrow, 32 - c + 15, cs - 32, lane); }
        } else if (MODE == 1) {
            const int qp0 = q0 + 32 * wid;
#pragma unroll
            for (int tl = 0; tl < 2; ++tl) { const int kp0 = q0 - 128 + 64 * (jwlo + (j - 4)) + 32 * tl; const int d = kp0 - qp0;
                const unsigned char* kt = kb + tl * 32 * AT_STRIDE; const unsigned char* vt = vb + tl * 32 * AT_STRIDE;
                if (d == -128) attn_tile<2>(kt, vt, qf, oacc, m, lsum, rpb_s, 0, 0, lane);
                else if (d == 128) attn_tile<3>(kt, vt, qf, oacc, m, lsum, rpb_s, 0, 0, lane);
                else if (d > -128 && d < 128) attn_tile<0>(kt, vt, qf, oacc, m, lsum, rpb_s, 0, 0, lane); }
        }
        if (j + 1 < nsteps) { *(uint4*)(smem + AT_KBUF(buf ^ 1) + soff) = rk; *(uint4*)(smem + AT_VBUF(buf ^ 1) + soff) = rv; }
        __syncthreads();
    }
    const float ltot = lsum + __shfl_xor(lsum, 32); const float inv = 1.0f / ltot;
    bf16_t* op = p.ycat + (size_t)(qtok + (lane & 31)) * 1024 + ocol + 4 * (lane >> 5);
#pragma unroll
    for (int cc = 0; cc < 2; ++cc)
#pragma unroll
        for (int g = 0; g < 4; ++g) { f32x4 v; v[0] = oacc[cc][4 * g] * inv; v[1] = oacc[cc][4 * g + 1] * inv; v[2] = oacc[cc][4 * g + 2] * inv; v[3] = oacc[cc][4 * g + 3] * inv;
            store4bf(op + 32 * cc + 8 * g, v); }
}

__device__ __forceinline__ void phase_mix2(const Params& p, int l, unsigned char* smem) {
    const int tid = ltid();
    const bool need_ctx = l < DEPTH - 1;
    {
        const int ntok = need_ctx ? T_ALL : T_LAT; const float* cw = p.conv_w + l * 3 * 256;
        for (int idx = blockIdx.x * NTHR + tid; idx < ntok * 32; idx += gridDim.x * NTHR) { const int t = idx >> 5, c = (idx & 31) * 8;
            int pos, len; if (t < T_LAT) { pos = t & 8191; len = SEQ; } else { pos = (t - T_LAT) & 255; len = CTXL; }
            const bf16_t* u = p.uA + (size_t)t * UA_LD + c;
            const bool hp = pos > 0, hn = pos + 1 < len;
            const pg8::u32x4 zero4 = (pg8::u32x4){0u, 0u, 0u, 0u};
            const pg8::u32x4 h1 = *(const pg8::u32x4*)u, c1 = *(const pg8::u32x4*)(u + 512), b1 = *(const pg8::u32x4*)(u + 256);
            const pg8::u32x4 h0 = hp ? *(const pg8::u32x4*)(u - UA_LD) : zero4, c0 = hp ? *(const pg8::u32x4*)(u + 512 - UA_LD) : zero4;
            const pg8::u32x4 h2 = hn ? *(const pg8::u32x4*)(u + UA_LD) : zero4, c2 = hn ? *(const pg8::u32x4*)(u + 512 + UA_LD) : zero4;
            f32x4 w0a = *(const f32x4*)(cw + c), w0b = *(const f32x4*)(cw + c + 4), w1a = *(const f32x4*)(cw + 256 + c), w1b = *(const f32x4*)(cw + 256 + c + 4), w2a = *(const f32x4*)(cw + 512 + c), w2b = *(const f32x4*)(cw + 512 + c + 4);
            f32x4 ha, hb, ca, cb, ya, yb;
            unpack8(h0, ha, hb); unpack8(c0, ca, cb); ya = ha * ca * w0a; yb = hb * cb * w0b;
            unpack8(h1, ha, hb); unpack8(c1, ca, cb); ya += ha * ca * w1a; yb += hb * cb * w1b;
            unpack8(h2, ha, hb); unpack8(c2, ca, cb); ya += ha * ca * w2a; yb += hb * cb * w2b;
            unpack8(b1, ha, hb); ya = ya * ha; yb = yb * hb;
            *(pg8::u32x4*)(p.ycat + (size_t)t * 1024 + c) = pack8(ya, yb); } }
    for (int u = blockIdx.x; u < 768; u += gridDim.x) attn_unit<0>(p, l, u, smem);
    for (int u = blockIdx.x; u < 768; u += gridDim.x) attn_unit<1>(p, l, u, smem);
    if (need_ctx) for (int u = blockIdx.x; u < 48; u += gridDim.x) attn_unit<2>(p, l, u, smem);
}

__device__ __forceinline__ void phase_gemm_merge(const Params& p, int l, unsigned char* smem) {
    const int tid = ltid(), lane = tid & 63, wid = tid >> 6, wm = wid >> 1, wn = wid & 1, q4 = (lane >> 4) * 4;
    const int ntok = (l < DEPTH - 1) ? T_ALL : T_LAT; const int nM = ntok / 128, nN = 8;
    for (int tile = blockIdx.x; tile < nM * nN; tile += gridDim.x) {
        const int tm = tile / nN, tn = tile % nN, m0 = tm * 128, n0 = tn * 128;
        f32x4 macc[2][4]; zero_acc(macc);
        RowsLinear ar{p.ycat + (size_t)m0 * 1024, 1024};
#pragma unroll
        for (int seg = 0; seg < 3; ++seg) {
            const int k0 = seg == 0 ? 0 : (seg == 1 ? 256 : 640), k1 = seg == 0 ? 256 : (seg == 1 ? 640 : 1024);
            f32x4 acc[2][4]; zero_acc(acc);
            gemm_core(smem, ar, p.wt_br + (size_t)n0 * 1024, 1024, k0, k1, acc);
#pragma unroll
            for (int mi = 0; mi < 2; ++mi) { const int t = m0 + wm * 32 + mi * 16 + (lane & 15);
#pragma unroll
                for (int nj = 0; nj < 4; ++nj) { const uint2 g = *(const uint2*)(p.uG + (size_t)t * UG_LD + seg * 1024 + n0 + wn * 64 + nj * 16 + q4);
                    macc[mi][nj][0] += bf2f((bf16_t)(g.x & 0xffff)) * acc[mi][nj][0]; macc[mi][nj][1] += bf2f((bf16_t)(g.x >> 16)) * acc[mi][nj][1];
                    macc[mi][nj][2] += bf2f((bf16_t)(g.y & 0xffff)) * acc[mi][nj][2]; macc[mi][nj][3] += bf2f((bf16_t)(g.y >> 16)) * acc[mi][nj][3]; } }
        }
#pragma unroll
        for (int mi = 0; mi < 2; ++mi) { const int t = m0 + wm * 32 + mi * 16 + (lane & 15);
#pragma unroll
            for (int nj = 0; nj < 4; ++nj) store4bf(p.mbuf + (size_t)t * 1024 + n0 + wn * 64 + nj * 16 + q4, macc[mi][nj]); }
    }
}

__device__ __forceinline__ void phase_gemm_o(const Params& p, int l, unsigned char* smem) {
    const int tid = ltid(), lane = tid & 63, wid = tid >> 6, wm = wid >> 1, wn = wid & 1, q4 = (lane >> 4) * 4;
    const int ntok = (l < DEPTH - 1) ? T_ALL : T_LAT; const int nM = ntok / 128, nN = 8;
    for (int tile = blockIdx.x; tile < nM * nN; tile += gridDim.x) {
        const int tm = tile / nN, tn = tile % nN, m0 = tm * 128, n0 = tn * 128;
        f32x4 acc[2][4]; zero_acc(acc);
        RowsLinear ar{p.mbuf + (size_t)m0 * 1024, 1024};
        gemm_core(smem, ar, p.wt_o + (size_t)n0 * 1024, 1024, 0, 1024, acc);
#pragma unroll
        for (int mi = 0; mi < 2; ++mi) { const int t = m0 + wm * 32 + mi * 16 + (lane & 15); const float* gt = p.modv + (size_t)(l * 5 + tok_variant(t)) * 6144 + 2048;
#pragma unroll
            for (int nj = 0; nj < 4; ++nj) { const int c = n0 + wn * 64 + nj * 16 + q4; float4* xp = (float4*)(p.xs + (size_t)t * 1024 + c); float4 xv = *xp; const float4 g = *(const float4*)(gt + c);
                xv.x += g.x * acc[mi][nj][0]; xv.y += g.y * acc[mi][nj][1]; xv.z += g.z * acc[mi][nj][2]; xv.w += g.w * acc[mi][nj][3]; *xp = xv; } }
    }
}

#define RT_LD 1028
__device__ __forceinline__ void phase_router(const Params& p, int l, float* smem) {
    const int tid = ltid(), lane = tid & 63, wid = tid >> 6;
    float* sh2 = smem;
    float* spart = smem + 16 * RT_LD;
    float* slg = spart + 8 * 16 * 32;
    int* bcnt = (int*)(slg + 16 * 36);
    if (tid < 32) bcnt[tid] = 0;
    const int ntok = (l < DEPTH - 1) ? T_ALL : T_LAT;
    const float* wre = p.w_re + (size_t)l * 1024 * 32; const float* wrg = p.w_rg + (size_t)l * 1024 * 4;
    float bw[32][2];
#pragma unroll
    for (int ks = 0; ks < 32; ++ks) { const float* wp = wre + (size_t)(wid * 128 + ks * 4 + (lane >> 4)) * 32 + (lane & 15); bw[ks][0] = wp[0]; bw[ks][1] = wp[16]; }
    for (int tb = blockIdx.x; tb < ntok / 16; tb += gridDim.x) {
#pragma unroll
        for (int j = 0; j < 2; ++j) { const int tt = wid * 2 + j, t = tb * 16 + tt; const int v = tok_variant(t);
            float4 xv[4]; float ss = 0.f;
#pragma unroll
            for (int i = 0; i < 4; ++i) { xv[i] = *(const float4*)(p.xs + (size_t)t * 1024 + i * 256 + lane * 4); ss += xv[i].x * xv[i].x + xv[i].y * xv[i].y + xv[i].z * xv[i].z + xv[i].w * xv[i].w; }
            ss = wave_sum(ss); const float rstd = rsqrtf(ss * (1.0f / 1024.0f) + 1e-6f);
            const float* mv = p.modv + (size_t)(l * 5 + v) * 6144 + 3072;
            float g0 = 0.f, g1 = 0.f, g2 = 0.f, g3 = 0.f;
#pragma unroll
            for (int i = 0; i < 4; ++i) { const int c = i * 256 + lane * 4;
                const float4 g = *(const float4*)(p.g_ffn + l * 1024 + c), sh = *(const float4*)(mv + c), sc = *(const float4*)(mv + 1024 + c);
                float4 o; o.x = xv[i].x * rstd * g.x * (1.f + sc.x) + sh.x; o.y = xv[i].y * rstd * g.y * (1.f + sc.y) + sh.y; o.z = xv[i].z * rstd * g.z * (1.f + sc.z) + sh.z; o.w = xv[i].w * rstd * g.w * (1.f + sc.w) + sh.w;
                *(float4*)(sh2 + tt * RT_LD + c) = o; uint2 ob; ob.x = pack2(o.x, o.y); ob.y = pack2(o.z, o.w); *(uint2*)(p.h + (size_t)t * 1024 + c) = ob;
                const float4 w0 = *(const float4*)(wrg + (c + 0) * 4), w1 = *(const float4*)(wrg + (c + 1) * 4), w2 = *(const float4*)(wrg + (c + 2) * 4), w3 = *(const float4*)(wrg + (c + 3) * 4);
                g0 += o.x * w0.x + o.y * w1.x + o.z * w2.x + o.w * w3.x; g1 += o.x * w0.y + o.y * w1.y + o.z * w2.y + o.w * w3.y;
                g2 += o.x * w0.z + o.y * w1.z + o.z * w2.z + o.w * w3.z; g3 += o.x * w0.w + o.y * w1.w + o.z * w2.w + o.w * w3.w; }
            g0 = wave_sum(g0); g1 = wave_sum(g1); g2 = wave_sum(g2); g3 = wave_sum(g3);
            if (lane == 0) { slg[tt * 36 + 0] = g0 + p.b_rg[l * 4 + 0]; slg[tt * 36 + 1] = g1 + p.b_rg[l * 4 + 1]; slg[tt * 36 + 2] = g2 + p.b_rg[l * 4 + 2]; slg[tt * 36 + 3] = g3 + p.b_rg[l * 4 + 3]; } }
        __syncthreads();
        {   f32x4 c0 = (f32x4){0.f, 0.f, 0.f, 0.f}, c1 = c0;
            const float* ap = sh2 + (lane & 15) * RT_LD + wid * 128 + (lane >> 4);
#pragma unroll
            for (int ks = 0; ks < 32; ++ks) { const float a = ap[ks * 4];
                c0 = __builtin_amdgcn_mfma_f32_16x16x4f32(a, bw[ks][0], c0, 0, 0, 0); c1 = __builtin_amdgcn_mfma_f32_16x16x4f32(a, bw[ks][1], c1, 0, 0, 0); }
#pragma unroll
            for (int r = 0; r < 4; ++r) { const int tk = 4 * (lane >> 4) + r; spart[(wid * 16 + tk) * 32 + (lane & 15)] = c0[r]; spart[(wid * 16 + tk) * 32 + 16 + (lane & 15)] = c1[r]; } }
        __syncthreads();
        {   const int tt = tid >> 5, j = tid & 31; float a = p.b_re[l * 32 + j];
#pragma unroll
            for (int w8 = 0; w8 < 8; ++w8) a += spart[(w8 * 16 + tt) * 32 + j];
            slg[tt * 36 + 4 + j] = a; }
        __syncthreads();
        if (tid < 16) { const int t = tb * 16 + tid; const float* lg = slg + tid * 36;
            int gi = 0; float gm = lg[0];
            for (int j = 1; j < 4; ++j) if (lg[j] > gm) { gm = lg[j]; gi = j; }
            float den = 0.f; for (int j = 0; j < 4; ++j) den += expf(lg[j] - gm);
            const float pg = 1.0f / den;
            const float* le = lg + 4 + gi * 8;
            int i1 = 0; float v1 = le[0]; for (int j = 1; j < 8; ++j) if (le[j] > v1) { v1 = le[j]; i1 = j; }
            int i2 = -1; float v2 = -3.0e38f; for (int j = 0; j < 8; ++j) if (j != i1 && le[j] > v2) { v2 = le[j]; i2 = j; }
            const float e2 = expf(v2 - v1); const float wa = 1.0f / (1.0f + e2), wb = e2 / (1.0f + e2);
            const int ea = gi * 8 + i1, eb = gi * 8 + i2;
            p.eid[t * 2] = ea; p.eid[t * 2 + 1] = eb; p.ewt[t * 2] = pg * wa; p.ewt[t * 2 + 1] = pg * wb;
            p.epos[t * 2] = atomicAdd(bcnt + ea, 1); p.epos[t * 2 + 1] = atomicAdd(bcnt + eb, 1); }
        __syncthreads();
    }
    __syncthreads();
    if (tid < 32) p.cnt[blockIdx.x * 32 + tid] = bcnt[tid];
}

__device__ __forceinline__ void phase_dispatch(const Params& p, int l, int* smem) {
    const int tid = ltid(), lane = tid & 63, wid = tid >> 6;
    int* sfull = smem;
    int* spre = smem + 512;
    int* pstart = smem + 1024;
    int* boff = smem + 1024 + 64;
    const int G = gridDim.x;
    {   const int e = tid & 31, part = tid >> 5; int sf = 0, sp = 0;
        for (int bb = part; bb < G; bb += 16) { const int c = p.cnt[bb * 32 + e]; sf += c; sp += (bb < (int)blockIdx.x) ? c : 0; }
        sfull[part * 32 + e] = sf; spre[part * 32 + e] = sp; }
    __syncthreads();
    if (tid < 32) { int tf = 0, tp = 0; for (int q = 0; q < 16; ++q) { tf += sfull[q * 32 + tid]; tp += spre[q * 32 + tid]; } sfull[tid] = tf; spre[tid] = tp; }
    __syncthreads();
    if (tid == 0) { int acc = 0; for (int e = 0; e < 32; ++e) { pstart[e] = acc; acc += ((sfull[e] + 255) >> 8) << 8; } pstart[32] = acc; }
    __syncthreads();
    if (tid < 32) boff[tid] = pstart[tid] + spre[tid];
    if (blockIdx.x == 0) { const int nb = pstart[32] >> 8;
        for (int rb = tid; rb < nb; rb += NTHR) { int e = 0; while (e < 31 && pstart[e + 1] <= rb * 256) ++e; p.blk_e[rb] = e; }
        if (tid == 0) p.nbu[0] = nb; }
    __syncthreads();
    const int ntok = (l < DEPTH - 1) ? T_ALL : T_LAT;
    for (int tb = blockIdx.x; tb < ntok / 16; tb += G) {
#pragma unroll
        for (int j = 0; j < 4; ++j) { const int a = tb * 32 + wid * 4 + j; const int t = a >> 1; const int sl = boff[p.eid[a]] + p.epos[a];
            if (lane == 0) p.slot[a] = sl;
            const uint4* src = (const uint4*)(p.h + (size_t)t * 1024); uint4* dst = (uint4*)(p.xd + (size_t)sl * 1024);
            dst[lane] = src[lane]; dst[lane + 64] = src[lane + 64]; }
    }
}

__device__ __forceinline__ void phase_gemm_e1(const Params& p, unsigned char* smem) {
    const int tid = ltid(), lane = tid & 63, wid = tid >> 6, wm = wid >> 1, wn = wid & 1, q4 = (lane >> 4) * 4;
    const int nb = p.nbu[0]; const int ntiles = nb * 2 * 4;
    for (int tile = blockIdx.x; tile < ntiles; tile += gridDim.x) {
        const int rb = tile >> 2, tn = tile & 3, m0 = rb * 128, e = p.blk_e[rb >> 1];
        f32x4 acc[2][4]; zero_acc(acc);
        RowsLinear ar{p.xd + (size_t)m0 * 1024, 1024};
        gemm_core(smem, ar, p.wt_gu + ((size_t)e * 512 + tn * 128) * 1024, 1024, 0, 1024, acc);
        const int pg = tn * 2 + wn;
#pragma unroll
        for (int mi = 0; mi < 2; ++mi) { const int sl = m0 + wm * 32 + mi * 16 + (lane & 15);
#pragma unroll
            for (int nj = 0; nj < 2; ++nj) { f32x4 g = acc[mi][nj], u = acc[mi][nj + 2], o;
#pragma unroll
                for (int e4 = 0; e4 < 4; ++e4) o[e4] = g[e4] / (1.f + __expf(-g[e4])) * u[e4];
                store4bf(p.hid + (size_t)sl * 256 + pg * 32 + nj * 16 + q4, o); } }
    }
}
__device__ __forceinline__ void phase_gemm_e2(const Params& p, unsigned char* smem) {
    const int tid = ltid(), lane = tid & 63, wid = tid >> 6, wm = wid >> 1, wn = wid & 1, q4 = (lane >> 4) * 4;
    const int nb = p.nbu[0]; const int ntiles = nb * 2 * 8;
    for (int tile = blockIdx.x; tile < ntiles; tile += gridDim.x) {
        const int rb = tile >> 3, tn = tile & 7, m0 = rb * 128, n0 = tn * 128, e = p.blk_e[rb >> 1];
        f32x4 acc[2][4]; zero_acc(acc);
        RowsLinear ar{p.hid + (size_t)m0 * 256, 256};
        gemm_core(smem, ar, p.wt_d + ((size_t)e * 1024 + n0) * 256, 256, 0, 256, acc);
#pragma unroll
        for (int mi = 0; mi < 2; ++mi) { const int sl = m0 + wm * 32 + mi * 16 + (lane & 15);
#pragma unroll
            for (int nj = 0; nj < 4; ++nj) store4bf(p.Y + (size_t)sl * 1024 + n0 + wn * 64 + nj * 16 + q4, acc[mi][nj]); }
    }
}


struct EpiIn { static constexpr bool PERM = true, AFTER_DRAIN = false, HOOK = false;
    bf16_t* uA; bf16_t* uG; const float* ropet;
    __device__ __forceinline__ void operator()(const f32x4 (&acc)[2][2][4][2], const pg8::Unit& u, int wr, int wc, int fr, int fq) const {
        const int row0 = u.pm * 256 + wr * 64 + fr; const bool latent = u.pm < 128;
#pragma unroll
        for (int bj = 0; bj < 2; ++bj) {
            const int cb32 = u.pn * 256 + bj * 128 + wc * 32, c0 = cb32 + 8 * fq;
            if (cb32 >= 2560) {
#pragma unroll
                for (int ai = 0; ai < 2; ++ai)
#pragma unroll
                    for (int m = 0; m < 4; ++m) { const int t = row0 + ai * 128 + m * 16; f32x4 v0 = acc[ai][bj][m][0], v1 = acc[ai][bj][m][1];
#pragma unroll
                        for (int e = 0; e < 4; ++e) { v0[e] = __builtin_amdgcn_rcpf(1.f + __expf(-v0[e])); v1[e] = __builtin_amdgcn_rcpf(1.f + __expf(-v1[e])); }
                        *(pg8::u32x4*)(uG + (size_t)t * UG_LD + (c0 - 2560)) = pack8(v0, v1); }
            } else {
                const bool isq = (cb32 >= 768 && cb32 < 1152) || (cb32 >= 1920 && cb32 < 2304);
                const bool rope = (cb32 >= 1920 && cb32 < 2432) && latent;
#pragma unroll
                for (int ai = 0; ai < 2; ++ai)
#pragma unroll
                    for (int m = 0; m < 4; ++m) { const int t = row0 + ai * 128 + m * 16; f32x4 v0 = acc[ai][bj][m][0], v1 = acc[ai][bj][m][1];
                        if (rope) { const int pos = t & 8191; const int posv = (wc & 1) ? (pos & 63) : (pos >> 6);
                            const float4* cs = (const float4*)(ropet + (posv * 16 + 8 * (fq & 1)) * 2);
                            const float4 c01 = cs[0], c23 = cs[1], c45 = cs[2], c67 = cs[3];
                            f32x4 p0, p1;
#pragma unroll
                            for (int e = 0; e < 4; ++e) { p0[e] = __shfl_xor(v0[e], 32); p1[e] = __shfl_xor(v1[e], 32); }
                            const float co0[4] = {c01.x, c01.z, c23.x, c23.z}, si0[4] = {c01.y, c01.w, c23.y, c23.w}, co1[4] = {c45.x, c45.z, c67.x, c67.z}, si1[4] = {c45.y, c45.w, c67.y, c67.w};
#pragma unroll
                            for (int e = 0; e < 4; ++e) {
                                if (fq < 2) { v0[e] = v0[e] * co0[e] - p0[e] * si0[e]; v1[e] = v1[e] * co1[e] - p1[e] * si1[e]; }
                                else { v0[e] = p0[e] * si0[e] + v0[e] * co0[e]; v1[e] = p1[e] * si1[e] + v1[e] * co1[e]; } } }
                        if (isq) { v0 = v0 * 0.125f; v1 = v1 * 0.125f; }
                        *(pg8::u32x4*)(uA + (size_t)t * UA_LD + c0) = pack8(v0, v1); }
            }
        }
    }
};

struct EpiMerge { static constexpr bool PERM = true, AFTER_DRAIN = false, HOOK = true;
    const bf16_t* uG; bf16_t* mo;
    __device__ __forceinline__ void hook(f32x4 (&acc)[2][2][4][2], const pg8::Unit& u, int t, int wr, int wc, int fr, int fq) const {
        int row0 = u.pm * 256 + wr * 64 + fr; asm volatile("" : "+v"(row0)); const int seg = (t == 2) ? 0 : 1;
#pragma unroll
        for (int ai = 0; ai < 2; ++ai)
#pragma unroll
            for (int m = 0; m < 4; ++m)
#pragma unroll
                for (int bj = 0; bj < 2; ++bj) { const int tr = row0 + ai * 128 + m * 16; const int c0 = u.pn * 256 + bj * 128 + wc * 32 + 8 * fq;
                    const bf16_t* gp = uG + (size_t)tr * UG_LD + seg * 1024 + c0;
                    const pg8::u32x4 wn = *(const pg8::u32x4*)gp, wd = *(const pg8::u32x4*)(gp + 1024);
                    f32x4 n0, n1, d0, d1; unpack8(wn, n0, n1); unpack8(wd, d0, d1);
#pragma unroll
                    for (int e = 0; e < 4; ++e) { acc[ai][bj][m][0][e] *= n0[e] * __builtin_amdgcn_rcpf(fmaxf(d0[e], 1e-20f)); acc[ai][bj][m][1][e] *= n1[e] * __builtin_amdgcn_rcpf(fmaxf(d1[e], 1e-20f)); }
                    if (bj == 1) asm volatile("" ::: "memory"); }
    }
    __device__ __forceinline__ void operator()(const f32x4 (&acc)[2][2][4][2], const pg8::Unit& u, int wr, int wc, int fr, int fq) const {
        const int row0 = u.pm * 256 + wr * 64 + fr;
#pragma unroll
        for (int ai = 0; ai < 2; ++ai)
#pragma unroll
            for (int m = 0; m < 4; ++m)
#pragma unroll
                for (int bj = 0; bj < 2; ++bj) { const int tr = row0 + ai * 128 + m * 16; const int c0 = u.pn * 256 + bj * 128 + wc * 32 + 8 * fq;
                    const pg8::u32x4 wg = *(const pg8::u32x4*)(uG + (size_t)tr * UG_LD + 2048 + c0); f32x4 g0, g1; unpack8(wg, g0, g1);
                    f32x4 v0 = acc[ai][bj][m][0], v1 = acc[ai][bj][m][1];
#pragma unroll
                    for (int e = 0; e < 4; ++e) { v0[e] *= fmaxf(g0[e], 1e-20f); v1[e] *= fmaxf(g1[e], 1e-20f); }
                    *(pg8::u32x4*)(mo + (size_t)tr * 1024 + c0) = pack8(v0, v1);
                    if (bj == 1) asm volatile("" ::: "memory"); }
    }
};

struct EpiO { static constexpr bool PERM = false, AFTER_DRAIN = false, HOOK = false;
    float* xs; const float* modv_l;
    __device__ __forceinline__ void operator()(const f32x4 (&acc)[2][2][4][2], const pg8::Unit& u, int wr, int wc, int fr, int fq) const {
        const int row0 = u.pm * 256 + wr * 64 + fr; const int v = u.pm < 128 ? (u.pm >> 5) : 4; const float* gt = modv_l + (size_t)v * 6144 + 2048;
        const int col0 = u.pn * 256 + wc * 32 + 4 * fq;
        f32x4 gv[2][2];
#pragma unroll
        for (int bj = 0; bj < 2; ++bj)
#pragma unroll
            for (int n = 0; n < 2; ++n) gv[bj][n] = *(const f32x4*)(gt + col0 + bj * 128 + n * 16);
#pragma unroll
        for (int ai = 0; ai < 2; ++ai)
#pragma unroll
            for (int m = 0; m < 4; ++m) { float* rowp = xs + (size_t)(row0 + ai * 128 + m * 16) * 1024 + col0;
#pragma unroll
                for (int bj = 0; bj < 2; ++bj)
#pragma unroll
                    for (int n = 0; n < 2; ++n) { f32x4* xp = (f32x4*)(rowp + bj * 128 + n * 16); *xp = *xp + gv[bj][n] * acc[ai][bj][m][n]; } }
    }
};

struct EpiE1 { static constexpr bool PERM = true, AFTER_DRAIN = false, HOOK = false;
    bf16_t* hid;
    __device__ __forceinline__ void operator()(const f32x4 (&acc)[2][2][4][2], const pg8::Unit& u, int wr, int wc, int fr, int fq) const {
        const int row0 = u.pm * 256 + wr * 64 + fr; const int c0 = (u.pn & 1) * 128 + wc * 32 + 8 * fq;
#pragma unroll
        for (int ai = 0; ai < 2; ++ai)
#pragma unroll
            for (int m = 0; m < 4; ++m) { f32x4 o0, o1;
#pragma unroll
                for (int e = 0; e < 4; ++e) { const float g0 = acc[ai][0][m][0][e], g1 = acc[ai][0][m][1][e];
                    o0[e] = g0 * __builtin_amdgcn_rcpf(1.f + __expf(-g0)) * acc[ai][1][m][0][e]; o1[e] = g1 * __builtin_amdgcn_rcpf(1.f + __expf(-g1)) * acc[ai][1][m][1][e]; }
                *(pg8::u32x4*)(hid + (size_t)(row0 + ai * 128 + m * 16) * 256 + c0) = pack8(o0, o1); }
    }
};

struct EpiE2 { static constexpr bool PERM = true, AFTER_DRAIN = false, HOOK = false;
    bf16_t* Y;
    __device__ __forceinline__ void operator()(const f32x4 (&acc)[2][2][4][2], const pg8::Unit& u, int wr, int wc, int fr, int fq) const {
        const int row0 = u.pm * 256 + wr * 64 + fr; const int c0 = (u.pn & 3) * 256 + wc * 32 + 8 * fq;
#pragma unroll
        for (int ai = 0; ai < 2; ++ai)
#pragma unroll
            for (int m = 0; m < 4; ++m)
#pragma unroll
                for (int bj = 0; bj < 2; ++bj) *(pg8::u32x4*)(Y + (size_t)(row0 + ai * 128 + m * 16) * 1024 + c0 + bj * 128) = pack8(acc[ai][bj][m][0], acc[ai][bj][m][1]);
    }
};

__device__ __forceinline__ void phase_pg_in(const Params& p, int l, unsigned char* smem) {
    pg8::Gemm g{p.h, p.wt_in, T_ALL, IN_COLS, 1024}; pg8::StaticOrder S; S.init(T_ALL, IN_COLS, (int)gridDim.x, (int)blockIdx.x);
    EpiIn E{p.uA, p.uG, p.ropet};
    pg8::gemm_phase<EpiIn, pg8::StaticOrder, true, true>((PG8_LAS unsigned char*)smem, g, S, E);
}
__device__ __forceinline__ void phase_pg_merge(const Params& p, int l, unsigned char* smem) {
    const int M = (l < DEPTH - 1) ? T_ALL : T_LAT;
    pg8::Gemm g{p.ycat, p.wt_br, M, 1024, 1024}; pg8::StaticOrder S; S.init(M, 1024, (int)gridDim.x, (int)blockIdx.x);
    EpiMerge E{p.uG, p.mbuf};
    pg8::gemm_phase<EpiMerge, pg8::StaticOrder, true, true>((PG8_LAS unsigned char*)smem, g, S, E);
}
__device__ __forceinline__ void phase_pg_o(const Params& p, int l, unsigned char* smem) {
    const int M = (l < DEPTH - 1) ? T_ALL : T_LAT;
    pg8::Gemm g{p.mbuf, p.wt_o, M, 1024, 1024}; pg8::StaticOrder S; S.init(M, 1024, (int)gridDim.x, (int)blockIdx.x);
    EpiO E{p.xs, p.modv + (size_t)l * 5 * 6144};
    pg8::gemm_phase<EpiO, pg8::StaticOrder, true, true>((PG8_LAS unsigned char*)smem, g, S, E);
}
__device__ __forceinline__ void phase_pg_e1(const Params& p, unsigned char* smem) {
    const int nb = p.nbu[0];
    pg8::Gemm g{p.xd, p.wt_gu, nb * 256, 512, 1024}; pg8::GroupedOrder<2> S{p.blk_e, nb * 2, (int)gridDim.x, (int)blockIdx.x};
    EpiE1 E{p.hid};
    pg8::gemm_phase<EpiE1, pg8::GroupedOrder<2>, true, true>((PG8_LAS unsigned char*)smem, g, S, E);
}
__device__ __forceinline__ void phase_pg_e2(const Params& p, unsigned char* smem) {
    const int nb = p.nbu[0];
    pg8::Gemm g{p.hid, p.wt_d, nb * 256, 1024, 256}; pg8::GroupedOrder<4> S{p.blk_e, nb * 4, (int)gridDim.x, (int)blockIdx.x};
    EpiE2 E{p.Y};
    pg8::gemm_phase<EpiE2, pg8::GroupedOrder<4>, true, true>((PG8_LAS unsigned char*)smem, g, S, E);
}

#define XB_TMO      128
#define XB_XCNT(j)  (256  + 64 * (j))
#define XB_XSUB(j)  (1280 + 64 * (j))
#define XB_XGEN(j)  (2304 + 64 * (j))
#define XB_TOP      3328
#define XB_TOPGEN   3392
#define XCD_BAR_WORDS 3456
#define XB_SPIN_CAP (1u << 18)
__device__ __forceinline__ unsigned xb_ld(unsigned* p)              { return __hip_atomic_load(p, __ATOMIC_RELAXED, __HIP_MEMORY_SCOPE_AGENT); }
__device__ __forceinline__ unsigned xb_add(unsigned* p, unsigned v) { return __hip_atomic_fetch_add(p, v, __ATOMIC_RELAXED, __HIP_MEMORY_SCOPE_AGENT); }
__device__ __forceinline__ unsigned xb_xcc_id() { return (unsigned)__builtin_amdgcn_s_getreg((3 << 11) | 20) & 0xFu; }
#define XB_SPIN(cond, bar) do { unsigned _sp = 0; while (cond) { __builtin_amdgcn_s_sleep(1); \
    if ((++_sp & 255u) == 0u) { if (xb_ld(&(bar)[XB_TMO])) break; if (_sp > XB_SPIN_CAP) { atomicAdd(&(bar)[XB_TMO], 1u); break; } } } } while (0)
struct XcdBarrier { unsigned* bar; unsigned x; volatile LAS unsigned* st; };
__device__ __forceinline__ XcdBarrier xcd_barrier_post(unsigned* bar, volatile LAS unsigned* st) {
    XcdBarrier b; b.bar = bar; b.x = xb_xcc_id(); b.st = st;
    if (threadIdx.x == 0) (void)xb_add(&bar[XB_XCNT(b.x)], 1u);
    return b;
}
__device__ __forceinline__ void xcd_barrier_complete(unsigned* bar, unsigned x, unsigned& nloc, unsigned& nx) {
    const unsigned G = gridDim.x * gridDim.y * gridDim.z;
    unsigned sum, cnt, mine, sp = 0u;
    for (;;) {
        sum = 0u; cnt = 0u; mine = 0u;
#pragma unroll
        for (unsigned j = 0; j < 16; ++j) { const unsigned c = xb_ld(&bar[XB_XCNT(j)]); sum += c; cnt += (c > 0u) ? 1u : 0u; mine = (j == x) ? c : mine; }
        if (sum == G) break;
        __builtin_amdgcn_s_sleep(1);
        if ((++sp & 255u) == 0u) { if (xb_ld(&bar[XB_TMO])) break; if (sp > XB_SPIN_CAP) { atomicAdd(&bar[XB_TMO], 1u); break; } }
    }
    nloc = mine > 0u ? mine : 1u; nx = cnt > 0u ? cnt : 1u;
}
__device__ __forceinline__ void xcd_barrier(const XcdBarrier& b) {
    asm volatile("s_waitcnt vmcnt(0)" ::: "memory");
    __syncthreads();
    if (threadIdx.x == 0) {
        unsigned* bar = b.bar;
        __builtin_amdgcn_s_waitcnt(0);
        unsigned nloc = b.st[0], nx = b.st[1];
        if (nloc == 0u) { xcd_barrier_complete(bar, b.x, nloc, nx); b.st[0] = nloc; b.st[1] = nx; }
        const unsigned old = xb_add(&bar[XB_XSUB(b.x)], 1u);
        const unsigned gen = old / nloc;
        if (old + 1u == (gen + 1u) * nloc) {
            __builtin_amdgcn_fence(__ATOMIC_RELEASE, "agent");
            asm volatile("s_waitcnt vmcnt(0)" ::: "memory");
            const unsigned og = xb_add(&bar[XB_TOP], 1u);
            const unsigned tg = og / nx;
            if (og + 1u == (tg + 1u) * nx) xb_add(&bar[XB_TOPGEN], 1u);
            else XB_SPIN(xb_ld(&bar[XB_TOPGEN]) == tg, bar);
            __builtin_amdgcn_fence(__ATOMIC_ACQUIRE, "agent");
            xb_add(&bar[XB_XGEN(b.x)], 1u);
            asm volatile("s_waitcnt vmcnt(0)" ::: "memory");
        } else {
            XB_SPIN(xb_ld(&bar[XB_XGEN(b.x)]) == gen, bar);
            __builtin_amdgcn_fence(__ATOMIC_ACQUIRE, "agent");
            asm volatile("s_waitcnt vmcnt(0)" ::: "memory");
        }
    }
    __syncthreads();
}

#define SMEM_BYTES 131072
#ifndef PROBE_MASK
#define PROBE_MASK 0
#endif
#define PROBE_MULT 4
#define PH_BEGIN(id) do { if (PROBE_MASK & (1 << (id))) t0 = wall_clock64(); } while (0)
#define PH_END(id) do { if (PROBE_MASK & (1 << (id))) tacc += wall_clock64() - t0; } while (0)
__global__ void __launch_bounds__(NTHR, 2) k_mega(Params p) {
    extern __shared__ __attribute__((aligned(16))) unsigned char smem[];
    volatile LAS unsigned* xbw = (volatile LAS unsigned*)(smem + SMEM_BYTES);
    if (threadIdx.x == 0) { xbw[0] = 0u; xbw[1] = 0u; xbw[2] = 0u; xbw[3] = 0u; }
    __syncthreads();
    (void)xcd_barrier_post(p.bar, xbw);
    unsigned long long tacc = 0, t0 = 0;
#define GRID_BAR() do { XcdBarrier bar_; bar_.bar = p.bar; bar_.x = xb_xcc_id(); bar_.st = xbw; xcd_barrier(bar_); } while (0)
    PH_BEGIN(0); phase_mod(p, (float*)smem); GRID_BAR(); PH_END(0);
    for (int l = 0; l < DEPTH; ++l) {
        PH_BEGIN(1); phase_norm1(p, l); phase_wconv(p, l, (float*)smem); GRID_BAR(); PH_END(1);
        PH_BEGIN(2); phase_pg_in(p, l, smem); GRID_BAR(); PH_END(2);
        PH_BEGIN(3); phase_mix2(p, l, smem); GRID_BAR(); PH_END(3);
        PH_BEGIN(4); phase_pg_merge(p, l, smem); GRID_BAR(); PH_END(4);
        PH_BEGIN(5); phase_pg_o(p, l, smem); GRID_BAR(); PH_END(5);
        PH_BEGIN(6); phase_router(p, l, (float*)smem); GRID_BAR(); PH_END(6);
        PH_BEGIN(7); phase_dispatch(p, l, (int*)smem); GRID_BAR(); PH_END(7);
        PH_BEGIN(8); phase_pg_e1(p, smem); GRID_BAR(); PH_END(8);
        PH_BEGIN(9); phase_pg_e2(p, smem); GRID_BAR(); PH_END(9);
    }
    PH_BEGIN(10); phase_norm1(p, DEPTH); PH_END(10);
    if (PROBE_MASK != 0 && blockIdx.x == 0) { const unsigned long long te = wall_clock64(); while (wall_clock64() - te < tacc * PROBE_MULT) __builtin_amdgcn_s_sleep(8); }
}

extern "C" void kernel_launch(void* const* d_in, const int* in_sizes, int n_in, void* d_out, int out_size, void* d_ws, size_t ws_size, hipStream_t stream) {
    Params p{};
    p.x = (const float*)d_in[0]; p.c = (const float*)d_in[1]; p.ctx = (const float*)d_in[2]; p.c_ctx = (const float*)d_in[3]; p.w_mod = (const float*)d_in[4]; p.b_mod = (const float*)d_in[5];
    p.g_attn = (const float*)d_in[6]; p.g_ffn = (const float*)d_in[7]; p.w_in = (const float*)d_in[8]; p.conv_w = (const float*)d_in[9]; p.rpb = (const float*)d_in[10]; p.sinks = (const float*)d_in[11];
    p.w_branch = (const float*)d_in[12]; p.w_o = (const float*)d_in[13]; p.w_rg = (const float*)d_in[14]; p.b_rg = (const float*)d_in[15]; p.w_re = (const float*)d_in[16]; p.b_re = (const float*)d_in[17];
    p.w_eg = (const float*)d_in[18]; p.w_eu = (const float*)d_in[19]; p.w_ed = (const float*)d_in[20]; p.g_final = (const float*)d_in[21];
    p.out = (float*)d_out;
    unsigned char* w = (unsigned char*)d_ws; size_t off = 0;
    auto take = [&](size_t bytes) { unsigned char* r = w + off; off += (bytes + 255) & ~(size_t)255; return r; };
    p.bar = (unsigned*)take(16384); p.cnt = (int*)take(1024 * 32 * 4); p.blk_e = (int*)take(MAXBLK * 4); p.nbu = (int*)take(256);
    p.modv = (float*)take((size_t)DEPTH * 5 * 6144 * 4); p.ropet = (float*)take(128 * 16 * 2 * 4);
    p.eid = (int*)take((size_t)T_ALL * 2 * 4); p.epos = (int*)take((size_t)T_ALL * 2 * 4); p.ewt = (float*)take((size_t)T_ALL * 2 * 4); p.slot = (int*)take((size_t)T_ALL * 2 * 4);
    p.xs = (float*)take((size_t)T_ALL * 1024 * 4);
    p.h = (bf16_t*)take((size_t)T_ALL * 1024 * 2);
    p.wt_in = (bf16_t*)take((size_t)IN_COLS * 1024 * 2); p.wt_br = (bf16_t*)take((size_t)1024 * 1024 * 2); p.wt_o = (bf16_t*)take((size_t)1024 * 1024 * 2);
    p.wt_gu = (bf16_t*)take((size_t)32 * 512 * 1024 * 2); p.wt_d = (bf16_t*)take((size_t)32 * 1024 * 256 * 2);
    p.uA = (bf16_t*)take((size_t)T_ALL * UA_LD * 2); p.uG = (bf16_t*)take((size_t)T_ALL * UG_LD * 2); p.ycat = (bf16_t*)take((size_t)T_ALL * 1024 * 2);
    p.mbuf = p.uA; p.xd = p.uA; p.hid = p.ycat; p.Y = p.uG;
    if (off > ws_size) return;
    constexpr size_t kDynLds = SMEM_BYTES + 16;
    static int grid = 0;
    if (!grid) {
        (void)hipFuncSetAttribute((const void*)k_mega, hipFuncAttributeMaxDynamicSharedMemorySize, (int)kDynLds);
        int dev = 0, cus = 0, per_cu = 0;
        (void)hipGetDevice(&dev);
        (void)hipDeviceGetAttribute(&cus, hipDeviceAttributeMultiprocessorCount, dev);
        (void)hipOccupancyMaxActiveBlocksPerMultiprocessor(&per_cu, (const void*)k_mega, NTHR, kDynLds);
        grid = cus * (per_cu < 1 ? per_cu : 1);
        if (grid <= 0) grid = 0;
    }
    if (!grid) return;
    (void)hipMemsetAsync(p.bar, 0, XCD_BAR_WORDS * sizeof(unsigned), stream);
    hipLaunchKernelGGL(k_mega, dim3(grid), dim3(NTHR), kDynLds, stream, p);
}
```

```cpp
#include <hip/hip_runtime.h>
#include <stdint.h>

typedef unsigned short bf16_t;
typedef short bf16x8 __attribute__((ext_vector_type(8)));
typedef float f32x4 __attribute__((ext_vector_type(4)));

#define D_MODEL 1024
#define NB 4
#define SEQ 8192
#define DEPTH 4
#define CTXL 256
#define T_LAT 32768
#define T_CTX 1024
#define T_ALL 33792
#define UA_LD 2560
#define UG_LD 3072
#define IN_COLS 5632
#define MAXBLK 296
#define NTHR 512
#define QLOG2E 1.4426950408889634f
#ifndef PGM
#define PGM 31
#endif
#define LAS __attribute__((address_space(3)))

struct Params {
    const float *x, *c, *ctx, *c_ctx, *w_mod, *b_mod, *g_attn, *g_ffn, *w_in, *conv_w, *rpb, *sinks, *w_branch, *w_o, *w_rg, *b_rg, *w_re, *b_re, *w_eg, *w_eu, *w_ed, *g_final;
    float* out;
    unsigned* bar; int* cnt; int* blk_e; int* nbu;
    float* modv; float* ropet; float* xs;
    bf16_t *h, *wt_in, *wt_br, *wt_o, *wt_gu, *wt_d, *uA, *uG, *ycat, *mbuf, *xd, *hid, *Y;
    int* eid; int* epos; float* ewt; int* slot; int* tokmap; int* pad_;
};
typedef const __attribute__((address_space(4))) Params* ParamsC;

__device__ __forceinline__ int lbid() { int b = blockIdx.x; asm volatile("" : "+s"(b)); return b; }
__device__ __forceinline__ int ltid() { int t = threadIdx.x; asm volatile("" : "+v"(t)); return t; }
__device__ __forceinline__ bf16_t f2bf(float f) { unsigned u = __float_as_uint(f); u += 0x7FFFu + ((u >> 16) & 1u); return (bf16_t)(u >> 16); }
__device__ __forceinline__ float bf2f(bf16_t b) { return __uint_as_float(((unsigned)b) << 16); }
typedef float f32x2_t __attribute__((ext_vector_type(2)));
typedef __bf16 bf16x2_t __attribute__((ext_vector_type(2)));
__device__ __forceinline__ unsigned pack2(float a, float b) { const f32x2_t v = {a, b}; const bf16x2_t r = __builtin_convertvector(v, bf16x2_t); return __builtin_bit_cast(unsigned, r); }
__device__ __forceinline__ float wave_sum(float v) { for (int o = 32; o > 0; o >>= 1) v += __shfl_xor(v, o); return v; }
__device__ __forceinline__ float wave_max(float v) { for (int o = 32; o > 0; o >>= 1) v = fmaxf(v, __shfl_xor(v, o)); return v; }
__device__ __forceinline__ int tok_variant(int t) { return t < T_LAT ? (t >> 13) : 4; }

__device__ __forceinline__ void phase_mod(ParamsC p, float* smem) {
    const int tid = ltid(), lane = tid & 63, wid = tid >> 6;
    float* s_silu = smem;
    float* s_part = smem + 5 * 1024;
    for (int i = tid; i < 5 * 1024; i += NTHR) { const int v = i >> 10, k = i & 1023; const float cv = v < 4 ? p->c[v * 1024 + k] : p->c_ctx[k]; s_silu[i] = cv / (1.0f + expf(-cv)); }
    __syncthreads();
    for (int item = lbid(); item < DEPTH * 96; item += gridDim.x) {
        const int l = item / 96, cb = item % 96, col = cb * 64 + lane;
        const float* w = p->w_mod + (size_t)l * 1024 * 6144 + col;
        float a0 = 0.f, a1 = 0.f, a2 = 0.f, a3 = 0.f, a4 = 0.f;
#pragma unroll 8
        for (int kk = 0; kk < 128; ++kk) { const int k = wid * 128 + kk; const float wv = w[(size_t)k * 6144];
            a0 += s_silu[k] * wv; a1 += s_silu[1024 + k] * wv; a2 += s_silu[2048 + k] * wv; a3 += s_silu[3072 + k] * wv; a4 += s_silu[4096 + k] * wv; }
        s_part[(wid * 5 + 0) * 64 + lane] = a0; s_part[(wid * 5 + 1) * 64 + lane] = a1; s_part[(wid * 5 + 2) * 64 + lane] = a2; s_part[(wid * 5 + 3) * 64 + lane] = a3; s_part[(wid * 5 + 4) * 64 + lane] = a4;
        __syncthreads();
        if (tid < 320) { const int v = tid >> 6, ln = tid & 63; float s = p->b_mod[l * 6144 + cb * 64 + ln];
            for (int w8 = 0; w8 < 8; ++w8) s += s_part[(w8 * 5 + v) * 64 + ln];
            p->modv[(size_t)(l * 5 + v) * 6144 + cb * 64 + ln] = s; }
        __syncthreads();
    }
    for (int i = lbid() * NTHR + tid; i < 128 * 16; i += gridDim.x * NTHR) { const int pos = i >> 4, f = i & 15;
        const float inv = powf(10000.0f, -(float)f / 16.0f); const float ang = (float)pos * inv; p->ropet[i * 2] = cosf(ang); p->ropet[i * 2 + 1] = sinf(ang); }
}

#define GU_IG 128
struct WcTile { const float* src; bf16_t* dst; int ldN, ldK, kt, nt, kind, e; };
__device__ __forceinline__ WcTile wconv_decode(ParamsC p, int l, int it) {
    const int n1 = 16 * 88, n2 = 256, n3 = 256, n4 = 2048, n5 = 2048;
    WcTile w; w.kind = 0; w.e = 0; int i = it;
    if (i < n1) { w.src = p->w_in + (size_t)l * 1024 * IN_COLS; w.ldN = IN_COLS; w.dst = p->wt_in; w.ldK = 1024; w.kt = i / 88; w.nt = i % 88; }
    else if ((i -= n1) < n2) { w.src = p->w_branch + (size_t)l * 1024 * 1024; w.ldN = 1024; w.dst = p->wt_br; w.ldK = 1024; w.kt = i / 16; w.nt = i % 16; }
    else if ((i -= n2) < n3) { w.src = p->w_o + (size_t)l * 1024 * 1024; w.ldN = 1024; w.dst = p->wt_o; w.ldK = 1024; w.kt = i / 16; w.nt = i % 16; }
    else if ((i -= n3) < n4) { w.e = i / 64; i %= 64; w.src = p->w_eg + ((size_t)l * 32 + w.e) * 1024 * 256; w.ldN = 256; w.dst = p->wt_gu; w.ldK = 1024; w.kt = i / 4; w.nt = i % 4; w.kind = 1; }
    else if ((i -= n4) < n5) { w.e = i / 64; i %= 64; w.src = p->w_eu + ((size_t)l * 32 + w.e) * 1024 * 256; w.ldN = 256; w.dst = p->wt_gu; w.ldK = 1024; w.kt = i / 4; w.nt = i % 4; w.kind = 2; }
    else { i -= n5; w.e = i / 64; i %= 64; w.src = p->w_ed + ((size_t)l * 32 + w.e) * 256 * 1024; w.ldN = 1024; w.dst = p->wt_d + (size_t)w.e * 1024 * 256; w.ldK = 256; w.kt = i / 16; w.nt = i % 16; }
    return w;
}
#define WC_TOTAL (16 * 88 + 256 + 256 + 2048 * 3)
__device__ __forceinline__ void phase_wconv(ParamsC p, int l, float* smem) {
    const int tid = ltid();
    float* tile = smem;
    const int r = tid >> 4, c4 = tid & 15;
    int it = lbid(); if (it >= WC_TOTAL) return;
    WcTile w = wconv_decode(p, l, it);
    float4 v0 = *(const float4*)(w.src + (size_t)(w.kt * 64 + r) * w.ldN + w.nt * 64 + c4 * 4), v1 = *(const float4*)(w.src + (size_t)(w.kt * 64 + r + 32) * w.ldN + w.nt * 64 + c4 * 4);
    for (;;) {
        tile[r * 65 + c4 * 4 + 0] = v0.x; tile[r * 65 + c4 * 4 + 1] = v0.y; tile[r * 65 + c4 * 4 + 2] = v0.z; tile[r * 65 + c4 * 4 + 3] = v0.w;
        tile[(r + 32) * 65 + c4 * 4 + 0] = v1.x; tile[(r + 32) * 65 + c4 * 4 + 1] = v1.y; tile[(r + 32) * 65 + c4 * 4 + 2] = v1.z; tile[(r + 32) * 65 + c4 * 4 + 3] = v1.w;
        __syncthreads();
        const int nit = it + gridDim.x; WcTile wn = w;
        if (nit < WC_TOTAL) { wn = wconv_decode(p, l, nit);
            v0 = *(const float4*)(wn.src + (size_t)(wn.kt * 64 + r) * wn.ldN + wn.nt * 64 + c4 * 4); v1 = *(const float4*)(wn.src + (size_t)(wn.kt * 64 + r + 32) * wn.ldN + wn.nt * 64 + c4 * 4); }
        {   const int n = tid >> 3, kc = tid & 7; const int ncol = w.nt * 64 + n; int drow = ncol;
            if (w.kind) drow = w.e * 512 + (ncol / GU_IG) * (2 * GU_IG) + (w.kind == 2 ? GU_IG : 0) + (ncol % GU_IG);
            uint4 o; o.x = pack2(tile[(kc * 8 + 0) * 65 + n], tile[(kc * 8 + 1) * 65 + n]); o.y = pack2(tile[(kc * 8 + 2) * 65 + n], tile[(kc * 8 + 3) * 65 + n]);
            o.z = pack2(tile[(kc * 8 + 4) * 65 + n], tile[(kc * 8 + 5) * 65 + n]); o.w = pack2(tile[(kc * 8 + 6) * 65 + n], tile[(kc * 8 + 7) * 65 + n]);
            *(uint4*)(w.dst + (size_t)drow * w.ldK + w.kt * 64 + kc * 8) = o; }
        __syncthreads();
        if (nit >= WC_TOTAL) break;
        it = nit; w = wn;
    }
}

__device__ __forceinline__ void phase_norm1(ParamsC p, int l) {
    const int tid = ltid(), lane = tid & 63, wid = tid >> 6;
    const int ntok = (l == DEPTH) ? T_LAT : T_ALL;
    for (int t = lbid() * 8 + wid; t < ntok; t += gridDim.x * 8) {
        const int v = tok_variant(t);
        float4 xv[4];
        if (l == 0) {
            const float* src = t < T_LAT ? p->x + (size_t)t * 1024 : p->ctx + (size_t)(t - T_LAT) * 1024;
#pragma unroll
            for (int i = 0; i < 4; ++i) xv[i] = *(const float4*)(src + i * 256 + lane * 4);
        } else {
            const float* src = p->xs + (size_t)t * 1024;
#pragma unroll
            for (int i = 0; i < 4; ++i) xv[i] = *(const float4*)(src + i * 256 + lane * 4);
            const bool had_moe = (l - 1 < DEPTH - 1) || t < T_LAT;
            if (had_moe) {
                const int s0 = p->slot[t * 2], s1 = p->slot[t * 2 + 1]; const float w0 = p->ewt[t * 2], w1 = p->ewt[t * 2 + 1];
                const float* gt = p->modv + (size_t)((l - 1) * 5 + v) * 6144 + 5120;
#pragma unroll
                for (int i = 0; i < 4; ++i) { const int c = i * 256 + lane * 4;
                    const uint2 y0 = *(const uint2*)(p->Y + (size_t)s0 * 1024 + c), y1 = *(const uint2*)(p->Y + (size_t)s1 * 1024 + c);
                    const float4 g = *(const float4*)(gt + c);
                    xv[i].x += g.x * (w0 * bf2f((bf16_t)(y0.x & 0xffff)) + w1 * bf2f((bf16_t)(y1.x & 0xffff)));
                    xv[i].y += g.y * (w0 * bf2f((bf16_t)(y0.x >> 16)) + w1 * bf2f((bf16_t)(y1.x >> 16)));
                    xv[i].z += g.z * (w0 * bf2f((bf16_t)(y0.y & 0xffff)) + w1 * bf2f((bf16_t)(y1.y & 0xffff)));
                    xv[i].w += g.w * (w0 * bf2f((bf16_t)(y0.y >> 16)) + w1 * bf2f((bf16_t)(y1.y >> 16))); }
            }
        }
        float ss = 0.f;
#pragma unroll
        for (int i = 0; i < 4; ++i) ss += xv[i].x * xv[i].x + xv[i].y * xv[i].y + xv[i].z * xv[i].z + xv[i].w * xv[i].w;
        ss = wave_sum(ss);
        const float rstd = rsqrtf(ss * (1.0f / 1024.0f) + 1e-6f);
        if (l == DEPTH) {
#pragma unroll
            for (int i = 0; i < 4; ++i) { const int c = i * 256 + lane * 4; const float4 g = *(const float4*)(p->g_final + c);
                float4 o; o.x = xv[i].x * rstd * g.x; o.y = xv[i].y * rstd * g.y; o.z = xv[i].z * rstd * g.z; o.w = xv[i].w * rstd * g.w;
                *(float4*)(p->out + (size_t)t * 1024 + c) = o; }
        } else {
            const float* mv = p->modv + (size_t)(l * 5 + v) * 6144;
#pragma unroll
            for (int i = 0; i < 4; ++i) { const int c = i * 256 + lane * 4;
                *(float4*)(p->xs + (size_t)t * 1024 + c) = xv[i];
                const float4 g = *(const float4*)(p->g_attn + l * 1024 + c), sh = *(const float4*)(mv + c), sc = *(const float4*)(mv + 1024 + c);
                uint2 o; o.x = pack2(xv[i].x * rstd * g.x * (1.f + sc.x) + sh.x, xv[i].y * rstd * g.y * (1.f + sc.y) + sh.y);
                o.y = pack2(xv[i].z * rstd * g.z * (1.f + sc.z) + sh.z, xv[i].w * rstd * g.w * (1.f + sc.w) + sh.w);
                *(uint2*)(p->h + (size_t)t * 1024 + c) = o; }
        }
    }
}

#define SG_STRIDE 144
#define SG_BOFF (128 * SG_STRIDE)
struct RowsLinear { const bf16_t* base; size_t ld; __device__ __forceinline__ const bf16_t* operator()(int r) const { return base + (size_t)r * ld; } };
template <class ARow>
__device__ __forceinline__ void gemm_core(unsigned char* smem, const ARow& arow, const bf16_t* Bt, size_t ldb, int k0, int k1, f32x4 (&acc)[2][4]) {
    const int tid = ltid(), lane = tid & 63, wid = tid >> 6, wm = wid >> 1, wn = wid & 1;
    const int row0 = tid >> 3, kc = tid & 7;
    const bf16_t* pa0 = arow(row0) + kc * 8; const bf16_t* pa1 = arow(row0 + 64) + kc * 8;
    const bf16_t* pb0 = Bt + (size_t)row0 * ldb + kc * 8; const bf16_t* pb1 = Bt + (size_t)(row0 + 64) * ldb + kc * 8;
    const int soff0 = row0 * SG_STRIDE + kc * 16, soff1 = soff0 + 64 * SG_STRIDE;
    uint4 ra0 = *(const uint4*)(pa0 + k0), ra1 = *(const uint4*)(pa1 + k0), rb0 = *(const uint4*)(pb0 + k0), rb1 = *(const uint4*)(pb1 + k0);
    const int fa = (wm * 32 + (lane & 15)) * SG_STRIDE + (lane >> 4) * 16, fb = SG_BOFF + (wn * 64 + (lane & 15)) * SG_STRIDE + (lane >> 4) * 16;
    for (int k = k0; k < k1; k += 64) {
        __syncthreads();
        *(uint4*)(smem + soff0) = ra0; *(uint4*)(smem + soff1) = ra1; *(uint4*)(smem + SG_BOFF + soff0) = rb0; *(uint4*)(smem + SG_BOFF + soff1) = rb1;
        __syncthreads();
        if (k + 64 < k1) { ra0 = *(const uint4*)(pa0 + k + 64); ra1 = *(const uint4*)(pa1 + k + 64); rb0 = *(const uint4*)(pb0 + k + 64); rb1 = *(const uint4*)(pb1 + k + 64); }
#pragma unroll
        for (int ks = 0; ks < 2; ++ks) {
            const bf16x8 af0 = *(const bf16x8*)(smem + fa + ks * 64), af1 = *(const bf16x8*)(smem + fa + 16 * SG_STRIDE + ks * 64);
            const bf16x8 b0 = *(const bf16x8*)(smem + fb + ks * 64), b1 = *(const bf16x8*)(smem + fb + 16 * SG_STRIDE + ks * 64);
            const bf16x8 b2 = *(const bf16x8*)(smem + fb + 32 * SG_STRIDE + ks * 64), b3 = *(const bf16x8*)(smem + fb + 48 * SG_STRIDE + ks * 64);
            acc[0][0] = __builtin_amdgcn_mfma_f32_16x16x32_bf16(b0, af0, acc[0][0], 0, 0, 0); acc[0][1] = __builtin_amdgcn_mfma_f32_16x16x32_bf16(b1, af0, acc[0][1], 0, 0, 0);
            acc[0][2] = __builtin_amdgcn_mfma_f32_16x16x32_bf16(b2, af0, acc[0][2], 0, 0, 0); acc[0][3] = __builtin_amdgcn_mfma_f32_16x16x32_bf16(b3, af0, acc[0][3], 0, 0, 0);
            acc[1][0] = __builtin_amdgcn_mfma_f32_16x16x32_bf16(b0, af1, acc[1][0], 0, 0, 0); acc[1][1] = __builtin_amdgcn_mfma_f32_16x16x32_bf16(b1, af1, acc[1][1], 0, 0, 0);
            acc[1][2] = __builtin_amdgcn_mfma_f32_16x16x32_bf16(b2, af1, acc[1][2], 0, 0, 0); acc[1][3] = __builtin_amdgcn_mfma_f32_16x16x32_bf16(b3, af1, acc[1][3], 0, 0, 0);
        }
    }
}
__device__ __forceinline__ void zero_acc(f32x4 (&acc)[2][4]) {
#pragma unroll
    for (int a = 0; a < 2; ++a)
#pragma unroll
        for (int b = 0; b < 4; ++b) acc[a][b] = (f32x4){0.f, 0.f, 0.f, 0.f};
}
__device__ __forceinline__ void store4bf(bf16_t* dst, f32x4 v) { uint2 o; o.x = pack2(v[0], v[1]); o.y = pack2(v[2], v[3]); *(uint2*)dst = o; }


namespace pg8 {
#define PG8_LAS __attribute__((address_space(3)))
typedef unsigned u32x4 __attribute__((ext_vector_type(4)));
constexpr int BM = 256, BK = 64, HALF = 128, HTB = HALF * BK * 2, STAGE_BYTES = 8 * HTB, NXCD = 8, WGM = 8;
__host__ __device__ __forceinline__ int lds_byte(int r, int c) { const int st = (r >> 4) * 2 + (c >> 5), rr = r & 15, cc = c & 31, ob = rr * 64 + cc * 2; return st * 1024 + (ob ^ (((ob >> 9) & 1) << 5)); }
__host__ __device__ __forceinline__ void stage_rc(int b, int& R, int& C) { const int st = b / 1024, sb = b % 1024, swz = sb ^ (((sb >> 9) & 1) << 5); R = (st >> 1) * 16 + swz / 64; C = (st & 1) * 32 + (swz % 64) / 2; }
__host__ __device__ __forceinline__ int perm32(int rho) { const int n = rho >> 4, i = rho & 15; return 8 * (i >> 2) + 4 * n + (i & 3); }
struct Unit { int pm, pn; };
struct Gemm { const bf16_t* A; const bf16_t* Bt; int M, N, K; const int* rowmap; };
struct StaticOrder {
    int nM, nN, nwg, G, c;
    __device__ void init(int M, int N, int G_, int c_) { nM = M / BM; nN = N / BM; nwg = nM * nN; G = G_; c = c_; }
    __device__ bool next(int i, Unit& u) const {
        const long L = (long)i * G + c; if (L >= nwg) return false;
        int wgid = (int)L; { const int q = nwg / NXCD, r = nwg % NXCD, xcd = wgid % NXCD, off = wgid / NXCD; wgid = (xcd < r ? xcd * (q + 1) : r * (q + 1) + (xcd - r) * q) + off; }
        const int nig = WGM * nN, gid = wgid / nig, fm = gid * WGM, gsz = (nM - fm) < WGM ? (nM - fm) : WGM;
        u.pm = fm + ((wgid % nig) % gsz); u.pn = (wgid % nig) / gsz; return true;
    }
    __device__ __forceinline__ void a_ready(const Unit&) const {}
    __device__ __forceinline__ void done(const Unit&) const {}
};
template <int NT> struct GroupedOrder {
    const int* blk_e; int nunits, G, c;
    __device__ bool next(int i, Unit& u) const { const long L = (long)i * G + c; if (L >= nunits) return false; const int rb = (int)L / NT; u.pm = rb; u.pn = blk_e[rb] * NT + (int)L % NT; return true; }
    __device__ __forceinline__ void a_ready(const Unit&) const {}
    __device__ __forceinline__ void done(const Unit&) const {}
};
template <class Epi, class Sched, bool ALIGN_EPI = false, bool SP2 = false, bool GATHER = false>
__device__ __forceinline__ void gemm_phase(PG8_LAS unsigned char* lds, const Gemm g, const Sched& S, const Epi& E) {
    const int tid = ltid(), wid = __builtin_amdgcn_readfirstlane(tid >> 6), lane = tid & 63, wr = wid >> 2, wc = wid & 3, fr = lane & 15, fq = lane >> 4;
    int K = g.K; asm volatile("" : "+s"(K)); const int nt = K / BK;
    unsigned voffA[2], voffB[2];
#pragma unroll
    for (int i = 0; i < 2; ++i) { int R, C; stage_rc(tid * 16 + i * 8192, R, C); const int Rb = Epi::PERM ? ((R & ~31) + perm32(R & 31)) : R;
        voffA[i] = (unsigned)(R * K + C) * 2u; voffB[i] = (unsigned)(Rb * K + C) * 2u; }
    const size_t kstep = (size_t)(BK * 2);
    const size_t hstep = (size_t)HALF * K * 2;
    const size_t tstep = 2 * hstep;
    const unsigned ldsw = (unsigned)wid * 1024u;
    const int aoff = lds_byte(wr * 64 + fr, fq * 8), boff = lds_byte(wc * 32 + fr, fq * 8);
#define PG8_SA(b, h) (((b) * 2 + (h)) * HTB)
#define PG8_SB(b, h) ((4 + (b) * 2 + (h)) * HTB)
#define PG8_STAGE(bufoff, gbase, voff) do { _Pragma("unroll") for (int _i = 0; _i < 2; ++_i) \
        __builtin_amdgcn_global_load_lds((const unsigned*)((const char*)(gbase) + (voff)[_i]), (PG8_LAS unsigned*)(lds + (bufoff) + ldsw + _i * 8192), 16, 0, 0); } while (0)
#define PG8_STAGE_A(bufoff, gptr, hf) do { if constexpr (GATHER) { _Pragma("unroll") for (int _i = 0; _i < 2; ++_i) \
        __builtin_amdgcn_global_load_lds((const unsigned*)((const char*)(gptr) + gC[hf][_i]), (PG8_LAS unsigned*)(lds + (bufoff) + ldsw + _i * 8192), 16, 0, 0); } \
        else { PG8_STAGE(bufoff, (gptr) + (hf) * hstep, voffA); } } while (0)
#define PG8_LOAD_GOFF(pm_) do { _Pragma("unroll") for (int _h = 0; _h < 2; ++_h) _Pragma("unroll") for (int _i = 0; _i < 2; ++_i) { int R_, C_; stage_rc(tid * 16 + _i * 8192, R_, C_); \
        gC[_h][_i] = (unsigned)(g.rowmap[(pm_) * 256 + _h * 128 + R_] * K + C_) * 2u; } } while (0)
#define PG8_LDA(dst, b, h) do { _Pragma("unroll") for (int m = 0; m < 4; ++m) _Pragma("unroll") for (int k = 0; k < 2; ++k) dst[m][k] = *(const PG8_LAS bf16x8*)(lds + PG8_SA(b, h) + aoff + m * 2048 + k * 1024); } while (0)
#define PG8_LDB(dst, b, h) do { _Pragma("unroll") for (int n = 0; n < 2; ++n) _Pragma("unroll") for (int k = 0; k < 2; ++k) dst[n][k] = *(const PG8_LAS bf16x8*)(lds + PG8_SB(b, h) + boff + n * 2048 + k * 1024); } while (0)
#define PG8_MMA(ai, bj, At, Bt) do { __builtin_amdgcn_s_setprio(1); _Pragma("unroll") for (int m = 0; m < 4; ++m) _Pragma("unroll") for (int n = 0; n < 2; ++n) _Pragma("unroll") for (int k = 0; k < 2; ++k) \
        acc[ai][bj][m][n] = __builtin_amdgcn_mfma_f32_16x16x32_bf16(Bt[n][k], At[m][k], acc[ai][bj][m][n], 0, 0, 0); __builtin_amdgcn_s_setprio(0); } while (0)
#define PG8_WAIT_V(n) asm volatile("s_waitcnt vmcnt(" #n ")" ::: "memory")
#define PG8_WAIT_L(n) asm volatile("s_waitcnt lgkmcnt(" #n ")" ::: "memory")
#define PG8_BAR __builtin_amdgcn_s_barrier()
#define PG8_SCHED __builtin_amdgcn_sched_barrier(0)
    Unit cur, nxt; int ui = 0;
    if (!S.next(0, cur)) return;
    f32x4 acc[2][2][4][2];
#pragma unroll
    for (int a = 0; a < 2; ++a)
#pragma unroll
        for (int b = 0; b < 2; ++b)
#pragma unroll
            for (int m = 0; m < 4; ++m)
#pragma unroll
                for (int n = 0; n < 2; ++n) acc[a][b][m][n] = (f32x4){0.f, 0.f, 0.f, 0.f};
    bf16x8 At[4][2], B0[2][2], B1[2][2];
    const char* cA = (const char*)g.A + (GATHER ? (size_t)0 : (size_t)cur.pm * tstep); const char* cB = (const char*)g.Bt + (size_t)cur.pn * tstep;
    unsigned gC[2][2] = {{0u, 0u}, {0u, 0u}};
    S.a_ready(cur);
    if constexpr (GATHER) PG8_LOAD_GOFF(cur.pm);
    if constexpr (SP2) {
        PG8_STAGE(PG8_SB(0, 0), cB, voffB); PG8_STAGE(PG8_SB(0, 1), cB + hstep, voffB); PG8_STAGE_A(PG8_SA(0, 0), cA, 0); PG8_STAGE_A(PG8_SA(0, 1), cA, 1);
        if (wr == 1) PG8_BAR;
        PG8_WAIT_V(2); PG8_BAR;
        PG8_STAGE(PG8_SB(1, 0), cB + kstep, voffB); PG8_STAGE_A(PG8_SA(1, 0), cA + kstep, 0); PG8_STAGE(PG8_SB(1, 1), cB + hstep + kstep, voffB);
        PG8_WAIT_V(6); PG8_BAR;
    } else {
        PG8_STAGE(PG8_SB(0, 0), cB, voffB); PG8_STAGE_A(PG8_SA(0, 0), cA, 0); PG8_STAGE(PG8_SB(0, 1), cB + hstep, voffB); PG8_STAGE_A(PG8_SA(0, 1), cA, 1);
        if (wr == 1) PG8_BAR;
        PG8_WAIT_V(4); PG8_BAR;
        PG8_STAGE(PG8_SB(1, 0), cB + kstep, voffB); PG8_STAGE_A(PG8_SA(1, 0), cA + kstep, 0); PG8_STAGE(PG8_SB(1, 1), cB + hstep + kstep, voffB);
        PG8_WAIT_V(6); PG8_BAR;
    }
    for (;;) {
        const bool has_next = S.next(ui + 1, nxt);
        const char* nA = (has_next && !GATHER) ? (const char*)g.A + (size_t)nxt.pm * tstep : cA; const char* nB = has_next ? (const char*)g.Bt + (size_t)nxt.pn * tstep : cB;
        for (int t = 0; t < nt; t += 2) {
            const bool last = (t == nt - 2);
            const char* a1 = cA + (size_t)(t + 1) * kstep;
            const char* a2 = last ? nA : cA + (size_t)(t + 2) * kstep; const char* b2 = last ? nB : cB + (size_t)(t + 2) * kstep;
            const char* a3 = a2 + kstep; const char* b3 = b2 + kstep;
            if (last && has_next) S.a_ready(nxt);
            if constexpr (SP2) {
            PG8_LDB(B0, 0, 0); PG8_LDB(B1, 0, 1); PG8_SCHED; PG8_LDA(At, 0, 0); PG8_STAGE_A(PG8_SA(1, 1), a1, 1); if constexpr (GATHER) { if (last && has_next) PG8_LOAD_GOFF(nxt.pm); }
            PG8_WAIT_V(8); PG8_WAIT_L(0); PG8_BAR; PG8_MMA(0, 0, At, B0); PG8_MMA(0, 1, At, B1); PG8_BAR; PG8_SCHED;
            PG8_LDA(At, 0, 1); PG8_STAGE(PG8_SB(0, 0), b2, voffB); PG8_STAGE(PG8_SB(0, 1), b2 + hstep, voffB); PG8_STAGE_A(PG8_SA(0, 0), a2, 0);
            PG8_WAIT_V(8); PG8_WAIT_L(0); PG8_BAR; PG8_MMA(1, 0, At, B0); PG8_MMA(1, 1, At, B1); PG8_BAR; PG8_SCHED;
            PG8_LDB(B0, 1, 0); PG8_LDB(B1, 1, 1); PG8_SCHED; PG8_LDA(At, 1, 0); PG8_STAGE_A(PG8_SA(0, 1), a2, 1);
            PG8_WAIT_V(8); PG8_WAIT_L(0); PG8_BAR; PG8_MMA(0, 0, At, B0); PG8_MMA(0, 1, At, B1); PG8_BAR; PG8_SCHED;
            PG8_LDA(At, 1, 1); PG8_STAGE(PG8_SB(1, 0), b3, voffB); PG8_STAGE(PG8_SB(1, 1), b3 + hstep, voffB); PG8_STAGE_A(PG8_SA(1, 0), a3, 0);
            PG8_WAIT_V(8); PG8_WAIT_L(0); PG8_BAR; PG8_MMA(1, 0, At, B0); PG8_MMA(1, 1, At, B1); PG8_BAR; PG8_SCHED;
            } else {
            PG8_LDB(B0, 0, 0); PG8_SCHED; PG8_LDA(At, 0, 0); PG8_STAGE_A(PG8_SA(1, 1), a1, 1); if constexpr (GATHER) { if (last && has_next) PG8_LOAD_GOFF(nxt.pm); }
            PG8_WAIT_L(8); PG8_BAR; PG8_WAIT_L(0); PG8_MMA(0, 0, At, B0); PG8_BAR; PG8_SCHED;
            PG8_LDB(B1, 0, 1); PG8_STAGE(PG8_SB(0, 0), b2, voffB);
            PG8_BAR; PG8_WAIT_L(0); PG8_MMA(0, 1, At, B1); PG8_BAR;
            PG8_LDA(At, 0, 1); PG8_STAGE_A(PG8_SA(0, 0), a2, 0);
            PG8_BAR; PG8_WAIT_L(0); PG8_MMA(1, 0, At, B0); PG8_BAR; PG8_SCHED;
            PG8_STAGE(PG8_SB(0, 1), b2 + hstep, voffB);
            PG8_WAIT_V(6); PG8_BAR; PG8_MMA(1, 1, At, B1); PG8_BAR;
            PG8_LDB(B0, 1, 0); PG8_SCHED; PG8_LDA(At, 1, 0); PG8_STAGE_A(PG8_SA(0, 1), a2, 1);
            PG8_WAIT_L(8); PG8_BAR; PG8_WAIT_L(0); PG8_MMA(0, 0, At, B0); PG8_BAR; PG8_SCHED;
            PG8_LDB(B1, 1, 1); PG8_STAGE(PG8_SB(1, 0), b3, voffB);
            PG8_BAR; PG8_WAIT_L(0); PG8_MMA(0, 1, At, B1); PG8_BAR;
            PG8_LDA(At, 1, 1); PG8_STAGE_A(PG8_SA(1, 0), a3, 0);
            PG8_BAR; PG8_WAIT_L(0); PG8_MMA(1, 0, At, B0); PG8_BAR; PG8_SCHED;
            PG8_STAGE(PG8_SB(1, 1), b3 + hstep, voffB);
            PG8_WAIT_V(6); PG8_BAR; PG8_MMA(1, 1, At, B1); PG8_BAR;
            }
            if constexpr (Epi::HOOK) { if (t == 2 || t == 8) E.hook(acc, cur, t, wr, wc, fr, fq); }
        }
        if constexpr (ALIGN_EPI) { if (wr == 0) PG8_BAR; }
        if constexpr (!Epi::AFTER_DRAIN) { E(acc, cur, wr, wc, fr, fq); S.done(cur); }
        if (!has_next) break;
#pragma unroll
        for (int a = 0; a < 2; ++a)
#pragma unroll
            for (int b = 0; b < 2; ++b)
#pragma unroll
                for (int m = 0; m < 4; ++m)
#pragma unroll
                    for (int n = 0; n < 2; ++n) acc[a][b][m][n] = (f32x4){0.f, 0.f, 0.f, 0.f};
        cur = nxt; cA = nA; cB = nB; ++ui;
        if constexpr (ALIGN_EPI) { if (wr == 1) PG8_BAR; }
    }
    PG8_WAIT_V(0);
    if constexpr (!ALIGN_EPI) { if (wr == 0) PG8_BAR; }
    PG8_BAR;
    if constexpr (Epi::AFTER_DRAIN) { E.fused(acc, cur, wr, wc, fr, fq, lds, wid, lane); S.done(cur); }
#undef PG8_SA
#undef PG8_SB
#undef PG8_STAGE
#undef PG8_LDA
#undef PG8_STAGE_A
#undef PG8_LOAD_GOFF
#undef PG8_LDB
#undef PG8_MMA
#undef PG8_WAIT_V
#undef PG8_WAIT_L
#undef PG8_BAR
#undef PG8_SCHED
}

}
__device__ __forceinline__ pg8::u32x4 pack8(const f32x4& a, const f32x4& b) { pg8::u32x4 w; w.x = pack2(a[0], a[1]); w.y = pack2(a[2], a[3]); w.z = pack2(b[0], b[1]); w.w = pack2(b[2], b[3]); return w; }
__device__ __forceinline__ void unpack8(const pg8::u32x4& w, f32x4& a, f32x4& b) {
    a[0] = __uint_as_float(w.x << 16); a[1] = __uint_as_float(w.x & 0xffff0000u); a[2] = __uint_as_float(w.y << 16); a[3] = __uint_as_float(w.y & 0xffff0000u);
    b[0] = __uint_as_float(w.z << 16); b[1] = __uint_as_float(w.z & 0xffff0000u); b[2] = __uint_as_float(w.w << 16); b[3] = __uint_as_float(w.w & 0xffff0000u); }


__device__ __forceinline__ void phase_gemm_in(ParamsC p, int l, unsigned char* smem) {
    const int tid = ltid(), lane = tid & 63, wid = tid >> 6, wm = wid >> 1, wn = wid & 1, q4 = (lane >> 4) * 4;
    const int nM = T_ALL / 128, nN = IN_COLS / 128;
    for (int tile = lbid(); tile < nM * nN; tile += gridDim.x) {
        const int tm = tile / nN, tn = tile % nN, m0 = tm * 128, n0 = tn * 128;
        f32x4 acc[2][4]; zero_acc(acc);
        RowsLinear ar{p->h + (size_t)m0 * 1024, 1024};
        gemm_core(smem, ar, p->wt_in + (size_t)n0 * 1024, 1024, 0, 1024, acc);
        const int cb = n0 + wn * 64;
#pragma unroll
        for (int mi = 0; mi < 2; ++mi) {
            const int t = m0 + wm * 32 + mi * 16 + (lane & 15);
            f32x4 v0 = acc[mi][0], v1 = acc[mi][1], v2 = acc[mi][2], v3 = acc[mi][3];
            if (cb >= 2560) {
                bf16_t* dst = p->uG + (size_t)t * UG_LD + (cb - 2560) + q4;
#pragma unroll
                for (int e = 0; e < 4; ++e) { v0[e] = 1.f / (1.f + __expf(-v0[e])); v1[e] = 1.f / (1.f + __expf(-v1[e])); v2[e] = 1.f / (1.f + __expf(-v2[e])); v3[e] = 1.f / (1.f + __expf(-v3[e])); }
                store4bf(dst, v0); store4bf(dst + 16, v1); store4bf(dst + 32, v2); store4bf(dst + 48, v3);
            } else {
                const bool isq = (cb >= 768 && cb < 1152) || (cb >= 1920 && cb < 2304);
                const bool rope = (cb >= 1920 && cb < 2432) && (t < T_LAT);
                if (rope) { const int pos = t & 8191, r = pos >> 6, cc = pos & 63;
#pragma unroll
                    for (int e = 0; e < 4; ++e) {
                        const float2 csr = *(const float2*)(p->ropet + (r * 16 + q4 + e) * 2), csc = *(const float2*)(p->ropet + (cc * 16 + q4 + e) * 2);
                        const float a1 = v0[e], a2 = v1[e]; v0[e] = a1 * csr.x - a2 * csr.y; v1[e] = a1 * csr.y + a2 * csr.x;
                        const float b1 = v2[e], b2 = v3[e]; v2[e] = b1 * csc.x - b2 * csc.y; v3[e] = b1 * csc.y + b2 * csc.x; } }
                if (isq) { v0 = v0 * 0.125f; v1 = v1 * 0.125f; v2 = v2 * 0.125f; v3 = v3 * 0.125f; }
                bf16_t* dst = p->uA + (size_t)t * UA_LD + cb + q4;
                store4bf(dst, v0); store4bf(dst + 16, v1); store4bf(dst + 32, v2); store4bf(dst + 48, v3);
            }
        }
    }
}

struct KmNA { int b, r, c, rs, cs; const float* rpb;
    __device__ __forceinline__ int tok(int kk) const { if (kk < 128) return b * SEQ + (rs + (kk >> 4)) * 64 + cs + (kk & 15); return T_LAT + b * CTXL + (kk - 128); }
    __device__ __forceinline__ float bias(int kk) const { if (kk < 128) return rpb[(rs + (kk >> 4) - r + 7) * 31 + (cs + (kk & 15) - c + 15)]; return 0.f; } };
struct KmSWA { int b, i;
    __device__ __forceinline__ int tok(int kk) const { if (kk < 257) { const int j = i - 128 + kk; return (j >= 0 && j < SEQ) ? b * SEQ + j : -1; } if (kk < 513) return T_LAT + b * CTXL + (kk - 257); return -1; }
    __device__ __forceinline__ float bias(int) const { return 0.f; } };
struct KmCtx { int b;
    __device__ __forceinline__ int tok(int kk) const { return T_LAT + b * CTXL + kk; }
    __device__ __forceinline__ float bias(int) const { return 0.f; } };

template <int NI, class KM>
__device__ __forceinline__ void attn_item(const bf16_t* uA, int tq, int qcol, int kcol, int vcol, const KM& km, bool has_sink, float sink, bf16_t* outp, int lane) {
    float q[64];
    {   const uint4* qp = (const uint4*)(uA + (size_t)tq * UA_LD + qcol);
#pragma unroll
        for (int c = 0; c < 8; ++c) { const uint4 v = qp[c];
            q[c * 8 + 0] = bf2f((bf16_t)(v.x & 0xffff)); q[c * 8 + 1] = bf2f((bf16_t)(v.x >> 16)); q[c * 8 + 2] = bf2f((bf16_t)(v.y & 0xffff)); q[c * 8 + 3] = bf2f((bf16_t)(v.y >> 16));
            q[c * 8 + 4] = bf2f((bf16_t)(v.z & 0xffff)); q[c * 8 + 5] = bf2f((bf16_t)(v.z >> 16)); q[c * 8 + 6] = bf2f((bf16_t)(v.w & 0xffff)); q[c * 8 + 7] = bf2f((bf16_t)(v.w >> 16)); } }
    float s[NI]; float mx = -3.0e38f;
#pragma unroll
    for (int i = 0; i < NI; ++i) { const int kk = i * 64 + lane; const int tk = km.tok(kk);
        float d = -3.0e38f;
        if (tk >= 0) { const uint4* kp = (const uint4*)(uA + (size_t)tk * UA_LD + kcol); d = 0.f;
#pragma unroll
            for (int c = 0; c < 8; ++c) { const uint4 v = kp[c];
                d += q[c * 8 + 0] * bf2f((bf16_t)(v.x & 0xffff)) + q[c * 8 + 1] * bf2f((bf16_t)(v.x >> 16)) + q[c * 8 + 2] * bf2f((bf16_t)(v.y & 0xffff)) + q[c * 8 + 3] * bf2f((bf16_t)(v.y >> 16))
                   + q[c * 8 + 4] * bf2f((bf16_t)(v.z & 0xffff)) + q[c * 8 + 5] * bf2f((bf16_t)(v.z >> 16)) + q[c * 8 + 6] * bf2f((bf16_t)(v.w & 0xffff)) + q[c * 8 + 7] * bf2f((bf16_t)(v.w >> 16)); }
            d += km.bias(kk); }
        s[i] = d; mx = fmaxf(mx, d); }
    mx = wave_max(mx); if (has_sink) mx = fmaxf(mx, sink);
    float sum = 0.f;
#pragma unroll
    for (int i = 0; i < NI; ++i) { const float pv = s[i] > -1.0e38f ? __expf(s[i] - mx) : 0.f; s[i] = pv; sum += pv; }
    sum = wave_sum(sum); if (has_sink) sum += __expf(sink - mx);
    const float inv = 1.0f / sum;
    float o = 0.f;
#pragma unroll
    for (int i = 0; i < NI; ++i) {
        for (int sl = 0; sl < 64; ++sl) { const int tk = km.tok(i * 64 + sl); const float pv = __shfl(s[i], sl);
            if (tk >= 0) o += pv * bf2f(uA[(size_t)tk * UA_LD + vcol + lane]); } }
    outp[lane] = f2bf(o * inv);
}

__device__ __forceinline__ void phase_mix(ParamsC p, int l) {
    const int tid = ltid(), lane = tid & 63, wid = tid >> 6;
    const bool need_ctx = l < DEPTH - 1;
    {   const int ntok = need_ctx ? T_ALL : T_LAT; const float* cw = p->conv_w + l * 3 * 256;
        for (int idx = lbid() * NTHR + tid; idx < ntok * 256; idx += gridDim.x * NTHR) { const int t = idx >> 8, c = idx & 255;
            int pos, len; if (t < T_LAT) { pos = t & 8191; len = SEQ; } else { pos = (t - T_LAT) & 255; len = CTXL; }
            const bf16_t* u = p->uA + (size_t)t * UA_LD + c;
            const float z1 = bf2f(u[512]) * bf2f(u[0]);
            const float z0 = pos > 0 ? bf2f(u[512 - UA_LD]) * bf2f(u[-UA_LD]) : 0.f;
            const float z2 = pos + 1 < len ? bf2f(u[512 + UA_LD]) * bf2f(u[UA_LD]) : 0.f;
            const float y = bf2f(u[256]) * (z0 * cw[c] + z1 * cw[256 + c] + z2 * cw[512 + c]);
            p->ycat[(size_t)t * 1024 + c] = f2bf(y); } }
    const int n_lat = T_LAT * 12, n_all = n_lat + (need_ctx ? T_CTX * 12 : 0);
    for (int it = lbid() * 8 + wid; it < n_all; it += gridDim.x * 8) {
        if (it < n_lat) { const int t = it / 12, hh = it % 12; const int b = t >> 13, pos = t & 8191;
            if (hh < 6) { KmNA km; km.b = b; km.r = pos >> 6; km.c = pos & 63; km.rs = min(max(km.r - 4, 0), 120); km.cs = min(max(km.c - 8, 0), 48); km.rpb = p->rpb + ((size_t)l * 6 + hh) * 15 * 31;
                attn_item<6>(p->uA, t, 768 + hh * 64, 1152 + hh * 64, 1536 + hh * 64, km, false, 0.f, p->ycat + (size_t)t * 1024 + 256 + hh * 64, lane); }
            else { const int hq = hh - 6, kh = hq / 3; KmSWA km; km.b = b; km.i = pos;
                attn_item<9>(p->uA, t, 1920 + hq * 64, 2304 + kh * 64, 2432 + kh * 64, km, true, p->sinks[l * 6 + hq], p->ycat + (size_t)t * 1024 + 640 + hq * 64, lane); }
        } else { const int it2 = it - n_lat; const int tc = it2 / 12, hh = it2 % 12; const int t = T_LAT + tc; KmCtx km; km.b = tc >> 8;
            if (hh < 6) attn_item<4>(p->uA, t, 768 + hh * 64, 1152 + hh * 64, 1536 + hh * 64, km, false, 0.f, p->ycat + (size_t)t * 1024 + 256 + hh * 64, lane);
            else { const int hq = hh - 6, kh = hq / 3; attn_item<4>(p->uA, t, 1920 + hq * 64, 2304 + kh * 64, 2432 + kh * 64, km, true, p->sinks[l * 6 + hq], p->ycat + (size_t)t * 1024 + 640 + hq * 64, lane); }
        }
    }
}


typedef float f32x16 __attribute__((ext_vector_type(16)));
typedef short s16x4 __attribute__((ext_vector_type(4)));
#define AT_STRIDE 144
#define AT_KBUF(b) ((b) * 9216)
#define AT_VBUF(b) (18432 + (b) * 9216)
#define AT_RPB 36864
#define LOG2E 1.4426950408889634f
#define AT_NEG (-1.0e30f)

template <int MK>
__device__ __forceinline__ void attn_tile(const unsigned char* kt, const unsigned char* vlane, const bf16x8 (&qf)[4], f32x16 (&oacc)[2], float& m, float& lsum,
                                          const float* rpb_row, int relc0  , int lo0  , int lane) {
    const int n = lane & 31, hh = lane >> 5;
    f32x16 sc;
#pragma unroll
    for (int r = 0; r < 16; ++r) sc[r] = 0.f;
#pragma unroll
    for (int sp = 0; sp < 4; ++sp) { const bf16x8 kf = *(const bf16x8*)(kt + n * AT_STRIDE + sp * 32 + hh * 16); sc = __builtin_amdgcn_mfma_f32_32x32x16_bf16(kf, qf[sp], sc, 0, 0, 0); }
    float mx = AT_NEG;
#pragma unroll
    for (int r = 0; r < 16; ++r) { const int i = (r & 3) + 8 * (r >> 2) + 4 * hh; float v = sc[r];
        if (MK == 1) { const bool ok = (unsigned)(i - lo0) < 16u; const int ridx = ok ? (relc0 + i) : 0; v = ok ? (v + rpb_row[ridx]) : AT_NEG; }
        else if (MK == 2) v = (i >= n) ? v : AT_NEG;
        else if (MK == 3) v = (i <= n) ? v : AT_NEG;
        sc[r] = v; mx = fmaxf(mx, v); }
    mx = fmaxf(mx, __shfl_xor(mx, 32));
    const float mn = fmaxf(m, mx);
    if (__any(mn > m)) { const float alpha = __builtin_amdgcn_exp2f(m - mn); lsum *= alpha;
#pragma unroll
        for (int r = 0; r < 16; ++r) { oacc[0][r] *= alpha; oacc[1][r] *= alpha; } }
    m = mn;
    float ps = 0.f;
#pragma unroll
    for (int r = 0; r < 16; ++r) { const float pv = __builtin_amdgcn_exp2f(sc[r] - mn); sc[r] = pv; ps += pv; }
    lsum += ps;
    bf16x8 pf[2];
#pragma unroll
    for (int s2 = 0; s2 < 2; ++s2) { pg8::u32x4 w; w.x = pack2(sc[s2 * 8 + 0], sc[s2 * 8 + 1]); w.y = pack2(sc[s2 * 8 + 2], sc[s2 * 8 + 3]); w.z = pack2(sc[s2 * 8 + 4], sc[s2 * 8 + 5]); w.w = pack2(sc[s2 * 8 + 6], sc[s2 * 8 + 7]);
        pf[s2] = __builtin_bit_cast(bf16x8, w); }
#pragma unroll
    for (int c = 0; c < 2; ++c)
#pragma unroll
        for (int s2 = 0; s2 < 2; ++s2) {
            const s16x4 v0 = __builtin_amdgcn_ds_read_tr16_b64_v4i16((LAS s16x4*)(vlane + (16 * s2) * AT_STRIDE + 64 * c));
            const s16x4 v1 = __builtin_amdgcn_ds_read_tr16_b64_v4i16((LAS s16x4*)(vlane + (16 * s2 + 8) * AT_STRIDE + 64 * c));
            bf16x8 vf; vf[0] = v0[0]; vf[1] = v0[1]; vf[2] = v0[2]; vf[3] = v0[3]; vf[4] = v1[0]; vf[5] = v1[1]; vf[6] = v1[2]; vf[7] = v1[3];
            oacc[c] = __builtin_amdgcn_mfma_f32_32x32x16_bf16(vf, pf[s2], oacc[c], 0, 0, 0);
        }
}

template <int MODE>
__device__ __forceinline__ void attn_unit(ParamsC p, int l, int u, unsigned char* smem) {
    const int tid = ltid(), lane = tid & 63, wid = tid >> 6;
    int b, qcol, kcol, vcol, ocol, qtok; bool has_sink = false; float sinkv = 0.f;
    int nsteps, krlo = 0, r = 0, rs = 0, c = 0, cs = 0, q0 = 0, jwlo = 0;
    if (MODE == 0) { b = u / 192; const int rem = u % 192, h = rem / 32, rg = rem % 32; qcol = 768 + h * 64; kcol = 1152 + h * 64; vcol = 1536 + h * 64; ocol = 256 + h * 64;
        r = rg * 4 + (wid >> 1); rs = min(max(r - 4, 0), 120); c = 32 * (wid & 1) + (lane & 31); cs = min(max(c - 8, 0), 48);
        krlo = min(max(rg * 4 - 4, 0), 120); const int krhi = min(max(rg * 4 + 3 - 4, 0), 120) + 7; nsteps = 4 + (krhi - krlo + 1);
        qtok = b * SEQ + r * 64 + 32 * (wid & 1);
        for (int i = tid; i < 15 * 31; i += NTHR) ((float*)(smem + AT_RPB))[i] = p->rpb[((size_t)l * 6 + h) * 465 + i] * LOG2E;
    } else if (MODE == 1) { b = u / 192; const int rem = u % 192, hq = rem / 32, qb = rem % 32, kh = hq / 3; qcol = 1920 + hq * 64; kcol = 2304 + kh * 64; vcol = 2432 + kh * 64; ocol = 640 + hq * 64;
        q0 = qb * 256; jwlo = (q0 == 0) ? 2 : 0; const int jwhi = min(8, (SEQ - q0 + 128) / 64); nsteps = 4 + (jwhi - jwlo);
        qtok = b * SEQ + q0 + 32 * wid; has_sink = true; sinkv = p->sinks[l * 6 + hq];
    } else { b = u / 12; const int hh = u % 12;
        if (hh < 6) { qcol = 768 + hh * 64; kcol = 1152 + hh * 64; vcol = 1536 + hh * 64; ocol = 256 + hh * 64; }
        else { const int hq = hh - 6, kh = hq / 3; qcol = 1920 + hq * 64; kcol = 2304 + kh * 64; vcol = 2432 + kh * 64; ocol = 640 + hq * 64; has_sink = true; sinkv = p->sinks[l * 6 + hq]; }
        nsteps = 4; qtok = T_LAT + b * CTXL + 32 * wid;
    }
    const bf16_t* uA = p->uA;
    bf16x8 qf[4];
    {   const bf16_t* qp = uA + (size_t)(qtok + (lane & 31)) * UA_LD + qcol + (lane >> 5) * 8;
#pragma unroll
        for (int sp = 0; sp < 4; ++sp) qf[sp] = *(const bf16x8*)(qp + sp * 16); }
    f32x16 oacc[2];
#pragma unroll
    for (int r16 = 0; r16 < 16; ++r16) { oacc[0][r16] = 0.f; oacc[1][r16] = 0.f; }
    float m = has_sink ? sinkv * LOG2E : AT_NEG, lsum = (has_sink && lane < 32) ? 1.f : 0.f;
    const int skey = tid >> 3, sch = tid & 7; const int soff = skey * AT_STRIDE + sch * 16;
    auto chunk_tok = [&](int j) -> int {
        if (j < 4) return T_LAT + b * CTXL + 64 * j;
        if (MODE == 0) return b * SEQ + (krlo + (j - 4)) * 64;
        return b * SEQ + q0 - 128 + 64 * (jwlo + (j - 4)); };
    uint4 rk, rv;
    {   const bf16_t* src = uA + (size_t)(chunk_tok(0) + skey) * UA_LD + sch * 8; rk = *(const uint4*)(src + kcol); rv = *(const uint4*)(src + vcol); }
    *(uint4*)(smem + AT_KBUF(0) + soff) = rk; *(uint4*)(smem + AT_VBUF(0) + soff) = rv;
    __syncthreads();
    const int vl_off = (4 * (lane >> 5) + ((lane & 15) >> 2)) * AT_STRIDE + (16 * ((lane >> 4) & 1) + 4 * (lane & 3)) * 2;
    const float* rpb_s = (const float*)(smem + AT_RPB);
    for (int j = 0; j < nsteps; ++j) {
        const int buf = j & 1;
        if (j + 1 < nsteps) { const bf16_t* src = uA + (size_t)(chunk_tok(j + 1) + skey) * UA_LD + sch * 8; rk = *(const uint4*)(src + kcol); rv = *(const uint4*)(src + vcol); }
        const unsigned char* kb = smem + AT_KBUF(buf); const unsigned char* vb = smem + AT_VBUF(buf) + vl_off;
        if (j < 4) {
            attn_tile<0>(kb, vb, qf, oacc, m, lsum, rpb_s, 0, 0, lane);
            attn_tile<0>(kb + 32 * AT_STRIDE, vb + 32 * AT_STRIDE, qf, oacc, m, lsum, rpb_s, 0, 0, lane);
        } else if (MODE == 0) {
            const int kr = krlo + (j - 4);
            if (kr >= rs && kr < rs + 8) { const float* rrow = rpb_s + (kr - r + 7) * 31;
                attn_tile<1>(kb, vb, qf, oacc, m, lsum, rrow, 0 - c + 15, cs, lane);
                attn_tile<1>(kb + 32 * AT_STRIDE, vb + 32 * AT_STRIDE, qf, oacc, m, lsum, rrow, 32 - c + 15, cs - 32, lane); }
        } else if (MODE == 1) {
            const int qp0 = q0 + 32 * wid;
#pragma unroll
            for (int tl = 0; tl < 2; ++tl) { const int kp0 = q0 - 128 + 64 * (jwlo + (j - 4)) + 32 * tl; const int d = kp0 - qp0;
                const unsigned char* kt = kb + tl * 32 * AT_STRIDE; const unsigned char* vt = vb + tl * 32 * AT_STRIDE;
                if (d == -128) attn_tile<2>(kt, vt, qf, oacc, m, lsum, rpb_s, 0, 0, lane);
                else if (d == 128) attn_tile<3>(kt, vt, qf, oacc, m, lsum, rpb_s, 0, 0, lane);
                else if (d > -128 && d < 128) attn_tile<0>(kt, vt, qf, oacc, m, lsum, rpb_s, 0, 0, lane); }
        }
        if (j + 1 < nsteps) { *(uint4*)(smem + AT_KBUF(buf ^ 1) + soff) = rk; *(uint4*)(smem + AT_VBUF(buf ^ 1) + soff) = rv; }
        __syncthreads();
    }
    const float ltot = lsum + __shfl_xor(lsum, 32); const float inv = 1.0f / ltot;
    bf16_t* op = p->ycat + (size_t)(qtok + (lane & 31)) * 1024 + ocol + 4 * (lane >> 5);
#pragma unroll
    for (int cc = 0; cc < 2; ++cc)
#pragma unroll
        for (int g = 0; g < 4; ++g) { f32x4 v; v[0] = oacc[cc][4 * g] * inv; v[1] = oacc[cc][4 * g + 1] * inv; v[2] = oacc[cc][4 * g + 2] * inv; v[3] = oacc[cc][4 * g + 3] * inv;
            store4bf(op + 32 * cc + 8 * g, v); }
}

__device__ __forceinline__ void phase_mix2(ParamsC p, int l, unsigned char* smem) {
    const int tid = ltid();
    const bool need_ctx = l < DEPTH - 1;
    {
        const int ntok = need_ctx ? T_ALL : T_LAT; const float* cw = p->conv_w + l * 3 * 256;
        for (int idx = lbid() * NTHR + tid; idx < ntok * 32; idx += gridDim.x * NTHR) { const int t = idx >> 5, c = (idx & 31) * 8;
            int pos, len; if (t < T_LAT) { pos = t & 8191; len = SEQ; } else { pos = (t - T_LAT) & 255; len = CTXL; }
            const bf16_t* u = p->uA + (size_t)t * UA_LD + c;
            const bool hp = pos > 0, hn = pos + 1 < len;
            const pg8::u32x4 zero4 = (pg8::u32x4){0u, 0u, 0u, 0u};
            const pg8::u32x4 h1 = *(const pg8::u32x4*)u, c1 = *(const pg8::u32x4*)(u + 512), b1 = *(const pg8::u32x4*)(u + 256);
            const pg8::u32x4 h0 = hp ? *(const pg8::u32x4*)(u - UA_LD) : zero4, c0 = hp ? *(const pg8::u32x4*)(u + 512 - UA_LD) : zero4;
            const pg8::u32x4 h2 = hn ? *(const pg8::u32x4*)(u + UA_LD) : zero4, c2 = hn ? *(const pg8::u32x4*)(u + 512 + UA_LD) : zero4;
            f32x4 w0a = *(const f32x4*)(cw + c), w0b = *(const f32x4*)(cw + c + 4), w1a = *(const f32x4*)(cw + 256 + c), w1b = *(const f32x4*)(cw + 256 + c + 4), w2a = *(const f32x4*)(cw + 512 + c), w2b = *(const f32x4*)(cw + 512 + c + 4);
            f32x4 ha, hb, ca, cb, ya, yb;
            unpack8(h0, ha, hb); unpack8(c0, ca, cb); ya = ha * ca * w0a; yb = hb * cb * w0b;
            unpack8(h1, ha, hb); unpack8(c1, ca, cb); ya += ha * ca * w1a; yb += hb * cb * w1b;
            unpack8(h2, ha, hb); unpack8(c2, ca, cb); ya += ha * ca * w2a; yb += hb * cb * w2b;
            unpack8(b1, ha, hb); ya = ya * ha; yb = yb * hb;
            *(pg8::u32x4*)(p->ycat + (size_t)t * 1024 + c) = pack8(ya, yb); } }
    for (int u = lbid(); u < 768; u += gridDim.x) attn_unit<0>(p, l, u, smem);
    for (int u = lbid(); u < 768; u += gridDim.x) attn_unit<1>(p, l, u, smem);
    if (need_ctx) for (int u = lbid(); u < 48; u += gridDim.x) attn_unit<2>(p, l, u, smem);
}

__device__ __forceinline__ void phase_gemm_merge(ParamsC p, int l, unsigned char* smem) {
    const int tid = ltid(), lane = tid & 63, wid = tid >> 6, wm = wid >> 1, wn = wid & 1, q4 = (lane >> 4) * 4;
    const int ntok = (l < DEPTH - 1) ? T_ALL : T_LAT; const int nM = ntok / 128, nN = 8;
    for (int tile = lbid(); tile < nM * nN; tile += gridDim.x) {
        const int tm = tile / nN, tn = tile % nN, m0 = tm * 128, n0 = tn * 128;
        f32x4 macc[2][4]; zero_acc(macc);
        RowsLinear ar{p->ycat + (size_t)m0 * 1024, 1024};
#pragma unroll
        for (int seg = 0; seg < 3; ++seg) {
            const int k0 = seg == 0 ? 0 : (seg == 1 ? 256 : 640), k1 = seg == 0 ? 256 : (seg == 1 ? 640 : 1024);
            f32x4 acc[2][4]; zero_acc(acc);
            gemm_core(smem, ar, p->wt_br + (size_t)n0 * 1024, 1024, k0, k1, acc);
#pragma unroll
            for (int mi = 0; mi < 2; ++mi) { const int t = m0 + wm * 32 + mi * 16 + (lane & 15);
#pragma unroll
                for (int nj = 0; nj < 4; ++nj) { const uint2 g = *(const uint2*)(p->uG + (size_t)t * UG_LD + seg * 1024 + n0 + wn * 64 + nj * 16 + q4);
                    macc[mi][nj][0] += bf2f((bf16_t)(g.x & 0xffff)) * acc[mi][nj][0]; macc[mi][nj][1] += bf2f((bf16_t)(g.x >> 16)) * acc[mi][nj][1];
                    macc[mi][nj][2] += bf2f((bf16_t)(g.y & 0xffff)) * acc[mi][nj][2]; macc[mi][nj][3] += bf2f((bf16_t)(g.y >> 16)) * acc[mi][nj][3]; } }
        }
#pragma unroll
        for (int mi = 0; mi < 2; ++mi) { const int t = m0 + wm * 32 + mi * 16 + (lane & 15);
#pragma unroll
            for (int nj = 0; nj < 4; ++nj) store4bf(p->mbuf + (size_t)t * 1024 + n0 + wn * 64 + nj * 16 + q4, macc[mi][nj]); }
    }
}

__device__ __forceinline__ void phase_gemm_o(ParamsC p, int l, unsigned char* smem) {
    const int tid = ltid(), lane = tid & 63, wid = tid >> 6, wm = wid >> 1, wn = wid & 1, q4 = (lane >> 4) * 4;
    const int ntok = (l < DEPTH - 1) ? T_ALL : T_LAT; const int nM = ntok / 128, nN = 8;
    for (int tile = lbid(); tile < nM * nN; tile += gridDim.x) {
        const int tm = tile / nN, tn = tile % nN, m0 = tm * 128, n0 = tn * 128;
        f32x4 acc[2][4]; zero_acc(acc);
        RowsLinear ar{p->mbuf + (size_t)m0 * 1024, 1024};
        gemm_core(smem, ar, p->wt_o + (size_t)n0 * 1024, 1024, 0, 1024, acc);
#pragma unroll
        for (int mi = 0; mi < 2; ++mi) { const int t = m0 + wm * 32 + mi * 16 + (lane & 15); const float* gt = p->modv + (size_t)(l * 5 + tok_variant(t)) * 6144 + 2048;
#pragma unroll
            for (int nj = 0; nj < 4; ++nj) { const int c = n0 + wn * 64 + nj * 16 + q4; float4* xp = (float4*)(p->xs + (size_t)t * 1024 + c); float4 xv = *xp; const float4 g = *(const float4*)(gt + c);
                xv.x += g.x * acc[mi][nj][0]; xv.y += g.y * acc[mi][nj][1]; xv.z += g.z * acc[mi][nj][2]; xv.w += g.w * acc[mi][nj][3]; *xp = xv; } }
    }
}

#define RT_LD 1028
__device__ __forceinline__ void phase_router(ParamsC p, int l, float* smem) {
    const int tid = ltid(), lane = tid & 63, wid = tid >> 6;
    float* sh2 = smem;
    float* spart = smem + 16 * RT_LD;
    float* slg = spart + 8 * 16 * 32;
    int* bcnt = (int*)(slg + 16 * 36);
    if (tid < 32) bcnt[tid] = 0;
    const int ntok = (l < DEPTH - 1) ? T_ALL : T_LAT;
    const float* wre = p->w_re + (size_t)l * 1024 * 32; const float* wrg = p->w_rg + (size_t)l * 1024 * 4;
    float bw[32][2];
#pragma unroll
    for (int ks = 0; ks < 32; ++ks) { const float* wp = wre + (size_t)(wid * 128 + ks * 4 + (lane >> 4)) * 32 + (lane & 15); bw[ks][0] = wp[0]; bw[ks][1] = wp[16]; }
    for (int tb = lbid(); tb < ntok / 16; tb += gridDim.x) {
#pragma unroll
        for (int j = 0; j < 2; ++j) { const int tt = wid * 2 + j, t = tb * 16 + tt; const int v = tok_variant(t);
            float4 xv[4]; float ss = 0.f;
#pragma unroll
            for (int i = 0; i < 4; ++i) { xv[i] = *(const float4*)(p->xs + (size_t)t * 1024 + i * 256 + lane * 4); ss += xv[i].x * xv[i].x + xv[i].y * xv[i].y + xv[i].z * xv[i].z + xv[i].w * xv[i].w; }
            ss = wave_sum(ss); const float rstd = rsqrtf(ss * (1.0f / 1024.0f) + 1e-6f);
            const float* mv = p->modv + (size_t)(l * 5 + v) * 6144 + 3072;
            float g0 = 0.f, g1 = 0.f, g2 = 0.f, g3 = 0.f;
#pragma unroll
            for (int i = 0; i < 4; ++i) { const int c = i * 256 + lane * 4;
                const float4 g = *(const float4*)(p->g_ffn + l * 1024 + c), sh = *(const float4*)(mv + c), sc = *(const float4*)(mv + 1024 + c);
                float4 o; o.x = xv[i].x * rstd * g.x * (1.f + sc.x) + sh.x; o.y = xv[i].y * rstd * g.y * (1.f + sc.y) + sh.y; o.z = xv[i].z * rstd * g.z * (1.f + sc.z) + sh.z; o.w = xv[i].w * rstd * g.w * (1.f + sc.w) + sh.w;
                *(float4*)(sh2 + tt * RT_LD + c) = o; uint2 ob; ob.x = pack2(o.x, o.y); ob.y = pack2(o.z, o.w); *(uint2*)(p->h + (size_t)t * 1024 + c) = ob;
                const float4 w0 = *(const float4*)(wrg + (c + 0) * 4), w1 = *(const float4*)(wrg + (c + 1) * 4), w2 = *(const float4*)(wrg + (c + 2) * 4), w3 = *(const float4*)(wrg + (c + 3) * 4);
                g0 += o.x * w0.x + o.y * w1.x + o.z * w2.x + o.w * w3.x; g1 += o.x * w0.y + o.y * w1.y + o.z * w2.y + o.w * w3.y;
                g2 += o.x * w0.z + o.y * w1.z + o.z * w2.z + o.w * w3.z; g3 += o.x * w0.w + o.y * w1.w + o.z * w2.w + o.w * w3.w; }
            g0 = wave_sum(g0); g1 = wave_sum(g1); g2 = wave_sum(g2); g3 = wave_sum(g3);
            if (lane == 0) { slg[tt * 36 + 0] = g0 + p->b_rg[l * 4 + 0]; slg[tt * 36 + 1] = g1 + p->b_rg[l * 4 + 1]; slg[tt * 36 + 2] = g2 + p->b_rg[l * 4 + 2]; slg[tt * 36 + 3] = g3 + p->b_rg[l * 4 + 3]; } }
        __syncthreads();
        {   f32x4 c0 = (f32x4){0.f, 0.f, 0.f, 0.f}, c1 = c0;
            const float* ap = sh2 + (lane & 15) * RT_LD + wid * 128 + (lane >> 4);
#pragma unroll
            for (int ks = 0; ks < 32; ++ks) { const float a = ap[ks * 4];
                c0 = __builtin_amdgcn_mfma_f32_16x16x4f32(a, bw[ks][0], c0, 0, 0, 0); c1 = __builtin_amdgcn_mfma_f32_16x16x4f32(a, bw[ks][1], c1, 0, 0, 0); }
#pragma unroll
            for (int r = 0; r < 4; ++r) { const int tk = 4 * (lane >> 4) + r; spart[(wid * 16 + tk) * 32 + (lane & 15)] = c0[r]; spart[(wid * 16 + tk) * 32 + 16 + (lane & 15)] = c1[r]; } }
        __syncthreads();
        {   const int tt = tid >> 5, j = tid & 31; float a = p->b_re[l * 32 + j];
#pragma unroll
            for (int w8 = 0; w8 < 8; ++w8) a += spart[(w8 * 16 + tt) * 32 + j];
            slg[tt * 36 + 4 + j] = a; }
        __syncthreads();
        if (tid < 16) { const int t = tb * 16 + tid; const float* lg = slg + tid * 36;
            int gi = 0; float gm = lg[0];
            for (int j = 1; j < 4; ++j) if (lg[j] > gm) { gm = lg[j]; gi = j; }
            float den = 0.f; for (int j = 0; j < 4; ++j) den += expf(lg[j] - gm);
            const float pg = 1.0f / den;
            const float* le = lg + 4 + gi * 8;
            int i1 = 0; float v1 = le[0]; for (int j = 1; j < 8; ++j) if (le[j] > v1) { v1 = le[j]; i1 = j; }
            int i2 = -1; float v2 = -3.0e38f; for (int j = 0; j < 8; ++j) if (j != i1 && le[j] > v2) { v2 = le[j]; i2 = j; }
            const float e2 = expf(v2 - v1); const float wa = 1.0f / (1.0f + e2), wb = e2 / (1.0f + e2);
            const int ea = gi * 8 + i1, eb = gi * 8 + i2;
            p->eid[t * 2] = ea; p->eid[t * 2 + 1] = eb; p->ewt[t * 2] = pg * wa; p->ewt[t * 2 + 1] = pg * wb;
            p->epos[t * 2] = atomicAdd(bcnt + ea, 1); p->epos[t * 2 + 1] = atomicAdd(bcnt + eb, 1); }
        __syncthreads();
    }
    __syncthreads();
    if (tid < 32) p->cnt[lbid() * 32 + tid] = bcnt[tid];
}

__device__ __forceinline__ void phase_dispatch(ParamsC p, int l, int* smem) {
    const int tid = ltid(), lane = tid & 63, wid = tid >> 6;
    int* sfull = smem;
    int* spre = smem + 512;
    int* pstart = smem + 1024;
    int* boff = smem + 1024 + 64;
    const int G = gridDim.x;
    {   const int e = tid & 31, part = tid >> 5; int sf = 0, sp = 0;
        for (int bb = part; bb < G; bb += 16) { const int c = p->cnt[bb * 32 + e]; sf += c; sp += (bb < lbid()) ? c : 0; }
        sfull[part * 32 + e] = sf; spre[part * 32 + e] = sp; }
    __syncthreads();
    if (tid < 32) { int tf = 0, tp = 0; for (int q = 0; q < 16; ++q) { tf += sfull[q * 32 + tid]; tp += spre[q * 32 + tid]; } sfull[tid] = tf; spre[tid] = tp; }
    __syncthreads();
    if (tid == 0) { int acc = 0; for (int e = 0; e < 32; ++e) { pstart[e] = acc; acc += ((sfull[e] + 255) >> 8) << 8; } pstart[32] = acc; }
    __syncthreads();
    if (tid < 32) boff[tid] = pstart[tid] + spre[tid];
    if (lbid() == 0) { const int nb = pstart[32] >> 8;
        for (int rb = tid; rb < nb; rb += NTHR) { int e = 0; while (e < 31 && pstart[e + 1] <= rb * 256) ++e; p->blk_e[rb] = e; }
        if (tid == 0) p->nbu[0] = nb; }
    __syncthreads();
    const int ntok = (l < DEPTH - 1) ? T_ALL : T_LAT;
    for (int tb = lbid(); tb < ntok / 16; tb += G) {
#pragma unroll
        for (int j = 0; j < 4; ++j) { const int a = tb * 32 + wid * 4 + j; const int t = a >> 1; const int sl = boff[p->eid[a]] + p->epos[a];
            if (lane == 0) { p->slot[a] = sl; p->tokmap[sl] = t; } }
    }
    for (int e = lbid(); e < 32; e += G) { const int lo = pstart[e] + sfull[e], hi = pstart[e + 1]; for (int sl = lo + tid; sl < hi; sl += NTHR) p->tokmap[sl] = 0; }
}

__device__ __forceinline__ void phase_gemm_e1(ParamsC p, unsigned char* smem) {
    const int tid = ltid(), lane = tid & 63, wid = tid >> 6, wm = wid >> 1, wn = wid & 1, q4 = (lane >> 4) * 4;
    const int nb = p->nbu[0]; const int ntiles = nb * 2 * 4;
    for (int tile = lbid(); tile < ntiles; tile += gridDim.x) {
        const int rb = tile >> 2, tn = tile & 3, m0 = rb * 128, e = p->blk_e[rb >> 1];
        f32x4 acc[2][4]; zero_acc(acc);
        RowsLinear ar{p->xd + (size_t)m0 * 1024, 1024};
        gemm_core(smem, ar, p->wt_gu + ((size_t)e * 512 + tn * 128) * 1024, 1024, 0, 1024, acc);
        const int pg = tn * 2 + wn;
#pragma unroll
        for (int mi = 0; mi < 2; ++mi) { const int sl = m0 + wm * 32 + mi * 16 + (lane & 15);
#pragma unroll
            for (int nj = 0; nj < 2; ++nj) { f32x4 g = acc[mi][nj], u = acc[mi][nj + 2], o;
#pragma unroll
                for (int e4 = 0; e4 < 4; ++e4) o[e4] = g[e4] / (1.f + __expf(-g[e4])) * u[e4];
                store4bf(p->hid + (size_t)sl * 256 + pg * 32 + nj * 16 + q4, o); } }
    }
}
__device__ __forceinline__ void phase_gemm_e2(ParamsC p, unsigned char* smem) {
    const int tid = ltid(), lane = tid & 63, wid = tid >> 6, wm = wid >> 1, wn = wid & 1, q4 = (lane >> 4) * 4;
    const int nb = p->nbu[0]; const int ntiles = nb * 2 * 8;
    for (int tile = lbid(); tile < ntiles; tile += gridDim.x) {
        const int rb = tile >> 3, tn = tile & 7, m0 = rb * 128, n0 = tn * 128, e = p->blk_e[rb >> 1];
        f32x4 acc[2][4]; zero_acc(acc);
        RowsLinear ar{p->hid + (size_t)m0 * 256, 256};
        gemm_core(smem, ar, p->wt_d + ((size_t)e * 1024 + n0) * 256, 256, 0, 256, acc);
#pragma unroll
        for (int mi = 0; mi < 2; ++mi) { const int sl = m0 + wm * 32 + mi * 16 + (lane & 15);
#pragma unroll
            for (int nj = 0; nj < 4; ++nj) store4bf(p->Y + (size_t)sl * 1024 + n0 + wn * 64 + nj * 16 + q4, acc[mi][nj]); }
    }
}


struct EpiIn { static constexpr bool PERM = true, AFTER_DRAIN = false, HOOK = false;
    bf16_t* uA; bf16_t* uG; const float* ropet;
    __device__ __forceinline__ void operator()(const f32x4 (&acc)[2][2][4][2], const pg8::Unit& u, int wr, int wc, int fr, int fq) const {
        const int row0 = u.pm * 256 + wr * 64 + fr; const bool latent = u.pm < 128;
#pragma unroll
        for (int bj = 0; bj < 2; ++bj) {
            const int cb32 = u.pn * 256 + bj * 128 + wc * 32, c0 = cb32 + 8 * fq;
            if (cb32 >= 2560) {
#pragma unroll
                for (int ai = 0; ai < 2; ++ai)
#pragma unroll
                    for (int m = 0; m < 4; ++m) { const int t = row0 + ai * 128 + m * 16; f32x4 v0 = acc[ai][bj][m][0], v1 = acc[ai][bj][m][1];
#pragma unroll
                        for (int e = 0; e < 4; ++e) { v0[e] = __builtin_amdgcn_rcpf(1.f + __expf(-v0[e])); v1[e] = __builtin_amdgcn_rcpf(1.f + __expf(-v1[e])); }
                        *(pg8::u32x4*)(uG + (size_t)t * UG_LD + (c0 - 2560)) = pack8(v0, v1); }
            } else {
                const bool isq = (cb32 >= 768 && cb32 < 1152) || (cb32 >= 1920 && cb32 < 2304);
                const bool rope = (cb32 >= 1920 && cb32 < 2432) && latent;
#pragma unroll
                for (int ai = 0; ai < 2; ++ai)
#pragma unroll
                    for (int m = 0; m < 4; ++m) { const int t = row0 + ai * 128 + m * 16; f32x4 v0 = acc[ai][bj][m][0], v1 = acc[ai][bj][m][1];
                        if (rope) { const int pos = t & 8191; const int posv = (wc & 1) ? (pos & 63) : (pos >> 6);
                            const float4* cs = (const float4*)(ropet + (posv * 16 + 8 * (fq & 1)) * 2);
                            const float4 c01 = cs[0], c23 = cs[1], c45 = cs[2], c67 = cs[3];
                            f32x4 p0, p1;
#pragma unroll
                            for (int e = 0; e < 4; ++e) { p0[e] = __shfl_xor(v0[e], 32); p1[e] = __shfl_xor(v1[e], 32); }
                            const float co0[4] = {c01.x, c01.z, c23.x, c23.z}, si0[4] = {c01.y, c01.w, c23.y, c23.w}, co1[4] = {c45.x, c45.z, c67.x, c67.z}, si1[4] = {c45.y, c45.w, c67.y, c67.w};
#pragma unroll
                            for (int e = 0; e < 4; ++e) {
                                if (fq < 2) { v0[e] = v0[e] * co0[e] - p0[e] * si0[e]; v1[e] = v1[e] * co1[e] - p1[e] * si1[e]; }
                                else { v0[e] = p0[e] * si0[e] + v0[e] * co0[e]; v1[e] = p1[e] * si1[e] + v1[e] * co1[e]; } } }
                        if (isq) { v0 = v0 * (0.125f * QLOG2E); v1 = v1 * (0.125f * QLOG2E); }
                        *(pg8::u32x4*)(uA + (size_t)t * UA_LD + c0) = pack8(v0, v1); }
            }
        }
    }
};

struct EpiMerge { static constexpr bool PERM = true, AFTER_DRAIN = false, HOOK = true;
    const bf16_t* uG; bf16_t* mo;
    __device__ __forceinline__ void hook(f32x4 (&acc)[2][2][4][2], const pg8::Unit& u, int t, int wr, int wc, int fr, int fq) const {
        int row0 = u.pm * 256 + wr * 64 + fr; asm volatile("" : "+v"(row0)); const int seg = (t == 2) ? 0 : 1;
        const bf16_t* gbase = uG + (size_t)row0 * UG_LD + seg * 1024 + u.pn * 256 + wc * 32 + 8 * fq;
#pragma unroll
        for (int ai = 0; ai < 2; ++ai) {
            pg8::u32x4 wn[4][2], wd[4][2];
#pragma unroll
            for (int m = 0; m < 4; ++m)
#pragma unroll
                for (int bj = 0; bj < 2; ++bj) { const bf16_t* gp = gbase + (size_t)(ai * 128 + m * 16) * UG_LD + bj * 128; wn[m][bj] = *(const pg8::u32x4*)gp; wd[m][bj] = *(const pg8::u32x4*)(gp + 1024); }
#pragma unroll
            for (int m = 0; m < 4; ++m)
#pragma unroll
                for (int bj = 0; bj < 2; ++bj) { f32x4 n0, n1, d0, d1; unpack8(wn[m][bj], n0, n1); unpack8(wd[m][bj], d0, d1);
#pragma unroll
                    for (int e = 0; e < 4; ++e) { acc[ai][bj][m][0][e] *= n0[e] * __builtin_amdgcn_rcpf(fmaxf(d0[e], 1e-20f)); acc[ai][bj][m][1][e] *= n1[e] * __builtin_amdgcn_rcpf(fmaxf(d1[e], 1e-20f)); } }
            asm volatile("" ::: "memory");
        }
    }
    __device__ __forceinline__ void operator()(const f32x4 (&acc)[2][2][4][2], const pg8::Unit& u, int wr, int wc, int fr, int fq) const {
        const int row0 = u.pm * 256 + wr * 64 + fr; const int c00 = u.pn * 256 + wc * 32 + 8 * fq;
#pragma unroll
        for (int ai = 0; ai < 2; ++ai) { pg8::u32x4 wg[4][2];
#pragma unroll
            for (int m = 0; m < 4; ++m)
#pragma unroll
                for (int bj = 0; bj < 2; ++bj) wg[m][bj] = *(const pg8::u32x4*)(uG + (size_t)(row0 + ai * 128 + m * 16) * UG_LD + 2048 + c00 + bj * 128);
#pragma unroll
            for (int m = 0; m < 4; ++m)
#pragma unroll
                for (int bj = 0; bj < 2; ++bj) { f32x4 g0, g1; unpack8(wg[m][bj], g0, g1); f32x4 v0 = acc[ai][bj][m][0], v1 = acc[ai][bj][m][1];
#pragma unroll
                    for (int e = 0; e < 4; ++e) { v0[e] *= fmaxf(g0[e], 1e-20f); v1[e] *= fmaxf(g1[e], 1e-20f); }
                    *(pg8::u32x4*)(mo + (size_t)(row0 + ai * 128 + m * 16) * 1024 + c00 + bj * 128) = pack8(v0, v1); }
            asm volatile("" ::: "memory"); }
    }
};

struct EpiO { static constexpr bool PERM = false, AFTER_DRAIN = false, HOOK = false;
    float* xs; const float* modv_l;
    __device__ __forceinline__ void operator()(const f32x4 (&acc)[2][2][4][2], const pg8::Unit& u, int wr, int wc, int fr, int fq) const {
        const int row0 = u.pm * 256 + wr * 64 + fr; const int v = u.pm < 128 ? (u.pm >> 5) : 4; const float* gt = modv_l + (size_t)v * 6144 + 2048;
        const int col0 = u.pn * 256 + wc * 32 + 4 * fq;
        f32x4 gv[2][2];
#pragma unroll
        for (int bj = 0; bj < 2; ++bj)
#pragma unroll
            for (int n = 0; n < 2; ++n) gv[bj][n] = *(const f32x4*)(gt + col0 + bj * 128 + n * 16);
#pragma unroll
        for (int ai = 0; ai < 2; ++ai)
#pragma unroll
            for (int mp = 0; mp < 2; ++mp) { f32x4 xv[2][2][2];
#pragma unroll
                for (int mm = 0; mm < 2; ++mm)
#pragma unroll
                    for (int bj = 0; bj < 2; ++bj)
#pragma unroll
                        for (int n = 0; n < 2; ++n) xv[mm][bj][n] = *(const f32x4*)(xs + (size_t)(row0 + ai * 128 + (mp * 2 + mm) * 16) * 1024 + col0 + bj * 128 + n * 16);
#pragma unroll
                for (int mm = 0; mm < 2; ++mm)
#pragma unroll
                    for (int bj = 0; bj < 2; ++bj)
#pragma unroll
                        for (int n = 0; n < 2; ++n) *(f32x4*)(xs + (size_t)(row0 + ai * 128 + (mp * 2 + mm) * 16) * 1024 + col0 + bj * 128 + n * 16) = xv[mm][bj][n] + gv[bj][n] * acc[ai][bj][mp * 2 + mm][n];
                asm volatile("" ::: "memory"); }
    }
};

struct EpiE1 { static constexpr bool PERM = true, AFTER_DRAIN = false, HOOK = false;
    bf16_t* hid;
    __device__ __forceinline__ void operator()(const f32x4 (&acc)[2][2][4][2], const pg8::Unit& u, int wr, int wc, int fr, int fq) const {
        const int row0 = u.pm * 256 + wr * 64 + fr; const int c0 = (u.pn & 1) * 128 + wc * 32 + 8 * fq;
#pragma unroll
        for (int ai = 0; ai < 2; ++ai)
#pragma unroll
            for (int m = 0; m < 4; ++m) { f32x4 o0, o1;
#pragma unroll
                for (int e = 0; e < 4; ++e) { const float g0 = acc[ai][0][m][0][e], g1 = acc[ai][0][m][1][e];
                    o0[e] = g0 * __builtin_amdgcn_rcpf(1.f + __expf(-g0)) * acc[ai][1][m][0][e]; o1[e] = g1 * __builtin_amdgcn_rcpf(1.f + __expf(-g1)) * acc[ai][1][m][1][e]; }
                *(pg8::u32x4*)(hid + (size_t)(row0 + ai * 128 + m * 16) * 256 + c0) = pack8(o0, o1); }
    }
};

struct EpiE2 { static constexpr bool PERM = true, AFTER_DRAIN = false, HOOK = false;
    bf16_t* Y;
    __device__ __forceinline__ void operator()(const f32x4 (&acc)[2][2][4][2], const pg8::Unit& u, int wr, int wc, int fr, int fq) const {
        const int row0 = u.pm * 256 + wr * 64 + fr; const int c0 = (u.pn & 3) * 256 + wc * 32 + 8 * fq;
#pragma unroll
        for (int ai = 0; ai < 2; ++ai)
#pragma unroll
            for (int m = 0; m < 4; ++m)
#pragma unroll
                for (int bj = 0; bj < 2; ++bj) *(pg8::u32x4*)(Y + (size_t)(row0 + ai * 128 + m * 16) * 1024 + c0 + bj * 128) = pack8(acc[ai][bj][m][0], acc[ai][bj][m][1]);
    }
};

__device__ __forceinline__ void phase_pg_in(ParamsC p, int l, unsigned char* smem) {
    pg8::Gemm g{p->h, p->wt_in, T_ALL, IN_COLS, 1024, nullptr}; pg8::StaticOrder S; S.init(T_ALL, IN_COLS, (int)gridDim.x, lbid());
    EpiIn E{p->uA, p->uG, p->ropet};
    pg8::gemm_phase<EpiIn, pg8::StaticOrder, true, true>((PG8_LAS unsigned char*)smem, g, S, E);
}
__device__ __forceinline__ void phase_pg_merge(ParamsC p, int l, unsigned char* smem) {
    const int M = (l < DEPTH - 1) ? T_ALL : T_LAT;
    pg8::Gemm g{p->ycat, p->wt_br, M, 1024, 1024, nullptr}; pg8::StaticOrder S; S.init(M, 1024, (int)gridDim.x, lbid());
    EpiMerge E{p->uG, p->mbuf};
    pg8::gemm_phase<EpiMerge, pg8::StaticOrder, true, true>((PG8_LAS unsigned char*)smem, g, S, E);
}
__device__ __forceinline__ void phase_pg_o(ParamsC p, int l, unsigned char* smem) {
    const int M = (l < DEPTH - 1) ? T_ALL : T_LAT;
    pg8::Gemm g{p->mbuf, p->wt_o, M, 1024, 1024, nullptr}; pg8::StaticOrder S; S.init(M, 1024, (int)gridDim.x, lbid());
    EpiO E{p->xs, p->modv + (size_t)l * 5 * 6144};
    pg8::gemm_phase<EpiO, pg8::StaticOrder, true, true>((PG8_LAS unsigned char*)smem, g, S, E);
}
__device__ __forceinline__ void phase_pg_e1(ParamsC p, unsigned char* smem) {
    const int nb = p->nbu[0];
    pg8::Gemm g{p->h, p->wt_gu, nb * 256, 512, 1024, p->tokmap}; pg8::GroupedOrder<2> S{p->blk_e, nb * 2, (int)gridDim.x, lbid()};
    EpiE1 E{p->hid};
    pg8::gemm_phase<EpiE1, pg8::GroupedOrder<2>, true, true, true>((PG8_LAS unsigned char*)smem, g, S, E);
}
__device__ __forceinline__ void phase_pg_e2(ParamsC p, unsigned char* smem) {
    const int nb = p->nbu[0];
    pg8::Gemm g{p->hid, p->wt_d, nb * 256, 1024, 256, nullptr}; pg8::GroupedOrder<4> S{p->blk_e, nb * 4, (int)gridDim.x, lbid()};
    EpiE2 E{p->Y};
    pg8::gemm_phase<EpiE2, pg8::GroupedOrder<4>, true, true>((PG8_LAS unsigned char*)smem, g, S, E);
}

#define XB_TMO      128
#define XB_XCNT(j)  (256  + 64 * (j))
#define XB_XSUB(j)  (1280 + 64 * (j))
#define XB_XGEN(j)  (2304 + 64 * (j))
#define XB_TOP      3328
#define XB_TOPGEN   3392
#define XCD_BAR_WORDS 3456
#define XB_SPIN_CAP (1u << 18)
__device__ __forceinline__ unsigned xb_ld(unsigned* p)              { return __hip_atomic_load(p, __ATOMIC_RELAXED, __HIP_MEMORY_SCOPE_AGENT); }
__device__ __forceinline__ unsigned xb_add(unsigned* p, unsigned v) { return __hip_atomic_fetch_add(p, v, __ATOMIC_RELAXED, __HIP_MEMORY_SCOPE_AGENT); }
__device__ __forceinline__ unsigned xb_xcc_id() { return (unsigned)__builtin_amdgcn_s_getreg((3 << 11) | 20) & 0xFu; }
#define XB_SPIN(cond, bar) do { unsigned _sp = 0; while (cond) { __builtin_amdgcn_s_sleep(1); \
    if ((++_sp & 255u) == 0u) { if (xb_ld(&(bar)[XB_TMO])) break; if (_sp > XB_SPIN_CAP) { atomicAdd(&(bar)[XB_TMO], 1u); break; } } } } while (0)
struct XcdBarrier { unsigned* bar; unsigned x; volatile LAS unsigned* st; };
__device__ __forceinline__ XcdBarrier xcd_barrier_post(unsigned* bar, volatile LAS unsigned* st) {
    XcdBarrier b; b.bar = bar; b.x = xb_xcc_id(); b.st = st;
    if (threadIdx.x == 0) (void)xb_add(&bar[XB_XCNT(b.x)], 1u);
    return b;
}
__device__ __forceinline__ void xcd_barrier_complete(unsigned* bar, unsigned x, unsigned& nloc, unsigned& nx) {
    const unsigned G = gridDim.x * gridDim.y * gridDim.z;
    unsigned sum, cnt, mine, sp = 0u;
    for (;;) {
        sum = 0u; cnt = 0u; mine = 0u;
#pragma unroll
        for (unsigned j = 0; j < 16; ++j) { const unsigned c = xb_ld(&bar[XB_XCNT(j)]); sum += c; cnt += (c > 0u) ? 1u : 0u; mine = (j == x) ? c : mine; }
        if (sum == G) break;
        __builtin_amdgcn_s_sleep(1);
        if ((++sp & 255u) == 0u) { if (xb_ld(&bar[XB_TMO])) break; if (sp > XB_SPIN_CAP) { atomicAdd(&bar[XB_TMO], 1u); break; } }
    }
    nloc = mine > 0u ? mine : 1u; nx = cnt > 0u ? cnt : 1u;
}
__device__ __forceinline__ void xcd_barrier(const XcdBarrier& b) {
    asm volatile("s_waitcnt vmcnt(0)" ::: "memory");
    __syncthreads();
    if (threadIdx.x == 0) {
        unsigned* bar = b.bar;
        __builtin_amdgcn_s_waitcnt(0);
        unsigned nloc = b.st[0], nx = b.st[1];
        if (nloc == 0u) { xcd_barrier_complete(bar, b.x, nloc, nx); b.st[0] = nloc; b.st[1] = nx; }
        const unsigned old = xb_add(&bar[XB_XSUB(b.x)], 1u);
        const unsigned gen = old / nloc;
        if (old + 1u == (gen + 1u) * nloc) {
            __builtin_amdgcn_fence(__ATOMIC_RELEASE, "agent");
            asm volatile("s_waitcnt vmcnt(0)" ::: "memory");
            const unsigned og = xb_add(&bar[XB_TOP], 1u);
            const unsigned tg = og / nx;
            if (og + 1u == (tg + 1u) * nx) xb_add(&bar[XB_TOPGEN], 1u);
            else XB_SPIN(xb_ld(&bar[XB_TOPGEN]) == tg, bar);
            __builtin_amdgcn_fence(__ATOMIC_ACQUIRE, "agent");
            xb_add(&bar[XB_XGEN(b.x)], 1u);
            asm volatile("s_waitcnt vmcnt(0)" ::: "memory");
        } else {
            XB_SPIN(xb_ld(&bar[XB_XGEN(b.x)]) == gen, bar);
            __builtin_amdgcn_fence(__ATOMIC_ACQUIRE, "agent");
            asm volatile("s_waitcnt vmcnt(0)" ::: "memory");
        }
    }
    __syncthreads();
}

#define SMEM_BYTES 131072
#ifndef PROBE_MASK
#define PROBE_MASK 0
#endif
#define PROBE_MULT 4
#define PH_BEGIN(id) do { if (PROBE_MASK & (1 << (id))) t0 = wall_clock64(); } while (0)
#define PH_END(id) do { if (PROBE_MASK & (1 << (id))) tacc += wall_clock64() - t0; } while (0)
__global__ void __launch_bounds__(NTHR, 2) k_mega(Params p_unused) {
    const ParamsC pk = (ParamsC)__builtin_amdgcn_kernarg_segment_ptr();
#define PP() ({ ParamsC q_ = pk; asm volatile("" : "+s"(q_)); q_; })
    extern __shared__ __attribute__((aligned(16))) unsigned char smem[];
    volatile LAS unsigned* xbw = (volatile LAS unsigned*)(smem + SMEM_BYTES);
    if (threadIdx.x == 0) { xbw[0] = 0u; xbw[1] = 0u; xbw[2] = 0u; xbw[3] = 0u; }
    __syncthreads();
    (void)xcd_barrier_post(PP()->bar, xbw);
    unsigned long long tacc = 0, t0 = 0;
#define GRID_BAR() do { XcdBarrier bar_; bar_.bar = PP()->bar; bar_.x = xb_xcc_id(); bar_.st = xbw; xcd_barrier(bar_); } while (0)
    PH_BEGIN(0); phase_mod(PP(), (float*)smem); GRID_BAR(); PH_END(0);
    for (int l = 0; l < DEPTH; ++l) {
        PH_BEGIN(1); phase_norm1(PP(), l); phase_wconv(PP(), l, (float*)smem); GRID_BAR(); PH_END(1);
        PH_BEGIN(2); phase_pg_in(PP(), l, smem); GRID_BAR(); PH_END(2);
        PH_BEGIN(3); phase_mix2(PP(), l, smem); GRID_BAR(); PH_END(3);
        PH_BEGIN(4); phase_pg_merge(PP(), l, smem); GRID_BAR(); PH_END(4);
        PH_BEGIN(5); phase_pg_o(PP(), l, smem); GRID_BAR(); PH_END(5);
        PH_BEGIN(6); phase_router(PP(), l, (float*)smem); GRID_BAR(); PH_END(6);
        PH_BEGIN(7); phase_dispatch(PP(), l, (int*)smem); GRID_BAR(); PH_END(7);
        PH_BEGIN(8); phase_pg_e1(PP(), smem); GRID_BAR(); PH_END(8);
        PH_BEGIN(9); phase_pg_e2(PP(), smem); GRID_BAR(); PH_END(9);
    }
    PH_BEGIN(10); phase_norm1(PP(), DEPTH); PH_END(10);
    if (PROBE_MASK != 0 && blockIdx.x == 0) { const unsigned long long te = wall_clock64(); while (wall_clock64() - te < tacc * PROBE_MULT) __builtin_amdgcn_s_sleep(8); }
}

extern "C" void kernel_launch(void* const* d_in, const int* in_sizes, int n_in, void* d_out, int out_size, void* d_ws, size_t ws_size, hipStream_t stream) {
    Params p{};
    p.x = (const float*)d_in[0]; p.c = (const float*)d_in[1]; p.ctx = (const float*)d_in[2]; p.c_ctx = (const float*)d_in[3]; p.w_mod = (const float*)d_in[4]; p.b_mod = (const float*)d_in[5];
    p.g_attn = (const float*)d_in[6]; p.g_ffn = (const float*)d_in[7]; p.w_in = (const float*)d_in[8]; p.conv_w = (const float*)d_in[9]; p.rpb = (const float*)d_in[10]; p.sinks = (const float*)d_in[11];
    p.w_branch = (const float*)d_in[12]; p.w_o = (const float*)d_in[13]; p.w_rg = (const float*)d_in[14]; p.b_rg = (const float*)d_in[15]; p.w_re = (const float*)d_in[16]; p.b_re = (const float*)d_in[17];
    p.w_eg = (const float*)d_in[18]; p.w_eu = (const float*)d_in[19]; p.w_ed = (const float*)d_in[20]; p.g_final = (const float*)d_in[21];
    p.out = (float*)d_out;
    unsigned char* w = (unsigned char*)d_ws; size_t off = 0;
    auto take = [&](size_t bytes) { unsigned char* r = w + off; off += (bytes + 255) & ~(size_t)255; return r; };
    p.bar = (unsigned*)take(16384); p.cnt = (int*)take(1024 * 32 * 4); p.blk_e = (int*)take(MAXBLK * 4); p.nbu = (int*)take(256);
    p.modv = (float*)take((size_t)DEPTH * 5 * 6144 * 4); p.ropet = (float*)take(128 * 16 * 2 * 4);
    p.eid = (int*)take((size_t)T_ALL * 2 * 4); p.epos = (int*)take((size_t)T_ALL * 2 * 4); p.ewt = (float*)take((size_t)T_ALL * 2 * 4); p.slot = (int*)take((size_t)T_ALL * 2 * 4); p.tokmap = (int*)take((size_t)MAXBLK * 256 * 4); p.pad_ = nullptr;
    p.xs = (float*)take((size_t)T_ALL * 1024 * 4);
    p.h = (bf16_t*)take((size_t)T_ALL * 1024 * 2);
    p.wt_in = (bf16_t*)take((size_t)IN_COLS * 1024 * 2); p.wt_br = (bf16_t*)take((size_t)1024 * 1024 * 2); p.wt_o = (bf16_t*)take((size_t)1024 * 1024 * 2);
    p.wt_gu = (bf16_t*)take((size_t)32 * 512 * 1024 * 2); p.wt_d = (bf16_t*)take((size_t)32 * 1024 * 256 * 2);
    p.uA = (bf16_t*)take((size_t)T_ALL * UA_LD * 2); p.uG = (bf16_t*)take((size_t)T_ALL * UG_LD * 2); p.ycat = (bf16_t*)take((size_t)T_ALL * 1024 * 2);
    p.mbuf = p.uA; p.xd = p.uA; p.hid = p.ycat; p.Y = p.uG;
    if (off > ws_size) return;
    constexpr size_t kDynLds = SMEM_BYTES + 16;
    static int grid = 0;
    if (!grid) {
        (void)hipFuncSetAttribute((const void*)k_mega, hipFuncAttributeMaxDynamicSharedMemorySize, (int)kDynLds);
        int dev = 0, cus = 0, per_cu = 0;
        (void)hipGetDevice(&dev);
        (void)hipDeviceGetAttribute(&cus, hipDeviceAttributeMultiprocessorCount, dev);
        (void)hipOccupancyMaxActiveBlocksPerMultiprocessor(&per_cu, (const void*)k_mega, NTHR, kDynLds);
        grid = cus * (per_cu < 1 ? per_cu : 1);
        if (grid <= 0) grid = 0;
    }
    if (!grid) return;
    (void)hipMemsetAsync(p.bar, 0, XCD_BAR_WORDS * sizeof(unsigned), stream);
    hipLaunchKernelGGL(k_mega, dim3(grid), dim3(NTHR), kDynLds, stream, p);
}
```

```cpp
#include <hip/hip_runtime.h>
#include <stdint.h>

typedef unsigned short bf16_t;
typedef short bf16x8 __attribute__((ext_vector_type(8)));
typedef float f32x4 __attribute__((ext_vector_type(4)));

#define D_MODEL 1024
#define NB 4
#define SEQ 8192
#define DEPTH 4
#define CTXL 256
#define T_LAT 32768
#define T_CTX 1024
#define T_ALL 33792
#define UA_LD 2560
#define UG_LD 3072
#define IN_COLS 5632
#define MAXBLK 296
#define NTHR 512
#define QLOG2E 1.4426950408889634f
#ifndef PGM
#define PGM 31
#endif
#define LAS __attribute__((address_space(3)))

struct Params {
    const float *x, *c, *ctx, *c_ctx, *w_mod, *b_mod, *g_attn, *g_ffn, *w_in, *conv_w, *rpb, *sinks, *w_branch, *w_o, *w_rg, *b_rg, *w_re, *b_re, *w_eg, *w_eu, *w_ed, *g_final;
    float* out;
    unsigned* bar; int* cnt; int* blk_e; int* nbu;
    float* modv; float* ropet; float* xs;
    bf16_t *h, *wt_in, *wt_br, *wt_o, *wt_gu, *wt_d, *uA, *uG, *ycat, *mbuf, *xd, *hid, *Y;
    int* eid; int* epos; float* ewt; int* slot; int* tokmap;
    bf16_t *wt_in1, *wt_br1, *wt_o1, *wt_gu1, *wt_d1;
};
typedef const __attribute__((address_space(4))) Params* ParamsC;
#define WSEL(X, l) (((l) & 1) ? p->X##1 : p->X)

__device__ __forceinline__ int lbid() { int b = blockIdx.x; asm volatile("" : "+s"(b) :: "memory"); return b; }
__device__ __forceinline__ int ltid() { int t = threadIdx.x; asm volatile("" : "+v"(t) :: "memory"); return t; }
__device__ __forceinline__ bf16_t f2bf(float f) { unsigned u = __float_as_uint(f); u += 0x7FFFu + ((u >> 16) & 1u); return (bf16_t)(u >> 16); }
__device__ __forceinline__ float bf2f(bf16_t b) { return __uint_as_float(((unsigned)b) << 16); }
typedef float f32x2_t __attribute__((ext_vector_type(2)));
typedef __bf16 bf16x2_t __attribute__((ext_vector_type(2)));
__device__ __forceinline__ unsigned pack2(float a, float b) { const f32x2_t v = {a, b}; const bf16x2_t r = __builtin_convertvector(v, bf16x2_t); return __builtin_bit_cast(unsigned, r); }
__device__ __forceinline__ float wave_sum(float v) { for (int o = 32; o > 0; o >>= 1) v += __shfl_xor(v, o); return v; }
__device__ __forceinline__ float wave_max(float v) { for (int o = 32; o > 0; o >>= 1) v = fmaxf(v, __shfl_xor(v, o)); return v; }
__device__ __forceinline__ int tok_variant(int t) { return t < T_LAT ? (t >> 13) : 4; }

__device__ __forceinline__ void phase_mod(ParamsC p, float* smem) {
    const int tid = ltid(), lane = tid & 63, wid = tid >> 6;
    float* s_silu = smem;
    float* s_part = smem + 5 * 1024;
    for (int i = tid; i < 5 * 1024; i += NTHR) { const int v = i >> 10, k = i & 1023; const float cv = v < 4 ? p->c[v * 1024 + k] : p->c_ctx[k]; s_silu[i] = cv / (1.0f + expf(-cv)); }
    __syncthreads();
    for (int item = lbid(); item < DEPTH * 96; item += gridDim.x) {
        const int l = item / 96, cb = item % 96, col = cb * 64 + lane;
        const float* w = p->w_mod + (size_t)l * 1024 * 6144 + col;
        float a0 = 0.f, a1 = 0.f, a2 = 0.f, a3 = 0.f, a4 = 0.f;
#pragma unroll 8
        for (int kk = 0; kk < 128; ++kk) { const int k = wid * 128 + kk; const float wv = w[(size_t)k * 6144];
            a0 += s_silu[k] * wv; a1 += s_silu[1024 + k] * wv; a2 += s_silu[2048 + k] * wv; a3 += s_silu[3072 + k] * wv; a4 += s_silu[4096 + k] * wv; }
        s_part[(wid * 5 + 0) * 64 + lane] = a0; s_part[(wid * 5 + 1) * 64 + lane] = a1; s_part[(wid * 5 + 2) * 64 + lane] = a2; s_part[(wid * 5 + 3) * 64 + lane] = a3; s_part[(wid * 5 + 4) * 64 + lane] = a4;
        __syncthreads();
        if (tid < 320) { const int v = tid >> 6, ln = tid & 63; float s = p->b_mod[l * 6144 + cb * 64 + ln];
            for (int w8 = 0; w8 < 8; ++w8) s += s_part[(w8 * 5 + v) * 64 + ln];
            p->modv[(size_t)(l * 5 + v) * 6144 + cb * 64 + ln] = s; }
        __syncthreads();
    }
    if (lbid() < 4) { const int i = lbid() * NTHR + tid; const int pos = i >> 4, f = i & 15;
        const float inv = powf(10000.0f, -(float)f / 16.0f); const float ang = (float)pos * inv; p->ropet[i * 2] = cosf(ang); p->ropet[i * 2 + 1] = sinf(ang); }
}

#define GU_IG 128
struct WcTile { const float* src; bf16_t* dst; int ldN, ldK, kt, nt, kind, e; };
__device__ __forceinline__ WcTile wconv_decode(ParamsC p, int l, int it) {
    const int n1 = 16 * 88, n2 = 256, n3 = 256, n4 = 2048, n5 = 2048;
    WcTile w; w.kind = 0; w.e = 0; int i = it;
    if (i < n1) { w.src = p->w_in + (size_t)l * 1024 * IN_COLS; w.ldN = IN_COLS; w.dst = WSEL(wt_in, l); w.ldK = 1024; w.kt = i / 88; w.nt = i % 88; }
    else if ((i -= n1) < n2) { w.src = p->w_branch + (size_t)l * 1024 * 1024; w.ldN = 1024; w.dst = WSEL(wt_br, l); w.ldK = 1024; w.kt = i / 16; w.nt = i % 16; }
    else if ((i -= n2) < n3) { w.src = p->w_o + (size_t)l * 1024 * 1024; w.ldN = 1024; w.dst = WSEL(wt_o, l); w.ldK = 1024; w.kt = i / 16; w.nt = i % 16; }
    else if ((i -= n3) < n4) { w.e = i / 64; i %= 64; w.src = p->w_eg + ((size_t)l * 32 + w.e) * 1024 * 256; w.ldN = 256; w.dst = WSEL(wt_gu, l); w.ldK = 1024; w.kt = i / 4; w.nt = i % 4; w.kind = 1; }
    else if ((i -= n4) < n5) { w.e = i / 64; i %= 64; w.src = p->w_eu + ((size_t)l * 32 + w.e) * 1024 * 256; w.ldN = 256; w.dst = WSEL(wt_gu, l); w.ldK = 1024; w.kt = i / 4; w.nt = i % 4; w.kind = 2; }
    else { i -= n5; w.e = i / 64; i %= 64; w.src = p->w_ed + ((size_t)l * 32 + w.e) * 256 * 1024; w.ldN = 1024; w.dst = WSEL(wt_d, l) + (size_t)w.e * 1024 * 256; w.ldK = 256; w.kt = i / 16; w.nt = i % 16; }
    return w;
}
#define WC_TOTAL (16 * 88 + 256 + 256 + 2048 * 3)
__device__ __forceinline__ void phase_wconv(ParamsC p, int l, float* smem, int lo, int hi, int first, int stride) {
    const int tid = ltid();
    float* tile = smem;
    const int r = tid >> 4, c4 = tid & 15;
    int it = lo + first; if (it >= hi) return;
    WcTile w = wconv_decode(p, l, it);
    float4 v0 = *(const float4*)(w.src + (size_t)(w.kt * 64 + r) * w.ldN + w.nt * 64 + c4 * 4), v1 = *(const float4*)(w.src + (size_t)(w.kt * 64 + r + 32) * w.ldN + w.nt * 64 + c4 * 4);
    for (;;) {
        tile[r * 65 + c4 * 4 + 0] = v0.x; tile[r * 65 + c4 * 4 + 1] = v0.y; tile[r * 65 + c4 * 4 + 2] = v0.z; tile[r * 65 + c4 * 4 + 3] = v0.w;
        tile[(r + 32) * 65 + c4 * 4 + 0] = v1.x; tile[(r + 32) * 65 + c4 * 4 + 1] = v1.y; tile[(r + 32) * 65 + c4 * 4 + 2] = v1.z; tile[(r + 32) * 65 + c4 * 4 + 3] = v1.w;
        __syncthreads();
        const int nit = it + stride; WcTile wn = w;
        if (nit < hi) { wn = wconv_decode(p, l, nit);
            v0 = *(const float4*)(wn.src + (size_t)(wn.kt * 64 + r) * wn.ldN + wn.nt * 64 + c4 * 4); v1 = *(const float4*)(wn.src + (size_t)(wn.kt * 64 + r + 32) * wn.ldN + wn.nt * 64 + c4 * 4); }
        {   const int n = tid >> 3, kc = tid & 7; const int ncol = w.nt * 64 + n; int drow = ncol;
            if (w.kind) drow = w.e * 512 + (ncol / GU_IG) * (2 * GU_IG) + (w.kind == 2 ? GU_IG : 0) + (ncol % GU_IG);
            uint4 o; o.x = pack2(tile[(kc * 8 + 0) * 65 + n], tile[(kc * 8 + 1) * 65 + n]); o.y = pack2(tile[(kc * 8 + 2) * 65 + n], tile[(kc * 8 + 3) * 65 + n]);
            o.z = pack2(tile[(kc * 8 + 4) * 65 + n], tile[(kc * 8 + 5) * 65 + n]); o.w = pack2(tile[(kc * 8 + 6) * 65 + n], tile[(kc * 8 + 7) * 65 + n]);
            *(uint4*)(w.dst + (size_t)drow * w.ldK + w.kt * 64 + kc * 8) = o; }
        __syncthreads();
        if (nit >= hi) break;
        it = nit; w = wn;
    }
}

__device__ __forceinline__ void phase_norm1(ParamsC p, int l) {
    const int tid = ltid(), lane = tid & 63, wid = tid >> 6;
    const int ntok = (l == DEPTH) ? T_LAT : T_ALL;
    for (int t = lbid() * 8 + wid; t < ntok; t += gridDim.x * 8) {
        const int v = tok_variant(t);
        float4 xv[4];
        if (l == 0) {
            const float* src = t < T_LAT ? p->x + (size_t)t * 1024 : p->ctx + (size_t)(t - T_LAT) * 1024;
#pragma unroll
            for (int i = 0; i < 4; ++i) xv[i] = *(const float4*)(src + i * 256 + lane * 4);
        } else {
            const float* src = p->xs + (size_t)t * 1024;
#pragma unroll
            for (int i = 0; i < 4; ++i) xv[i] = *(const float4*)(src + i * 256 + lane * 4);
            const bool had_moe = (l - 1 < DEPTH - 1) || t < T_LAT;
            if (had_moe) {
                const int s0 = p->slot[t * 2], s1 = p->slot[t * 2 + 1]; const float w0 = p->ewt[t * 2], w1 = p->ewt[t * 2 + 1];
                const float* gt = p->modv + (size_t)((l - 1) * 5 + v) * 6144 + 5120;
#pragma unroll
                for (int i = 0; i < 4; ++i) { const int c = i * 256 + lane * 4;
                    const uint2 y0 = *(const uint2*)(p->Y + (size_t)s0 * 1024 + c), y1 = *(const uint2*)(p->Y + (size_t)s1 * 1024 + c);
                    const float4 g = *(const float4*)(gt + c);
                    xv[i].x += g.x * (w0 * bf2f((bf16_t)(y0.x & 0xffff)) + w1 * bf2f((bf16_t)(y1.x & 0xffff)));
                    xv[i].y += g.y * (w0 * bf2f((bf16_t)(y0.x >> 16)) + w1 * bf2f((bf16_t)(y1.x >> 16)));
                    xv[i].z += g.z * (w0 * bf2f((bf16_t)(y0.y & 0xffff)) + w1 * bf2f((bf16_t)(y1.y & 0xffff)));
                    xv[i].w += g.w * (w0 * bf2f((bf16_t)(y0.y >> 16)) + w1 * bf2f((bf16_t)(y1.y >> 16))); }
            }
        }
        float ss = 0.f;
#pragma unroll
        for (int i = 0; i < 4; ++i) ss += xv[i].x * xv[i].x + xv[i].y * xv[i].y + xv[i].z * xv[i].z + xv[i].w * xv[i].w;
        ss = wave_sum(ss);
        const float rstd = rsqrtf(ss * (1.0f / 1024.0f) + 1e-6f);
        if (l == DEPTH) {
#pragma unroll
            for (int i = 0; i < 4; ++i) { const int c = i * 256 + lane * 4; const float4 g = *(const float4*)(p->g_final + c);
                float4 o; o.x = xv[i].x * rstd * g.x; o.y = xv[i].y * rstd * g.y; o.z = xv[i].z * rstd * g.z; o.w = xv[i].w * rstd * g.w;
                *(float4*)(p->out + (size_t)t * 1024 + c) = o; }
        } else {
            const float* mv = p->modv + (size_t)(l * 5 + v) * 6144;
#pragma unroll
            for (int i = 0; i < 4; ++i) { const int c = i * 256 + lane * 4;
                *(float4*)(p->xs + (size_t)t * 1024 + c) = xv[i];
                const float4 g = *(const float4*)(p->g_attn + l * 1024 + c), sh = *(const float4*)(mv + c), sc = *(const float4*)(mv + 1024 + c);
                uint2 o; o.x = pack2(xv[i].x * rstd * g.x * (1.f + sc.x) + sh.x, xv[i].y * rstd * g.y * (1.f + sc.y) + sh.y);
                o.y = pack2(xv[i].z * rstd * g.z * (1.f + sc.z) + sh.z, xv[i].w * rstd * g.w * (1.f + sc.w) + sh.w);
                *(uint2*)(p->h + (size_t)t * 1024 + c) = o; }
        }
    }
}

#define SG_STRIDE 144
#define SG_BOFF (128 * SG_STRIDE)
struct RowsLinear { const bf16_t* base; size_t ld; __device__ __forceinline__ const bf16_t* operator()(int r) const { return base + (size_t)r * ld; } };
template <class ARow>
__device__ __forceinline__ void gemm_core(unsigned char* smem, const ARow& arow, const bf16_t* Bt, size_t ldb, int k0, int k1, f32x4 (&acc)[2][4]) {
    const int tid = ltid(), lane = tid & 63, wid = tid >> 6, wm = wid >> 1, wn = wid & 1;
    const int row0 = tid >> 3, kc = tid & 7;
    const bf16_t* pa0 = arow(row0) + kc * 8; const bf16_t* pa1 = arow(row0 + 64) + kc * 8;
    const bf16_t* pb0 = Bt + (size_t)row0 * ldb + kc * 8; const bf16_t* pb1 = Bt + (size_t)(row0 + 64) * ldb + kc * 8;
    const int soff0 = row0 * SG_STRIDE + kc * 16, soff1 = soff0 + 64 * SG_STRIDE;
    uint4 ra0 = *(const uint4*)(pa0 + k0), ra1 = *(const uint4*)(pa1 + k0), rb0 = *(const uint4*)(pb0 + k0), rb1 = *(const uint4*)(pb1 + k0);
    const int fa = (wm * 32 + (lane & 15)) * SG_STRIDE + (lane >> 4) * 16, fb = SG_BOFF + (wn * 64 + (lane & 15)) * SG_STRIDE + (lane >> 4) * 16;
    for (int k = k0; k < k1; k += 64) {
        __syncthreads();
        *(uint4*)(smem + soff0) = ra0; *(uint4*)(smem + soff1) = ra1; *(uint4*)(smem + SG_BOFF + soff0) = rb0; *(uint4*)(smem + SG_BOFF + soff1) = rb1;
        __syncthreads();
        if (k + 64 < k1) { ra0 = *(const uint4*)(pa0 + k + 64); ra1 = *(const uint4*)(pa1 + k + 64); rb0 = *(const uint4*)(pb0 + k + 64); rb1 = *(const uint4*)(pb1 + k + 64); }
#pragma unroll
        for (int ks = 0; ks < 2; ++ks) {
            const bf16x8 af0 = *(const bf16x8*)(smem + fa + ks * 64), af1 = *(const bf16x8*)(smem + fa + 16 * SG_STRIDE + ks * 64);
            const bf16x8 b0 = *(const bf16x8*)(smem + fb + ks * 64), b1 = *(const bf16x8*)(smem + fb + 16 * SG_STRIDE + ks * 64);
            const bf16x8 b2 = *(const bf16x8*)(smem + fb + 32 * SG_STRIDE + ks * 64), b3 = *(const bf16x8*)(smem + fb + 48 * SG_STRIDE + ks * 64);
            acc[0][0] = __builtin_amdgcn_mfma_f32_16x16x32_bf16(b0, af0, acc[0][0], 0, 0, 0); acc[0][1] = __builtin_amdgcn_mfma_f32_16x16x32_bf16(b1, af0, acc[0][1], 0, 0, 0);
            acc[0][2] = __builtin_amdgcn_mfma_f32_16x16x32_bf16(b2, af0, acc[0][2], 0, 0, 0); acc[0][3] = __builtin_amdgcn_mfma_f32_16x16x32_bf16(b3, af0, acc[0][3], 0, 0, 0);
            acc[1][0] = __builtin_amdgcn_mfma_f32_16x16x32_bf16(b0, af1, acc[1][0], 0, 0, 0); acc[1][1] = __builtin_amdgcn_mfma_f32_16x16x32_bf16(b1, af1, acc[1][1], 0, 0, 0);
            acc[1][2] = __builtin_amdgcn_mfma_f32_16x16x32_bf16(b2, af1, acc[1][2], 0, 0, 0); acc[1][3] = __builtin_amdgcn_mfma_f32_16x16x32_bf16(b3, af1, acc[1][3], 0, 0, 0);
        }
    }
}
__device__ __forceinline__ void zero_acc(f32x4 (&acc)[2][4]) {
#pragma unroll
    for (int a = 0; a < 2; ++a)
#pragma unroll
        for (int b = 0; b < 4; ++b) acc[a][b] = (f32x4){0.f, 0.f, 0.f, 0.f};
}
__device__ __forceinline__ void store4bf(bf16_t* dst, f32x4 v) { uint2 o; o.x = pack2(v[0], v[1]); o.y = pack2(v[2], v[3]); *(uint2*)dst = o; }


namespace pg8 {
#define PG8_LAS __attribute__((address_space(3)))
typedef unsigned u32x4 __attribute__((ext_vector_type(4)));
constexpr int BM = 256, BK = 64, HALF = 128, HTB = HALF * BK * 2, STAGE_BYTES = 8 * HTB, NXCD = 8, WGM = 8;
__host__ __device__ __forceinline__ int lds_byte(int r, int c) { const int st = (r >> 4) * 2 + (c >> 5), rr = r & 15, cc = c & 31, ob = rr * 64 + cc * 2; return st * 1024 + (ob ^ (((ob >> 9) & 1) << 5)); }
__host__ __device__ __forceinline__ void stage_rc(int b, int& R, int& C) { const int st = b / 1024, sb = b % 1024, swz = sb ^ (((sb >> 9) & 1) << 5); R = (st >> 1) * 16 + swz / 64; C = (st & 1) * 32 + (swz % 64) / 2; }
__host__ __device__ __forceinline__ int perm32(int rho) { const int n = rho >> 4, i = rho & 15; return 8 * (i >> 2) + 4 * n + (i & 3); }
struct Unit { int pm, pn; };
struct Gemm { const bf16_t* A; const bf16_t* Bt; int M, N, K; const int* rowmap; };
struct StaticOrder {
    int nM, nN, nwg, G, c;
    __device__ void init(int M, int N, int G_, int c_) { nM = M / BM; nN = N / BM; nwg = nM * nN; G = G_; c = c_; }
    __device__ bool next(int i, Unit& u) const {
        const long L = (long)i * G + c; if (L >= nwg) return false;
        int wgid = (int)L; { const int q = nwg / NXCD, r = nwg % NXCD, xcd = wgid % NXCD, off = wgid / NXCD; wgid = (xcd < r ? xcd * (q + 1) : r * (q + 1) + (xcd - r) * q) + off; }
        const int nig = WGM * nN, gid = wgid / nig, fm = gid * WGM, gsz = (nM - fm) < WGM ? (nM - fm) : WGM;
        u.pm = fm + ((wgid % nig) % gsz); u.pn = (wgid % nig) / gsz; return true;
    }
    __device__ __forceinline__ void a_ready(const Unit&) const {}
    __device__ __forceinline__ void done(const Unit&) const {}
};
template <int NT> struct GroupedOrder {
    const int* blk_e; int nunits, G, c;
    __device__ bool next(int i, Unit& u) const { const long L = (long)i * G + c; if (L >= nunits) return false; const int rb = (int)L / NT; u.pm = rb; u.pn = blk_e[rb] * NT + (int)L % NT; return true; }
    __device__ __forceinline__ void a_ready(const Unit&) const {}
    __device__ __forceinline__ void done(const Unit&) const {}
};
template <class Epi, class Sched, bool ALIGN_EPI = false, bool SP2 = false, bool GATHER = false>
__device__ __forceinline__ void gemm_phase(PG8_LAS unsigned char* lds, const Gemm g, const Sched& S, const Epi& E) {
    const int tid = ltid(), wid = __builtin_amdgcn_readfirstlane(tid >> 6), lane = tid & 63, wr = wid >> 2, wc = wid & 3, fr = lane & 15, fq = lane >> 4;
    int K = g.K; asm volatile("" : "+s"(K)); const int nt = K / BK;
    unsigned voffA[2], voffB[2];
#pragma unroll
    for (int i = 0; i < 2; ++i) { int R, C; stage_rc(tid * 16 + i * 8192, R, C); const int Rb = Epi::PERM ? ((R & ~31) + perm32(R & 31)) : R;
        voffA[i] = (unsigned)(R * K + C) * 2u; voffB[i] = (unsigned)(Rb * K + C) * 2u; }
    const size_t kstep = (size_t)(BK * 2);
    const size_t hstep = (size_t)HALF * K * 2;
    const size_t tstep = 2 * hstep;
    const unsigned ldsw = (unsigned)wid * 1024u;
    const int aoff = lds_byte(wr * 64 + fr, fq * 8), boff = lds_byte(wc * 32 + fr, fq * 8);
#define PG8_SA(b, h) (((b) * 2 + (h)) * HTB)
#define PG8_SB(b, h) ((4 + (b) * 2 + (h)) * HTB)
#define PG8_STAGE(bufoff, gbase, voff) do { _Pragma("unroll") for (int _i = 0; _i < 2; ++_i) \
        __builtin_amdgcn_global_load_lds((const unsigned*)((const char*)(gbase) + (voff)[_i]), (PG8_LAS unsigned*)(lds + (bufoff) + ldsw + _i * 8192), 16, 0, 0); } while (0)
#define PG8_STAGE_A(bufoff, gptr, hf) do { if constexpr (GATHER) { _Pragma("unroll") for (int _i = 0; _i < 2; ++_i) \
        __builtin_amdgcn_global_load_lds((const unsigned*)((const char*)(gptr) + gC[hf][_i]), (PG8_LAS unsigned*)(lds + (bufoff) + ldsw + _i * 8192), 16, 0, 0); } \
        else { PG8_STAGE(bufoff, (gptr) + (hf) * hstep, voffA); } } while (0)
#define PG8_LOAD_GOFF(pm_) do { _Pragma("unroll") for (int _h = 0; _h < 2; ++_h) _Pragma("unroll") for (int _i = 0; _i < 2; ++_i) { int R_, C_; stage_rc(tid * 16 + _i * 8192, R_, C_); \
        gC[_h][_i] = (unsigned)(g.rowmap[(pm_) * 256 + _h * 128 + R_] * K + C_) * 2u; } } while (0)
#define PG8_LDA(dst, b, h) do { _Pragma("unroll") for (int m = 0; m < 4; ++m) _Pragma("unroll") for (int k = 0; k < 2; ++k) dst[m][k] = *(const PG8_LAS bf16x8*)(lds + PG8_SA(b, h) + aoff + m * 2048 + k * 1024); } while (0)
#define PG8_LDB(dst, b, h) do { _Pragma("unroll") for (int n = 0; n < 2; ++n) _Pragma("unroll") for (int k = 0; k < 2; ++k) dst[n][k] = *(const PG8_LAS bf16x8*)(lds + PG8_SB(b, h) + boff + n * 2048 + k * 1024); } while (0)
#define PG8_MMA(ai, bj, At, Bt) do { __builtin_amdgcn_s_setprio(1); _Pragma("unroll") for (int m = 0; m < 4; ++m) _Pragma("unroll") for (int n = 0; n < 2; ++n) _Pragma("unroll") for (int k = 0; k < 2; ++k) \
        acc[ai][bj][m][n] = __builtin_amdgcn_mfma_f32_16x16x32_bf16(Bt[n][k], At[m][k], acc[ai][bj][m][n], 0, 0, 0); __builtin_amdgcn_s_setprio(0); } while (0)
#define PG8_WAIT_V(n) asm volatile("s_waitcnt vmcnt(" #n ")" ::: "memory")
#define PG8_WAIT_L(n) asm volatile("s_waitcnt lgkmcnt(" #n ")" ::: "memory")
#define PG8_BAR __builtin_amdgcn_s_barrier()
#define PG8_SCHED __builtin_amdgcn_sched_barrier(0)
    Unit cur, nxt; int ui = 0;
    if (!S.next(0, cur)) return;
    f32x4 acc[2][2][4][2];
#pragma unroll
    for (int a = 0; a < 2; ++a)
#pragma unroll
        for (int b = 0; b < 2; ++b)
#pragma unroll
            for (int m = 0; m < 4; ++m)
#pragma unroll
                for (int n = 0; n < 2; ++n) acc[a][b][m][n] = (f32x4){0.f, 0.f, 0.f, 0.f};
    bf16x8 At[4][2], B0[2][2], B1[2][2];
    const char* cA = (const char*)g.A + (GATHER ? (size_t)0 : (size_t)cur.pm * tstep); const char* cB = (const char*)g.Bt + (size_t)cur.pn * tstep;
    unsigned gC[2][2] = {{0u, 0u}, {0u, 0u}};
    S.a_ready(cur);
    if constexpr (GATHER) PG8_LOAD_GOFF(cur.pm);
    if constexpr (SP2) {
        PG8_STAGE(PG8_SB(0, 0), cB, voffB); PG8_STAGE(PG8_SB(0, 1), cB + hstep, voffB); PG8_STAGE_A(PG8_SA(0, 0), cA, 0); PG8_STAGE_A(PG8_SA(0, 1), cA, 1);
        if (wr == 1) PG8_BAR;
        PG8_WAIT_V(2); PG8_BAR;
        PG8_STAGE(PG8_SB(1, 0), cB + kstep, voffB); PG8_STAGE_A(PG8_SA(1, 0), cA + kstep, 0); PG8_STAGE(PG8_SB(1, 1), cB + hstep + kstep, voffB);
        PG8_WAIT_V(6); PG8_BAR;
    } else {
        PG8_STAGE(PG8_SB(0, 0), cB, voffB); PG8_STAGE_A(PG8_SA(0, 0), cA, 0); PG8_STAGE(PG8_SB(0, 1), cB + hstep, voffB); PG8_STAGE_A(PG8_SA(0, 1), cA, 1);
        if (wr == 1) PG8_BAR;
        PG8_WAIT_V(4); PG8_BAR;
        PG8_STAGE(PG8_SB(1, 0), cB + kstep, voffB); PG8_STAGE_A(PG8_SA(1, 0), cA + kstep, 0); PG8_STAGE(PG8_SB(1, 1), cB + hstep + kstep, voffB);
        PG8_WAIT_V(6); PG8_BAR;
    }
    for (;;) {
        const bool has_next = S.next(ui + 1, nxt);
        const char* nA = (has_next && !GATHER) ? (const char*)g.A + (size_t)nxt.pm * tstep : cA; const char* nB = has_next ? (const char*)g.Bt + (size_t)nxt.pn * tstep : cB;
        for (int t = 0; t < nt; t += 2) {
            const bool last = (t == nt - 2);
            const char* a1 = cA + (size_t)(t + 1) * kstep;
            const char* a2 = last ? nA : cA + (size_t)(t + 2) * kstep; const char* b2 = last ? nB : cB + (size_t)(t + 2) * kstep;
            const char* a3 = a2 + kstep; const char* b3 = b2 + kstep;
            if (last && has_next) S.a_ready(nxt);
            if constexpr (SP2) {
            PG8_LDB(B0, 0, 0); PG8_LDB(B1, 0, 1); PG8_SCHED; PG8_LDA(At, 0, 0); PG8_STAGE_A(PG8_SA(1, 1), a1, 1); if constexpr (GATHER) { if (last && has_next) PG8_LOAD_GOFF(nxt.pm); }
            PG8_WAIT_V(8); PG8_WAIT_L(0); PG8_BAR; PG8_MMA(0, 0, At, B0); PG8_MMA(0, 1, At, B1); PG8_BAR; PG8_SCHED;
            PG8_LDA(At, 0, 1); PG8_STAGE(PG8_SB(0, 0), b2, voffB); PG8_STAGE(PG8_SB(0, 1), b2 + hstep, voffB); PG8_STAGE_A(PG8_SA(0, 0), a2, 0);
            PG8_WAIT_V(8); PG8_WAIT_L(0); PG8_BAR; PG8_MMA(1, 0, At, B0); PG8_MMA(1, 1, At, B1); PG8_BAR; PG8_SCHED;
            PG8_LDB(B0, 1, 0); PG8_LDB(B1, 1, 1); PG8_SCHED; PG8_LDA(At, 1, 0); PG8_STAGE_A(PG8_SA(0, 1), a2, 1);
            PG8_WAIT_V(8); PG8_WAIT_L(0); PG8_BAR; PG8_MMA(0, 0, At, B0); PG8_MMA(0, 1, At, B1); PG8_BAR; PG8_SCHED;
            PG8_LDA(At, 1, 1); PG8_STAGE(PG8_SB(1, 0), b3, voffB); PG8_STAGE(PG8_SB(1, 1), b3 + hstep, voffB); PG8_STAGE_A(PG8_SA(1, 0), a3, 0);
            PG8_WAIT_V(8); PG8_WAIT_L(0); PG8_BAR; PG8_MMA(1, 0, At, B0); PG8_MMA(1, 1, At, B1); PG8_BAR; PG8_SCHED;
            } else {
            PG8_LDB(B0, 0, 0); PG8_SCHED; PG8_LDA(At, 0, 0); PG8_STAGE_A(PG8_SA(1, 1), a1, 1); if constexpr (GATHER) { if (last && has_next) PG8_LOAD_GOFF(nxt.pm); }
            PG8_WAIT_L(8); PG8_BAR; PG8_WAIT_L(0); PG8_MMA(0, 0, At, B0); PG8_BAR; PG8_SCHED;
            PG8_LDB(B1, 0, 1); PG8_STAGE(PG8_SB(0, 0), b2, voffB);
            PG8_BAR; PG8_WAIT_L(0); PG8_MMA(0, 1, At, B1); PG8_BAR;
            PG8_LDA(At, 0, 1); PG8_STAGE_A(PG8_SA(0, 0), a2, 0);
            PG8_BAR; PG8_WAIT_L(0); PG8_MMA(1, 0, At, B0); PG8_BAR; PG8_SCHED;
            PG8_STAGE(PG8_SB(0, 1), b2 + hstep, voffB);
            PG8_WAIT_V(6); PG8_BAR; PG8_MMA(1, 1, At, B1); PG8_BAR;
            PG8_LDB(B0, 1, 0); PG8_SCHED; PG8_LDA(At, 1, 0); PG8_STAGE_A(PG8_SA(0, 1), a2, 1);
            PG8_WAIT_L(8); PG8_BAR; PG8_WAIT_L(0); PG8_MMA(0, 0, At, B0); PG8_BAR; PG8_SCHED;
            PG8_LDB(B1, 1, 1); PG8_STAGE(PG8_SB(1, 0), b3, voffB);
            PG8_BAR; PG8_WAIT_L(0); PG8_MMA(0, 1, At, B1); PG8_BAR;
            PG8_LDA(At, 1, 1); PG8_STAGE_A(PG8_SA(1, 0), a3, 0);
            PG8_BAR; PG8_WAIT_L(0); PG8_MMA(1, 0, At, B0); PG8_BAR; PG8_SCHED;
            PG8_STAGE(PG8_SB(1, 1), b3 + hstep, voffB);
            PG8_WAIT_V(6); PG8_BAR; PG8_MMA(1, 1, At, B1); PG8_BAR;
            }
            if constexpr (Epi::HOOK) { if (t == 2 || t == 8) E.hook(acc, cur, t, wr, wc, fr, fq); }
        }
        if constexpr (ALIGN_EPI) { if (wr == 0) PG8_BAR; }
        if constexpr (!Epi::AFTER_DRAIN) { E(acc, cur, wr, wc, fr, fq); S.done(cur); }
        if (!has_next) break;
#pragma unroll
        for (int a = 0; a < 2; ++a)
#pragma unroll
            for (int b = 0; b < 2; ++b)
#pragma unroll
                for (int m = 0; m < 4; ++m)
#pragma unroll
                    for (int n = 0; n < 2; ++n) acc[a][b][m][n] = (f32x4){0.f, 0.f, 0.f, 0.f};
        cur = nxt; cA = nA; cB = nB; ++ui;
        if constexpr (ALIGN_EPI) { if (wr == 1) PG8_BAR; }
    }
    PG8_WAIT_V(0);
    if constexpr (!ALIGN_EPI) { if (wr == 0) PG8_BAR; }
    PG8_BAR;
    if constexpr (Epi::AFTER_DRAIN) { E.fused(acc, cur, wr, wc, fr, fq, lds, wid, lane); S.done(cur); }
#undef PG8_SA
#undef PG8_SB
#undef PG8_STAGE
#undef PG8_LDA
#undef PG8_STAGE_A
#undef PG8_LOAD_GOFF
#undef PG8_LDB
#undef PG8_MMA
#undef PG8_WAIT_V
#undef PG8_WAIT_L
#undef PG8_BAR
#undef PG8_SCHED
}

}
__device__ __forceinline__ pg8::u32x4 pack8(const f32x4& a, const f32x4& b) { pg8::u32x4 w; w.x = pack2(a[0], a[1]); w.y = pack2(a[2], a[3]); w.z = pack2(b[0], b[1]); w.w = pack2(b[2], b[3]); return w; }
__device__ __forceinline__ void unpack8(const pg8::u32x4& w, f32x4& a, f32x4& b) {
    a[0] = __uint_as_float(w.x << 16); a[1] = __uint_as_float(w.x & 0xffff0000u); a[2] = __uint_as_float(w.y << 16); a[3] = __uint_as_float(w.y & 0xffff0000u);
    b[0] = __uint_as_float(w.z << 16); b[1] = __uint_as_float(w.z & 0xffff0000u); b[2] = __uint_as_float(w.w << 16); b[3] = __uint_as_float(w.w & 0xffff0000u); }


__device__ __forceinline__ void phase_gemm_in(ParamsC p, int l, unsigned char* smem) {
    const int tid = ltid(), lane = tid & 63, wid = tid >> 6, wm = wid >> 1, wn = wid & 1, q4 = (lane >> 4) * 4;
    const int nM = T_ALL / 128, nN = IN_COLS / 128;
    for (int tile = lbid(); tile < nM * nN; tile += gridDim.x) {
        const int tm = tile / nN, tn = tile % nN, m0 = tm * 128, n0 = tn * 128;
        f32x4 acc[2][4]; zero_acc(acc);
        RowsLinear ar{p->h + (size_t)m0 * 1024, 1024};
        gemm_core(smem, ar, p->wt_in + (size_t)n0 * 1024, 1024, 0, 1024, acc);
        const int cb = n0 + wn * 64;
#pragma unroll
        for (int mi = 0; mi < 2; ++mi) {
            const int t = m0 + wm * 32 + mi * 16 + (lane & 15);
            f32x4 v0 = acc[mi][0], v1 = acc[mi][1], v2 = acc[mi][2], v3 = acc[mi][3];
            if (cb >= 2560) {
                bf16_t* dst = p->uG + (size_t)t * UG_LD + (cb - 2560) + q4;
#pragma unroll
                for (int e = 0; e < 4; ++e) { v0[e] = 1.f / (1.f + __expf(-v0[e])); v1[e] = 1.f / (1.f + __expf(-v1[e])); v2[e] = 1.f / (1.f + __expf(-v2[e])); v3[e] = 1.f / (1.f + __expf(-v3[e])); }
                store4bf(dst, v0); store4bf(dst + 16, v1); store4bf(dst + 32, v2); store4bf(dst + 48, v3);
            } else {
                const bool isq = (cb >= 768 && cb < 1152) || (cb >= 1920 && cb < 2304);
                const bool rope = (cb >= 1920 && cb < 2432) && (t < T_LAT);
                if (rope) { const int pos = t & 8191, r = pos >> 6, cc = pos & 63;
#pragma unroll
                    for (int e = 0; e < 4; ++e) {
                        const float2 csr = *(const float2*)(p->ropet + (r * 16 + q4 + e) * 2), csc = *(const float2*)(p->ropet + (cc * 16 + q4 + e) * 2);
                        const float a1 = v0[e], a2 = v1[e]; v0[e] = a1 * csr.x - a2 * csr.y; v1[e] = a1 * csr.y + a2 * csr.x;
                        const float b1 = v2[e], b2 = v3[e]; v2[e] = b1 * csc.x - b2 * csc.y; v3[e] = b1 * csc.y + b2 * csc.x; } }
                if (isq) { v0 = v0 * 0.125f; v1 = v1 * 0.125f; v2 = v2 * 0.125f; v3 = v3 * 0.125f; }
                bf16_t* dst = p->uA + (size_t)t * UA_LD + cb + q4;
                store4bf(dst, v0); store4bf(dst + 16, v1); store4bf(dst + 32, v2); store4bf(dst + 48, v3);
            }
        }
    }
}

struct KmNA { int b, r, c, rs, cs; const float* rpb;
    __device__ __forceinline__ int tok(int kk) const { if (kk < 128) return b * SEQ + (rs + (kk >> 4)) * 64 + cs + (kk & 15); return T_LAT + b * CTXL + (kk - 128); }
    __device__ __forceinline__ float bias(int kk) const { if (kk < 128) return rpb[(rs + (kk >> 4) - r + 7) * 31 + (cs + (kk & 15) - c + 15)]; return 0.f; } };
struct KmSWA { int b, i;
    __device__ __forceinline__ int tok(int kk) const { if (kk < 257) { const int j = i - 128 + kk; return (j >= 0 && j < SEQ) ? b * SEQ + j : -1; } if (kk < 513) return T_LAT + b * CTXL + (kk - 257); return -1; }
    __device__ __forceinline__ float bias(int) const { return 0.f; } };
struct KmCtx { int b;
    __device__ __forceinline__ int tok(int kk) const { return T_LAT + b * CTXL + kk; }
    __device__ __forceinline__ float bias(int) const { return 0.f; } };

template <int NI, class KM>
__device__ __forceinline__ void attn_item(const bf16_t* uA, int tq, int qcol, int kcol, int vcol, const KM& km, bool has_sink, float sink, bf16_t* outp, int lane) {
    float q[64];
    {   const uint4* qp = (const uint4*)(uA + (size_t)tq * UA_LD + qcol);
#pragma unroll
        for (int c = 0; c < 8; ++c) { const uint4 v = qp[c];
            q[c * 8 + 0] = bf2f((bf16_t)(v.x & 0xffff)); q[c * 8 + 1] = bf2f((bf16_t)(v.x >> 16)); q[c * 8 + 2] = bf2f((bf16_t)(v.y & 0xffff)); q[c * 8 + 3] = bf2f((bf16_t)(v.y >> 16));
            q[c * 8 + 4] = bf2f((bf16_t)(v.z & 0xffff)); q[c * 8 + 5] = bf2f((bf16_t)(v.z >> 16)); q[c * 8 + 6] = bf2f((bf16_t)(v.w & 0xffff)); q[c * 8 + 7] = bf2f((bf16_t)(v.w >> 16)); } }
    float s[NI]; float mx = -3.0e38f;
#pragma unroll
    for (int i = 0; i < NI; ++i) { const int kk = i * 64 + lane; const int tk = km.tok(kk);
        float d = -3.0e38f;
        if (tk >= 0) { const uint4* kp = (const uint4*)(uA + (size_t)tk * UA_LD + kcol); d = 0.f;
#pragma unroll
            for (int c = 0; c < 8; ++c) { const uint4 v = kp[c];
                d += q[c * 8 + 0] * bf2f((bf16_t)(v.x & 0xffff)) + q[c * 8 + 1] * bf2f((bf16_t)(v.x >> 16)) + q[c * 8 + 2] * bf2f((bf16_t)(v.y & 0xffff)) + q[c * 8 + 3] * bf2f((bf16_t)(v.y >> 16))
                   + q[c * 8 + 4] * bf2f((bf16_t)(v.z & 0xffff)) + q[c * 8 + 5] * bf2f((bf16_t)(v.z >> 16)) + q[c * 8 + 6] * bf2f((bf16_t)(v.w & 0xffff)) + q[c * 8 + 7] * bf2f((bf16_t)(v.w >> 16)); }
            d += km.bias(kk); }
        s[i] = d; mx = fmaxf(mx, d); }
    mx = wave_max(mx); if (has_sink) mx = fmaxf(mx, sink);
    float sum = 0.f;
#pragma unroll
    for (int i = 0; i < NI; ++i) { const float pv = s[i] > -1.0e38f ? __expf(s[i] - mx) : 0.f; s[i] = pv; sum += pv; }
    sum = wave_sum(sum); if (has_sink) sum += __expf(sink - mx);
    const float inv = 1.0f / sum;
    float o = 0.f;
#pragma unroll
    for (int i = 0; i < NI; ++i) {
        for (int sl = 0; sl < 64; ++sl) { const int tk = km.tok(i * 64 + sl); const float pv = __shfl(s[i], sl);
            if (tk >= 0) o += pv * bf2f(uA[(size_t)tk * UA_LD + vcol + lane]); } }
    outp[lane] = f2bf(o * inv);
}

__device__ __forceinline__ void phase_mix(ParamsC p, int l) {
    const int tid = ltid(), lane = tid & 63, wid = tid >> 6;
    const bool need_ctx = l < DEPTH - 1;
    {   const int ntok = need_ctx ? T_ALL : T_LAT; const float* cw = p->conv_w + l * 3 * 256;
        for (int idx = lbid() * NTHR + tid; idx < ntok * 256; idx += gridDim.x * NTHR) { const int t = idx >> 8, c = idx & 255;
            int pos, len; if (t < T_LAT) { pos = t & 8191; len = SEQ; } else { pos = (t - T_LAT) & 255; len = CTXL; }
            const bf16_t* u = p->uA + (size_t)t * UA_LD + c;
            const float z1 = bf2f(u[512]) * bf2f(u[0]);
            const float z0 = pos > 0 ? bf2f(u[512 - UA_LD]) * bf2f(u[-UA_LD]) : 0.f;
            const float z2 = pos + 1 < len ? bf2f(u[512 + UA_LD]) * bf2f(u[UA_LD]) : 0.f;
            const float y = bf2f(u[256]) * (z0 * cw[c] + z1 * cw[256 + c] + z2 * cw[512 + c]);
            p->ycat[(size_t)t * 1024 + c] = f2bf(y); } }
    const int n_lat = T_LAT * 12, n_all = n_lat + (need_ctx ? T_CTX * 12 : 0);
    for (int it = lbid() * 8 + wid; it < n_all; it += gridDim.x * 8) {
        if (it < n_lat) { const int t = it / 12, hh = it % 12; const int b = t >> 13, pos = t & 8191;
            if (hh < 6) { KmNA km; km.b = b; km.r = pos >> 6; km.c = pos & 63; km.rs = min(max(km.r - 4, 0), 120); km.cs = min(max(km.c - 8, 0), 48); km.rpb = p->rpb + ((size_t)l * 6 + hh) * 15 * 31;
                attn_item<6>(p->uA, t, 768 + hh * 64, 1152 + hh * 64, 1536 + hh * 64, km, false, 0.f, p->ycat + (size_t)t * 1024 + 256 + hh * 64, lane); }
            else { const int hq = hh - 6, kh = hq / 3; KmSWA km; km.b = b; km.i = pos;
                attn_item<9>(p->uA, t, 1920 + hq * 64, 2304 + kh * 64, 2432 + kh * 64, km, true, p->sinks[l * 6 + hq], p->ycat + (size_t)t * 1024 + 640 + hq * 64, lane); }
        } else { const int it2 = it - n_lat; const int tc = it2 / 12, hh = it2 % 12; const int t = T_LAT + tc; KmCtx km; km.b = tc >> 8;
            if (hh < 6) attn_item<4>(p->uA, t, 768 + hh * 64, 1152 + hh * 64, 1536 + hh * 64, km, false, 0.f, p->ycat + (size_t)t * 1024 + 256 + hh * 64, lane);
            else { const int hq = hh - 6, kh = hq / 3; attn_item<4>(p->uA, t, 1920 + hq * 64, 2304 + kh * 64, 2432 + kh * 64, km, true, p->sinks[l * 6 + hq], p->ycat + (size_t)t * 1024 + 640 + hq * 64, lane); }
        }
    }
}


typedef float f32x16 __attribute__((ext_vector_type(16)));
typedef short s16x4 __attribute__((ext_vector_type(4)));
#define AT_STRIDE 144
#define AT_KBUF(b) ((b) * 9216)
#define AT_VBUF(b) (18432 + (b) * 9216)
#define AT_RPB 36864
#define LOG2E 1.4426950408889634f
#define AT_NEG (-1.0e30f)

template <int MK>
__device__ __forceinline__ void attn_tile(const unsigned char* kt, const unsigned char* vlane, const bf16x8 (&qf)[4], f32x16 (&oacc)[2], float& m, float& lsum,
                                          const float* rpb_row, int relc0  , int lo0  , int lane) {
    const int n = lane & 31, hh = lane >> 5;
    f32x16 sc;
#pragma unroll
    for (int r = 0; r < 16; ++r) sc[r] = 0.f;
#pragma unroll
    for (int sp = 0; sp < 4; ++sp) { const bf16x8 kf = *(const bf16x8*)(kt + n * AT_STRIDE + sp * 32 + hh * 16); sc = __builtin_amdgcn_mfma_f32_32x32x16_bf16(kf, qf[sp], sc, 0, 0, 0); }
    float mx = AT_NEG;
#pragma unroll
    for (int r = 0; r < 16; ++r) { const int i = (r & 3) + 8 * (r >> 2) + 4 * hh; float v = sc[r];
        if (MK == 1) { const bool ok = (unsigned)(i - lo0) < 16u; const int ridx = ok ? (relc0 + i) : 0; v = ok ? (v + rpb_row[ridx]) : AT_NEG; }
        else if (MK == 2) v = (i >= n) ? v : AT_NEG;
        else if (MK == 3) v = (i <= n) ? v : AT_NEG;
        sc[r] = v; mx = fmaxf(mx, v); }
    mx = fmaxf(mx, __shfl_xor(mx, 32));
    const float mn = fmaxf(m, mx);
    if (__any(mn > m)) { const float alpha = __builtin_amdgcn_exp2f(m - mn); lsum *= alpha;
#pragma unroll
        for (int r = 0; r < 16; ++r) { oacc[0][r] *= alpha; oacc[1][r] *= alpha; } }
    m = mn;
    float ps = 0.f;
#pragma unroll
    for (int r = 0; r < 16; ++r) { const float pv = __builtin_amdgcn_exp2f(sc[r] - mn); sc[r] = pv; ps += pv; }
    lsum += ps;
    bf16x8 pf[2];
#pragma unroll
    for (int s2 = 0; s2 < 2; ++s2) { pg8::u32x4 w; w.x = pack2(sc[s2 * 8 + 0], sc[s2 * 8 + 1]); w.y = pack2(sc[s2 * 8 + 2], sc[s2 * 8 + 3]); w.z = pack2(sc[s2 * 8 + 4], sc[s2 * 8 + 5]); w.w = pack2(sc[s2 * 8 + 6], sc[s2 * 8 + 7]);
        pf[s2] = __builtin_bit_cast(bf16x8, w); }
#pragma unroll
    for (int c = 0; c < 2; ++c)
#pragma unroll
        for (int s2 = 0; s2 < 2; ++s2) {
            const s16x4 v0 = __builtin_amdgcn_ds_read_tr16_b64_v4i16((LAS s16x4*)(vlane + (16 * s2) * AT_STRIDE + 64 * c));
            const s16x4 v1 = __builtin_amdgcn_ds_read_tr16_b64_v4i16((LAS s16x4*)(vlane + (16 * s2 + 8) * AT_STRIDE + 64 * c));
            bf16x8 vf; vf[0] = v0[0]; vf[1] = v0[1]; vf[2] = v0[2]; vf[3] = v0[3]; vf[4] = v1[0]; vf[5] = v1[1]; vf[6] = v1[2]; vf[7] = v1[3];
            oacc[c] = __builtin_amdgcn_mfma_f32_32x32x16_bf16(vf, pf[s2], oacc[c], 0, 0, 0);
        }
}

template <int MODE>
__device__ __forceinline__ void attn_unit(ParamsC p, int l, int u, unsigned char* smem) {
    const int tid = ltid(), lane = tid & 63, wid = tid >> 6;
    int b, qcol, kcol, vcol, ocol, qtok; bool has_sink = false; float sinkv = 0.f;
    int nsteps, krlo = 0, r = 0, rs = 0, c = 0, cs = 0, q0 = 0, jwlo = 0;
    if (MODE == 0) { b = u / 192; const int rem = u % 192, h = rem / 32, rg = rem % 32; qcol = 768 + h * 64; kcol = 1152 + h * 64; vcol = 1536 + h * 64; ocol = 256 + h * 64;
        r = rg * 4 + (wid >> 1); rs = min(max(r - 4, 0), 120); c = 32 * (wid & 1) + (lane & 31); cs = min(max(c - 8, 0), 48);
        krlo = min(max(rg * 4 - 4, 0), 120); const int krhi = min(max(rg * 4 + 3 - 4, 0), 120) + 7; nsteps = 4 + (krhi - krlo + 1);
        qtok = b * SEQ + r * 64 + 32 * (wid & 1);
        for (int i = tid; i < 15 * 31; i += NTHR) ((float*)(smem + AT_RPB))[i] = p->rpb[((size_t)l * 6 + h) * 465 + i] * LOG2E;
    } else if (MODE == 1) { b = u / 192; const int rem = u % 192, hq = rem / 32, qb = rem % 32, kh = hq / 3; qcol = 1920 + hq * 64; kcol = 2304 + kh * 64; vcol = 2432 + kh * 64; ocol = 640 + hq * 64;
        q0 = qb * 256; jwlo = (q0 == 0) ? 2 : 0; const int jwhi = min(8, (SEQ - q0 + 128) / 64); nsteps = 4 + (jwhi - jwlo);
        qtok = b * SEQ + q0 + 32 * wid; has_sink = true; sinkv = p->sinks[l * 6 + hq];
    } else { b = u / 12; const int hh = u % 12;
        if (hh < 6) { qcol = 768 + hh * 64; kcol = 1152 + hh * 64; vcol = 1536 + hh * 64; ocol = 256 + hh * 64; }
        else { const int hq = hh - 6, kh = hq / 3; qcol = 1920 + hq * 64; kcol = 2304 + kh * 64; vcol = 2432 + kh * 64; ocol = 640 + hq * 64; has_sink = true; sinkv = p->sinks[l * 6 + hq]; }
        nsteps = 4; qtok = T_LAT + b * CTXL + 32 * wid;
    }
    const bf16_t* uA = p->uA;
    bf16x8 qf[4];
    {   const bf16_t* qp = uA + (size_t)(qtok + (lane & 31)) * UA_LD + qcol + (lane >> 5) * 8;
#pragma unroll
        for (int sp = 0; sp < 4; ++sp) qf[sp] = *(const bf16x8*)(qp + sp * 16); }
    f32x16 oacc[2];
#pragma unroll
    for (int r16 = 0; r16 < 16; ++r16) { oacc[0][r16] = 0.f; oacc[1][r16] = 0.f; }
    float m = has_sink ? sinkv * LOG2E : AT_NEG, lsum = (has_sink && lane < 32) ? 1.f : 0.f;
    const int skey = tid >> 3, sch = tid & 7; const int soff = skey * AT_STRIDE + sch * 16;
    auto chunk_tok = [&](int j) -> int {
        if (j < 4) return T_LAT + b * CTXL + 64 * j;
        if (MODE == 0) return b * SEQ + (krlo + (j - 4)) * 64;
        return b * SEQ + q0 - 128 + 64 * (jwlo + (j - 4)); };
    uint4 rk, rv;
    {   const bf16_t* src = uA + (size_t)(chunk_tok(0) + skey) * UA_LD + sch * 8; rk = *(const uint4*)(src + kcol); rv = *(const uint4*)(src + vcol); }
    *(uint4*)(smem + AT_KBUF(0) + soff) = rk; *(uint4*)(smem + AT_VBUF(0) + soff) = rv;
    __syncthreads();
    const int vl_off = (4 * (lane >> 5) + ((lane & 15) >> 2)) * AT_STRIDE + (16 * ((lane >> 4) & 1) + 4 * (lane & 3)) * 2;
    const float* rpb_s = (const float*)(smem + AT_RPB);
    for (int j = 0; j < nsteps; ++j) {
        const int buf = j & 1;
        if (j + 1 < nsteps) { const bf16_t* src = uA + (size_t)(chunk_tok(j + 1) + skey) * UA_LD + sch * 8; rk = *(const uint4*)(src + kcol); rv = *(const uint4*)(src + vcol); }
        const unsigned char* kb = smem + AT_KBUF(buf); const unsigned char* vb = smem + AT_VBUF(buf) + vl_off;
        if (j < 4) {
            attn_tile<0>(kb, vb, qf, oacc, m, lsum, rpb_s, 0, 0, lane);
            attn_tile<0>(kb + 32 * AT_STRIDE, vb + 32 * AT_STRIDE, qf, oacc, m, lsum, rpb_s, 0, 0, lane);
        } else if (MODE == 0) {
            const int kr = krlo + (j - 4);
            if (kr >= rs && kr < rs + 8) { const float* rrow = rpb_s + (kr - r + 7) * 31;
                attn_tile<1>(kb, vb, qf, oacc, m, lsum, rrow, 0 - c + 15, cs, lane);
                attn_tile<1>(kb + 32 * AT_STRIDE, vb + 32 * AT_STRIDE, qf, oacc, m, lsum, rrow, 32 - c + 15, cs - 32, lane); }
        } else if (MODE == 1) {
            const int qp0 = q0 + 32 * wid;
#pragma unroll
            for (int tl = 0; tl < 2; ++tl) { const int kp0 = q0 - 128 + 64 * (jwlo + (j - 4)) + 32 * tl; const int d = kp0 - qp0;
                const unsigned char* kt = kb + tl * 32 * AT_STRIDE; const unsigned char* vt = vb + tl * 32 * AT_STRIDE;
                if (d == -128) attn_tile<2>(kt, vt, qf, oacc, m, lsum, rpb_s, 0, 0, lane);
                else if (d == 128) attn_tile<3>(kt, vt, qf, oacc, m, lsum, rpb_s, 0, 0, lane);
                else if (d > -128 && d < 128) attn_tile<0>(kt, vt, qf, oacc, m, lsum, rpb_s, 0, 0, lane); }
        }
        if (j + 1 < nsteps) { *(uint4*)(smem + AT_KBUF(buf ^ 1) + soff) = rk; *(uint4*)(smem + AT_VBUF(buf ^ 1) + soff) = rv; }
        __syncthreads();
    }
    const float ltot = lsum + __shfl_xor(lsum, 32); const float inv = 1.0f / ltot;
    bf16_t* op = p->ycat + (size_t)(qtok + (lane & 31)) * 1024 + ocol + 4 * (lane >> 5);
#pragma unroll
    for (int cc = 0; cc < 2; ++cc)
#pragma unroll
        for (int g = 0; g < 4; ++g) { f32x4 v; v[0] = oacc[cc][4 * g] * inv; v[1] = oacc[cc][4 * g + 1] * inv; v[2] = oacc[cc][4 * g + 2] * inv; v[3] = oacc[cc][4 * g + 3] * inv;
            store4bf(op + 32 * cc + 8 * g, v); }
}

__device__ __forceinline__ void phase_mix2(ParamsC p, int l, unsigned char* smem) {
    const int tid = ltid();
    const bool need_ctx = l < DEPTH - 1;
    {
        const int ntok = need_ctx ? T_ALL : T_LAT; const float* cw = p->conv_w + l * 3 * 256;
        for (int idx = lbid() * NTHR + tid; idx < ntok * 32; idx += gridDim.x * NTHR) { const int t = idx >> 5, c = (idx & 31) * 8;
            int pos, len; if (t < T_LAT) { pos = t & 8191; len = SEQ; } else { pos = (t - T_LAT) & 255; len = CTXL; }
            const bf16_t* u = p->uA + (size_t)t * UA_LD + c;
            const bool hp = pos > 0, hn = pos + 1 < len;
            const pg8::u32x4 zero4 = (pg8::u32x4){0u, 0u, 0u, 0u};
            const pg8::u32x4 h1 = *(const pg8::u32x4*)u, c1 = *(const pg8::u32x4*)(u + 512), b1 = *(const pg8::u32x4*)(u + 256);
            const pg8::u32x4 h0 = hp ? *(const pg8::u32x4*)(u - UA_LD) : zero4, c0 = hp ? *(const pg8::u32x4*)(u + 512 - UA_LD) : zero4;
            const pg8::u32x4 h2 = hn ? *(const pg8::u32x4*)(u + UA_LD) : zero4, c2 = hn ? *(const pg8::u32x4*)(u + 512 + UA_LD) : zero4;
            f32x4 w0a = *(const f32x4*)(cw + c), w0b = *(const f32x4*)(cw + c + 4), w1a = *(const f32x4*)(cw + 256 + c), w1b = *(const f32x4*)(cw + 256 + c + 4), w2a = *(const f32x4*)(cw + 512 + c), w2b = *(const f32x4*)(cw + 512 + c + 4);
            f32x4 ha, hb, ca, cb, ya, yb;
            unpack8(h0, ha, hb); unpack8(c0, ca, cb); ya = ha * ca * w0a; yb = hb * cb * w0b;
            unpack8(h1, ha, hb); unpack8(c1, ca, cb); ya += ha * ca * w1a; yb += hb * cb * w1b;
            unpack8(h2, ha, hb); unpack8(c2, ca, cb); ya += ha * ca * w2a; yb += hb * cb * w2b;
            unpack8(b1, ha, hb); ya = ya * ha; yb = yb * hb;
            *(pg8::u32x4*)(p->ycat + (size_t)t * 1024 + c) = pack8(ya, yb); } }
    for (int u = lbid(); u < 768; u += gridDim.x) attn_unit<0>(p, l, u, smem);
    for (int u = lbid(); u < 768; u += gridDim.x) attn_unit<1>(p, l, u, smem);
    if (need_ctx) for (int u = lbid(); u < 48; u += gridDim.x) attn_unit<2>(p, l, u, smem);
}

__device__ __forceinline__ void phase_gemm_merge(ParamsC p, int l, unsigned char* smem) {
    const int tid = ltid(), lane = tid & 63, wid = tid >> 6, wm = wid >> 1, wn = wid & 1, q4 = (lane >> 4) * 4;
    const int ntok = (l < DEPTH - 1) ? T_ALL : T_LAT; const int nM = ntok / 128, nN = 8;
    for (int tile = lbid(); tile < nM * nN; tile += gridDim.x) {
        const int tm = tile / nN, tn = tile % nN, m0 = tm * 128, n0 = tn * 128;
        f32x4 macc[2][4]; zero_acc(macc);
        RowsLinear ar{p->ycat + (size_t)m0 * 1024, 1024};
#pragma unroll
        for (int seg = 0; seg < 3; ++seg) {
            const int k0 = seg == 0 ? 0 : (seg == 1 ? 256 : 640), k1 = seg == 0 ? 256 : (seg == 1 ? 640 : 1024);
            f32x4 acc[2][4]; zero_acc(acc);
            gemm_core(smem, ar, p->wt_br + (size_t)n0 * 1024, 1024, k0, k1, acc);
#pragma unroll
            for (int mi = 0; mi < 2; ++mi) { const int t = m0 + wm * 32 + mi * 16 + (lane & 15);
#pragma unroll
                for (int nj = 0; nj < 4; ++nj) { const uint2 g = *(const uint2*)(p->uG + (size_t)t * UG_LD + seg * 1024 + n0 + wn * 64 + nj * 16 + q4);
                    macc[mi][nj][0] += bf2f((bf16_t)(g.x & 0xffff)) * acc[mi][nj][0]; macc[mi][nj][1] += bf2f((bf16_t)(g.x >> 16)) * acc[mi][nj][1];
                    macc[mi][nj][2] += bf2f((bf16_t)(g.y & 0xffff)) * acc[mi][nj][2]; macc[mi][nj][3] += bf2f((bf16_t)(g.y >> 16)) * acc[mi][nj][3]; } }
        }
#pragma unroll
        for (int mi = 0; mi < 2; ++mi) { const int t = m0 + wm * 32 + mi * 16 + (lane & 15);
#pragma unroll
            for (int nj = 0; nj < 4; ++nj) store4bf(p->mbuf + (size_t)t * 1024 + n0 + wn * 64 + nj * 16 + q4, macc[mi][nj]); }
    }
}

__device__ __forceinline__ void phase_gemm_o(ParamsC p, int l, unsigned char* smem) {
    const int tid = ltid(), lane = tid & 63, wid = tid >> 6, wm = wid >> 1, wn = wid & 1, q4 = (lane >> 4) * 4;
    const int ntok = (l < DEPTH - 1) ? T_ALL : T_LAT; const int nM = ntok / 128, nN = 8;
    for (int tile = lbid(); tile < nM * nN; tile += gridDim.x) {
        const int tm = tile / nN, tn = tile % nN, m0 = tm * 128, n0 = tn * 128;
        f32x4 acc[2][4]; zero_acc(acc);
        RowsLinear ar{p->mbuf + (size_t)m0 * 1024, 1024};
        gemm_core(smem, ar, p->wt_o + (size_t)n0 * 1024, 1024, 0, 1024, acc);
#pragma unroll
        for (int mi = 0; mi < 2; ++mi) { const int t = m0 + wm * 32 + mi * 16 + (lane & 15); const float* gt = p->modv + (size_t)(l * 5 + tok_variant(t)) * 6144 + 2048;
#pragma unroll
            for (int nj = 0; nj < 4; ++nj) { const int c = n0 + wn * 64 + nj * 16 + q4; float4* xp = (float4*)(p->xs + (size_t)t * 1024 + c); float4 xv = *xp; const float4 g = *(const float4*)(gt + c);
                xv.x += g.x * acc[mi][nj][0]; xv.y += g.y * acc[mi][nj][1]; xv.z += g.z * acc[mi][nj][2]; xv.w += g.w * acc[mi][nj][3]; *xp = xv; } }
    }
}

#define RT_LD 1028
__device__ __forceinline__ void split8(const float (&x)[8], bf16x8& hi, bf16x8& lo) {
    pg8::u32x4 h, lw; float r[8];
    h.x = pack2(x[0], x[1]); h.y = pack2(x[2], x[3]); h.z = pack2(x[4], x[5]); h.w = pack2(x[6], x[7]);
    r[0] = x[0] - __uint_as_float(h.x << 16); r[1] = x[1] - __uint_as_float(h.x & 0xffff0000u); r[2] = x[2] - __uint_as_float(h.y << 16); r[3] = x[3] - __uint_as_float(h.y & 0xffff0000u);
    r[4] = x[4] - __uint_as_float(h.z << 16); r[5] = x[5] - __uint_as_float(h.z & 0xffff0000u); r[6] = x[6] - __uint_as_float(h.w << 16); r[7] = x[7] - __uint_as_float(h.w & 0xffff0000u);
    lw.x = pack2(r[0], r[1]); lw.y = pack2(r[2], r[3]); lw.z = pack2(r[4], r[5]); lw.w = pack2(r[6], r[7]);
    hi = __builtin_bit_cast(bf16x8, h); lo = __builtin_bit_cast(bf16x8, lw);
}
__device__ __forceinline__ void phase_router(ParamsC p, int l, float* smem) {
    const int tid = ltid(), lane = tid & 63, wid = tid >> 6;
    float* sh2 = smem;
    float* spart = smem + 16 * RT_LD;
    float* slg = spart + 8 * 16 * 48;
    int* bcnt = (int*)(slg + 16 * 36);
    if (tid < 32) bcnt[tid] = 0;
    const int ntok = (l < DEPTH - 1) ? T_ALL : T_LAT;
    const float* wre = p->w_re + (size_t)l * 1024 * 32; const float* wrg = p->w_rg + (size_t)l * 1024 * 4;
    bf16x8 bh[4][3], bl[4][3];
#pragma unroll
    for (int ks = 0; ks < 4; ++ks)
#pragma unroll
        for (int nt = 0; nt < 3; ++nt) { float w[8]; const int k0 = wid * 128 + ks * 32 + (lane >> 4) * 8, n = lane & 15;
#pragma unroll
            for (int j = 0; j < 8; ++j) w[j] = (nt < 2) ? wre[(size_t)(k0 + j) * 32 + nt * 16 + n] : (n < 4 ? wrg[(size_t)(k0 + j) * 4 + n] : 0.f);
            split8(w, bh[ks][nt], bl[ks][nt]); }
    float4 gf[4];
#pragma unroll
    for (int i = 0; i < 4; ++i) gf[i] = *(const float4*)(p->g_ffn + l * 1024 + i * 256 + lane * 4);
    const float* xs = p->xs; bf16_t* hout = p->h; const float* modv = p->modv + (size_t)l * 5 * 6144 + 3072;
    const int G = gridDim.x, ntb = ntok / 16;
    __syncthreads();
    for (int tb = lbid(); tb < ntb; tb += G) {
#pragma unroll
        for (int j = 0; j < 2; ++j) { const int tt = wid * 2 + j, t = tb * 16 + tt; const int v = tok_variant(t);
            float4 xv[4]; float ss = 0.f;
#pragma unroll
            for (int i = 0; i < 4; ++i) { xv[i] = *(const float4*)(xs + (size_t)t * 1024 + i * 256 + lane * 4); ss += xv[i].x * xv[i].x + xv[i].y * xv[i].y + xv[i].z * xv[i].z + xv[i].w * xv[i].w; }
            ss = wave_sum(ss); const float rstd = rsqrtf(ss * (1.0f / 1024.0f) + 1e-6f);
            const float* mv = modv + (size_t)v * 6144;
#pragma unroll
            for (int i = 0; i < 4; ++i) { const int c = i * 256 + lane * 4;
                const float4 g = gf[i], sh = *(const float4*)(mv + c), sc = *(const float4*)(mv + 1024 + c);
                float4 o; o.x = xv[i].x * rstd * g.x * (1.f + sc.x) + sh.x; o.y = xv[i].y * rstd * g.y * (1.f + sc.y) + sh.y; o.z = xv[i].z * rstd * g.z * (1.f + sc.z) + sh.z; o.w = xv[i].w * rstd * g.w * (1.f + sc.w) + sh.w;
                *(float4*)(sh2 + tt * RT_LD + c) = o; uint2 ob; ob.x = pack2(o.x, o.y); ob.y = pack2(o.z, o.w); *(uint2*)(hout + (size_t)t * 1024 + c) = ob; } }
        __syncthreads();
        {   f32x4 c0 = (f32x4){0.f, 0.f, 0.f, 0.f}, c1 = c0, c2 = c0;
            const float* ap = sh2 + (lane & 15) * RT_LD + wid * 128 + (lane >> 4) * 8;
#pragma unroll
            for (int ks = 0; ks < 4; ++ks) { const float4 a0 = *(const float4*)(ap + ks * 32), a1 = *(const float4*)(ap + ks * 32 + 4);
                const float x8[8] = {a0.x, a0.y, a0.z, a0.w, a1.x, a1.y, a1.z, a1.w}; bf16x8 ah, al; split8(x8, ah, al);
                c0 = __builtin_amdgcn_mfma_f32_16x16x32_bf16(ah, bh[ks][0], c0, 0, 0, 0); c0 = __builtin_amdgcn_mfma_f32_16x16x32_bf16(ah, bl[ks][0], c0, 0, 0, 0); c0 = __builtin_amdgcn_mfma_f32_16x16x32_bf16(al, bh[ks][0], c0, 0, 0, 0);
                c1 = __builtin_amdgcn_mfma_f32_16x16x32_bf16(ah, bh[ks][1], c1, 0, 0, 0); c1 = __builtin_amdgcn_mfma_f32_16x16x32_bf16(ah, bl[ks][1], c1, 0, 0, 0); c1 = __builtin_amdgcn_mfma_f32_16x16x32_bf16(al, bh[ks][1], c1, 0, 0, 0);
                c2 = __builtin_amdgcn_mfma_f32_16x16x32_bf16(ah, bh[ks][2], c2, 0, 0, 0); c2 = __builtin_amdgcn_mfma_f32_16x16x32_bf16(ah, bl[ks][2], c2, 0, 0, 0); c2 = __builtin_amdgcn_mfma_f32_16x16x32_bf16(al, bh[ks][2], c2, 0, 0, 0); }
#pragma unroll
            for (int r = 0; r < 4; ++r) { float* sp = spart + (wid * 16 + 4 * (lane >> 4) + r) * 48 + (lane & 15); sp[0] = c0[r]; sp[16] = c1[r]; sp[32] = c2[r]; } }
        __syncthreads();
        {   const int tt = tid >> 5, j = tid & 31; float a = p->b_re[l * 32 + j];
#pragma unroll
            for (int w8 = 0; w8 < 8; ++w8) a += spart[(w8 * 16 + tt) * 48 + j];
            slg[tt * 36 + 4 + j] = a;
            if (tid < 64) { const int t2 = tid >> 2, j2 = tid & 3; float a2 = p->b_rg[l * 4 + j2];
#pragma unroll
                for (int w8 = 0; w8 < 8; ++w8) a2 += spart[(w8 * 16 + t2) * 48 + 32 + j2];
                slg[t2 * 36 + j2] = a2; } }
        __syncthreads();
        if (tid < 16) { const int t = tb * 16 + tid; const float* lg = slg + tid * 36;
            int gi = 0; float gm = lg[0];
#pragma unroll
            for (int j = 1; j < 4; ++j) if (lg[j] > gm) { gm = lg[j]; gi = j; }
            float den = 0.f;
#pragma unroll
            for (int j = 0; j < 4; ++j) den += __expf(lg[j] - gm);
            const float pg = __builtin_amdgcn_rcpf(den);
            const float* le = lg + 4 + gi * 8;
            int i1 = 0; float v1 = le[0];
#pragma unroll
            for (int j = 1; j < 8; ++j) if (le[j] > v1) { v1 = le[j]; i1 = j; }
            int i2 = -1; float v2 = -3.0e38f;
#pragma unroll
            for (int j = 0; j < 8; ++j) if (j != i1 && le[j] > v2) { v2 = le[j]; i2 = j; }
            const float e2 = __expf(v2 - v1); const float wa = __builtin_amdgcn_rcpf(1.0f + e2), wb = e2 * wa;
            const int ea = gi * 8 + i1, eb = gi * 8 + i2;
            p->eid[t * 2] = ea; p->eid[t * 2 + 1] = eb; p->ewt[t * 2] = pg * wa; p->ewt[t * 2 + 1] = pg * wb;
            p->epos[t * 2] = atomicAdd(bcnt + ea, 1); p->epos[t * 2 + 1] = atomicAdd(bcnt + eb, 1); }
        __syncthreads();
    }
    __syncthreads();
    if (tid < 32) p->cnt[lbid() * 32 + tid] = bcnt[tid];
}

__device__ __forceinline__ void phase_dispatch(ParamsC p, int l, int* smem) {
    const int tid = ltid(), lane = tid & 63, wid = tid >> 6;
    int* sfull = smem;
    int* spre = smem + 512;
    int* pstart = smem + 1024;
    int* boff = smem + 1024 + 64;
    const int G = gridDim.x;
    {   const int e = tid & 31, part = tid >> 5; int sf = 0, sp = 0;
        for (int bb = part; bb < G; bb += 16) { const int c = p->cnt[bb * 32 + e]; sf += c; sp += (bb < lbid()) ? c : 0; }
        sfull[part * 32 + e] = sf; spre[part * 32 + e] = sp; }
    __syncthreads();
    if (tid < 32) { int tf = 0, tp = 0; for (int q = 0; q < 16; ++q) { tf += sfull[q * 32 + tid]; tp += spre[q * 32 + tid]; } sfull[tid] = tf; spre[tid] = tp; }
    __syncthreads();
    if (tid == 0) { int acc = 0; for (int e = 0; e < 32; ++e) { pstart[e] = acc; acc += ((sfull[e] + 255) >> 8) << 8; } pstart[32] = acc; }
    __syncthreads();
    if (tid < 32) boff[tid] = pstart[tid] + spre[tid];
    if (lbid() == 0) { const int nb = pstart[32] >> 8;
        for (int rb = tid; rb < nb; rb += NTHR) { int e = 0; while (e < 31 && pstart[e + 1] <= rb * 256) ++e; p->blk_e[rb] = e; }
        if (tid == 0) p->nbu[0] = nb; }
    __syncthreads();
    const int ntok = (l < DEPTH - 1) ? T_ALL : T_LAT;
    for (int tb = lbid(); tb < ntok / 16; tb += G) {
#pragma unroll
        for (int j = 0; j < 4; ++j) { const int a = tb * 32 + wid * 4 + j; const int t = a >> 1; const int sl = boff[p->eid[a]] + p->epos[a];
            if (lane == 0) { p->slot[a] = sl; p->tokmap[sl] = t; } }
    }
    for (int e = lbid(); e < 32; e += G) { const int lo = pstart[e] + sfull[e], hi = pstart[e + 1]; for (int sl = lo + tid; sl < hi; sl += NTHR) p->tokmap[sl] = 0; }
}

__device__ __forceinline__ void phase_gemm_e1(ParamsC p, unsigned char* smem) {
    const int tid = ltid(), lane = tid & 63, wid = tid >> 6, wm = wid >> 1, wn = wid & 1, q4 = (lane >> 4) * 4;
    const int nb = p->nbu[0]; const int ntiles = nb * 2 * 4;
    for (int tile = lbid(); tile < ntiles; tile += gridDim.x) {
        const int rb = tile >> 2, tn = tile & 3, m0 = rb * 128, e = p->blk_e[rb >> 1];
        f32x4 acc[2][4]; zero_acc(acc);
        RowsLinear ar{p->xd + (size_t)m0 * 1024, 1024};
        gemm_core(smem, ar, p->wt_gu + ((size_t)e * 512 + tn * 128) * 1024, 1024, 0, 1024, acc);
        const int pg = tn * 2 + wn;
#pragma unroll
        for (int mi = 0; mi < 2; ++mi) { const int sl = m0 + wm * 32 + mi * 16 + (lane & 15);
#pragma unroll
            for (int nj = 0; nj < 2; ++nj) { f32x4 g = acc[mi][nj], u = acc[mi][nj + 2], o;
#pragma unroll
                for (int e4 = 0; e4 < 4; ++e4) o[e4] = g[e4] / (1.f + __expf(-g[e4])) * u[e4];
                store4bf(p->hid + (size_t)sl * 256 + pg * 32 + nj * 16 + q4, o); } }
    }
}
__device__ __forceinline__ void phase_gemm_e2(ParamsC p, unsigned char* smem) {
    const int tid = ltid(), lane = tid & 63, wid = tid >> 6, wm = wid >> 1, wn = wid & 1, q4 = (lane >> 4) * 4;
    const int nb = p->nbu[0]; const int ntiles = nb * 2 * 8;
    for (int tile = lbid(); tile < ntiles; tile += gridDim.x) {
        const int rb = tile >> 3, tn = tile & 7, m0 = rb * 128, n0 = tn * 128, e = p->blk_e[rb >> 1];
        f32x4 acc[2][4]; zero_acc(acc);
        RowsLinear ar{p->hid + (size_t)m0 * 256, 256};
        gemm_core(smem, ar, p->wt_d + ((size_t)e * 1024 + n0) * 256, 256, 0, 256, acc);
#pragma unroll
        for (int mi = 0; mi < 2; ++mi) { const int sl = m0 + wm * 32 + mi * 16 + (lane & 15);
#pragma unroll
            for (int nj = 0; nj < 4; ++nj) store4bf(p->Y + (size_t)sl * 1024 + n0 + wn * 64 + nj * 16 + q4, acc[mi][nj]); }
    }
}


struct EpiIn { static constexpr bool PERM = true, AFTER_DRAIN = false, HOOK = false;
    bf16_t* uA; bf16_t* uG; const float* ropet;
    __device__ __forceinline__ void operator()(const f32x4 (&acc)[2][2][4][2], const pg8::Unit& u, int wr, int wc, int fr, int fq) const {
        const int row0 = u.pm * 256 + wr * 64 + fr; const bool latent = u.pm < 128;
#pragma unroll
        for (int bj = 0; bj < 2; ++bj) {
            const int cb32 = u.pn * 256 + bj * 128 + wc * 32, c0 = cb32 + 8 * fq;
            if (cb32 >= 2560) {
#pragma unroll
                for (int ai = 0; ai < 2; ++ai)
#pragma unroll
                    for (int m = 0; m < 4; ++m) { const int t = row0 + ai * 128 + m * 16; f32x4 v0 = acc[ai][bj][m][0], v1 = acc[ai][bj][m][1];
#pragma unroll
                        for (int e = 0; e < 4; ++e) { v0[e] = __builtin_amdgcn_rcpf(1.f + __expf(-v0[e])); v1[e] = __builtin_amdgcn_rcpf(1.f + __expf(-v1[e])); }
                        *(pg8::u32x4*)(uG + (size_t)t * UG_LD + (c0 - 2560)) = pack8(v0, v1); }
            } else {
                const bool isq = (cb32 >= 768 && cb32 < 1152) || (cb32 >= 1920 && cb32 < 2304);
                const bool rope = (cb32 >= 1920 && cb32 < 2432) && latent;
#pragma unroll
                for (int ai = 0; ai < 2; ++ai)
#pragma unroll
                    for (int m = 0; m < 4; ++m) { const int t = row0 + ai * 128 + m * 16; f32x4 v0 = acc[ai][bj][m][0], v1 = acc[ai][bj][m][1];
                        if (rope) { const int pos = t & 8191; const int posv = (wc & 1) ? (pos & 63) : (pos >> 6);
                            const float4* cs = (const float4*)(ropet + (posv * 16 + 8 * (fq & 1)) * 2);
                            const float4 c01 = cs[0], c23 = cs[1], c45 = cs[2], c67 = cs[3];
                            f32x4 p0, p1;
#pragma unroll
                            for (int e = 0; e < 4; ++e) { p0[e] = __shfl_xor(v0[e], 32); p1[e] = __shfl_xor(v1[e], 32); }
                            const float co0[4] = {c01.x, c01.z, c23.x, c23.z}, si0[4] = {c01.y, c01.w, c23.y, c23.w}, co1[4] = {c45.x, c45.z, c67.x, c67.z}, si1[4] = {c45.y, c45.w, c67.y, c67.w};
#pragma unroll
                            for (int e = 0; e < 4; ++e) {
                                if (fq < 2) { v0[e] = v0[e] * co0[e] - p0[e] * si0[e]; v1[e] = v1[e] * co1[e] - p1[e] * si1[e]; }
                                else { v0[e] = p0[e] * si0[e] + v0[e] * co0[e]; v1[e] = p1[e] * si1[e] + v1[e] * co1[e]; } } }
                        if (isq) { v0 = v0 * (0.125f * QLOG2E); v1 = v1 * (0.125f * QLOG2E); }
                        *(pg8::u32x4*)(uA + (size_t)t * UA_LD + c0) = pack8(v0, v1); }
            }
        }
    }
};

struct EpiMerge { static constexpr bool PERM = true, AFTER_DRAIN = false, HOOK = true;
    const bf16_t* uG; bf16_t* mo;
    __device__ __forceinline__ void hook(f32x4 (&acc)[2][2][4][2], const pg8::Unit& u, int t, int wr, int wc, int fr, int fq) const {
        int row0 = u.pm * 256 + wr * 64 + fr; asm volatile("" : "+v"(row0)); const int seg = (t == 2) ? 0 : 1;
        const bf16_t* gbase = uG + (size_t)row0 * UG_LD + seg * 1024 + u.pn * 256 + wc * 32 + 8 * fq;
#pragma unroll
        for (int ai = 0; ai < 2; ++ai) {
            pg8::u32x4 wn[4][2], wd[4][2];
#pragma unroll
            for (int m = 0; m < 4; ++m)
#pragma unroll
                for (int bj = 0; bj < 2; ++bj) { const bf16_t* gp = gbase + (size_t)(ai * 128 + m * 16) * UG_LD + bj * 128; wn[m][bj] = *(const pg8::u32x4*)gp; wd[m][bj] = *(const pg8::u32x4*)(gp + 1024); }
#pragma unroll
            for (int m = 0; m < 4; ++m)
#pragma unroll
                for (int bj = 0; bj < 2; ++bj) { f32x4 n0, n1, d0, d1; unpack8(wn[m][bj], n0, n1); unpack8(wd[m][bj], d0, d1);
#pragma unroll
                    for (int e = 0; e < 4; ++e) { acc[ai][bj][m][0][e] *= n0[e] * __builtin_amdgcn_rcpf(fmaxf(d0[e], 1e-20f)); acc[ai][bj][m][1][e] *= n1[e] * __builtin_amdgcn_rcpf(fmaxf(d1[e], 1e-20f)); } }
            asm volatile("" ::: "memory");
        }
    }
    __device__ __forceinline__ void operator()(const f32x4 (&acc)[2][2][4][2], const pg8::Unit& u, int wr, int wc, int fr, int fq) const {
        const int row0 = u.pm * 256 + wr * 64 + fr; const int c00 = u.pn * 256 + wc * 32 + 8 * fq;
#pragma unroll
        for (int ai = 0; ai < 2; ++ai) { pg8::u32x4 wg[4][2];
#pragma unroll
            for (int m = 0; m < 4; ++m)
#pragma unroll
                for (int bj = 0; bj < 2; ++bj) wg[m][bj] = *(const pg8::u32x4*)(uG + (size_t)(row0 + ai * 128 + m * 16) * UG_LD + 2048 + c00 + bj * 128);
#pragma unroll
            for (int m = 0; m < 4; ++m)
#pragma unroll
                for (int bj = 0; bj < 2; ++bj) { f32x4 g0, g1; unpack8(wg[m][bj], g0, g1); f32x4 v0 = acc[ai][bj][m][0], v1 = acc[ai][bj][m][1];
#pragma unroll
                    for (int e = 0; e < 4; ++e) { v0[e] *= fmaxf(g0[e], 1e-20f); v1[e] *= fmaxf(g1[e], 1e-20f); }
                    *(pg8::u32x4*)(mo + (size_t)(row0 + ai * 128 + m * 16) * 1024 + c00 + bj * 128) = pack8(v0, v1); }
            asm volatile("" ::: "memory"); }
    }
};

struct EpiO { static constexpr bool PERM = false, AFTER_DRAIN = false, HOOK = false;
    float* xs; const float* modv_l;
    __device__ __forceinline__ void operator()(const f32x4 (&acc)[2][2][4][2], const pg8::Unit& u, int wr, int wc, int fr, int fq) const {
        const int row0 = u.pm * 256 + wr * 64 + fr; const int v = u.pm < 128 ? (u.pm >> 5) : 4; const float* gt = modv_l + (size_t)v * 6144 + 2048;
        const int col0 = u.pn * 256 + wc * 32 + 4 * fq;
        f32x4 gv[2][2];
#pragma unroll
        for (int bj = 0; bj < 2; ++bj)
#pragma unroll
            for (int n = 0; n < 2; ++n) gv[bj][n] = *(const f32x4*)(gt + col0 + bj * 128 + n * 16);
#pragma unroll
        for (int ai = 0; ai < 2; ++ai)
#pragma unroll
            for (int mp = 0; mp < 2; ++mp) { f32x4 xv[2][2][2];
#pragma unroll
                for (int mm = 0; mm < 2; ++mm)
#pragma unroll
                    for (int bj = 0; bj < 2; ++bj)
#pragma unroll
                        for (int n = 0; n < 2; ++n) xv[mm][bj][n] = *(const f32x4*)(xs + (size_t)(row0 + ai * 128 + (mp * 2 + mm) * 16) * 1024 + col0 + bj * 128 + n * 16);
#pragma unroll
                for (int mm = 0; mm < 2; ++mm)
#pragma unroll
                    for (int bj = 0; bj < 2; ++bj)
#pragma unroll
                        for (int n = 0; n < 2; ++n) *(f32x4*)(xs + (size_t)(row0 + ai * 128 + (mp * 2 + mm) * 16) * 1024 + col0 + bj * 128 + n * 16) = xv[mm][bj][n] + gv[bj][n] * acc[ai][bj][mp * 2 + mm][n];
                asm volatile("" ::: "memory"); }
    }
};

struct EpiE1 { static constexpr bool PERM = true, AFTER_DRAIN = false, HOOK = false;
    bf16_t* hid;
    __device__ __forceinline__ void operator()(const f32x4 (&acc)[2][2][4][2], const pg8::Unit& u, int wr, int wc, int fr, int fq) const {
        const int row0 = u.pm * 256 + wr * 64 + fr; const int c0 = (u.pn & 1) * 128 + wc * 32 + 8 * fq;
#pragma unroll
        for (int ai = 0; ai < 2; ++ai)
#pragma unroll
            for (int m = 0; m < 4; ++m) { f32x4 o0, o1;
#pragma unroll
                for (int e = 0; e < 4; ++e) { const float g0 = acc[ai][0][m][0][e], g1 = acc[ai][0][m][1][e];
                    o0[e] = g0 * __builtin_amdgcn_rcpf(1.f + __expf(-g0)) * acc[ai][1][m][0][e]; o1[e] = g1 * __builtin_amdgcn_rcpf(1.f + __expf(-g1)) * acc[ai][1][m][1][e]; }
                *(pg8::u32x4*)(hid + (size_t)(row0 + ai * 128 + m * 16) * 256 + c0) = pack8(o0, o1); }
    }
};

struct EpiE2 { static constexpr bool PERM = true, AFTER_DRAIN = false, HOOK = false;
    bf16_t* Y;
    __device__ __forceinline__ void operator()(const f32x4 (&acc)[2][2][4][2], const pg8::Unit& u, int wr, int wc, int fr, int fq) const {
        const int row0 = u.pm * 256 + wr * 64 + fr; const int c0 = (u.pn & 3) * 256 + wc * 32 + 8 * fq;
#pragma unroll
        for (int ai = 0; ai < 2; ++ai)
#pragma unroll
            for (int m = 0; m < 4; ++m)
#pragma unroll
                for (int bj = 0; bj < 2; ++bj) *(pg8::u32x4*)(Y + (size_t)(row0 + ai * 128 + m * 16) * 1024 + c0 + bj * 128) = pack8(acc[ai][bj][m][0], acc[ai][bj][m][1]);
    }
};

__device__ __forceinline__ void phase_pg_in(ParamsC p, int l, unsigned char* smem) {
    pg8::Gemm g{p->h, WSEL(wt_in, l), T_ALL, IN_COLS, 1024, nullptr}; pg8::StaticOrder S; S.init(T_ALL, IN_COLS, (int)gridDim.x, lbid());
    EpiIn E{p->uA, p->uG, p->ropet};
    pg8::gemm_phase<EpiIn, pg8::StaticOrder, true, true>((PG8_LAS unsigned char*)smem, g, S, E);
}
__device__ __forceinline__ void phase_pg_merge(ParamsC p, int l, unsigned char* smem) {
    const int M = (l < DEPTH - 1) ? T_ALL : T_LAT;
    pg8::Gemm g{p->ycat, WSEL(wt_br, l), M, 1024, 1024, nullptr}; pg8::StaticOrder S; S.init(M, 1024, (int)gridDim.x, lbid());
    EpiMerge E{p->uG, p->mbuf};
    pg8::gemm_phase<EpiMerge, pg8::StaticOrder, true, true>((PG8_LAS unsigned char*)smem, g, S, E);
    if (l < DEPTH - 1) { const int G = (int)gridDim.x, extra = (M / 256) * 4 - 2 * G, c = lbid(); const bool part = extra > 0 && extra < G;
        const int first = part ? c - extra : c, stride = part ? G - extra : G;
        if (first >= 0) phase_wconv(p, l + 1, (float*)smem, 0, WC_TOTAL / 2, first, stride); }
}
__device__ __forceinline__ void phase_pg_o(ParamsC p, int l, unsigned char* smem) {
    const int M = (l < DEPTH - 1) ? T_ALL : T_LAT;
    pg8::Gemm g{p->mbuf, WSEL(wt_o, l), M, 1024, 1024, nullptr}; pg8::StaticOrder S; S.init(M, 1024, (int)gridDim.x, lbid());
    EpiO E{p->xs, p->modv + (size_t)l * 5 * 6144};
    pg8::gemm_phase<EpiO, pg8::StaticOrder, true, true>((PG8_LAS unsigned char*)smem, g, S, E);
    if (l < DEPTH - 1) { const int G = (int)gridDim.x, extra = (M / 256) * 4 - 2 * G, c = lbid(); const bool part = extra > 0 && extra < G;
        const int first = part ? c - extra : c, stride = part ? G - extra : G;
        if (first >= 0) phase_wconv(p, l + 1, (float*)smem, WC_TOTAL / 2, WC_TOTAL, first, stride); }
}
__device__ __forceinline__ void phase_pg_e1(ParamsC p, int l, unsigned char* smem) {
    const int nb = p->nbu[0];
    pg8::Gemm g{p->h, WSEL(wt_gu, l), nb * 256, 512, 1024, p->tokmap}; pg8::GroupedOrder<2> S{p->blk_e, nb * 2, (int)gridDim.x, lbid()};
    EpiE1 E{p->hid};
    pg8::gemm_phase<EpiE1, pg8::GroupedOrder<2>, true, true, true>((PG8_LAS unsigned char*)smem, g, S, E);
}
__device__ __forceinline__ void phase_pg_e2(ParamsC p, int l, unsigned char* smem) {
    const int nb = p->nbu[0];
    pg8::Gemm g{p->hid, WSEL(wt_d, l), nb * 256, 1024, 256, nullptr}; pg8::GroupedOrder<4> S{p->blk_e, nb * 4, (int)gridDim.x, lbid()};
    EpiE2 E{p->Y};
    pg8::gemm_phase<EpiE2, pg8::GroupedOrder<4>, true, true>((PG8_LAS unsigned char*)smem, g, S, E);
}

#define XB_TMO      128
#define XB_XCNT(j)  (256  + 64 * (j))
#define XB_XSUB(j)  (1280 + 64 * (j))
#define XB_XGEN(j)  (2304 + 64 * (j))
#define XB_TOP      3328
#define XB_TOPGEN   3392
#define XCD_BAR_WORDS 3456
#define XB_SPIN_CAP (1u << 18)
__device__ __forceinline__ unsigned xb_ld(unsigned* p)              { return __hip_atomic_load(p, __ATOMIC_RELAXED, __HIP_MEMORY_SCOPE_AGENT); }
__device__ __forceinline__ unsigned xb_add(unsigned* p, unsigned v) { return __hip_atomic_fetch_add(p, v, __ATOMIC_RELAXED, __HIP_MEMORY_SCOPE_AGENT); }
__device__ __forceinline__ unsigned xb_xcc_id() { return (unsigned)__builtin_amdgcn_s_getreg((3 << 11) | 20) & 0xFu; }
#define XB_SPIN(cond, bar) do { unsigned _sp = 0; while (cond) { __builtin_amdgcn_s_sleep(1); \
    if ((++_sp & 255u) == 0u) { if (xb_ld(&(bar)[XB_TMO])) break; if (_sp > XB_SPIN_CAP) { atomicAdd(&(bar)[XB_TMO], 1u); break; } } } } while (0)
struct XcdBarrier { unsigned* bar; unsigned x; volatile LAS unsigned* st; };
__device__ __forceinline__ XcdBarrier xcd_barrier_post(unsigned* bar, volatile LAS unsigned* st) {
    XcdBarrier b; b.bar = bar; b.x = xb_xcc_id(); b.st = st;
    if (threadIdx.x == 0) (void)xb_add(&bar[XB_XCNT(b.x)], 1u);
    return b;
}
__device__ __forceinline__ void xcd_barrier_complete(unsigned* bar, unsigned x, unsigned& nloc, unsigned& nx) {
    const unsigned G = gridDim.x * gridDim.y * gridDim.z;
    unsigned sum, cnt, mine, sp = 0u;
    for (;;) {
        sum = 0u; cnt = 0u; mine = 0u;
#pragma unroll
        for (unsigned j = 0; j < 16; ++j) { const unsigned c = xb_ld(&bar[XB_XCNT(j)]); sum += c; cnt += (c > 0u) ? 1u : 0u; mine = (j == x) ? c : mine; }
        if (sum == G) break;
        __builtin_amdgcn_s_sleep(1);
        if ((++sp & 255u) == 0u) { if (xb_ld(&bar[XB_TMO])) break; if (sp > XB_SPIN_CAP) { atomicAdd(&bar[XB_TMO], 1u); break; } }
    }
    nloc = mine > 0u ? mine : 1u; nx = cnt > 0u ? cnt : 1u;
}
__device__ __forceinline__ void xcd_barrier(const XcdBarrier& b) {
    asm volatile("s_waitcnt vmcnt(0)" ::: "memory");
    __syncthreads();
    if (threadIdx.x == 0) {
        unsigned* bar = b.bar;
        __builtin_amdgcn_s_waitcnt(0);
        unsigned nloc = b.st[0], nx = b.st[1];
        if (nloc == 0u) { xcd_barrier_complete(bar, b.x, nloc, nx); b.st[0] = nloc; b.st[1] = nx; }
        const unsigned old = xb_add(&bar[XB_XSUB(b.x)], 1u);
        const unsigned gen = old / nloc;
        if (old + 1u == (gen + 1u) * nloc) {
            __builtin_amdgcn_fence(__ATOMIC_RELEASE, "agent");
            asm volatile("s_waitcnt vmcnt(0)" ::: "memory");
            const unsigned og = xb_add(&bar[XB_TOP], 1u);
            const unsigned tg = og / nx;
            if (og + 1u == (tg + 1u) * nx) xb_add(&bar[XB_TOPGEN], 1u);
            else XB_SPIN(xb_ld(&bar[XB_TOPGEN]) == tg, bar);
            __builtin_amdgcn_fence(__ATOMIC_ACQUIRE, "agent");
            xb_add(&bar[XB_XGEN(b.x)], 1u);
            asm volatile("s_waitcnt vmcnt(0)" ::: "memory");
        } else {
            XB_SPIN(xb_ld(&bar[XB_XGEN(b.x)]) == gen, bar);
            __builtin_amdgcn_fence(__ATOMIC_ACQUIRE, "agent");
            asm volatile("s_waitcnt vmcnt(0)" ::: "memory");
        }
    }
    __syncthreads();
}

#define SMEM_BYTES 131072
#ifndef PROBE_MASK
#define PROBE_MASK 0
#endif
#define PROBE_MULT 4
#define PH_BEGIN(id) do { if (PROBE_MASK & (1 << (id))) t0 = wall_clock64(); } while (0)
#define PH_END(id) do { if (PROBE_MASK & (1 << (id))) tacc += wall_clock64() - t0; } while (0)
__global__ void __launch_bounds__(NTHR, 2) k_mega(Params p_unused) {
    const ParamsC pk = (ParamsC)__builtin_amdgcn_kernarg_segment_ptr();
#define PP() ({ ParamsC q_ = pk; asm volatile("" : "+s"(q_) :: "memory"); q_; })
    extern __shared__ __attribute__((aligned(16))) unsigned char smem[];
    volatile LAS unsigned* xbw = (volatile LAS unsigned*)(smem + SMEM_BYTES);
    if (threadIdx.x == 0) { xbw[0] = 0u; xbw[1] = 0u; xbw[2] = 0u; xbw[3] = 0u; }
    __syncthreads();
    (void)xcd_barrier_post(PP()->bar, xbw);
    unsigned long long tacc = 0, t0 = 0;
#define GRID_BAR() do { XcdBarrier bar_; bar_.bar = PP()->bar; bar_.x = xb_xcc_id(); bar_.st = xbw; xcd_barrier(bar_); } while (0)
    PH_BEGIN(0); phase_mod(PP(), (float*)smem); phase_wconv(PP(), 0, (float*)smem, 0, WC_TOTAL, lbid(), (int)gridDim.x); GRID_BAR(); PH_END(0);
    for (int l = 0; l < DEPTH; ++l) {
        PH_BEGIN(1); phase_norm1(PP(), l); GRID_BAR(); PH_END(1);
        PH_BEGIN(2); phase_pg_in(PP(), l, smem); GRID_BAR(); PH_END(2);
        PH_BEGIN(3); phase_mix2(PP(), l, smem); GRID_BAR(); PH_END(3);
        PH_BEGIN(4); phase_pg_merge(PP(), l, smem); GRID_BAR(); PH_END(4);
        PH_BEGIN(5); phase_pg_o(PP(), l, smem); GRID_BAR(); PH_END(5);
        PH_BEGIN(6); phase_router(PP(), l, (float*)smem); GRID_BAR(); PH_END(6);
        PH_BEGIN(7); phase_dispatch(PP(), l, (int*)smem); GRID_BAR(); PH_END(7);
        PH_BEGIN(8); phase_pg_e1(PP(), l, smem); GRID_BAR(); PH_END(8);
        PH_BEGIN(9); phase_pg_e2(PP(), l, smem); GRID_BAR(); PH_END(9);
    }
    PH_BEGIN(10); phase_norm1(PP(), DEPTH); PH_END(10);
    if (PROBE_MASK != 0 && blockIdx.x == 0) { const unsigned long long te = wall_clock64(); while (wall_clock64() - te < tacc * PROBE_MULT) __builtin_amdgcn_s_sleep(8); }
}

extern "C" void kernel_launch(void* const* d_in, const int* in_sizes, int n_in, void* d_out, int out_size, void* d_ws, size_t ws_size, hipStream_t stream) {
    Params p{};
    p.x = (const float*)d_in[0]; p.c = (const float*)d_in[1]; p.ctx = (const float*)d_in[2]; p.c_ctx = (const float*)d_in[3]; p.w_mod = (const float*)d_in[4]; p.b_mod = (const float*)d_in[5];
    p.g_attn = (const float*)d_in[6]; p.g_ffn = (const float*)d_in[7]; p.w_in = (const float*)d_in[8]; p.conv_w = (const float*)d_in[9]; p.rpb = (const float*)d_in[10]; p.sinks = (const float*)d_in[11];
    p.w_branch = (const float*)d_in[12]; p.w_o = (const float*)d_in[13]; p.w_rg = (const float*)d_in[14]; p.b_rg = (const float*)d_in[15]; p.w_re = (const float*)d_in[16]; p.b_re = (const float*)d_in[17];
    p.w_eg = (const float*)d_in[18]; p.w_eu = (const float*)d_in[19]; p.w_ed = (const float*)d_in[20]; p.g_final = (const float*)d_in[21];
    p.out = (float*)d_out;
    unsigned char* w = (unsigned char*)d_ws; size_t off = 0;
    auto take = [&](size_t bytes) { unsigned char* r = w + off; off += (bytes + 255) & ~(size_t)255; return r; };
    p.bar = (unsigned*)take(16384); p.cnt = (int*)take(1024 * 32 * 4); p.blk_e = (int*)take(MAXBLK * 4); p.nbu = (int*)take(256);
    p.modv = (float*)take((size_t)DEPTH * 5 * 6144 * 4); p.ropet = (float*)take(128 * 16 * 2 * 4);
    p.eid = (int*)take((size_t)T_ALL * 2 * 4); p.epos = (int*)take((size_t)T_ALL * 2 * 4); p.ewt = (float*)take((size_t)T_ALL * 2 * 4); p.slot = (int*)take((size_t)T_ALL * 2 * 4); p.tokmap = (int*)take((size_t)MAXBLK * 256 * 4);
    p.xs = (float*)take((size_t)T_ALL * 1024 * 4);
    p.h = (bf16_t*)take((size_t)T_ALL * 1024 * 2);
    p.wt_in = (bf16_t*)take((size_t)IN_COLS * 1024 * 2); p.wt_br = (bf16_t*)take((size_t)1024 * 1024 * 2); p.wt_o = (bf16_t*)take((size_t)1024 * 1024 * 2);
    p.wt_gu = (bf16_t*)take((size_t)32 * 512 * 1024 * 2); p.wt_d = (bf16_t*)take((size_t)32 * 1024 * 256 * 2);
    {   unsigned char* o = (unsigned char*)d_out; size_t oo = 0;
        auto take_o = [&](size_t bytes) { unsigned char* r = o + oo; oo += (bytes + 255) & ~(size_t)255; return r; };
        p.wt_in1 = (bf16_t*)take_o((size_t)IN_COLS * 1024 * 2); p.wt_br1 = (bf16_t*)take_o((size_t)1024 * 1024 * 2); p.wt_o1 = (bf16_t*)take_o((size_t)1024 * 1024 * 2);
        p.wt_gu1 = (bf16_t*)take_o((size_t)32 * 512 * 1024 * 2); p.wt_d1 = (bf16_t*)take_o((size_t)32 * 1024 * 256 * 2);
        if (oo > (size_t)out_size * 4) return; }
    p.uA = (bf16_t*)take((size_t)T_ALL * UA_LD * 2); p.uG = (bf16_t*)take((size_t)T_ALL * UG_LD * 2); p.ycat = (bf16_t*)take((size_t)T_ALL * 1024 * 2);
    p.mbuf = p.uA; p.xd = p.uA; p.hid = p.ycat; p.Y = p.uG;
    if (off > ws_size) return;
    constexpr size_t kDynLds = SMEM_BYTES + 16;
    static int grid = 0;
    if (!grid) {
        (void)hipFuncSetAttribute((const void*)k_mega, hipFuncAttributeMaxDynamicSharedMemorySize, (int)kDynLds);
        int dev = 0, cus = 0, per_cu = 0;
        (void)hipGetDevice(&dev);
        (void)hipDeviceGetAttribute(&cus, hipDeviceAttributeMultiprocessorCount, dev);
        (void)hipOccupancyMaxActiveBlocksPerMultiprocessor(&per_cu, (const void*)k_mega, NTHR, kDynLds);
        grid = cus * (per_cu < 1 ? per_cu : 1);
        if (grid <= 0) grid = 0;
    }
    if (!grid) return;
    (void)hipMemsetAsync(p.bar, 0, XCD_BAR_WORDS * sizeof(unsigned), stream);
    hipLaunchKernelGGL(k_mega, dim3(grid), dim3(NTHR), kDynLds, stream, p);
}
```

```cpp
#include <hip/hip_runtime.h>
#include <stdint.h>

typedef unsigned short bf16_t;
typedef short bf16x8 __attribute__((ext_vector_type(8)));
typedef float f32x4 __attribute__((ext_vector_type(4)));

#define D_MODEL 1024
#define NB 4
#define SEQ 8192
#define DEPTH 4
#define CTXL 256
#define T_LAT 32768
#define T_CTX 1024
#define T_ALL 33792
#define UA_LD 2560
#define UG_LD 3072
#define IN_COLS 5632
#define MAXBLK 296
#define NTHR 512
#ifndef PROBE_SUB
#define PROBE_SUB 0
#endif
#define SUB_T0(id) unsigned long long st0_ = 0; if (PROBE_SUB == (id) && threadIdx.x == 0) st0_ = wall_clock64();
#define SUB_ACC(id) if (PROBE_SUB == (id) && threadIdx.x == 0) { volatile LAS unsigned* sw_ = (volatile LAS unsigned*)(smem + 131072 + 8); sw_[0] = sw_[0] + (unsigned)(wall_clock64() - st0_); }
#define QLOG2E 1.4426950408889634f
#ifndef PGM
#define PGM 31
#endif
#define LAS __attribute__((address_space(3)))

struct Params {
    const float *x, *c, *ctx, *c_ctx, *w_mod, *b_mod, *g_attn, *g_ffn, *w_in, *conv_w, *rpb, *sinks, *w_branch, *w_o, *w_rg, *b_rg, *w_re, *b_re, *w_eg, *w_eu, *w_ed, *g_final;
    float* out;
    unsigned* bar; int* cnt; int* blk_e; int* nbu;
    float* modv; float* ropet; float* xs;
    bf16_t *h, *wt_in, *wt_br, *wt_o, *wt_gu, *wt_d, *uA, *uG, *ycat, *mbuf, *xd, *hid, *Y;
    int* eid; int* epos; float* ewt; int* slot; int* tokmap;
    bf16_t *wt_in1, *wt_br1, *wt_o1, *wt_gu1, *wt_d1;
};
typedef const __attribute__((address_space(4))) Params* ParamsC;
#define WSEL(X, l) (((l) & 1) ? p->X##1 : p->X)

__device__ __forceinline__ int lbid() { int b = blockIdx.x; asm volatile("" : "+s"(b) :: "memory"); return b; }
__device__ __forceinline__ int ltid() { int t = threadIdx.x; asm volatile("" : "+v"(t) :: "memory"); return t; }
__device__ __forceinline__ bf16_t f2bf(float f) { unsigned u = __float_as_uint(f); u += 0x7FFFu + ((u >> 16) & 1u); return (bf16_t)(u >> 16); }
__device__ __forceinline__ float bf2f(bf16_t b) { return __uint_as_float(((unsigned)b) << 16); }
typedef float f32x2_t __attribute__((ext_vector_type(2)));
typedef __bf16 bf16x2_t __attribute__((ext_vector_type(2)));
__device__ __forceinline__ unsigned pack2(float a, float b) { const f32x2_t v = {a, b}; const bf16x2_t r = __builtin_convertvector(v, bf16x2_t); return __builtin_bit_cast(unsigned, r); }
__device__ __forceinline__ float wave_sum(float v) { for (int o = 32; o > 0; o >>= 1) v += __shfl_xor(v, o); return v; }
__device__ __forceinline__ float wave_max(float v) { for (int o = 32; o > 0; o >>= 1) v = fmaxf(v, __shfl_xor(v, o)); return v; }
__device__ __forceinline__ int tok_variant(int t) { return t < T_LAT ? (t >> 13) : 4; }

__device__ __forceinline__ void phase_mod(ParamsC p, float* smem) {
    const int tid = ltid(), lane = tid & 63, wid = tid >> 6;
    float* s_silu = smem;
    float* s_part = smem + 5 * 1024;
    for (int i = tid; i < 5 * 1024; i += NTHR) { const int v = i >> 10, k = i & 1023; const float cv = v < 4 ? p->c[v * 1024 + k] : p->c_ctx[k]; s_silu[i] = cv / (1.0f + expf(-cv)); }
    __syncthreads();
    for (int item = lbid(); item < DEPTH * 96; item += gridDim.x) {
        const int l = item / 96, cb = item % 96, col = cb * 64 + lane;
        const float* w = p->w_mod + (size_t)l * 1024 * 6144 + col;
        float a0 = 0.f, a1 = 0.f, a2 = 0.f, a3 = 0.f, a4 = 0.f;
#pragma unroll 8
        for (int kk = 0; kk < 128; ++kk) { const int k = wid * 128 + kk; const float wv = w[(size_t)k * 6144];
            a0 += s_silu[k] * wv; a1 += s_silu[1024 + k] * wv; a2 += s_silu[2048 + k] * wv; a3 += s_silu[3072 + k] * wv; a4 += s_silu[4096 + k] * wv; }
        s_part[(wid * 5 + 0) * 64 + lane] = a0; s_part[(wid * 5 + 1) * 64 + lane] = a1; s_part[(wid * 5 + 2) * 64 + lane] = a2; s_part[(wid * 5 + 3) * 64 + lane] = a3; s_part[(wid * 5 + 4) * 64 + lane] = a4;
        __syncthreads();
        if (tid < 320) { const int v = tid >> 6, ln = tid & 63; float s = p->b_mod[l * 6144 + cb * 64 + ln];
            for (int w8 = 0; w8 < 8; ++w8) s += s_part[(w8 * 5 + v) * 64 + ln];
            p->modv[(size_t)(l * 5 + v) * 6144 + cb * 64 + ln] = s; }
        __syncthreads();
    }
    if (lbid() < 4) { const int i = lbid() * NTHR + tid; const int pos = i >> 4, f = i & 15;
        const float inv = powf(10000.0f, -(float)f / 16.0f); const float ang = (float)pos * inv; p->ropet[i * 2] = cosf(ang); p->ropet[i * 2 + 1] = sinf(ang); }
}

#define GU_IG 128
struct WcTile { const float* src; bf16_t* dst; int ldN, ldK, kt, nt, kind, e; };
__device__ __forceinline__ WcTile wconv_decode(ParamsC p, int l, int it) {
    const int n1 = 16 * 88, n2 = 256, n3 = 256, n4 = 2048, n5 = 2048;
    WcTile w; w.kind = 0; w.e = 0; int i = it;
    if (i < n1) { w.src = p->w_in + (size_t)l * 1024 * IN_COLS; w.ldN = IN_COLS; w.dst = WSEL(wt_in, l); w.ldK = 1024; w.kt = i / 88; w.nt = i % 88; }
    else if ((i -= n1) < n2) { w.src = p->w_branch + (size_t)l * 1024 * 1024; w.ldN = 1024; w.dst = WSEL(wt_br, l); w.ldK = 1024; w.kt = i / 16; w.nt = i % 16; }
    else if ((i -= n2) < n3) { w.src = p->w_o + (size_t)l * 1024 * 1024; w.ldN = 1024; w.dst = WSEL(wt_o, l); w.ldK = 1024; w.kt = i / 16; w.nt = i % 16; }
    else if ((i -= n3) < n4) { w.e = i / 64; i %= 64; w.src = p->w_eg + ((size_t)l * 32 + w.e) * 1024 * 256; w.ldN = 256; w.dst = WSEL(wt_gu, l); w.ldK = 1024; w.kt = i / 4; w.nt = i % 4; w.kind = 1; }
    else if ((i -= n4) < n5) { w.e = i / 64; i %= 64; w.src = p->w_eu + ((size_t)l * 32 + w.e) * 1024 * 256; w.ldN = 256; w.dst = WSEL(wt_gu, l); w.ldK = 1024; w.kt = i / 4; w.nt = i % 4; w.kind = 2; }
    else { i -= n5; w.e = i / 64; i %= 64; w.src = p->w_ed + ((size_t)l * 32 + w.e) * 256 * 1024; w.ldN = 1024; w.dst = WSEL(wt_d, l) + (size_t)w.e * 1024 * 256; w.ldK = 256; w.kt = i / 16; w.nt = i % 16; }
    return w;
}
#define WC_TOTAL (16 * 88 + 256 + 256 + 2048 * 3)
__device__ __forceinline__ void phase_wconv(ParamsC p, int l, float* smem, int lo, int hi, int first, int stride) {
    const int tid = ltid();
    float* tile = smem;
    const int r = tid >> 4, c4 = tid & 15;
    int it = lo + first; if (it >= hi) return;
    WcTile w = wconv_decode(p, l, it);
    float4 v0 = *(const float4*)(w.src + (size_t)(w.kt * 64 + r) * w.ldN + w.nt * 64 + c4 * 4), v1 = *(const float4*)(w.src + (size_t)(w.kt * 64 + r + 32) * w.ldN + w.nt * 64 + c4 * 4);
    for (;;) {
        tile[r * 65 + c4 * 4 + 0] = v0.x; tile[r * 65 + c4 * 4 + 1] = v0.y; tile[r * 65 + c4 * 4 + 2] = v0.z; tile[r * 65 + c4 * 4 + 3] = v0.w;
        tile[(r + 32) * 65 + c4 * 4 + 0] = v1.x; tile[(r + 32) * 65 + c4 * 4 + 1] = v1.y; tile[(r + 32) * 65 + c4 * 4 + 2] = v1.z; tile[(r + 32) * 65 + c4 * 4 + 3] = v1.w;
        __syncthreads();
        const int nit = it + stride; WcTile wn = w;
        if (nit < hi) { wn = wconv_decode(p, l, nit);
            v0 = *(const float4*)(wn.src + (size_t)(wn.kt * 64 + r) * wn.ldN + wn.nt * 64 + c4 * 4); v1 = *(const float4*)(wn.src + (size_t)(wn.kt * 64 + r + 32) * wn.ldN + wn.nt * 64 + c4 * 4); }
        {   const int n = tid >> 3, kc = tid & 7; const int ncol = w.nt * 64 + n; int drow = ncol;
            if (w.kind) drow = w.e * 512 + (ncol / GU_IG) * (2 * GU_IG) + (w.kind == 2 ? GU_IG : 0) + (ncol % GU_IG);
            uint4 o; o.x = pack2(tile[(kc * 8 + 0) * 65 + n], tile[(kc * 8 + 1) * 65 + n]); o.y = pack2(tile[(kc * 8 + 2) * 65 + n], tile[(kc * 8 + 3) * 65 + n]);
            o.z = pack2(tile[(kc * 8 + 4) * 65 + n], tile[(kc * 8 + 5) * 65 + n]); o.w = pack2(tile[(kc * 8 + 6) * 65 + n], tile[(kc * 8 + 7) * 65 + n]);
            *(uint4*)(w.dst + (size_t)drow * w.ldK + w.kt * 64 + kc * 8) = o; }
        __syncthreads();
        if (nit >= hi) break;
        it = nit; w = wn;
    }
}

__device__ __forceinline__ void phase_norm1(ParamsC p, int l) {
    const int tid = ltid(), lane = tid & 63, wid = tid >> 6;
    const int ntok = (l == DEPTH) ? T_LAT : T_ALL;
    for (int t = lbid() * 8 + wid; t < ntok; t += gridDim.x * 8) {
        const int v = tok_variant(t);
        float4 xv[4];
        if (l == 0) {
            const float* src = t < T_LAT ? p->x + (size_t)t * 1024 : p->ctx + (size_t)(t - T_LAT) * 1024;
#pragma unroll
            for (int i = 0; i < 4; ++i) xv[i] = *(const float4*)(src + i * 256 + lane * 4);
        } else {
            const float* src = p->xs + (size_t)t * 1024;
#pragma unroll
            for (int i = 0; i < 4; ++i) xv[i] = *(const float4*)(src + i * 256 + lane * 4);
            const bool had_moe = (l - 1 < DEPTH - 1) || t < T_LAT;
            if (had_moe) {
                const int s0 = p->slot[t * 2], s1 = p->slot[t * 2 + 1]; const float w0 = p->ewt[t * 2], w1 = p->ewt[t * 2 + 1];
                const float* gt = p->modv + (size_t)((l - 1) * 5 + v) * 6144 + 5120;
#pragma unroll
                for (int i = 0; i < 4; ++i) { const int c = i * 256 + lane * 4;
                    const uint2 y0 = *(const uint2*)(p->Y + (size_t)s0 * 1024 + c), y1 = *(const uint2*)(p->Y + (size_t)s1 * 1024 + c);
                    const float4 g = *(const float4*)(gt + c);
                    xv[i].x += g.x * (w0 * bf2f((bf16_t)(y0.x & 0xffff)) + w1 * bf2f((bf16_t)(y1.x & 0xffff)));
                    xv[i].y += g.y * (w0 * bf2f((bf16_t)(y0.x >> 16)) + w1 * bf2f((bf16_t)(y1.x >> 16)));
                    xv[i].z += g.z * (w0 * bf2f((bf16_t)(y0.y & 0xffff)) + w1 * bf2f((bf16_t)(y1.y & 0xffff)));
                    xv[i].w += g.w * (w0 * bf2f((bf16_t)(y0.y >> 16)) + w1 * bf2f((bf16_t)(y1.y >> 16))); }
            }
        }
        float ss = 0.f;
#pragma unroll
        for (int i = 0; i < 4; ++i) ss += xv[i].x * xv[i].x + xv[i].y * xv[i].y + xv[i].z * xv[i].z + xv[i].w * xv[i].w;
        ss = wave_sum(ss);
        const float rstd = rsqrtf(ss * (1.0f / 1024.0f) + 1e-6f);
        if (l == DEPTH) {
#pragma unroll
            for (int i = 0; i < 4; ++i) { const int c = i * 256 + lane * 4; const float4 g = *(const float4*)(p->g_final + c);
                float4 o; o.x = xv[i].x * rstd * g.x; o.y = xv[i].y * rstd * g.y; o.z = xv[i].z * rstd * g.z; o.w = xv[i].w * rstd * g.w;
                *(float4*)(p->out + (size_t)t * 1024 + c) = o; }
        } else {
            const float* mv = p->modv + (size_t)(l * 5 + v) * 6144;
#pragma unroll
            for (int i = 0; i < 4; ++i) { const int c = i * 256 + lane * 4;
                *(float4*)(p->xs + (size_t)t * 1024 + c) = xv[i];
                const float4 g = *(const float4*)(p->g_attn + l * 1024 + c), sh = *(const float4*)(mv + c), sc = *(const float4*)(mv + 1024 + c);
                uint2 o; o.x = pack2(xv[i].x * rstd * g.x * (1.f + sc.x) + sh.x, xv[i].y * rstd * g.y * (1.f + sc.y) + sh.y);
                o.y = pack2(xv[i].z * rstd * g.z * (1.f + sc.z) + sh.z, xv[i].w * rstd * g.w * (1.f + sc.w) + sh.w);
                *(uint2*)(p->h + (size_t)t * 1024 + c) = o; }
        }
    }
}

#define SG_STRIDE 144
#define SG_BOFF (128 * SG_STRIDE)
struct RowsLinear { const bf16_t* base; size_t ld; __device__ __forceinline__ const bf16_t* operator()(int r) const { return base + (size_t)r * ld; } };
template <class ARow>
__device__ __forceinline__ void gemm_core(unsigned char* smem, const ARow& arow, const bf16_t* Bt, size_t ldb, int k0, int k1, f32x4 (&acc)[2][4]) {
    const int tid = ltid(), lane = tid & 63, wid = tid >> 6, wm = wid >> 1, wn = wid & 1;
    const int row0 = tid >> 3, kc = tid & 7;
    const bf16_t* pa0 = arow(row0) + kc * 8; const bf16_t* pa1 = arow(row0 + 64) + kc * 8;
    const bf16_t* pb0 = Bt + (size_t)row0 * ldb + kc * 8; const bf16_t* pb1 = Bt + (size_t)(row0 + 64) * ldb + kc * 8;
    const int soff0 = row0 * SG_STRIDE + kc * 16, soff1 = soff0 + 64 * SG_STRIDE;
    uint4 ra0 = *(const uint4*)(pa0 + k0), ra1 = *(const uint4*)(pa1 + k0), rb0 = *(const uint4*)(pb0 + k0), rb1 = *(const uint4*)(pb1 + k0);
    const int fa = (wm * 32 + (lane & 15)) * SG_STRIDE + (lane >> 4) * 16, fb = SG_BOFF + (wn * 64 + (lane & 15)) * SG_STRIDE + (lane >> 4) * 16;
    for (int k = k0; k < k1; k += 64) {
        __syncthreads();
        *(uint4*)(smem + soff0) = ra0; *(uint4*)(smem + soff1) = ra1; *(uint4*)(smem + SG_BOFF + soff0) = rb0; *(uint4*)(smem + SG_BOFF + soff1) = rb1;
        __syncthreads();
        if (k + 64 < k1) { ra0 = *(const uint4*)(pa0 + k + 64); ra1 = *(const uint4*)(pa1 + k + 64); rb0 = *(const uint4*)(pb0 + k + 64); rb1 = *(const uint4*)(pb1 + k + 64); }
#pragma unroll
        for (int ks = 0; ks < 2; ++ks) {
            const bf16x8 af0 = *(const bf16x8*)(smem + fa + ks * 64), af1 = *(const bf16x8*)(smem + fa + 16 * SG_STRIDE + ks * 64);
            const bf16x8 b0 = *(const bf16x8*)(smem + fb + ks * 64), b1 = *(const bf16x8*)(smem + fb + 16 * SG_STRIDE + ks * 64);
            const bf16x8 b2 = *(const bf16x8*)(smem + fb + 32 * SG_STRIDE + ks * 64), b3 = *(const bf16x8*)(smem + fb + 48 * SG_STRIDE + ks * 64);
            acc[0][0] = __builtin_amdgcn_mfma_f32_16x16x32_bf16(b0, af0, acc[0][0], 0, 0, 0); acc[0][1] = __builtin_amdgcn_mfma_f32_16x16x32_bf16(b1, af0, acc[0][1], 0, 0, 0);
            acc[0][2] = __builtin_amdgcn_mfma_f32_16x16x32_bf16(b2, af0, acc[0][2], 0, 0, 0); acc[0][3] = __builtin_amdgcn_mfma_f32_16x16x32_bf16(b3, af0, acc[0][3], 0, 0, 0);
            acc[1][0] = __builtin_amdgcn_mfma_f32_16x16x32_bf16(b0, af1, acc[1][0], 0, 0, 0); acc[1][1] = __builtin_amdgcn_mfma_f32_16x16x32_bf16(b1, af1, acc[1][1], 0, 0, 0);
            acc[1][2] = __builtin_amdgcn_mfma_f32_16x16x32_bf16(b2, af1, acc[1][2], 0, 0, 0); acc[1][3] = __builtin_amdgcn_mfma_f32_16x16x32_bf16(b3, af1, acc[1][3], 0, 0, 0);
        }
    }
}
__device__ __forceinline__ void zero_acc(f32x4 (&acc)[2][4]) {
#pragma unroll
    for (int a = 0; a < 2; ++a)
#pragma unroll
        for (int b = 0; b < 4; ++b) acc[a][b] = (f32x4){0.f, 0.f, 0.f, 0.f};
}
__device__ __forceinline__ void store4bf(bf16_t* dst, f32x4 v) { uint2 o; o.x = pack2(v[0], v[1]); o.y = pack2(v[2], v[3]); *(uint2*)dst = o; }


namespace pg8 {
#define PG8_LAS __attribute__((address_space(3)))
typedef unsigned u32x4 __attribute__((ext_vector_type(4)));
constexpr int BM = 256, BK = 64, HALF = 128, HTB = HALF * BK * 2, STAGE_BYTES = 8 * HTB, NXCD = 8, WGM = 8;
__host__ __device__ __forceinline__ int lds_byte(int r, int c) { const int st = (r >> 4) * 2 + (c >> 5), rr = r & 15, cc = c & 31, ob = rr * 64 + cc * 2; return st * 1024 + (ob ^ (((ob >> 9) & 1) << 5)); }
__host__ __device__ __forceinline__ void stage_rc(int b, int& R, int& C) { const int st = b / 1024, sb = b % 1024, swz = sb ^ (((sb >> 9) & 1) << 5); R = (st >> 1) * 16 + swz / 64; C = (st & 1) * 32 + (swz % 64) / 2; }
__host__ __device__ __forceinline__ int perm32(int rho) { const int n = rho >> 4, i = rho & 15; return 8 * (i >> 2) + 4 * n + (i & 3); }
struct Unit { int pm, pn; };
struct Gemm { const bf16_t* A; const bf16_t* Bt; int M, N, K; const int* rowmap; };
struct StaticOrder {
    int nM, nN, nwg, G, c;
    __device__ void init(int M, int N, int G_, int c_) { nM = M / BM; nN = N / BM; nwg = nM * nN; G = G_; c = c_; }
    __device__ bool next(int i, Unit& u) const {
        const long L = (long)i * G + c; if (L >= nwg) return false;
        int wgid = (int)L; { const int q = nwg / NXCD, r = nwg % NXCD, xcd = wgid % NXCD, off = wgid / NXCD; wgid = (xcd < r ? xcd * (q + 1) : r * (q + 1) + (xcd - r) * q) + off; }
        const int nig = WGM * nN, gid = wgid / nig, fm = gid * WGM, gsz = (nM - fm) < WGM ? (nM - fm) : WGM;
        u.pm = fm + ((wgid % nig) % gsz); u.pn = (wgid % nig) / gsz; return true;
    }
    __device__ __forceinline__ void a_ready(const Unit&) const {}
    __device__ __forceinline__ void done(const Unit&) const {}
};
template <int NT> struct GroupedOrder {
    const int* blk_e; int nunits, G, c;
    __device__ bool next(int i, Unit& u) const { const long L = (long)i * G + c; if (L >= nunits) return false; const int rb = (int)L / NT; u.pm = rb; u.pn = blk_e[rb] * NT + (int)L % NT; return true; }
    __device__ __forceinline__ void a_ready(const Unit&) const {}
    __device__ __forceinline__ void done(const Unit&) const {}
};
template <class Epi, class Sched, bool ALIGN_EPI = false, bool SP2 = false, bool GATHER = false>
__device__ __forceinline__ void gemm_phase(PG8_LAS unsigned char* lds, const Gemm g, const Sched& S, const Epi& E) {
    const int tid = ltid(), wid = __builtin_amdgcn_readfirstlane(tid >> 6), lane = tid & 63, wr = wid >> 2, wc = wid & 3, fr = lane & 15, fq = lane >> 4;
    int K = g.K; asm volatile("" : "+s"(K)); const int nt = K / BK;
    unsigned voffA[2], voffB[2];
#pragma unroll
    for (int i = 0; i < 2; ++i) { int R, C; stage_rc(tid * 16 + i * 8192, R, C); const int Rb = Epi::PERM ? ((R & ~31) + perm32(R & 31)) : R;
        voffA[i] = (unsigned)(R * K + C) * 2u; voffB[i] = (unsigned)(Rb * K + C) * 2u; }
    const size_t kstep = (size_t)(BK * 2);
    const size_t hstep = (size_t)HALF * K * 2;
    const size_t tstep = 2 * hstep;
    const unsigned ldsw = (unsigned)wid * 1024u;
    const int aoff = lds_byte(wr * 64 + fr, fq * 8), boff = lds_byte(wc * 32 + fr, fq * 8);
#define PG8_SA(b, h) (((b) * 2 + (h)) * HTB)
#define PG8_SB(b, h) ((4 + (b) * 2 + (h)) * HTB)
#define PG8_STAGE(bufoff, gbase, voff) do { _Pragma("unroll") for (int _i = 0; _i < 2; ++_i) \
        __builtin_amdgcn_global_load_lds((const unsigned*)((const char*)(gbase) + (voff)[_i]), (PG8_LAS unsigned*)(lds + (bufoff) + ldsw + _i * 8192), 16, 0, 0); } while (0)
#define PG8_STAGE_A(bufoff, gptr, hf) do { if constexpr (GATHER) { _Pragma("unroll") for (int _i = 0; _i < 2; ++_i) \
        __builtin_amdgcn_global_load_lds((const unsigned*)((const char*)(gptr) + gC[hf][_i]), (PG8_LAS unsigned*)(lds + (bufoff) + ldsw + _i * 8192), 16, 0, 0); } \
        else { PG8_STAGE(bufoff, (gptr) + (hf) * hstep, voffA); } } while (0)
#define PG8_LOAD_GOFF(pm_) do { _Pragma("unroll") for (int _h = 0; _h < 2; ++_h) _Pragma("unroll") for (int _i = 0; _i < 2; ++_i) { int R_, C_; stage_rc(tid * 16 + _i * 8192, R_, C_); \
        gC[_h][_i] = (unsigned)(g.rowmap[(pm_) * 256 + _h * 128 + R_] * K + C_) * 2u; } } while (0)
#define PG8_LDA(dst, b, h) do { _Pragma("unroll") for (int m = 0; m < 4; ++m) _Pragma("unroll") for (int k = 0; k < 2; ++k) dst[m][k] = *(const PG8_LAS bf16x8*)(lds + PG8_SA(b, h) + aoff + m * 2048 + k * 1024); } while (0)
#define PG8_LDB(dst, b, h) do { _Pragma("unroll") for (int n = 0; n < 2; ++n) _Pragma("unroll") for (int k = 0; k < 2; ++k) dst[n][k] = *(const PG8_LAS bf16x8*)(lds + PG8_SB(b, h) + boff + n * 2048 + k * 1024); } while (0)
#define PG8_MMA(ai, bj, At, Bt) do { __builtin_amdgcn_s_setprio(1); _Pragma("unroll") for (int m = 0; m < 4; ++m) _Pragma("unroll") for (int n = 0; n < 2; ++n) _Pragma("unroll") for (int k = 0; k < 2; ++k) \
        acc[ai][bj][m][n] = __builtin_amdgcn_mfma_f32_16x16x32_bf16(Bt[n][k], At[m][k], acc[ai][bj][m][n], 0, 0, 0); __builtin_amdgcn_s_setprio(0); } while (0)
#define PG8_WAIT_V(n) asm volatile("s_waitcnt vmcnt(" #n ")" ::: "memory")
#define PG8_WAIT_L(n) asm volatile("s_waitcnt lgkmcnt(" #n ")" ::: "memory")
#define PG8_BAR __builtin_amdgcn_s_barrier()
#define PG8_SCHED __builtin_amdgcn_sched_barrier(0)
    Unit cur, nxt; int ui = 0;
    if (!S.next(0, cur)) return;
    f32x4 acc[2][2][4][2];
#pragma unroll
    for (int a = 0; a < 2; ++a)
#pragma unroll
        for (int b = 0; b < 2; ++b)
#pragma unroll
            for (int m = 0; m < 4; ++m)
#pragma unroll
                for (int n = 0; n < 2; ++n) acc[a][b][m][n] = (f32x4){0.f, 0.f, 0.f, 0.f};
    bf16x8 At[4][2], B0[2][2], B1[2][2];
    const char* cA = (const char*)g.A + (GATHER ? (size_t)0 : (size_t)cur.pm * tstep); const char* cB = (const char*)g.Bt + (size_t)cur.pn * tstep;
    unsigned gC[2][2] = {{0u, 0u}, {0u, 0u}};
    S.a_ready(cur);
    if constexpr (GATHER) PG8_LOAD_GOFF(cur.pm);
    if constexpr (SP2) {
        PG8_STAGE(PG8_SB(0, 0), cB, voffB); PG8_STAGE(PG8_SB(0, 1), cB + hstep, voffB); PG8_STAGE_A(PG8_SA(0, 0), cA, 0); PG8_STAGE_A(PG8_SA(0, 1), cA, 1);
        if (wr == 1) PG8_BAR;
        PG8_WAIT_V(2); PG8_BAR;
        PG8_STAGE(PG8_SB(1, 0), cB + kstep, voffB); PG8_STAGE_A(PG8_SA(1, 0), cA + kstep, 0); PG8_STAGE(PG8_SB(1, 1), cB + hstep + kstep, voffB);
        PG8_WAIT_V(6); PG8_BAR;
    } else {
        PG8_STAGE(PG8_SB(0, 0), cB, voffB); PG8_STAGE_A(PG8_SA(0, 0), cA, 0); PG8_STAGE(PG8_SB(0, 1), cB + hstep, voffB); PG8_STAGE_A(PG8_SA(0, 1), cA, 1);
        if (wr == 1) PG8_BAR;
        PG8_WAIT_V(4); PG8_BAR;
        PG8_STAGE(PG8_SB(1, 0), cB + kstep, voffB); PG8_STAGE_A(PG8_SA(1, 0), cA + kstep, 0); PG8_STAGE(PG8_SB(1, 1), cB + hstep + kstep, voffB);
        PG8_WAIT_V(6); PG8_BAR;
    }
    for (;;) {
        const bool has_next = S.next(ui + 1, nxt);
        const char* nA = (has_next && !GATHER) ? (const char*)g.A + (size_t)nxt.pm * tstep : cA; const char* nB = has_next ? (const char*)g.Bt + (size_t)nxt.pn * tstep : cB;
        for (int t = 0; t < nt; t += 2) {
            const bool last = (t == nt - 2);
            const char* a1 = cA + (size_t)(t + 1) * kstep;
            const char* a2 = last ? nA : cA + (size_t)(t + 2) * kstep; const char* b2 = last ? nB : cB + (size_t)(t + 2) * kstep;
            const char* a3 = a2 + kstep; const char* b3 = b2 + kstep;
            if (last && has_next) S.a_ready(nxt);
            if constexpr (SP2) {
            PG8_LDB(B0, 0, 0); PG8_LDB(B1, 0, 1); PG8_SCHED; PG8_LDA(At, 0, 0); PG8_STAGE_A(PG8_SA(1, 1), a1, 1); if constexpr (GATHER) { if (last && has_next) PG8_LOAD_GOFF(nxt.pm); }
            PG8_WAIT_V(8); PG8_WAIT_L(0); PG8_BAR; PG8_MMA(0, 0, At, B0); PG8_MMA(0, 1, At, B1); PG8_BAR; PG8_SCHED;
            PG8_LDA(At, 0, 1); PG8_STAGE(PG8_SB(0, 0), b2, voffB); PG8_STAGE(PG8_SB(0, 1), b2 + hstep, voffB); PG8_STAGE_A(PG8_SA(0, 0), a2, 0);
            PG8_WAIT_V(8); PG8_WAIT_L(0); PG8_BAR; PG8_MMA(1, 0, At, B0); PG8_MMA(1, 1, At, B1); PG8_BAR; PG8_SCHED;
            PG8_LDB(B0, 1, 0); PG8_LDB(B1, 1, 1); PG8_SCHED; PG8_LDA(At, 1, 0); PG8_STAGE_A(PG8_SA(0, 1), a2, 1);
            PG8_WAIT_V(8); PG8_WAIT_L(0); PG8_BAR; PG8_MMA(0, 0, At, B0); PG8_MMA(0, 1, At, B1); PG8_BAR; PG8_SCHED;
            PG8_LDA(At, 1, 1); PG8_STAGE(PG8_SB(1, 0), b3, voffB); PG8_STAGE(PG8_SB(1, 1), b3 + hstep, voffB); PG8_STAGE_A(PG8_SA(1, 0), a3, 0);
            PG8_WAIT_V(8); PG8_WAIT_L(0); PG8_BAR; PG8_MMA(1, 0, At, B0); PG8_MMA(1, 1, At, B1); PG8_BAR; PG8_SCHED;
            } else {
            PG8_LDB(B0, 0, 0); PG8_SCHED; PG8_LDA(At, 0, 0); PG8_STAGE_A(PG8_SA(1, 1), a1, 1); if constexpr (GATHER) { if (last && has_next) PG8_LOAD_GOFF(nxt.pm); }
            PG8_WAIT_L(8); PG8_BAR; PG8_WAIT_L(0); PG8_MMA(0, 0, At, B0); PG8_BAR; PG8_SCHED;
            PG8_LDB(B1, 0, 1); PG8_STAGE(PG8_SB(0, 0), b2, voffB);
            PG8_BAR; PG8_WAIT_L(0); PG8_MMA(0, 1, At, B1); PG8_BAR;
            PG8_LDA(At, 0, 1); PG8_STAGE_A(PG8_SA(0, 0), a2, 0);
            PG8_BAR; PG8_WAIT_L(0); PG8_MMA(1, 0, At, B0); PG8_BAR; PG8_SCHED;
            PG8_STAGE(PG8_SB(0, 1), b2 + hstep, voffB);
            PG8_WAIT_V(6); PG8_BAR; PG8_MMA(1, 1, At, B1); PG8_BAR;
            PG8_LDB(B0, 1, 0); PG8_SCHED; PG8_LDA(At, 1, 0); PG8_STAGE_A(PG8_SA(0, 1), a2, 1);
            PG8_WAIT_L(8); PG8_BAR; PG8_WAIT_L(0); PG8_MMA(0, 0, At, B0); PG8_BAR; PG8_SCHED;
            PG8_LDB(B1, 1, 1); PG8_STAGE(PG8_SB(1, 0), b3, voffB);
            PG8_BAR; PG8_WAIT_L(0); PG8_MMA(0, 1, At, B1); PG8_BAR;
            PG8_LDA(At, 1, 1); PG8_STAGE_A(PG8_SA(1, 0), a3, 0);
            PG8_BAR; PG8_WAIT_L(0); PG8_MMA(1, 0, At, B0); PG8_BAR; PG8_SCHED;
            PG8_STAGE(PG8_SB(1, 1), b3 + hstep, voffB);
            PG8_WAIT_V(6); PG8_BAR; PG8_MMA(1, 1, At, B1); PG8_BAR;
            }
            if constexpr (Epi::HOOK) { if (t == 2 || t == 8) E.hook(acc, cur, t, wr, wc, fr, fq); }
        }
        if constexpr (ALIGN_EPI) { if (wr == 0) PG8_BAR; }
        if constexpr (!Epi::AFTER_DRAIN) { E(acc, cur, wr, wc, fr, fq); S.done(cur); }
        if (!has_next) break;
#pragma unroll
        for (int a = 0; a < 2; ++a)
#pragma unroll
            for (int b = 0; b < 2; ++b)
#pragma unroll
                for (int m = 0; m < 4; ++m)
#pragma unroll
                    for (int n = 0; n < 2; ++n) acc[a][b][m][n] = (f32x4){0.f, 0.f, 0.f, 0.f};
        cur = nxt; cA = nA; cB = nB; ++ui;
        if constexpr (ALIGN_EPI) { if (wr == 1) PG8_BAR; }
    }
    PG8_WAIT_V(0);
    if constexpr (!ALIGN_EPI) { if (wr == 0) PG8_BAR; }
    PG8_BAR;
    if constexpr (Epi::AFTER_DRAIN) { E.fused(acc, cur, wr, wc, fr, fq, lds, wid, lane); S.done(cur); }
#undef PG8_SA
#undef PG8_SB
#undef PG8_STAGE
#undef PG8_LDA
#undef PG8_STAGE_A
#undef PG8_LOAD_GOFF
#undef PG8_LDB
#undef PG8_MMA
#undef PG8_WAIT_V
#undef PG8_WAIT_L
#undef PG8_BAR
#undef PG8_SCHED
}

}
__device__ __forceinline__ pg8::u32x4 pack8(const f32x4& a, const f32x4& b) { pg8::u32x4 w; w.x = pack2(a[0], a[1]); w.y = pack2(a[2], a[3]); w.z = pack2(b[0], b[1]); w.w = pack2(b[2], b[3]); return w; }
__device__ __forceinline__ void unpack8(const pg8::u32x4& w, f32x4& a, f32x4& b) {
    a[0] = __uint_as_float(w.x << 16); a[1] = __uint_as_float(w.x & 0xffff0000u); a[2] = __uint_as_float(w.y << 16); a[3] = __uint_as_float(w.y & 0xffff0000u);
    b[0] = __uint_as_float(w.z << 16); b[1] = __uint_as_float(w.z & 0xffff0000u); b[2] = __uint_as_float(w.w << 16); b[3] = __uint_as_float(w.w & 0xffff0000u); }


__device__ __forceinline__ void phase_gemm_in(ParamsC p, int l, unsigned char* smem) {
    const int tid = ltid(), lane = tid & 63, wid = tid >> 6, wm = wid >> 1, wn = wid & 1, q4 = (lane >> 4) * 4;
    const int nM = T_ALL / 128, nN = IN_COLS / 128;
    for (int tile = lbid(); tile < nM * nN; tile += gridDim.x) {
        const int tm = tile / nN, tn = tile % nN, m0 = tm * 128, n0 = tn * 128;
        f32x4 acc[2][4]; zero_acc(acc);
        RowsLinear ar{p->h + (size_t)m0 * 1024, 1024};
        gemm_core(smem, ar, p->wt_in + (size_t)n0 * 1024, 1024, 0, 1024, acc);
        const int cb = n0 + wn * 64;
#pragma unroll
        for (int mi = 0; mi < 2; ++mi) {
            const int t = m0 + wm * 32 + mi * 16 + (lane & 15);
            f32x4 v0 = acc[mi][0], v1 = acc[mi][1], v2 = acc[mi][2], v3 = acc[mi][3];
            if (cb >= 2560) {
                bf16_t* dst = p->uG + (size_t)t * UG_LD + (cb - 2560) + q4;
#pragma unroll
                for (int e = 0; e < 4; ++e) { v0[e] = 1.f / (1.f + __expf(-v0[e])); v1[e] = 1.f / (1.f + __expf(-v1[e])); v2[e] = 1.f / (1.f + __expf(-v2[e])); v3[e] = 1.f / (1.f + __expf(-v3[e])); }
                store4bf(dst, v0); store4bf(dst + 16, v1); store4bf(dst + 32, v2); store4bf(dst + 48, v3);
            } else {
                const bool isq = (cb >= 768 && cb < 1152) || (cb >= 1920 && cb < 2304);
                const bool rope = (cb >= 1920 && cb < 2432) && (t < T_LAT);
                if (rope) { const int pos = t & 8191, r = pos >> 6, cc = pos & 63;
#pragma unroll
                    for (int e = 0; e < 4; ++e) {
                        const float2 csr = *(const float2*)(p->ropet + (r * 16 + q4 + e) * 2), csc = *(const float2*)(p->ropet + (cc * 16 + q4 + e) * 2);
                        const float a1 = v0[e], a2 = v1[e]; v0[e] = a1 * csr.x - a2 * csr.y; v1[e] = a1 * csr.y + a2 * csr.x;
                        const float b1 = v2[e], b2 = v3[e]; v2[e] = b1 * csc.x - b2 * csc.y; v3[e] = b1 * csc.y + b2 * csc.x; } }
                if (isq) { v0 = v0 * 0.125f; v1 = v1 * 0.125f; v2 = v2 * 0.125f; v3 = v3 * 0.125f; }
                bf16_t* dst = p->uA + (size_t)t * UA_LD + cb + q4;
                store4bf(dst, v0); store4bf(dst + 16, v1); store4bf(dst + 32, v2); store4bf(dst + 48, v3);
            }
        }
    }
}

struct KmNA { int b, r, c, rs, cs; const float* rpb;
    __device__ __forceinline__ int tok(int kk) const { if (kk < 128) return b * SEQ + (rs + (kk >> 4)) * 64 + cs + (kk & 15); return T_LAT + b * CTXL + (kk - 128); }
    __device__ __forceinline__ float bias(int kk) const { if (kk < 128) return rpb[(rs + (kk >> 4) - r + 7) * 31 + (cs + (kk & 15) - c + 15)]; return 0.f; } };
struct KmSWA { int b, i;
    __device__ __forceinline__ int tok(int kk) const { if (kk < 257) { const int j = i - 128 + kk; return (j >= 0 && j < SEQ) ? b * SEQ + j : -1; } if (kk < 513) return T_LAT + b * CTXL + (kk - 257); return -1; }
    __device__ __forceinline__ float bias(int) const { return 0.f; } };
struct KmCtx { int b;
    __device__ __forceinline__ int tok(int kk) const { return T_LAT + b * CTXL + kk; }
    __device__ __forceinline__ float bias(int) const { return 0.f; } };

template <int NI, class KM>
__device__ __forceinline__ void attn_item(const bf16_t* uA, int tq, int qcol, int kcol, int vcol, const KM& km, bool has_sink, float sink, bf16_t* outp, int lane) {
    float q[64];
    {   const uint4* qp = (const uint4*)(uA + (size_t)tq * UA_LD + qcol);
#pragma unroll
        for (int c = 0; c < 8; ++c) { const uint4 v = qp[c];
            q[c * 8 + 0] = bf2f((bf16_t)(v.x & 0xffff)); q[c * 8 + 1] = bf2f((bf16_t)(v.x >> 16)); q[c * 8 + 2] = bf2f((bf16_t)(v.y & 0xffff)); q[c * 8 + 3] = bf2f((bf16_t)(v.y >> 16));
            q[c * 8 + 4] = bf2f((bf16_t)(v.z & 0xffff)); q[c * 8 + 5] = bf2f((bf16_t)(v.z >> 16)); q[c * 8 + 6] = bf2f((bf16_t)(v.w & 0xffff)); q[c * 8 + 7] = bf2f((bf16_t)(v.w >> 16)); } }
    float s[NI]; float mx = -3.0e38f;
#pragma unroll
    for (int i = 0; i < NI; ++i) { const int kk = i * 64 + lane; const int tk = km.tok(kk);
        float d = -3.0e38f;
        if (tk >= 0) { const uint4* kp = (const uint4*)(uA + (size_t)tk * UA_LD + kcol); d = 0.f;
#pragma unroll
            for (int c = 0; c < 8; ++c) { const uint4 v = kp[c];
                d += q[c * 8 + 0] * bf2f((bf16_t)(v.x & 0xffff)) + q[c * 8 + 1] * bf2f((bf16_t)(v.x >> 16)) + q[c * 8 + 2] * bf2f((bf16_t)(v.y & 0xffff)) + q[c * 8 + 3] * bf2f((bf16_t)(v.y >> 16))
                   + q[c * 8 + 4] * bf2f((bf16_t)(v.z & 0xffff)) + q[c * 8 + 5] * bf2f((bf16_t)(v.z >> 16)) + q[c * 8 + 6] * bf2f((bf16_t)(v.w & 0xffff)) + q[c * 8 + 7] * bf2f((bf16_t)(v.w >> 16)); }
            d += km.bias(kk); }
        s[i] = d; mx = fmaxf(mx, d); }
    mx = wave_max(mx); if (has_sink) mx = fmaxf(mx, sink);
    float sum = 0.f;
#pragma unroll
    for (int i = 0; i < NI; ++i) { const float pv = s[i] > -1.0e38f ? __expf(s[i] - mx) : 0.f; s[i] = pv; sum += pv; }
    sum = wave_sum(sum); if (has_sink) sum += __expf(sink - mx);
    const float inv = 1.0f / sum;
    float o = 0.f;
#pragma unroll
    for (int i = 0; i < NI; ++i) {
        for (int sl = 0; sl < 64; ++sl) { const int tk = km.tok(i * 64 + sl); const float pv = __shfl(s[i], sl);
            if (tk >= 0) o += pv * bf2f(uA[(size_t)tk * UA_LD + vcol + lane]); } }
    outp[lane] = f2bf(o * inv);
}

__device__ __forceinline__ void phase_mix(ParamsC p, int l) {
    const int tid = ltid(), lane = tid & 63, wid = tid >> 6;
    const bool need_ctx = l < DEPTH - 1;
    {   const int ntok = need_ctx ? T_ALL : T_LAT; const float* cw = p->conv_w + l * 3 * 256;
        for (int idx = lbid() * NTHR + tid; idx < ntok * 256; idx += gridDim.x * NTHR) { const int t = idx >> 8, c = idx & 255;
            int pos, len; if (t < T_LAT) { pos = t & 8191; len = SEQ; } else { pos = (t - T_LAT) & 255; len = CTXL; }
            const bf16_t* u = p->uA + (size_t)t * UA_LD + c;
            const float z1 = bf2f(u[512]) * bf2f(u[0]);
            const float z0 = pos > 0 ? bf2f(u[512 - UA_LD]) * bf2f(u[-UA_LD]) : 0.f;
            const float z2 = pos + 1 < len ? bf2f(u[512 + UA_LD]) * bf2f(u[UA_LD]) : 0.f;
            const float y = bf2f(u[256]) * (z0 * cw[c] + z1 * cw[256 + c] + z2 * cw[512 + c]);
            p->ycat[(size_t)t * 1024 + c] = f2bf(y); } }
    const int n_lat = T_LAT * 12, n_all = n_lat + (need_ctx ? T_CTX * 12 : 0);
    for (int it = lbid() * 8 + wid; it < n_all; it += gridDim.x * 8) {
        if (it < n_lat) { const int t = it / 12, hh = it % 12; const int b = t >> 13, pos = t & 8191;
            if (hh < 6) { KmNA km; km.b = b; km.r = pos >> 6; km.c = pos & 63; km.rs = min(max(km.r - 4, 0), 120); km.cs = min(max(km.c - 8, 0), 48); km.rpb = p->rpb + ((size_t)l * 6 + hh) * 15 * 31;
                attn_item<6>(p->uA, t, 768 + hh * 64, 1152 + hh * 64, 1536 + hh * 64, km, false, 0.f, p->ycat + (size_t)t * 1024 + 256 + hh * 64, lane); }
            else { const int hq = hh - 6, kh = hq / 3; KmSWA km; km.b = b; km.i = pos;
                attn_item<9>(p->uA, t, 1920 + hq * 64, 2304 + kh * 64, 2432 + kh * 64, km, true, p->sinks[l * 6 + hq], p->ycat + (size_t)t * 1024 + 640 + hq * 64, lane); }
        } else { const int it2 = it - n_lat; const int tc = it2 / 12, hh = it2 % 12; const int t = T_LAT + tc; KmCtx km; km.b = tc >> 8;
            if (hh < 6) attn_item<4>(p->uA, t, 768 + hh * 64, 1152 + hh * 64, 1536 + hh * 64, km, false, 0.f, p->ycat + (size_t)t * 1024 + 256 + hh * 64, lane);
            else { const int hq = hh - 6, kh = hq / 3; attn_item<4>(p->uA, t, 1920 + hq * 64, 2304 + kh * 64, 2432 + kh * 64, km, true, p->sinks[l * 6 + hq], p->ycat + (size_t)t * 1024 + 640 + hq * 64, lane); }
        }
    }
}


typedef float f32x16 __attribute__((ext_vector_type(16)));
typedef short s16x4 __attribute__((ext_vector_type(4)));
#define AT_STRIDE 144
#define AT_KBUF(b) ((b) * 9216)
#define AT_VBUF(b) (18432 + (b) * 9216)
#define AT_RPB 36864
#define LOG2E 1.4426950408889634f
#define AT_NEG (-1.0e30f)
#define AT_THR 16.0f

template <int MK>
__device__ __forceinline__ void attn_tile(const unsigned char* kt, const unsigned char* vlane, const bf16x8 (&qf)[4], f32x16 (&oacc)[2], float& m, float& lsum,
                                          const float* rpb_row, int relc0  , int lo0  , int lane) {
    const int n = lane & 31, hh = lane >> 5;
    f32x16 sc;
#pragma unroll
    for (int r = 0; r < 16; ++r) sc[r] = 0.f;
#pragma unroll
    for (int sp = 0; sp < 4; ++sp) { const bf16x8 kf = *(const bf16x8*)(kt + n * AT_STRIDE + sp * 32 + hh * 16); sc = __builtin_amdgcn_mfma_f32_32x32x16_bf16(kf, qf[sp], sc, 0, 0, 0); }
    float mx = AT_NEG;
#pragma unroll
    for (int r = 0; r < 16; ++r) { const int i = (r & 3) + 8 * (r >> 2) + 4 * hh; float v = sc[r];
        if (MK == 1) { const bool ok = (unsigned)(i - lo0) < 16u; const int ridx = ok ? (relc0 + i) : 0; v = ok ? (v + rpb_row[ridx]) : AT_NEG; }
        else if (MK == 2) v = (i >= n) ? v : AT_NEG;
        else if (MK == 3) v = (i <= n) ? v : AT_NEG;
        sc[r] = v; mx = fmaxf(mx, v); }
    if (__any(mx > m + AT_THR)) { mx = fmaxf(mx, __shfl_xor(mx, 32)); const float mn = fmaxf(m, mx); const float alpha = __builtin_amdgcn_exp2f(m - mn); lsum *= alpha; m = mn;
#pragma unroll
        for (int r = 0; r < 16; ++r) { oacc[0][r] *= alpha; oacc[1][r] *= alpha; } }
    float ps = 0.f;
#pragma unroll
    for (int r = 0; r < 16; ++r) { const float pv = __builtin_amdgcn_exp2f(sc[r] - m); sc[r] = pv; ps += pv; }
    lsum += ps;
    bf16x8 pf[2];
#pragma unroll
    for (int s2 = 0; s2 < 2; ++s2) { pg8::u32x4 w; w.x = pack2(sc[s2 * 8 + 0], sc[s2 * 8 + 1]); w.y = pack2(sc[s2 * 8 + 2], sc[s2 * 8 + 3]); w.z = pack2(sc[s2 * 8 + 4], sc[s2 * 8 + 5]); w.w = pack2(sc[s2 * 8 + 6], sc[s2 * 8 + 7]);
        pf[s2] = __builtin_bit_cast(bf16x8, w); }
#pragma unroll
    for (int c = 0; c < 2; ++c)
#pragma unroll
        for (int s2 = 0; s2 < 2; ++s2) {
            const s16x4 v0 = __builtin_amdgcn_ds_read_tr16_b64_v4i16((LAS s16x4*)(vlane + (16 * s2) * AT_STRIDE + 64 * c));
            const s16x4 v1 = __builtin_amdgcn_ds_read_tr16_b64_v4i16((LAS s16x4*)(vlane + (16 * s2 + 8) * AT_STRIDE + 64 * c));
            bf16x8 vf; vf[0] = v0[0]; vf[1] = v0[1]; vf[2] = v0[2]; vf[3] = v0[3]; vf[4] = v1[0]; vf[5] = v1[1]; vf[6] = v1[2]; vf[7] = v1[3];
            oacc[c] = __builtin_amdgcn_mfma_f32_32x32x16_bf16(vf, pf[s2], oacc[c], 0, 0, 0);
        }
}

template <int MODE>
__device__ __forceinline__ void attn_unit(ParamsC p, int l, int u, unsigned char* smem) {
    const int tid = ltid(), lane = tid & 63, wid = tid >> 6;
    int b, qcol, kcol, vcol, ocol, qtok; bool has_sink = false; float sinkv = 0.f;
    int nsteps, krlo = 0, r = 0, rs = 0, c = 0, cs = 0, q0 = 0, jwlo = 0;
    if (MODE == 0) { b = u / 192; const int rem = u % 192, h = rem / 32, rg = rem % 32; qcol = 768 + h * 64; kcol = 1152 + h * 64; vcol = 1536 + h * 64; ocol = 256 + h * 64;
        r = rg * 4 + (wid >> 1); rs = min(max(r - 4, 0), 120); c = 32 * (wid & 1) + (lane & 31); cs = min(max(c - 8, 0), 48);
        krlo = min(max(rg * 4 - 4, 0), 120); const int krhi = min(max(rg * 4 + 3 - 4, 0), 120) + 7; nsteps = 4 + (krhi - krlo + 1);
        qtok = b * SEQ + r * 64 + 32 * (wid & 1);
        for (int i = tid; i < 15 * 31; i += NTHR) ((float*)(smem + AT_RPB))[i] = p->rpb[((size_t)l * 6 + h) * 465 + i] * LOG2E;
    } else if (MODE == 1) { b = u / 192; const int rem = u % 192, hq = rem / 32, qb = rem % 32, kh = hq / 3; qcol = 1920 + hq * 64; kcol = 2304 + kh * 64; vcol = 2432 + kh * 64; ocol = 640 + hq * 64;
        q0 = qb * 256; jwlo = (q0 == 0) ? 2 : 0; const int jwhi = min(8, (SEQ - q0 + 128) / 64); nsteps = 4 + (jwhi - jwlo);
        qtok = b * SEQ + q0 + 32 * wid; has_sink = true; sinkv = p->sinks[l * 6 + hq];
    } else { b = u / 12; const int hh = u % 12;
        if (hh < 6) { qcol = 768 + hh * 64; kcol = 1152 + hh * 64; vcol = 1536 + hh * 64; ocol = 256 + hh * 64; }
        else { const int hq = hh - 6, kh = hq / 3; qcol = 1920 + hq * 64; kcol = 2304 + kh * 64; vcol = 2432 + kh * 64; ocol = 640 + hq * 64; has_sink = true; sinkv = p->sinks[l * 6 + hq]; }
        nsteps = 4; qtok = T_LAT + b * CTXL + 32 * wid;
    }
    const bf16_t* uA = p->uA;
    bf16x8 qf[4];
    {   const bf16_t* qp = uA + (size_t)(qtok + (lane & 31)) * UA_LD + qcol + (lane >> 5) * 8;
#pragma unroll
        for (int sp = 0; sp < 4; ++sp) qf[sp] = *(const bf16x8*)(qp + sp * 16); }
    f32x16 oacc[2];
#pragma unroll
    for (int r16 = 0; r16 < 16; ++r16) { oacc[0][r16] = 0.f; oacc[1][r16] = 0.f; }
    float m = has_sink ? sinkv * LOG2E : AT_NEG, lsum = (has_sink && lane < 32) ? 1.f : 0.f;
    const int skey = tid >> 3, sch = tid & 7; const int soff = skey * AT_STRIDE + sch * 16;
    auto chunk_tok = [&](int j) -> int {
        if (j < 4) return T_LAT + b * CTXL + 64 * j;
        if (MODE == 0) return b * SEQ + (krlo + (j - 4)) * 64;
        return b * SEQ + q0 - 128 + 64 * (jwlo + (j - 4)); };
    uint4 rk0, rv0, rk1, rv1;
#define AT_LOAD(RK, RV, jj) do { const bf16_t* src_ = uA + (size_t)(chunk_tok(jj) + skey) * UA_LD + sch * 8; RK = *(const uint4*)(src_ + kcol); RV = *(const uint4*)(src_ + vcol); } while (0)
#define AT_STORE(RK, RV, bb) do { *(uint4*)(smem + AT_KBUF(bb) + soff) = RK; *(uint4*)(smem + AT_VBUF(bb) + soff) = RV; } while (0)
    AT_LOAD(rk0, rv0, 0); AT_STORE(rk0, rv0, 0);
    if (1 < nsteps) AT_LOAD(rk1, rv1, 1);
    if (2 < nsteps) AT_LOAD(rk0, rv0, 2);
    __syncthreads();
    const int vl_off = (4 * (lane >> 5) + ((lane & 15) >> 2)) * AT_STRIDE + (16 * ((lane >> 4) & 1) + 4 * (lane & 3)) * 2;
    const float* rpb_s = (const float*)(smem + AT_RPB);
    for (int j = 0; j < nsteps; ++j) {
        const int buf = j & 1;
        if (j & 1) { if (j + 1 < nsteps) AT_STORE(rk0, rv0, 0); if (j + 3 < nsteps) AT_LOAD(rk0, rv0, j + 3); }
        else       { if (j + 1 < nsteps) AT_STORE(rk1, rv1, 1); if (j + 3 < nsteps) AT_LOAD(rk1, rv1, j + 3); }
        const unsigned char* kb = smem + AT_KBUF(buf); const unsigned char* vb = smem + AT_VBUF(buf) + vl_off;
        if (j < 4) {
            attn_tile<0>(kb, vb, qf, oacc, m, lsum, rpb_s, 0, 0, lane);
            attn_tile<0>(kb + 32 * AT_STRIDE, vb + 32 * AT_STRIDE, qf, oacc, m, lsum, rpb_s, 0, 0, lane);
        } else if (MODE == 0) {
            const int kr = krlo + (j - 4);
            if (kr >= rs && kr < rs + 8) { const float* rrow = rpb_s + (kr - r + 7) * 31;
                attn_tile<1>(kb, vb, qf, oacc, m, lsum, rrow, 0 - c + 15, cs, lane);
                attn_tile<1>(kb + 32 * AT_STRIDE, vb + 32 * AT_STRIDE, qf, oacc, m, lsum, rrow, 32 - c + 15, cs - 32, lane); }
        } else if (MODE == 1) {
            const int qp0 = q0 + 32 * wid;
#pragma unroll
            for (int tl = 0; tl < 2; ++tl) { const int kp0 = q0 - 128 + 64 * (jwlo + (j - 4)) + 32 * tl; const int d = kp0 - qp0;
                const unsigned char* kt = kb + tl * 32 * AT_STRIDE; const unsigned char* vt = vb + tl * 32 * AT_STRIDE;
                if (d == -128) attn_tile<2>(kt, vt, qf, oacc, m, lsum, rpb_s, 0, 0, lane);
                else if (d == 128) attn_tile<3>(kt, vt, qf, oacc, m, lsum, rpb_s, 0, 0, lane);
                else if (d > -128 && d < 128) attn_tile<0>(kt, vt, qf, oacc, m, lsum, rpb_s, 0, 0, lane); }
        }
        __syncthreads();
    }
    const float ltot = lsum + __shfl_xor(lsum, 32); const float inv = 1.0f / ltot;
    bf16_t* op = p->ycat + (size_t)(qtok + (lane & 31)) * 1024 + ocol + 4 * (lane >> 5);
#pragma unroll
    for (int cc = 0; cc < 2; ++cc)
#pragma unroll
        for (int g = 0; g < 4; ++g) { f32x4 v; v[0] = oacc[cc][4 * g] * inv; v[1] = oacc[cc][4 * g + 1] * inv; v[2] = oacc[cc][4 * g + 2] * inv; v[3] = oacc[cc][4 * g + 3] * inv;
            store4bf(op + 32 * cc + 8 * g, v); }
}


#define NA_TBL 36864
#define NA_TROW 48
#define NA_TLEAD 16
__device__ __forceinline__ void na_softmax8(f32x4& s0, f32x4& s1, float& m, float& lsum, f32x4 (&oacc)[4], bf16x8& pf) {
    float mx = fmaxf(fmaxf(fmaxf(s0[0], s0[1]), fmaxf(s0[2], s0[3])), fmaxf(fmaxf(s1[0], s1[1]), fmaxf(s1[2], s1[3])));
    if (__any(mx > m + AT_THR)) { mx = fmaxf(mx, __shfl_xor(mx, 16)); mx = fmaxf(mx, __shfl_xor(mx, 32)); const float mn = fmaxf(m, mx); const float alpha = __builtin_amdgcn_exp2f(m - mn); lsum *= alpha; m = mn;
#pragma unroll
        for (int db = 0; db < 4; ++db) oacc[db] = oacc[db] * alpha; }
#pragma unroll
    for (int e = 0; e < 4; ++e) { s0[e] = __builtin_amdgcn_exp2f(s0[e] - m); s1[e] = __builtin_amdgcn_exp2f(s1[e] - m); }
    lsum += (s0[0] + s0[1]) + (s0[2] + s0[3]) + (s1[0] + s1[1]) + (s1[2] + s1[3]);
    pg8::u32x4 w; w.x = pack2(s0[0], s0[1]); w.y = pack2(s0[2], s0[3]); w.z = pack2(s1[0], s1[1]); w.w = pack2(s1[2], s1[3]);
    pf = __builtin_bit_cast(bf16x8, w);
}
__device__ __forceinline__ void attn_unit_na(ParamsC p, int l, int u, unsigned char* smem) {
    const int tid = ltid(), lane = tid & 63, wid = tid >> 6, q16 = lane & 15, kg = lane >> 4;
    const int b = u / 192, rem = u % 192, h = rem / 32, rg = rem % 32;
    const int qcol = 768 + h * 64, kcol = 1152 + h * 64, vcol = 1536 + h * 64, ocol = 256 + h * 64;
    const int r = rg * 4 + (wid >> 1), qh = wid & 1, rs = min(max(r - 4, 0), 120);
    const int krlo = min(max(rg * 4 - 4, 0), 120), krhi = min(max(rg * 4 + 3 - 4, 0), 120) + 7, nsteps = 4 + (krhi - krlo + 1);
    const int qtok = b * SEQ + r * 64 + 32 * qh;
    const bf16_t* uA = p->uA;
    {   float* T = (float*)(smem + NA_TBL); const float* rp = p->rpb + ((size_t)l * 6 + h) * 465;
        for (int i = tid; i < NA_TLEAD + 16 * 15 * NA_TROW; i += NTHR) { float v = AT_NEG;
            if (i >= NA_TLEAD) { const int k = i - NA_TLEAD, j = k % NA_TROW, rr = (k / NA_TROW) % 15, dl = k / (NA_TROW * 15); if (j < 16) v = rp[rr * 31 + j + dl] * LOG2E; }
            T[i] = v; } }
    int kc0[2], tbase[2];
#pragma unroll
    for (int g2 = 0; g2 < 2; ++g2) { const int c = 32 * qh + 16 * g2 + q16, cs = min(max(c - 8, 0), 48), dl = cs - c + 15;
        kc0[g2] = (qh == 0) ? (g2 == 0 ? 0 : 8) : (g2 == 0 ? 24 : 32);
        tbase[g2] = NA_TLEAD + dl * (15 * NA_TROW) + (kc0[g2] - cs) + 4 * kg; }
    bf16x8 qf[2][2];
#pragma unroll
    for (int g2 = 0; g2 < 2; ++g2)
#pragma unroll
        for (int ds = 0; ds < 2; ++ds) qf[g2][ds] = *(const bf16x8*)(uA + (size_t)(qtok + 16 * g2 + q16) * UA_LD + qcol + ds * 32 + kg * 8);
    f32x4 oacc[2][4];
#pragma unroll
    for (int g2 = 0; g2 < 2; ++g2)
#pragma unroll
        for (int db = 0; db < 4; ++db) oacc[g2][db] = (f32x4){0.f, 0.f, 0.f, 0.f};
    float m[2] = {AT_NEG, AT_NEG}, lsum[2] = {0.f, 0.f};
    const int skey = tid >> 3, sch = tid & 7; const int soff = skey * AT_STRIDE + sch * 16;
    auto chunk_tok = [&](int j) -> int { return (j < 4) ? (T_LAT + b * CTXL + 64 * j) : (b * SEQ + (krlo + (j - 4)) * 64); };
    uint4 rk0, rv0, rk1, rv1;
    AT_LOAD(rk0, rv0, 0); AT_STORE(rk0, rv0, 0);
    if (1 < nsteps) AT_LOAD(rk1, rv1, 1);
    if (2 < nsteps) AT_LOAD(rk0, rv0, 2);
    __syncthreads();
    const int ka_off = q16 * AT_STRIDE + kg * 16;
    const int va_off = (4 * kg + (q16 >> 2)) * AT_STRIDE + (4 * (q16 & 3)) * 2;
    const float* T = (const float*)(smem + NA_TBL);
    for (int j = 0; j < nsteps; ++j) {
        const int buf = j & 1;
        { SUB_T0(1)
        if (j & 1) { if (j + 1 < nsteps) AT_STORE(rk0, rv0, 0); if (j + 3 < nsteps) AT_LOAD(rk0, rv0, j + 3); }
        else       { if (j + 1 < nsteps) AT_STORE(rk1, rv1, 1); if (j + 3 < nsteps) AT_LOAD(rk1, rv1, j + 3); }
        SUB_ACC(1) }
        const unsigned char* kb = smem + AT_KBUF(buf); const unsigned char* vb = smem + AT_VBUF(buf);
        if (j < 4) {
#pragma unroll
            for (int tp = 0; tp < 2; ++tp) {
                bf16x8 kf[2][2];
#pragma unroll
                for (int t = 0; t < 2; ++t)
#pragma unroll
                    for (int ds = 0; ds < 2; ++ds) kf[t][ds] = *(const bf16x8*)(kb + (32 * tp + 16 * t) * AT_STRIDE + ka_off + ds * 64);
                bf16x8 pf[2];
#pragma unroll
                for (int g2 = 0; g2 < 2; ++g2) { f32x4 s0 = (f32x4){0.f, 0.f, 0.f, 0.f}, s1 = s0;
                    s0 = __builtin_amdgcn_mfma_f32_16x16x32_bf16(kf[0][0], qf[g2][0], s0, 0, 0, 0); s0 = __builtin_amdgcn_mfma_f32_16x16x32_bf16(kf[0][1], qf[g2][1], s0, 0, 0, 0);
                    s1 = __builtin_amdgcn_mfma_f32_16x16x32_bf16(kf[1][0], qf[g2][0], s1, 0, 0, 0); s1 = __builtin_amdgcn_mfma_f32_16x16x32_bf16(kf[1][1], qf[g2][1], s1, 0, 0, 0);
                    na_softmax8(s0, s1, m[g2], lsum[g2], oacc[g2], pf[g2]); }
#pragma unroll
                for (int db = 0; db < 4; ++db) {
                    const s16x4 v0 = __builtin_amdgcn_ds_read_tr16_b64_v4i16((LAS s16x4*)(vb + (32 * tp) * AT_STRIDE + va_off + db * 32));
                    const s16x4 v1 = __builtin_amdgcn_ds_read_tr16_b64_v4i16((LAS s16x4*)(vb + (32 * tp + 16) * AT_STRIDE + va_off + db * 32));
                    bf16x8 vf; vf[0] = v0[0]; vf[1] = v0[1]; vf[2] = v0[2]; vf[3] = v0[3]; vf[4] = v1[0]; vf[5] = v1[1]; vf[6] = v1[2]; vf[7] = v1[3];
                    oacc[0][db] = __builtin_amdgcn_mfma_f32_16x16x32_bf16(vf, pf[0], oacc[0][db], 0, 0, 0); oacc[1][db] = __builtin_amdgcn_mfma_f32_16x16x32_bf16(vf, pf[1], oacc[1][db], 0, 0, 0); }
            }
        } else { const int kr = krlo + (j - 4);
            if (kr >= rs && kr < rs + 8) { const int trow = (kr - r + 7) * NA_TROW;
#pragma unroll
                for (int g2 = 0; g2 < 2; ++g2) { const unsigned char* kt = kb + kc0[g2] * AT_STRIDE; const unsigned char* vt = vb + kc0[g2] * AT_STRIDE;
                    f32x4 s0 = (f32x4){0.f, 0.f, 0.f, 0.f}, s1 = s0;
#pragma unroll
                    for (int ds = 0; ds < 2; ++ds) { const bf16x8 k0 = *(const bf16x8*)(kt + ka_off + ds * 64), k1 = *(const bf16x8*)(kt + 16 * AT_STRIDE + ka_off + ds * 64);
                        s0 = __builtin_amdgcn_mfma_f32_16x16x32_bf16(k0, qf[g2][ds], s0, 0, 0, 0); s1 = __builtin_amdgcn_mfma_f32_16x16x32_bf16(k1, qf[g2][ds], s1, 0, 0, 0); }
                    const float* tp_ = T + tbase[g2] + trow;
#pragma unroll
                    for (int e = 0; e < 4; ++e) { s0[e] += tp_[e]; s1[e] += tp_[16 + e]; }
                    bf16x8 pf; na_softmax8(s0, s1, m[g2], lsum[g2], oacc[g2], pf);
#pragma unroll
                    for (int db = 0; db < 4; ++db) {
                        const s16x4 v0 = __builtin_amdgcn_ds_read_tr16_b64_v4i16((LAS s16x4*)(vt + va_off + db * 32));
                        const s16x4 v1 = __builtin_amdgcn_ds_read_tr16_b64_v4i16((LAS s16x4*)(vt + 16 * AT_STRIDE + va_off + db * 32));
                        bf16x8 vf; vf[0] = v0[0]; vf[1] = v0[1]; vf[2] = v0[2]; vf[3] = v0[3]; vf[4] = v1[0]; vf[5] = v1[1]; vf[6] = v1[2]; vf[7] = v1[3];
                        oacc[g2][db] = __builtin_amdgcn_mfma_f32_16x16x32_bf16(vf, pf, oacc[g2][db], 0, 0, 0); } }
            }
        }
        { SUB_T0(2) __syncthreads(); SUB_ACC(2) }
    }
#pragma unroll
    for (int g2 = 0; g2 < 2; ++g2) { float lt = lsum[g2]; lt += __shfl_xor(lt, 16); lt += __shfl_xor(lt, 32); const float inv = 1.0f / lt;
        bf16_t* op = p->ycat + (size_t)(qtok + 16 * g2 + q16) * 1024 + ocol + 4 * kg;
#pragma unroll
        for (int db = 0; db < 4; ++db) store4bf(op + 16 * db, oacc[g2][db] * inv); }
}

__device__ __forceinline__ void phase_conv(ParamsC p, int l) {
    const int tid = ltid();
    const bool need_ctx = l < DEPTH - 1;
    {
        const int ntok = need_ctx ? T_ALL : T_LAT; const float* cw = p->conv_w + l * 3 * 256;
        for (int idx = lbid() * NTHR + tid; idx < ntok * 32; idx += gridDim.x * NTHR) { const int t = idx >> 5, c = (idx & 31) * 8;
            int pos, len; if (t < T_LAT) { pos = t & 8191; len = SEQ; } else { pos = (t - T_LAT) & 255; len = CTXL; }
            const bf16_t* u = p->uA + (size_t)t * UA_LD + c;
            const bool hp = pos > 0, hn = pos + 1 < len;
            const pg8::u32x4 zero4 = (pg8::u32x4){0u, 0u, 0u, 0u};
            const pg8::u32x4 h1 = *(const pg8::u32x4*)u, c1 = *(const pg8::u32x4*)(u + 512), b1 = *(const pg8::u32x4*)(u + 256);
            const pg8::u32x4 h0 = hp ? *(const pg8::u32x4*)(u - UA_LD) : zero4, c0 = hp ? *(const pg8::u32x4*)(u + 512 - UA_LD) : zero4;
            const pg8::u32x4 h2 = hn ? *(const pg8::u32x4*)(u + UA_LD) : zero4, c2 = hn ? *(const pg8::u32x4*)(u + 512 + UA_LD) : zero4;
            f32x4 w0a = *(const f32x4*)(cw + c), w0b = *(const f32x4*)(cw + c + 4), w1a = *(const f32x4*)(cw + 256 + c), w1b = *(const f32x4*)(cw + 256 + c + 4), w2a = *(const f32x4*)(cw + 512 + c), w2b = *(const f32x4*)(cw + 512 + c + 4);
            f32x4 ha, hb, ca, cb, ya, yb;
            unpack8(h0, ha, hb); unpack8(c0, ca, cb); ya = ha * ca * w0a; yb = hb * cb * w0b;
            unpack8(h1, ha, hb); unpack8(c1, ca, cb); ya += ha * ca * w1a; yb += hb * cb * w1b;
            unpack8(h2, ha, hb); unpack8(c2, ca, cb); ya += ha * ca * w2a; yb += hb * cb * w2b;
            unpack8(b1, ha, hb); ya = ya * ha; yb = yb * hb;
            *(pg8::u32x4*)(p->ycat + (size_t)t * 1024 + c) = pack8(ya, yb); } }
}
__device__ __forceinline__ void phase_na(ParamsC p, int l, unsigned char* smem) {
    for (int u = lbid(); u < 768; u += gridDim.x) attn_unit_na(p, l, u, smem);
}
__device__ __forceinline__ void phase_swa(ParamsC p, int l, unsigned char* smem) {
    for (int u = lbid(); u < 768; u += gridDim.x) attn_unit<1>(p, l, u, smem);
    if (l < DEPTH - 1) for (int u = lbid(); u < 48; u += gridDim.x) attn_unit<2>(p, l, u, smem);
}

__device__ __forceinline__ void phase_gemm_merge(ParamsC p, int l, unsigned char* smem) {
    const int tid = ltid(), lane = tid & 63, wid = tid >> 6, wm = wid >> 1, wn = wid & 1, q4 = (lane >> 4) * 4;
    const int ntok = (l < DEPTH - 1) ? T_ALL : T_LAT; const int nM = ntok / 128, nN = 8;
    for (int tile = lbid(); tile < nM * nN; tile += gridDim.x) {
        const int tm = tile / nN, tn = tile % nN, m0 = tm * 128, n0 = tn * 128;
        f32x4 macc[2][4]; zero_acc(macc);
        RowsLinear ar{p->ycat + (size_t)m0 * 1024, 1024};
#pragma unroll
        for (int seg = 0; seg < 3; ++seg) {
            const int k0 = seg == 0 ? 0 : (seg == 1 ? 256 : 640), k1 = seg == 0 ? 256 : (seg == 1 ? 640 : 1024);
            f32x4 acc[2][4]; zero_acc(acc);
            gemm_core(smem, ar, p->wt_br + (size_t)n0 * 1024, 1024, k0, k1, acc);
#pragma unroll
            for (int mi = 0; mi < 2; ++mi) { const int t = m0 + wm * 32 + mi * 16 + (lane & 15);
#pragma unroll
                for (int nj = 0; nj < 4; ++nj) { const uint2 g = *(const uint2*)(p->uG + (size_t)t * UG_LD + seg * 1024 + n0 + wn * 64 + nj * 16 + q4);
                    macc[mi][nj][0] += bf2f((bf16_t)(g.x & 0xffff)) * acc[mi][nj][0]; macc[mi][nj][1] += bf2f((bf16_t)(g.x >> 16)) * acc[mi][nj][1];
                    macc[mi][nj][2] += bf2f((bf16_t)(g.y & 0xffff)) * acc[mi][nj][2]; macc[mi][nj][3] += bf2f((bf16_t)(g.y >> 16)) * acc[mi][nj][3]; } }
        }
#pragma unroll
        for (int mi = 0; mi < 2; ++mi) { const int t = m0 + wm * 32 + mi * 16 + (lane & 15);
#pragma unroll
            for (int nj = 0; nj < 4; ++nj) store4bf(p->mbuf + (size_t)t * 1024 + n0 + wn * 64 + nj * 16 + q4, macc[mi][nj]); }
    }
}

__device__ __forceinline__ void phase_gemm_o(ParamsC p, int l, unsigned char* smem) {
    const int tid = ltid(), lane = tid & 63, wid = tid >> 6, wm = wid >> 1, wn = wid & 1, q4 = (lane >> 4) * 4;
    const int ntok = (l < DEPTH - 1) ? T_ALL : T_LAT; const int nM = ntok / 128, nN = 8;
    for (int tile = lbid(); tile < nM * nN; tile += gridDim.x) {
        const int tm = tile / nN, tn = tile % nN, m0 = tm * 128, n0 = tn * 128;
        f32x4 acc[2][4]; zero_acc(acc);
        RowsLinear ar{p->mbuf + (size_t)m0 * 1024, 1024};
        gemm_core(smem, ar, p->wt_o + (size_t)n0 * 1024, 1024, 0, 1024, acc);
#pragma unroll
        for (int mi = 0; mi < 2; ++mi) { const int t = m0 + wm * 32 + mi * 16 + (lane & 15); const float* gt = p->modv + (size_t)(l * 5 + tok_variant(t)) * 6144 + 2048;
#pragma unroll
            for (int nj = 0; nj < 4; ++nj) { const int c = n0 + wn * 64 + nj * 16 + q4; float4* xp = (float4*)(p->xs + (size_t)t * 1024 + c); float4 xv = *xp; const float4 g = *(const float4*)(gt + c);
                xv.x += g.x * acc[mi][nj][0]; xv.y += g.y * acc[mi][nj][1]; xv.z += g.z * acc[mi][nj][2]; xv.w += g.w * acc[mi][nj][3]; *xp = xv; } }
    }
}

#define RT_LD 1028
__device__ __forceinline__ void split8(const float (&x)[8], bf16x8& hi, bf16x8& lo) {
    pg8::u32x4 h, lw; float r[8];
    h.x = pack2(x[0], x[1]); h.y = pack2(x[2], x[3]); h.z = pack2(x[4], x[5]); h.w = pack2(x[6], x[7]);
    r[0] = x[0] - __uint_as_float(h.x << 16); r[1] = x[1] - __uint_as_float(h.x & 0xffff0000u); r[2] = x[2] - __uint_as_float(h.y << 16); r[3] = x[3] - __uint_as_float(h.y & 0xffff0000u);
    r[4] = x[4] - __uint_as_float(h.z << 16); r[5] = x[5] - __uint_as_float(h.z & 0xffff0000u); r[6] = x[6] - __uint_as_float(h.w << 16); r[7] = x[7] - __uint_as_float(h.w & 0xffff0000u);
    lw.x = pack2(r[0], r[1]); lw.y = pack2(r[2], r[3]); lw.z = pack2(r[4], r[5]); lw.w = pack2(r[6], r[7]);
    hi = __builtin_bit_cast(bf16x8, h); lo = __builtin_bit_cast(bf16x8, lw);
}
__device__ __forceinline__ void phase_router(ParamsC p, int l, float* smem) {
    const int tid = ltid(), lane = tid & 63, wid = tid >> 6;
    float* sh2 = smem;
    float* spart = smem + 16 * RT_LD;
    float* slg = spart + 8 * 16 * 48;
    int* bcnt = (int*)(slg + 16 * 36);
    if (tid < 32) bcnt[tid] = 0;
    const int ntok = (l < DEPTH - 1) ? T_ALL : T_LAT;
    const float* wre = p->w_re + (size_t)l * 1024 * 32; const float* wrg = p->w_rg + (size_t)l * 1024 * 4;
    bf16x8 bh[4][3], bl[4][3];
#pragma unroll
    for (int ks = 0; ks < 4; ++ks)
#pragma unroll
        for (int nt = 0; nt < 3; ++nt) { float w[8]; const int k0 = wid * 128 + ks * 32 + (lane >> 4) * 8, n = lane & 15;
#pragma unroll
            for (int j = 0; j < 8; ++j) w[j] = (nt < 2) ? wre[(size_t)(k0 + j) * 32 + nt * 16 + n] : (n < 4 ? wrg[(size_t)(k0 + j) * 4 + n] : 0.f);
            split8(w, bh[ks][nt], bl[ks][nt]); }
    float4 gf[4];
#pragma unroll
    for (int i = 0; i < 4; ++i) gf[i] = *(const float4*)(p->g_ffn + l * 1024 + i * 256 + lane * 4);
    const float* xs = p->xs; bf16_t* hout = p->h; const float* modv = p->modv + (size_t)l * 5 * 6144 + 3072;
    const int G = gridDim.x, ntb = ntok / 16;
    __syncthreads();
    for (int tb = lbid(); tb < ntb; tb += G) {
#pragma unroll
        for (int j = 0; j < 2; ++j) { const int tt = wid * 2 + j, t = tb * 16 + tt; const int v = tok_variant(t);
            float4 xv[4]; float ss = 0.f;
#pragma unroll
            for (int i = 0; i < 4; ++i) { xv[i] = *(const float4*)(xs + (size_t)t * 1024 + i * 256 + lane * 4); ss += xv[i].x * xv[i].x + xv[i].y * xv[i].y + xv[i].z * xv[i].z + xv[i].w * xv[i].w; }
            ss = wave_sum(ss); const float rstd = rsqrtf(ss * (1.0f / 1024.0f) + 1e-6f);
            const float* mv = modv + (size_t)v * 6144;
#pragma unroll
            for (int i = 0; i < 4; ++i) { const int c = i * 256 + lane * 4;
                const float4 g = gf[i], sh = *(const float4*)(mv + c), sc = *(const float4*)(mv + 1024 + c);
                float4 o; o.x = xv[i].x * rstd * g.x * (1.f + sc.x) + sh.x; o.y = xv[i].y * rstd * g.y * (1.f + sc.y) + sh.y; o.z = xv[i].z * rstd * g.z * (1.f + sc.z) + sh.z; o.w = xv[i].w * rstd * g.w * (1.f + sc.w) + sh.w;
                *(float4*)(sh2 + tt * RT_LD + c) = o; uint2 ob; ob.x = pack2(o.x, o.y); ob.y = pack2(o.z, o.w); *(uint2*)(hout + (size_t)t * 1024 + c) = ob; } }
        __syncthreads();
        {   f32x4 c0 = (f32x4){0.f, 0.f, 0.f, 0.f}, c1 = c0, c2 = c0;
            const float* ap = sh2 + (lane & 15) * RT_LD + wid * 128 + (lane >> 4) * 8;
#pragma unroll
            for (int ks = 0; ks < 4; ++ks) { const float4 a0 = *(const float4*)(ap + ks * 32), a1 = *(const float4*)(ap + ks * 32 + 4);
                const float x8[8] = {a0.x, a0.y, a0.z, a0.w, a1.x, a1.y, a1.z, a1.w}; bf16x8 ah, al; split8(x8, ah, al);
                c0 = __builtin_amdgcn_mfma_f32_16x16x32_bf16(ah, bh[ks][0], c0, 0, 0, 0); c0 = __builtin_amdgcn_mfma_f32_16x16x32_bf16(ah, bl[ks][0], c0, 0, 0, 0); c0 = __builtin_amdgcn_mfma_f32_16x16x32_bf16(al, bh[ks][0], c0, 0, 0, 0);
                c1 = __builtin_amdgcn_mfma_f32_16x16x32_bf16(ah, bh[ks][1], c1, 0, 0, 0); c1 = __builtin_amdgcn_mfma_f32_16x16x32_bf16(ah, bl[ks][1], c1, 0, 0, 0); c1 = __builtin_amdgcn_mfma_f32_16x16x32_bf16(al, bh[ks][1], c1, 0, 0, 0);
                c2 = __builtin_amdgcn_mfma_f32_16x16x32_bf16(ah, bh[ks][2], c2, 0, 0, 0); c2 = __builtin_amdgcn_mfma_f32_16x16x32_bf16(ah, bl[ks][2], c2, 0, 0, 0); c2 = __builtin_amdgcn_mfma_f32_16x16x32_bf16(al, bh[ks][2], c2, 0, 0, 0); }
#pragma unroll
            for (int r = 0; r < 4; ++r) { float* sp = spart + (wid * 16 + 4 * (lane >> 4) + r) * 48 + (lane & 15); sp[0] = c0[r]; sp[16] = c1[r]; sp[32] = c2[r]; } }
        __syncthreads();
        {   const int tt = tid >> 5, j = tid & 31; float a = p->b_re[l * 32 + j];
#pragma unroll
            for (int w8 = 0; w8 < 8; ++w8) a += spart[(w8 * 16 + tt) * 48 + j];
            slg[tt * 36 + 4 + j] = a;
            if (tid < 64) { const int t2 = tid >> 2, j2 = tid & 3; float a2 = p->b_rg[l * 4 + j2];
#pragma unroll
                for (int w8 = 0; w8 < 8; ++w8) a2 += spart[(w8 * 16 + t2) * 48 + 32 + j2];
                slg[t2 * 36 + j2] = a2; } }
        __syncthreads();
        if (tid < 16) { const int t = tb * 16 + tid; const float* lg = slg + tid * 36;
            int gi = 0; float gm = lg[0];
#pragma unroll
            for (int j = 1; j < 4; ++j) if (lg[j] > gm) { gm = lg[j]; gi = j; }
            float den = 0.f;
#pragma unroll
            for (int j = 0; j < 4; ++j) den += __expf(lg[j] - gm);
            const float pg = __builtin_amdgcn_rcpf(den);
            const float* le = lg + 4 + gi * 8;
            int i1 = 0; float v1 = le[0];
#pragma unroll
            for (int j = 1; j < 8; ++j) if (le[j] > v1) { v1 = le[j]; i1 = j; }
            int i2 = -1; float v2 = -3.0e38f;
#pragma unroll
            for (int j = 0; j < 8; ++j) if (j != i1 && le[j] > v2) { v2 = le[j]; i2 = j; }
            const float e2 = __expf(v2 - v1); const float wa = __builtin_amdgcn_rcpf(1.0f + e2), wb = e2 * wa;
            const int ea = gi * 8 + i1, eb = gi * 8 + i2;
            p->eid[t * 2] = ea; p->eid[t * 2 + 1] = eb; p->ewt[t * 2] = pg * wa; p->ewt[t * 2 + 1] = pg * wb;
            p->epos[t * 2] = atomicAdd(bcnt + ea, 1); p->epos[t * 2 + 1] = atomicAdd(bcnt + eb, 1); }
        __syncthreads();
    }
    __syncthreads();
    if (tid < 32) p->cnt[lbid() * 32 + tid] = bcnt[tid];
}

__device__ __forceinline__ void phase_dispatch(ParamsC p, int l, int* smem) {
    const int tid = ltid(), lane = tid & 63, wid = tid >> 6;
    int* sfull = smem;
    int* spre = smem + 512;
    int* pstart = smem + 1024;
    int* boff = smem + 1024 + 64;
    const int G = gridDim.x;
    {   const int e = tid & 31, part = tid >> 5; int sf = 0, sp = 0;
        for (int bb = part; bb < G; bb += 16) { const int c = p->cnt[bb * 32 + e]; sf += c; sp += (bb < lbid()) ? c : 0; }
        sfull[part * 32 + e] = sf; spre[part * 32 + e] = sp; }
    __syncthreads();
    if (tid < 32) { int tf = 0, tp = 0; for (int q = 0; q < 16; ++q) { tf += sfull[q * 32 + tid]; tp += spre[q * 32 + tid]; } sfull[tid] = tf; spre[tid] = tp; }
    __syncthreads();
    if (tid == 0) { int acc = 0; for (int e = 0; e < 32; ++e) { pstart[e] = acc; acc += ((sfull[e] + 255) >> 8) << 8; } pstart[32] = acc; }
    __syncthreads();
    if (tid < 32) boff[tid] = pstart[tid] + spre[tid];
    if (lbid() == 0) { const int nb = pstart[32] >> 8;
        for (int rb = tid; rb < nb; rb += NTHR) { int e = 0; while (e < 31 && pstart[e + 1] <= rb * 256) ++e; p->blk_e[rb] = e; }
        if (tid == 0) p->nbu[0] = nb; }
    __syncthreads();
    const int ntok = (l < DEPTH - 1) ? T_ALL : T_LAT;
    for (int tb = lbid(); tb < ntok / 16; tb += G) {
#pragma unroll
        for (int j = 0; j < 4; ++j) { const int a = tb * 32 + wid * 4 + j; const int t = a >> 1; const int sl = boff[p->eid[a]] + p->epos[a];
            if (lane == 0) { p->slot[a] = sl; p->tokmap[sl] = t; } }
    }
    for (int e = lbid(); e < 32; e += G) { const int lo = pstart[e] + sfull[e], hi = pstart[e + 1]; for (int sl = lo + tid; sl < hi; sl += NTHR) p->tokmap[sl] = 0; }
}

__device__ __forceinline__ void phase_gemm_e1(ParamsC p, unsigned char* smem) {
    const int tid = ltid(), lane = tid & 63, wid = tid >> 6, wm = wid >> 1, wn = wid & 1, q4 = (lane >> 4) * 4;
    const int nb = p->nbu[0]; const int ntiles = nb * 2 * 4;
    for (int tile = lbid(); tile < ntiles; tile += gridDim.x) {
        const int rb = tile >> 2, tn = tile & 3, m0 = rb * 128, e = p->blk_e[rb >> 1];
        f32x4 acc[2][4]; zero_acc(acc);
        RowsLinear ar{p->xd + (size_t)m0 * 1024, 1024};
        gemm_core(smem, ar, p->wt_gu + ((size_t)e * 512 + tn * 128) * 1024, 1024, 0, 1024, acc);
        const int pg = tn * 2 + wn;
#pragma unroll
        for (int mi = 0; mi < 2; ++mi) { const int sl = m0 + wm * 32 + mi * 16 + (lane & 15);
#pragma unroll
            for (int nj = 0; nj < 2; ++nj) { f32x4 g = acc[mi][nj], u = acc[mi][nj + 2], o;
#pragma unroll
                for (int e4 = 0; e4 < 4; ++e4) o[e4] = g[e4] / (1.f + __expf(-g[e4])) * u[e4];
                store4bf(p->hid + (size_t)sl * 256 + pg * 32 + nj * 16 + q4, o); } }
    }
}
__device__ __forceinline__ void phase_gemm_e2(ParamsC p, unsigned char* smem) {
    const int tid = ltid(), lane = tid & 63, wid = tid >> 6, wm = wid >> 1, wn = wid & 1, q4 = (lane >> 4) * 4;
    const int nb = p->nbu[0]; const int ntiles = nb * 2 * 8;
    for (int tile = lbid(); tile < ntiles; tile += gridDim.x) {
        const int rb = tile >> 3, tn = tile & 7, m0 = rb * 128, n0 = tn * 128, e = p->blk_e[rb >> 1];
        f32x4 acc[2][4]; zero_acc(acc);
        RowsLinear ar{p->hid + (size_t)m0 * 256, 256};
        gemm_core(smem, ar, p->wt_d + ((size_t)e * 1024 + n0) * 256, 256, 0, 256, acc);
#pragma unroll
        for (int mi = 0; mi < 2; ++mi) { const int sl = m0 + wm * 32 + mi * 16 + (lane & 15);
#pragma unroll
            for (int nj = 0; nj < 4; ++nj) store4bf(p->Y + (size_t)sl * 1024 + n0 + wn * 64 + nj * 16 + q4, acc[mi][nj]); }
    }
}


struct EpiIn { static constexpr bool PERM = true, AFTER_DRAIN = false, HOOK = false;
    bf16_t* uA; bf16_t* uG; const float* ropet;
    __device__ __forceinline__ void operator()(const f32x4 (&acc)[2][2][4][2], const pg8::Unit& u, int wr, int wc, int fr, int fq) const {
        const int row0 = u.pm * 256 + wr * 64 + fr; const bool latent = u.pm < 128;
#pragma unroll
        for (int bj = 0; bj < 2; ++bj) {
            const int cb32 = u.pn * 256 + bj * 128 + wc * 32, c0 = cb32 + 8 * fq;
            if (cb32 >= 2560) {
#pragma unroll
                for (int ai = 0; ai < 2; ++ai)
#pragma unroll
                    for (int m = 0; m < 4; ++m) { const int t = row0 + ai * 128 + m * 16; f32x4 v0 = acc[ai][bj][m][0], v1 = acc[ai][bj][m][1];
#pragma unroll
                        for (int e = 0; e < 4; ++e) { v0[e] = __builtin_amdgcn_rcpf(1.f + __expf(-v0[e])); v1[e] = __builtin_amdgcn_rcpf(1.f + __expf(-v1[e])); }
                        const int gt_ = (u.pn - 10), wv_ = wr * 4 + wc;
                        *(pg8::u32x4*)(uG + ((((size_t)u.pm * 12 + gt_) * 8 + wv_) * 16 + (ai * 8 + m * 2 + bj)) * 512 + (fq * 16 + fr) * 8) = pack8(v0, v1); }
            } else {
                const bool isq = (cb32 >= 768 && cb32 < 1152) || (cb32 >= 1920 && cb32 < 2304);
                const bool rope = (cb32 >= 1920 && cb32 < 2432) && latent;
#pragma unroll
                for (int ai = 0; ai < 2; ++ai)
#pragma unroll
                    for (int m = 0; m < 4; ++m) { const int t = row0 + ai * 128 + m * 16; f32x4 v0 = acc[ai][bj][m][0], v1 = acc[ai][bj][m][1];
                        if (rope) { const int pos = t & 8191; const int posv = (wc & 1) ? (pos & 63) : (pos >> 6);
                            const float4* cs = (const float4*)(ropet + (posv * 16 + 8 * (fq & 1)) * 2);
                            const float4 c01 = cs[0], c23 = cs[1], c45 = cs[2], c67 = cs[3];
                            f32x4 p0, p1;
#pragma unroll
                            for (int e = 0; e < 4; ++e) { p0[e] = __shfl_xor(v0[e], 32); p1[e] = __shfl_xor(v1[e], 32); }
                            const float co0[4] = {c01.x, c01.z, c23.x, c23.z}, si0[4] = {c01.y, c01.w, c23.y, c23.w}, co1[4] = {c45.x, c45.z, c67.x, c67.z}, si1[4] = {c45.y, c45.w, c67.y, c67.w};
#pragma unroll
                            for (int e = 0; e < 4; ++e) {
                                if (fq < 2) { v0[e] = v0[e] * co0[e] - p0[e] * si0[e]; v1[e] = v1[e] * co1[e] - p1[e] * si1[e]; }
                                else { v0[e] = p0[e] * si0[e] + v0[e] * co0[e]; v1[e] = p1[e] * si1[e] + v1[e] * co1[e]; } } }
                        if (isq) { v0 = v0 * (0.125f * QLOG2E); v1 = v1 * (0.125f * QLOG2E); }
                        *(pg8::u32x4*)(uA + (size_t)t * UA_LD + c0) = pack8(v0, v1); }
            }
        }
    }
};

struct EpiMerge { static constexpr bool PERM = true, AFTER_DRAIN = false, HOOK = true;
    const bf16_t* uG; bf16_t* mo;
    __device__ __forceinline__ void hook(f32x4 (&acc)[2][2][4][2], const pg8::Unit& u, int t, int wr, int wc, int fr, int fq) const {
        int lo_ = (fq * 16 + fr) * 8; asm volatile("" : "+v"(lo_)); const int seg = (t == 2) ? 0 : 1;
        const bf16_t* gbase = uG + ((((size_t)u.pm * 12 + seg * 4 + u.pn) * 8 + (wr * 4 + wc)) * 16) * 512 + lo_;
#pragma unroll
        for (int ai = 0; ai < 2; ++ai) {
            pg8::u32x4 wn[4][2], wd[4][2];
#pragma unroll
            for (int m = 0; m < 4; ++m)
#pragma unroll
                for (int bj = 0; bj < 2; ++bj) { const bf16_t* gp = gbase + (ai * 8 + m * 2 + bj) * 512; wn[m][bj] = *(const pg8::u32x4*)gp; wd[m][bj] = *(const pg8::u32x4*)(gp + 4 * 65536); }
#pragma unroll
            for (int m = 0; m < 4; ++m)
#pragma unroll
                for (int bj = 0; bj < 2; ++bj) { f32x4 n0, n1, d0, d1; unpack8(wn[m][bj], n0, n1); unpack8(wd[m][bj], d0, d1);
#pragma unroll
                    for (int e = 0; e < 4; ++e) { acc[ai][bj][m][0][e] *= n0[e] * __builtin_amdgcn_rcpf(fmaxf(d0[e], 1e-20f)); acc[ai][bj][m][1][e] *= n1[e] * __builtin_amdgcn_rcpf(fmaxf(d1[e], 1e-20f)); } }
            asm volatile("" ::: "memory");
        }
    }
    __device__ __forceinline__ void operator()(const f32x4 (&acc)[2][2][4][2], const pg8::Unit& u, int wr, int wc, int fr, int fq) const {
        const int row0 = u.pm * 256 + wr * 64 + fr; const int c00 = u.pn * 256 + wc * 32 + 8 * fq;
#pragma unroll
        for (int ai = 0; ai < 2; ++ai) { pg8::u32x4 wg[4][2];
#pragma unroll
            for (int m = 0; m < 4; ++m)
#pragma unroll
                for (int bj = 0; bj < 2; ++bj) wg[m][bj] = *(const pg8::u32x4*)(uG + ((((size_t)u.pm * 12 + 8 + u.pn) * 8 + (wr * 4 + wc)) * 16 + (ai * 8 + m * 2 + bj)) * 512 + (fq * 16 + fr) * 8);
#pragma unroll
            for (int m = 0; m < 4; ++m)
#pragma unroll
                for (int bj = 0; bj < 2; ++bj) { f32x4 g0, g1; unpack8(wg[m][bj], g0, g1); f32x4 v0 = acc[ai][bj][m][0], v1 = acc[ai][bj][m][1];
#pragma unroll
                    for (int e = 0; e < 4; ++e) { v0[e] *= fmaxf(g0[e], 1e-20f); v1[e] *= fmaxf(g1[e], 1e-20f); }
                    *(pg8::u32x4*)(mo + (size_t)(row0 + ai * 128 + m * 16) * 1024 + c00 + bj * 128) = pack8(v0, v1); }
            asm volatile("" ::: "memory"); }
    }
};

struct EpiO { static constexpr bool PERM = false, AFTER_DRAIN = false, HOOK = false;
    float* xs; const float* modv_l;
    __device__ __forceinline__ void operator()(const f32x4 (&acc)[2][2][4][2], const pg8::Unit& u, int wr, int wc, int fr, int fq) const {
        const int row0 = u.pm * 256 + wr * 64 + fr; const int v = u.pm < 128 ? (u.pm >> 5) : 4; const float* gt = modv_l + (size_t)v * 6144 + 2048;
        const int col0 = u.pn * 256 + wc * 32 + 4 * fq;
        f32x4 gv[2][2];
#pragma unroll
        for (int bj = 0; bj < 2; ++bj)
#pragma unroll
            for (int n = 0; n < 2; ++n) gv[bj][n] = *(const f32x4*)(gt + col0 + bj * 128 + n * 16);
#pragma unroll
        for (int ai = 0; ai < 2; ++ai)
#pragma unroll
            for (int mp = 0; mp < 2; ++mp) { f32x4 xv[2][2][2];
#pragma unroll
                for (int mm = 0; mm < 2; ++mm)
#pragma unroll
                    for (int bj = 0; bj < 2; ++bj)
#pragma unroll
                        for (int n = 0; n < 2; ++n) xv[mm][bj][n] = *(const f32x4*)(xs + (size_t)(row0 + ai * 128 + (mp * 2 + mm) * 16) * 1024 + col0 + bj * 128 + n * 16);
#pragma unroll
                for (int mm = 0; mm < 2; ++mm)
#pragma unroll
                    for (int bj = 0; bj < 2; ++bj)
#pragma unroll
                        for (int n = 0; n < 2; ++n) *(f32x4*)(xs + (size_t)(row0 + ai * 128 + (mp * 2 + mm) * 16) * 1024 + col0 + bj * 128 + n * 16) = xv[mm][bj][n] + gv[bj][n] * acc[ai][bj][mp * 2 + mm][n];
                asm volatile("" ::: "memory"); }
    }
};

struct EpiE1 { static constexpr bool PERM = true, AFTER_DRAIN = false, HOOK = false;
    bf16_t* hid;
    __device__ __forceinline__ void operator()(const f32x4 (&acc)[2][2][4][2], const pg8::Unit& u, int wr, int wc, int fr, int fq) const {
        const int row0 = u.pm * 256 + wr * 64 + fr; const int c0 = (u.pn & 1) * 128 + wc * 32 + 8 * fq;
#pragma unroll
        for (int ai = 0; ai < 2; ++ai)
#pragma unroll
            for (int m = 0; m < 4; ++m) { f32x4 o0, o1;
#pragma unroll
                for (int e = 0; e < 4; ++e) { const float g0 = acc[ai][0][m][0][e], g1 = acc[ai][0][m][1][e];
                    o0[e] = g0 * __builtin_amdgcn_rcpf(1.f + __expf(-g0)) * acc[ai][1][m][0][e]; o1[e] = g1 * __builtin_amdgcn_rcpf(1.f + __expf(-g1)) * acc[ai][1][m][1][e]; }
                *(pg8::u32x4*)(hid + (size_t)(row0 + ai * 128 + m * 16) * 256 + c0) = pack8(o0, o1); }
    }
};

struct EpiE2 { static constexpr bool PERM = true, AFTER_DRAIN = false, HOOK = false;
    bf16_t* Y;
    __device__ __forceinline__ void operator()(const f32x4 (&acc)[2][2][4][2], const pg8::Unit& u, int wr, int wc, int fr, int fq) const {
        const int row0 = u.pm * 256 + wr * 64 + fr; const int c0 = (u.pn & 3) * 256 + wc * 32 + 8 * fq;
#pragma unroll
        for (int ai = 0; ai < 2; ++ai)
#pragma unroll
            for (int m = 0; m < 4; ++m)
#pragma unroll
                for (int bj = 0; bj < 2; ++bj) *(pg8::u32x4*)(Y + (size_t)(row0 + ai * 128 + m * 16) * 1024 + c0 + bj * 128) = pack8(acc[ai][bj][m][0], acc[ai][bj][m][1]);
    }
};

__device__ __forceinline__ void phase_pg_in(ParamsC p, int l, unsigned char* smem) {
    pg8::Gemm g{p->h, WSEL(wt_in, l), T_ALL, IN_COLS, 1024, nullptr}; pg8::StaticOrder S; S.init(T_ALL, IN_COLS, (int)gridDim.x, lbid());
    EpiIn E{p->uA, p->uG, p->ropet};
    pg8::gemm_phase<EpiIn, pg8::StaticOrder, true, true>((PG8_LAS unsigned char*)smem, g, S, E);
}
__device__ __forceinline__ void phase_pg_merge(ParamsC p, int l, unsigned char* smem) {
    const int M = (l < DEPTH - 1) ? T_ALL : T_LAT;
    pg8::Gemm g{p->ycat, WSEL(wt_br, l), M, 1024, 1024, nullptr}; pg8::StaticOrder S; S.init(M, 1024, (int)gridDim.x, lbid());
    EpiMerge E{p->uG, p->mbuf};
    pg8::gemm_phase<EpiMerge, pg8::StaticOrder, true, true>((PG8_LAS unsigned char*)smem, g, S, E);
    if (l < DEPTH - 1) { const int G = (int)gridDim.x, extra = (M / 256) * 4 - 2 * G, c = lbid(); const bool part = extra > 0 && extra < G;
        const int first = part ? c - extra : c, stride = part ? G - extra : G;
        if (first >= 0) phase_wconv(p, l + 1, (float*)smem, 0, WC_TOTAL / 2, first, stride); }
}
__device__ __forceinline__ void phase_pg_o(ParamsC p, int l, unsigned char* smem) {
    const int M = (l < DEPTH - 1) ? T_ALL : T_LAT;
    pg8::Gemm g{p->mbuf, WSEL(wt_o, l), M, 1024, 1024, nullptr}; pg8::StaticOrder S; S.init(M, 1024, (int)gridDim.x, lbid());
    EpiO E{p->xs, p->modv + (size_t)l * 5 * 6144};
    pg8::gemm_phase<EpiO, pg8::StaticOrder, true, true>((PG8_LAS unsigned char*)smem, g, S, E);
    if (l < DEPTH - 1) { const int G = (int)gridDim.x, extra = (M / 256) * 4 - 2 * G, c = lbid(); const bool part = extra > 0 && extra < G;
        const int first = part ? c - extra : c, stride = part ? G - extra : G;
        if (first >= 0) phase_wconv(p, l + 1, (float*)smem, WC_TOTAL / 2, WC_TOTAL, first, stride); }
}
__device__ __forceinline__ void phase_pg_e1(ParamsC p, int l, unsigned char* smem) {
    const int nb = p->nbu[0];
    pg8::Gemm g{p->h, WSEL(wt_gu, l), nb * 256, 512, 1024, p->tokmap}; pg8::GroupedOrder<2> S{p->blk_e, nb * 2, (int)gridDim.x, lbid()};
    EpiE1 E{p->hid};
    pg8::gemm_phase<EpiE1, pg8::GroupedOrder<2>, true, true, true>((PG8_LAS unsigned char*)smem, g, S, E);
}
__device__ __forceinline__ void phase_pg_e2(ParamsC p, int l, unsigned char* smem) {
    const int nb = p->nbu[0];
    pg8::Gemm g{p->hid, WSEL(wt_d, l), nb * 256, 1024, 256, nullptr}; pg8::GroupedOrder<4> S{p->blk_e, nb * 4, (int)gridDim.x, lbid()};
    EpiE2 E{p->Y};
    pg8::gemm_phase<EpiE2, pg8::GroupedOrder<4>, true, true>((PG8_LAS unsigned char*)smem, g, S, E);
}

#define XB_TMO      128
#define XB_XCNT(j)  (256  + 64 * (j))
#define XB_XSUB(j)  (1280 + 64 * (j))
#define XB_XGEN(j)  (2304 + 64 * (j))
#define XB_TOP      3328
#define XB_TOPGEN   3392
#define XCD_BAR_WORDS 3456
#define XB_SPIN_CAP (1u << 18)
__device__ __forceinline__ unsigned xb_ld(unsigned* p)              { return __hip_atomic_load(p, __ATOMIC_RELAXED, __HIP_MEMORY_SCOPE_AGENT); }
__device__ __forceinline__ unsigned xb_add(unsigned* p, unsigned v) { return __hip_atomic_fetch_add(p, v, __ATOMIC_RELAXED, __HIP_MEMORY_SCOPE_AGENT); }
__device__ __forceinline__ unsigned xb_xcc_id() { return (unsigned)__builtin_amdgcn_s_getreg((3 << 11) | 20) & 0xFu; }
#define XB_SPIN(cond, bar) do { unsigned _sp = 0; while (cond) { __builtin_amdgcn_s_sleep(1); \
    if ((++_sp & 255u) == 0u) { if (xb_ld(&(bar)[XB_TMO])) break; if (_sp > XB_SPIN_CAP) { atomicAdd(&(bar)[XB_TMO], 1u); break; } } } } while (0)
struct XcdBarrier { unsigned* bar; unsigned x; volatile LAS unsigned* st; };
__device__ __forceinline__ XcdBarrier xcd_barrier_post(unsigned* bar, volatile LAS unsigned* st) {
    XcdBarrier b; b.bar = bar; b.x = xb_xcc_id(); b.st = st;
    if (threadIdx.x == 0) (void)xb_add(&bar[XB_XCNT(b.x)], 1u);
    return b;
}
__device__ __forceinline__ void xcd_barrier_complete(unsigned* bar, unsigned x, unsigned& nloc, unsigned& nx) {
    const unsigned G = gridDim.x * gridDim.y * gridDim.z;
    unsigned sum, cnt, mine, sp = 0u;
    for (;;) {
        sum = 0u; cnt = 0u; mine = 0u;
#pragma unroll
        for (unsigned j = 0; j < 16; ++j) { const unsigned c = xb_ld(&bar[XB_XCNT(j)]); sum += c; cnt += (c > 0u) ? 1u : 0u; mine = (j == x) ? c : mine; }
        if (sum == G) break;
        __builtin_amdgcn_s_sleep(1);
        if ((++sp & 255u) == 0u) { if (xb_ld(&bar[XB_TMO])) break; if (sp > XB_SPIN_CAP) { atomicAdd(&bar[XB_TMO], 1u); break; } }
    }
    nloc = mine > 0u ? mine : 1u; nx = cnt > 0u ? cnt : 1u;
}
__device__ __forceinline__ void xcd_barrier(const XcdBarrier& b) {
    asm volatile("s_waitcnt vmcnt(0)" ::: "memory");
    __syncthreads();
    if (threadIdx.x == 0) {
        unsigned* bar = b.bar;
        __builtin_amdgcn_s_waitcnt(0);
        unsigned nloc = b.st[0], nx = b.st[1];
        if (nloc == 0u) { xcd_barrier_complete(bar, b.x, nloc, nx); b.st[0] = nloc; b.st[1] = nx; }
        const unsigned old = xb_add(&bar[XB_XSUB(b.x)], 1u);
        const unsigned gen = old / nloc;
        if (old + 1u == (gen + 1u) * nloc) {
            __builtin_amdgcn_fence(__ATOMIC_RELEASE, "agent");
            asm volatile("s_waitcnt vmcnt(0)" ::: "memory");
            const unsigned og = xb_add(&bar[XB_TOP], 1u);
            const unsigned tg = og / nx;
            if (og + 1u == (tg + 1u) * nx) xb_add(&bar[XB_TOPGEN], 1u);
            else XB_SPIN(xb_ld(&bar[XB_TOPGEN]) == tg, bar);
            __builtin_amdgcn_fence(__ATOMIC_ACQUIRE, "agent");
            xb_add(&bar[XB_XGEN(b.x)], 1u);
            asm volatile("s_waitcnt vmcnt(0)" ::: "memory");
        } else {
            XB_SPIN(xb_ld(&bar[XB_XGEN(b.x)]) == gen, bar);
            __builtin_amdgcn_fence(__ATOMIC_ACQUIRE, "agent");
            asm volatile("s_waitcnt vmcnt(0)" ::: "memory");
        }
    }
    __syncthreads();
}

#define SMEM_BYTES 131072
#ifndef PROBE_MASK
#define PROBE_MASK 0
#endif
#define PROBE_MULT 4
#define PH_BEGIN(id) do { if (PROBE_MASK & (1 << (id))) t0 = wall_clock64(); } while (0)
#define PH_END(id) do { if (PROBE_MASK & (1 << (id))) tacc += wall_clock64() - t0; } while (0)
__global__ void __launch_bounds__(NTHR, 2) k_mega(Params p_unused) {
    const ParamsC pk = (ParamsC)__builtin_amdgcn_kernarg_segment_ptr();
#define PP() ({ ParamsC q_ = pk; asm volatile("" : "+s"(q_) :: "memory"); q_; })
    extern __shared__ __attribute__((aligned(16))) unsigned char smem[];
    volatile LAS unsigned* xbw = (volatile LAS unsigned*)(smem + SMEM_BYTES);
    if (threadIdx.x == 0) { xbw[0] = 0u; xbw[1] = 0u; xbw[2] = 0u; xbw[3] = 0u; }
    __syncthreads();
    (void)xcd_barrier_post(PP()->bar, xbw);
    unsigned long long tacc = 0, t0 = 0;
#define GRID_BAR() do { XcdBarrier bar_; bar_.bar = PP()->bar; bar_.x = xb_xcc_id(); bar_.st = xbw; xcd_barrier(bar_); } while (0)
    PH_BEGIN(0); phase_mod(PP(), (float*)smem); phase_wconv(PP(), 0, (float*)smem, 0, WC_TOTAL, lbid(), (int)gridDim.x); GRID_BAR(); PH_END(0);
    for (int l = 0; l < DEPTH; ++l) {
        PH_BEGIN(1); phase_norm1(PP(), l); GRID_BAR(); PH_END(1);
        PH_BEGIN(2); phase_pg_in(PP(), l, smem); GRID_BAR(); PH_END(2);
        PH_BEGIN(3); PH_BEGIN(11); phase_conv(PP(), l); PH_END(11); PH_BEGIN(12); phase_na(PP(), l, smem); PH_END(12); PH_BEGIN(13); phase_swa(PP(), l, smem); PH_END(13); GRID_BAR(); PH_END(3);
        PH_BEGIN(4); phase_pg_merge(PP(), l, smem); GRID_BAR(); PH_END(4);
        PH_BEGIN(5); phase_pg_o(PP(), l, smem); GRID_BAR(); PH_END(5);
        PH_BEGIN(6); phase_router(PP(), l, (float*)smem); GRID_BAR(); PH_END(6);
        PH_BEGIN(7); phase_dispatch(PP(), l, (int*)smem); GRID_BAR(); PH_END(7);
        PH_BEGIN(8); phase_pg_e1(PP(), l, smem); GRID_BAR(); PH_END(8);
        PH_BEGIN(9); phase_pg_e2(PP(), l, smem); GRID_BAR(); PH_END(9);
    }
    PH_BEGIN(10); phase_norm1(PP(), DEPTH); PH_END(10);
    if (PROBE_SUB != 0 && threadIdx.x == 0) tacc += ((volatile LAS unsigned*)(smem + 131072 + 8))[0];
    if ((PROBE_MASK != 0 || PROBE_SUB != 0) && blockIdx.x == 0) { const unsigned long long te = wall_clock64(); while (wall_clock64() - te < tacc * PROBE_MULT) __builtin_amdgcn_s_sleep(8); }
}

extern "C" void kernel_launch(void* const* d_in, const int* in_sizes, int n_in, void* d_out, int out_size, void* d_ws, size_t ws_size, hipStream_t stream) {
    Params p{};
    p.x = (const float*)d_in[0]; p.c = (const float*)d_in[1]; p.ctx = (const float*)d_in[2]; p.c_ctx = (const float*)d_in[3]; p.w_mod = (const float*)d_in[4]; p.b_mod = (const float*)d_in[5];
    p.g_attn = (const float*)d_in[6]; p.g_ffn = (const float*)d_in[7]; p.w_in = (const float*)d_in[8]; p.conv_w = (const float*)d_in[9]; p.rpb = (const float*)d_in[10]; p.sinks = (const float*)d_in[11];
    p.w_branch = (const float*)d_in[12]; p.w_o = (const float*)d_in[13]; p.w_rg = (const float*)d_in[14]; p.b_rg = (const float*)d_in[15]; p.w_re = (const float*)d_in[16]; p.b_re = (const float*)d_in[17];
    p.w_eg = (const float*)d_in[18]; p.w_eu = (const float*)d_in[19]; p.w_ed = (const float*)d_in[20]; p.g_final = (const float*)d_in[21];
    p.out = (float*)d_out;
    unsigned char* w = (unsigned char*)d_ws; size_t off = 0;
    auto take = [&](size_t bytes) { unsigned char* r = w + off; off += (bytes + 255) & ~(size_t)255; return r; };
    p.bar = (unsigned*)take(16384); p.cnt = (int*)take(1024 * 32 * 4); p.blk_e = (int*)take(MAXBLK * 4); p.nbu = (int*)take(256);
    p.modv = (float*)take((size_t)DEPTH * 5 * 6144 * 4); p.ropet = (float*)take(128 * 16 * 2 * 4);
    p.eid = (int*)take((size_t)T_ALL * 2 * 4); p.epos = (int*)take((size_t)T_ALL * 2 * 4); p.ewt = (float*)take((size_t)T_ALL * 2 * 4); p.slot = (int*)take((size_t)T_ALL * 2 * 4); p.tokmap = (int*)take((size_t)MAXBLK * 256 * 4);
    p.xs = (float*)take((size_t)T_ALL * 1024 * 4);
    p.h = (bf16_t*)take((size_t)T_ALL * 1024 * 2);
    p.wt_in = (bf16_t*)take((size_t)IN_COLS * 1024 * 2); p.wt_br = (bf16_t*)take((size_t)1024 * 1024 * 2); p.wt_o = (bf16_t*)take((size_t)1024 * 1024 * 2);
    p.wt_gu = (bf16_t*)take((size_t)32 * 512 * 1024 * 2); p.wt_d = (bf16_t*)take((size_t)32 * 1024 * 256 * 2);
    {   unsigned char* o = (unsigned char*)d_out; size_t oo = 0;
        auto take_o = [&](size_t bytes) { unsigned char* r = o + oo; oo += (bytes + 255) & ~(size_t)255; return r; };
        p.wt_in1 = (bf16_t*)take_o((size_t)IN_COLS * 1024 * 2); p.wt_br1 = (bf16_t*)take_o((size_t)1024 * 1024 * 2); p.wt_o1 = (bf16_t*)take_o((size_t)1024 * 1024 * 2);
        p.wt_gu1 = (bf16_t*)take_o((size_t)32 * 512 * 1024 * 2); p.wt_d1 = (bf16_t*)take_o((size_t)32 * 1024 * 256 * 2);
        if (oo > (size_t)out_size * 4) return; }
    p.uA = (bf16_t*)take((size_t)T_ALL * UA_LD * 2); p.uG = (bf16_t*)take((size_t)T_ALL * UG_LD * 2); p.ycat = (bf16_t*)take((size_t)T_ALL * 1024 * 2);
    p.mbuf = p.uA; p.xd = p.uA; p.hid = p.ycat; p.Y = p.uG;
    if (off > ws_size) return;
    constexpr size_t kDynLds = SMEM_BYTES + 16;
    static int grid = 0;
    if (!grid) {
        (void)hipFuncSetAttribute((const void*)k_mega, hipFuncAttributeMaxDynamicSharedMemorySize, (int)kDynLds);
        int dev = 0, cus = 0, per_cu = 0;
        (void)hipGetDevice(&dev);
        (void)hipDeviceGetAttribute(&cus, hipDeviceAttributeMultiprocessorCount, dev);
        (void)hipOccupancyMaxActiveBlocksPerMultiprocessor(&per_cu, (const void*)k_mega, NTHR, kDynLds);
        grid = cus * (per_cu < 1 ? per_cu : 1);
        if (grid <= 0) grid = 0;
    }
    if (!grid) return;
    (void)hipMemsetAsync(p.bar, 0, XCD_BAR_WORDS * sizeof(unsigned), stream);
    hipLaunchKernelGGL(k_mega, dim3(grid), dim3(NTHR), kDynLds, stream, p);
}
```

```cpp
#include <hip/hip_runtime.h>
#include <stdint.h>

typedef unsigned short bf16_t;
typedef short bf16x8 __attribute__((ext_vector_type(8)));
typedef float f32x4 __attribute__((ext_vector_type(4)));

#define D_MODEL 1024
#define NB 4
#define SEQ 8192
#define DEPTH 4
#define CTXL 256
#define T_LAT 32768
#define T_CTX 1024
#define T_ALL 33792
#define UA_LD 2560
#define UG_LD 3072
#define IN_COLS 5632
#define MAXBLK 296
#define NTHR 512
#ifndef PROBE_SUB
#define PROBE_SUB 0
#endif
#define SUB_T0(id) unsigned long long st0_ = 0; if (PROBE_SUB == (id) && threadIdx.x == 0) st0_ = wall_clock64();
#define SUB_ACC(id) if (PROBE_SUB == (id) && threadIdx.x == 0) { volatile LAS unsigned* sw_ = (volatile LAS unsigned*)(smem + 131072 + 8); sw_[0] = sw_[0] + (unsigned)(wall_clock64() - st0_); }
#define QLOG2E 1.4426950408889634f
#ifndef PGM
#define PGM 31
#endif
#define LAS __attribute__((address_space(3)))

struct Params {
    const float *x, *c, *ctx, *c_ctx, *w_mod, *b_mod, *g_attn, *g_ffn, *w_in, *conv_w, *rpb, *sinks, *w_branch, *w_o, *w_rg, *b_rg, *w_re, *b_re, *w_eg, *w_eu, *w_ed, *g_final;
    float* out;
    unsigned* bar; int* cnt; int* blk_e; int* nbu;
    float* modv; float* ropet; bf16_t* xs;
    bf16_t *h, *wt_in, *wt_br, *wt_o, *wt_gu, *wt_d, *uA, *uG, *ycat, *mbuf, *xd, *hid, *Y;
    int* eid; int* epos; float* ewt; int* slot; int* tokmap;
    bf16_t *wt_in1, *wt_br1, *wt_o1, *wt_gu1, *wt_d1;
};
typedef const __attribute__((address_space(4))) Params* ParamsC;
#define WSEL(X, l) (((l) & 1) ? p->X##1 : p->X)

__device__ __forceinline__ int lbid() { int b = blockIdx.x; asm volatile("" : "+s"(b) :: "memory"); return b; }
__device__ __forceinline__ int ltid() { int t = threadIdx.x; asm volatile("" : "+v"(t) :: "memory"); return t; }
__device__ __forceinline__ bf16_t f2bf(float f) { unsigned u = __float_as_uint(f); u += 0x7FFFu + ((u >> 16) & 1u); return (bf16_t)(u >> 16); }
__device__ __forceinline__ float bf2f(bf16_t b) { return __uint_as_float(((unsigned)b) << 16); }
typedef float f32x2_t __attribute__((ext_vector_type(2)));
typedef __bf16 bf16x2_t __attribute__((ext_vector_type(2)));
__device__ __forceinline__ unsigned pack2(float a, float b) { const f32x2_t v = {a, b}; const bf16x2_t r = __builtin_convertvector(v, bf16x2_t); return __builtin_bit_cast(unsigned, r); }
__device__ __forceinline__ float4 load4bf(const bf16_t* p) { const uint2 w = *(const uint2*)p; float4 r; r.x = __uint_as_float(w.x << 16); r.y = __uint_as_float(w.x & 0xffff0000u); r.z = __uint_as_float(w.y << 16); r.w = __uint_as_float(w.y & 0xffff0000u); return r; }
__device__ __forceinline__ float wave_sum(float v) { for (int o = 32; o > 0; o >>= 1) v += __shfl_xor(v, o); return v; }
__device__ __forceinline__ float wave_max(float v) { for (int o = 32; o > 0; o >>= 1) v = fmaxf(v, __shfl_xor(v, o)); return v; }
__device__ __forceinline__ int tok_variant(int t) { return t < T_LAT ? (t >> 13) : 4; }

__device__ __forceinline__ void phase_mod(ParamsC p, float* smem) {
    const int tid = ltid(), lane = tid & 63, wid = tid >> 6;
    float* s_silu = smem;
    float* s_part = smem + 5 * 1024;
    for (int i = tid; i < 5 * 1024; i += NTHR) { const int v = i >> 10, k = i & 1023; const float cv = v < 4 ? p->c[v * 1024 + k] : p->c_ctx[k]; s_silu[i] = cv / (1.0f + expf(-cv)); }
    __syncthreads();
    for (int item = lbid(); item < DEPTH * 96; item += gridDim.x) {
        const int l = item / 96, cb = item % 96, col = cb * 64 + lane;
        const float* w = p->w_mod + (size_t)l * 1024 * 6144 + col;
        float a0 = 0.f, a1 = 0.f, a2 = 0.f, a3 = 0.f, a4 = 0.f;
#pragma unroll 8
        for (int kk = 0; kk < 128; ++kk) { const int k = wid * 128 + kk; const float wv = w[(size_t)k * 6144];
            a0 += s_silu[k] * wv; a1 += s_silu[1024 + k] * wv; a2 += s_silu[2048 + k] * wv; a3 += s_silu[3072 + k] * wv; a4 += s_silu[4096 + k] * wv; }
        s_part[(wid * 5 + 0) * 64 + lane] = a0; s_part[(wid * 5 + 1) * 64 + lane] = a1; s_part[(wid * 5 + 2) * 64 + lane] = a2; s_part[(wid * 5 + 3) * 64 + lane] = a3; s_part[(wid * 5 + 4) * 64 + lane] = a4;
        __syncthreads();
        if (tid < 320) { const int v = tid >> 6, ln = tid & 63; float s = p->b_mod[l * 6144 + cb * 64 + ln];
            for (int w8 = 0; w8 < 8; ++w8) s += s_part[(w8 * 5 + v) * 64 + ln];
            p->modv[(size_t)(l * 5 + v) * 6144 + cb * 64 + ln] = s; }
        __syncthreads();
    }
    if (lbid() < 4) { const int i = lbid() * NTHR + tid; const int pos = i >> 4, f = i & 15;
        const float inv = powf(10000.0f, -(float)f / 16.0f); const float ang = (float)pos * inv; p->ropet[i * 2] = cosf(ang); p->ropet[i * 2 + 1] = sinf(ang); }
}

#define GU_IG 128
struct WcTile { const float* src; bf16_t* dst; int ldN, ldK, kt, nt, kind, e; };
__device__ __forceinline__ WcTile wconv_decode(ParamsC p, int l, int it) {
    const int n1 = 16 * 88, n2 = 256, n3 = 256, n4 = 2048, n5 = 2048;
    WcTile w; w.kind = 0; w.e = 0; int i = it;
    if (i < n1) { w.src = p->w_in + (size_t)l * 1024 * IN_COLS; w.ldN = IN_COLS; w.dst = WSEL(wt_in, l); w.ldK = 1024; w.kt = i / 88; w.nt = i % 88; }
    else if ((i -= n1) < n2) { w.src = p->w_branch + (size_t)l * 1024 * 1024; w.ldN = 1024; w.dst = WSEL(wt_br, l); w.ldK = 1024; w.kt = i / 16; w.nt = i % 16; }
    else if ((i -= n2) < n3) { w.src = p->w_o + (size_t)l * 1024 * 1024; w.ldN = 1024; w.dst = WSEL(wt_o, l); w.ldK = 1024; w.kt = i / 16; w.nt = i % 16; }
    else if ((i -= n3) < n4) { w.e = i / 64; i %= 64; w.src = p->w_eg + ((size_t)l * 32 + w.e) * 1024 * 256; w.ldN = 256; w.dst = WSEL(wt_gu, l); w.ldK = 1024; w.kt = i / 4; w.nt = i % 4; w.kind = 1; }
    else if ((i -= n4) < n5) { w.e = i / 64; i %= 64; w.src = p->w_eu + ((size_t)l * 32 + w.e) * 1024 * 256; w.ldN = 256; w.dst = WSEL(wt_gu, l); w.ldK = 1024; w.kt = i / 4; w.nt = i % 4; w.kind = 2; }
    else { i -= n5; w.e = i / 64; i %= 64; w.src = p->w_ed + ((size_t)l * 32 + w.e) * 256 * 1024; w.ldN = 1024; w.dst = WSEL(wt_d, l) + (size_t)w.e * 1024 * 256; w.ldK = 256; w.kt = i / 16; w.nt = i % 16; }
    return w;
}
#define WC_TOTAL (16 * 88 + 256 + 256 + 2048 * 3)
__device__ __forceinline__ void phase_wconv(ParamsC p, int l, float* smem, int lo, int hi, int first, int stride) {
    const int tid = ltid();
    float* tile = smem;
    const int r = tid >> 4, c4 = tid & 15;
    int it = lo + first; if (it >= hi) return;
    WcTile w = wconv_decode(p, l, it);
    float4 v0 = *(const float4*)(w.src + (size_t)(w.kt * 64 + r) * w.ldN + w.nt * 64 + c4 * 4), v1 = *(const float4*)(w.src + (size_t)(w.kt * 64 + r + 32) * w.ldN + w.nt * 64 + c4 * 4);
    for (;;) {
        tile[r * 65 + c4 * 4 + 0] = v0.x; tile[r * 65 + c4 * 4 + 1] = v0.y; tile[r * 65 + c4 * 4 + 2] = v0.z; tile[r * 65 + c4 * 4 + 3] = v0.w;
        tile[(r + 32) * 65 + c4 * 4 + 0] = v1.x; tile[(r + 32) * 65 + c4 * 4 + 1] = v1.y; tile[(r + 32) * 65 + c4 * 4 + 2] = v1.z; tile[(r + 32) * 65 + c4 * 4 + 3] = v1.w;
        __syncthreads();
        const int nit = it + stride; WcTile wn = w;
        if (nit < hi) { wn = wconv_decode(p, l, nit);
            v0 = *(const float4*)(wn.src + (size_t)(wn.kt * 64 + r) * wn.ldN + wn.nt * 64 + c4 * 4); v1 = *(const float4*)(wn.src + (size_t)(wn.kt * 64 + r + 32) * wn.ldN + wn.nt * 64 + c4 * 4); }
        {   const int n = tid >> 3, kc = tid & 7; const int ncol = w.nt * 64 + n; int drow = ncol;
            if (w.kind) drow = w.e * 512 + (ncol / GU_IG) * (2 * GU_IG) + (w.kind == 2 ? GU_IG : 0) + (ncol % GU_IG);
            uint4 o; o.x = pack2(tile[(kc * 8 + 0) * 65 + n], tile[(kc * 8 + 1) * 65 + n]); o.y = pack2(tile[(kc * 8 + 2) * 65 + n], tile[(kc * 8 + 3) * 65 + n]);
            o.z = pack2(tile[(kc * 8 + 4) * 65 + n], tile[(kc * 8 + 5) * 65 + n]); o.w = pack2(tile[(kc * 8 + 6) * 65 + n], tile[(kc * 8 + 7) * 65 + n]);
            *(uint4*)(w.dst + (size_t)drow * w.ldK + w.kt * 64 + kc * 8) = o; }
        __syncthreads();
        if (nit >= hi) break;
        it = nit; w = wn;
    }
}

__device__ __forceinline__ void phase_norm1(ParamsC p, int l) {
    const int tid = ltid(), lane = tid & 63, wid = tid >> 6;
    const int ntok = (l == DEPTH) ? T_LAT : T_ALL;
    for (int t = lbid() * 8 + wid; t < ntok; t += gridDim.x * 8) {
        const int v = tok_variant(t);
        float4 xv[4];
        if (l == 0) {
            const float* src = t < T_LAT ? p->x + (size_t)t * 1024 : p->ctx + (size_t)(t - T_LAT) * 1024;
#pragma unroll
            for (int i = 0; i < 4; ++i) xv[i] = *(const float4*)(src + i * 256 + lane * 4);
        } else {
            const bf16_t* src = p->xs + (size_t)t * 1024;
#pragma unroll
            for (int i = 0; i < 4; ++i) xv[i] = load4bf(src + i * 256 + lane * 4);
            const bool had_moe = (l - 1 < DEPTH - 1) || t < T_LAT;
            if (had_moe) {
                const int s0 = p->slot[t * 2], s1 = p->slot[t * 2 + 1]; const float w0 = p->ewt[t * 2], w1 = p->ewt[t * 2 + 1];
                const float* gt = p->modv + (size_t)((l - 1) * 5 + v) * 6144 + 5120;
#pragma unroll
                for (int i = 0; i < 4; ++i) { const int c = i * 256 + lane * 4;
                    const uint2 y0 = *(const uint2*)(p->Y + (size_t)s0 * 1024 + c), y1 = *(const uint2*)(p->Y + (size_t)s1 * 1024 + c);
                    const float4 g = *(const float4*)(gt + c);
                    xv[i].x += g.x * (w0 * bf2f((bf16_t)(y0.x & 0xffff)) + w1 * bf2f((bf16_t)(y1.x & 0xffff)));
                    xv[i].y += g.y * (w0 * bf2f((bf16_t)(y0.x >> 16)) + w1 * bf2f((bf16_t)(y1.x >> 16)));
                    xv[i].z += g.z * (w0 * bf2f((bf16_t)(y0.y & 0xffff)) + w1 * bf2f((bf16_t)(y1.y & 0xffff)));
                    xv[i].w += g.w * (w0 * bf2f((bf16_t)(y0.y >> 16)) + w1 * bf2f((bf16_t)(y1.y >> 16))); }
            }
        }
        float ss = 0.f;
#pragma unroll
        for (int i = 0; i < 4; ++i) ss += xv[i].x * xv[i].x + xv[i].y * xv[i].y + xv[i].z * xv[i].z + xv[i].w * xv[i].w;
        ss = wave_sum(ss);
        const float rstd = rsqrtf(ss * (1.0f / 1024.0f) + 1e-6f);
        if (l == DEPTH) {
#pragma unroll
            for (int i = 0; i < 4; ++i) { const int c = i * 256 + lane * 4; const float4 g = *(const float4*)(p->g_final + c);
                float4 o; o.x = xv[i].x * rstd * g.x; o.y = xv[i].y * rstd * g.y; o.z = xv[i].z * rstd * g.z; o.w = xv[i].w * rstd * g.w;
                *(float4*)(p->out + (size_t)t * 1024 + c) = o; }
        } else {
            const float* mv = p->modv + (size_t)(l * 5 + v) * 6144;
#pragma unroll
            for (int i = 0; i < 4; ++i) { const int c = i * 256 + lane * 4;
                { uint2 xo; xo.x = pack2(xv[i].x, xv[i].y); xo.y = pack2(xv[i].z, xv[i].w); *(uint2*)(p->xs + (size_t)t * 1024 + c) = xo; }
                const float4 g = *(const float4*)(p->g_attn + l * 1024 + c), sh = *(const float4*)(mv + c), sc = *(const float4*)(mv + 1024 + c);
                uint2 o; o.x = pack2(xv[i].x * rstd * g.x * (1.f + sc.x) + sh.x, xv[i].y * rstd * g.y * (1.f + sc.y) + sh.y);
                o.y = pack2(xv[i].z * rstd * g.z * (1.f + sc.z) + sh.z, xv[i].w * rstd * g.w * (1.f + sc.w) + sh.w);
                *(uint2*)(p->h + (size_t)t * 1024 + c) = o; }
        }
    }
}

#define SG_STRIDE 144
#define SG_BOFF (128 * SG_STRIDE)
struct RowsLinear { const bf16_t* base; size_t ld; __device__ __forceinline__ const bf16_t* operator()(int r) const { return base + (size_t)r * ld; } };
template <class ARow>
__device__ __forceinline__ void gemm_core(unsigned char* smem, const ARow& arow, const bf16_t* Bt, size_t ldb, int k0, int k1, f32x4 (&acc)[2][4]) {
    const int tid = ltid(), lane = tid & 63, wid = tid >> 6, wm = wid >> 1, wn = wid & 1;
    const int row0 = tid >> 3, kc = tid & 7;
    const bf16_t* pa0 = arow(row0) + kc * 8; const bf16_t* pa1 = arow(row0 + 64) + kc * 8;
    const bf16_t* pb0 = Bt + (size_t)row0 * ldb + kc * 8; const bf16_t* pb1 = Bt + (size_t)(row0 + 64) * ldb + kc * 8;
    const int soff0 = row0 * SG_STRIDE + kc * 16, soff1 = soff0 + 64 * SG_STRIDE;
    uint4 ra0 = *(const uint4*)(pa0 + k0), ra1 = *(const uint4*)(pa1 + k0), rb0 = *(const uint4*)(pb0 + k0), rb1 = *(const uint4*)(pb1 + k0);
    const int fa = (wm * 32 + (lane & 15)) * SG_STRIDE + (lane >> 4) * 16, fb = SG_BOFF + (wn * 64 + (lane & 15)) * SG_STRIDE + (lane >> 4) * 16;
    for (int k = k0; k < k1; k += 64) {
        __syncthreads();
        *(uint4*)(smem + soff0) = ra0; *(uint4*)(smem + soff1) = ra1; *(uint4*)(smem + SG_BOFF + soff0) = rb0; *(uint4*)(smem + SG_BOFF + soff1) = rb1;
        __syncthreads();
        if (k + 64 < k1) { ra0 = *(const uint4*)(pa0 + k + 64); ra1 = *(const uint4*)(pa1 + k + 64); rb0 = *(const uint4*)(pb0 + k + 64); rb1 = *(const uint4*)(pb1 + k + 64); }
#pragma unroll
        for (int ks = 0; ks < 2; ++ks) {
            const bf16x8 af0 = *(const bf16x8*)(smem + fa + ks * 64), af1 = *(const bf16x8*)(smem + fa + 16 * SG_STRIDE + ks * 64);
            const bf16x8 b0 = *(const bf16x8*)(smem + fb + ks * 64), b1 = *(const bf16x8*)(smem + fb + 16 * SG_STRIDE + ks * 64);
            const bf16x8 b2 = *(const bf16x8*)(smem + fb + 32 * SG_STRIDE + ks * 64), b3 = *(const bf16x8*)(smem + fb + 48 * SG_STRIDE + ks * 64);
            acc[0][0] = __builtin_amdgcn_mfma_f32_16x16x32_bf16(b0, af0, acc[0][0], 0, 0, 0); acc[0][1] = __builtin_amdgcn_mfma_f32_16x16x32_bf16(b1, af0, acc[0][1], 0, 0, 0);
            acc[0][2] = __builtin_amdgcn_mfma_f32_16x16x32_bf16(b2, af0, acc[0][2], 0, 0, 0); acc[0][3] = __builtin_amdgcn_mfma_f32_16x16x32_bf16(b3, af0, acc[0][3], 0, 0, 0);
            acc[1][0] = __builtin_amdgcn_mfma_f32_16x16x32_bf16(b0, af1, acc[1][0], 0, 0, 0); acc[1][1] = __builtin_amdgcn_mfma_f32_16x16x32_bf16(b1, af1, acc[1][1], 0, 0, 0);
            acc[1][2] = __builtin_amdgcn_mfma_f32_16x16x32_bf16(b2, af1, acc[1][2], 0, 0, 0); acc[1][3] = __builtin_amdgcn_mfma_f32_16x16x32_bf16(b3, af1, acc[1][3], 0, 0, 0);
        }
    }
}
__device__ __forceinline__ void zero_acc(f32x4 (&acc)[2][4]) {
#pragma unroll
    for (int a = 0; a < 2; ++a)
#pragma unroll
        for (int b = 0; b < 4; ++b) acc[a][b] = (f32x4){0.f, 0.f, 0.f, 0.f};
}
__device__ __forceinline__ void store4bf(bf16_t* dst, f32x4 v) { uint2 o; o.x = pack2(v[0], v[1]); o.y = pack2(v[2], v[3]); *(uint2*)dst = o; }


namespace pg8 {
#define PG8_LAS __attribute__((address_space(3)))
typedef unsigned u32x4 __attribute__((ext_vector_type(4)));
constexpr int BM = 256, BK = 64, HALF = 128, HTB = HALF * BK * 2, STAGE_BYTES = 8 * HTB, NXCD = 8, WGM = 8;
__host__ __device__ __forceinline__ int lds_byte(int r, int c) { const int st = (r >> 4) * 2 + (c >> 5), rr = r & 15, cc = c & 31, ob = rr * 64 + cc * 2; return st * 1024 + (ob ^ (((ob >> 9) & 1) << 5)); }
__host__ __device__ __forceinline__ void stage_rc(int b, int& R, int& C) { const int st = b / 1024, sb = b % 1024, swz = sb ^ (((sb >> 9) & 1) << 5); R = (st >> 1) * 16 + swz / 64; C = (st & 1) * 32 + (swz % 64) / 2; }
__host__ __device__ __forceinline__ int perm32(int rho) { const int n = rho >> 4, i = rho & 15; return 8 * (i >> 2) + 4 * n + (i & 3); }
struct Unit { int pm, pn; };
struct Gemm { const bf16_t* A; const bf16_t* Bt; int M, N, K; const int* rowmap; };
struct StaticOrder {
    int nM, nN, nwg, G, c;
    __device__ void init(int M, int N, int G_, int c_) { nM = M / BM; nN = N / BM; nwg = nM * nN; G = G_; c = c_; }
    __device__ bool next(int i, Unit& u) const {
        const long L = (long)i * G + c; if (L >= nwg) return false;
        int wgid = (int)L; { const int q = nwg / NXCD, r = nwg % NXCD, xcd = wgid % NXCD, off = wgid / NXCD; wgid = (xcd < r ? xcd * (q + 1) : r * (q + 1) + (xcd - r) * q) + off; }
        const int nig = WGM * nN, gid = wgid / nig, fm = gid * WGM, gsz = (nM - fm) < WGM ? (nM - fm) : WGM;
        u.pm = fm + ((wgid % nig) % gsz); u.pn = (wgid % nig) / gsz; return true;
    }
    __device__ __forceinline__ void a_ready(const Unit&) const {}
    __device__ __forceinline__ void done(const Unit&) const {}
};
template <int NT> struct GroupedOrder {
    const int* blk_e; int nunits, G, c;
    __device__ bool next(int i, Unit& u) const { const long L = (long)i * G + c; if (L >= nunits) return false; const int rb = (int)L / NT; u.pm = rb; u.pn = blk_e[rb] * NT + (int)L % NT; return true; }
    __device__ __forceinline__ void a_ready(const Unit&) const {}
    __device__ __forceinline__ void done(const Unit&) const {}
};
template <class Epi, class Sched, bool ALIGN_EPI = false, bool SP2 = false, bool GATHER = false>
__device__ __forceinline__ void gemm_phase(PG8_LAS unsigned char* lds, const Gemm g, const Sched& S, const Epi& E) {
    const int tid = ltid(), wid = __builtin_amdgcn_readfirstlane(tid >> 6), lane = tid & 63, wr = wid >> 2, wc = wid & 3, fr = lane & 15, fq = lane >> 4;
    int K = g.K; asm volatile("" : "+s"(K)); const int nt = K / BK;
    unsigned voffA[2], voffB[2];
#pragma unroll
    for (int i = 0; i < 2; ++i) { int R, C; stage_rc(tid * 16 + i * 8192, R, C); const int Rb = Epi::PERM ? ((R & ~31) + perm32(R & 31)) : R;
        voffA[i] = (unsigned)(R * K + C) * 2u; voffB[i] = (unsigned)(Rb * K + C) * 2u; }
    const size_t kstep = (size_t)(BK * 2);
    const size_t hstep = (size_t)HALF * K * 2;
    const size_t tstep = 2 * hstep;
    const unsigned ldsw = (unsigned)wid * 1024u;
    const int aoff = lds_byte(wr * 64 + fr, fq * 8), boff = lds_byte(wc * 32 + fr, fq * 8);
#define PG8_SA(b, h) (((b) * 2 + (h)) * HTB)
#define PG8_SB(b, h) ((4 + (b) * 2 + (h)) * HTB)
#define PG8_STAGE(bufoff, gbase, voff) do { _Pragma("unroll") for (int _i = 0; _i < 2; ++_i) \
        __builtin_amdgcn_global_load_lds((const unsigned*)((const char*)(gbase) + (voff)[_i]), (PG8_LAS unsigned*)(lds + (bufoff) + ldsw + _i * 8192), 16, 0, 0); } while (0)
#define PG8_STAGE_A(bufoff, gptr, hf) do { if constexpr (GATHER) { _Pragma("unroll") for (int _i = 0; _i < 2; ++_i) \
        __builtin_amdgcn_global_load_lds((const unsigned*)((const char*)(gptr) + gC[hf][_i]), (PG8_LAS unsigned*)(lds + (bufoff) + ldsw + _i * 8192), 16, 0, 0); } \
        else { PG8_STAGE(bufoff, (gptr) + (hf) * hstep, voffA); } } while (0)
#define PG8_LOAD_GOFF(pm_) do { _Pragma("unroll") for (int _h = 0; _h < 2; ++_h) _Pragma("unroll") for (int _i = 0; _i < 2; ++_i) { int R_, C_; stage_rc(tid * 16 + _i * 8192, R_, C_); \
        gC[_h][_i] = (unsigned)(g.rowmap[(pm_) * 256 + _h * 128 + R_] * K + C_) * 2u; } } while (0)
#define PG8_LDA(dst, b, h) do { _Pragma("unroll") for (int m = 0; m < 4; ++m) _Pragma("unroll") for (int k = 0; k < 2; ++k) dst[m][k] = *(const PG8_LAS bf16x8*)(lds + PG8_SA(b, h) + aoff + m * 2048 + k * 1024); } while (0)
#define PG8_LDB(dst, b, h) do { _Pragma("unroll") for (int n = 0; n < 2; ++n) _Pragma("unroll") for (int k = 0; k < 2; ++k) dst[n][k] = *(const PG8_LAS bf16x8*)(lds + PG8_SB(b, h) + boff + n * 2048 + k * 1024); } while (0)
#define PG8_MMA(ai, bj, At, Bt) do { __builtin_amdgcn_s_setprio(1); _Pragma("unroll") for (int m = 0; m < 4; ++m) _Pragma("unroll") for (int n = 0; n < 2; ++n) _Pragma("unroll") for (int k = 0; k < 2; ++k) \
        acc[ai][bj][m][n] = __builtin_amdgcn_mfma_f32_16x16x32_bf16(Bt[n][k], At[m][k], acc[ai][bj][m][n], 0, 0, 0); __builtin_amdgcn_s_setprio(0); } while (0)
#define PG8_WAIT_V(n) asm volatile("s_waitcnt vmcnt(" #n ")" ::: "memory")
#define PG8_WAIT_L(n) asm volatile("s_waitcnt lgkmcnt(" #n ")" ::: "memory")
#define PG8_BAR __builtin_amdgcn_s_barrier()
#define PG8_SCHED __builtin_amdgcn_sched_barrier(0)
    Unit cur, nxt; int ui = 0;
    if (!S.next(0, cur)) return;
    f32x4 acc[2][2][4][2];
#pragma unroll
    for (int a = 0; a < 2; ++a)
#pragma unroll
        for (int b = 0; b < 2; ++b)
#pragma unroll
            for (int m = 0; m < 4; ++m)
#pragma unroll
                for (int n = 0; n < 2; ++n) acc[a][b][m][n] = (f32x4){0.f, 0.f, 0.f, 0.f};
    bf16x8 At[4][2], B0[2][2], B1[2][2];
    const char* cA = (const char*)g.A + (GATHER ? (size_t)0 : (size_t)cur.pm * tstep); const char* cB = (const char*)g.Bt + (size_t)cur.pn * tstep;
    unsigned gC[2][2] = {{0u, 0u}, {0u, 0u}};
    S.a_ready(cur);
    if constexpr (GATHER) PG8_LOAD_GOFF(cur.pm);
    if constexpr (SP2) {
        PG8_STAGE(PG8_SB(0, 0), cB, voffB); PG8_STAGE(PG8_SB(0, 1), cB + hstep, voffB); PG8_STAGE_A(PG8_SA(0, 0), cA, 0); PG8_STAGE_A(PG8_SA(0, 1), cA, 1);
        if (wr == 1) PG8_BAR;
        PG8_WAIT_V(2); PG8_BAR;
        PG8_STAGE(PG8_SB(1, 0), cB + kstep, voffB); PG8_STAGE_A(PG8_SA(1, 0), cA + kstep, 0); PG8_STAGE(PG8_SB(1, 1), cB + hstep + kstep, voffB);
        PG8_WAIT_V(6); PG8_BAR;
    } else {
        PG8_STAGE(PG8_SB(0, 0), cB, voffB); PG8_STAGE_A(PG8_SA(0, 0), cA, 0); PG8_STAGE(PG8_SB(0, 1), cB + hstep, voffB); PG8_STAGE_A(PG8_SA(0, 1), cA, 1);
        if (wr == 1) PG8_BAR;
        PG8_WAIT_V(4); PG8_BAR;
        PG8_STAGE(PG8_SB(1, 0), cB + kstep, voffB); PG8_STAGE_A(PG8_SA(1, 0), cA + kstep, 0); PG8_STAGE(PG8_SB(1, 1), cB + hstep + kstep, voffB);
        PG8_WAIT_V(6); PG8_BAR;
    }
    for (;;) {
        const bool has_next = S.next(ui + 1, nxt);
        const char* nA = (has_next && !GATHER) ? (const char*)g.A + (size_t)nxt.pm * tstep : cA; const char* nB = has_next ? (const char*)g.Bt + (size_t)nxt.pn * tstep : cB;
        for (int t = 0; t < nt; t += 2) {
            const bool last = (t == nt - 2);
            const char* a1 = cA + (size_t)(t + 1) * kstep;
            const char* a2 = last ? nA : cA + (size_t)(t + 2) * kstep; const char* b2 = last ? nB : cB + (size_t)(t + 2) * kstep;
            const char* a3 = a2 + kstep; const char* b3 = b2 + kstep;
            if (last && has_next) S.a_ready(nxt);
            if constexpr (SP2) {
            PG8_LDB(B0, 0, 0); PG8_LDB(B1, 0, 1); PG8_SCHED; PG8_LDA(At, 0, 0); PG8_STAGE_A(PG8_SA(1, 1), a1, 1); if constexpr (GATHER) { if (last && has_next) PG8_LOAD_GOFF(nxt.pm); }
            PG8_WAIT_V(8); PG8_WAIT_L(0); PG8_BAR; PG8_MMA(0, 0, At, B0); PG8_MMA(0, 1, At, B1); PG8_BAR; PG8_SCHED;
            PG8_LDA(At, 0, 1); PG8_STAGE(PG8_SB(0, 0), b2, voffB); PG8_STAGE(PG8_SB(0, 1), b2 + hstep, voffB); PG8_STAGE_A(PG8_SA(0, 0), a2, 0);
            PG8_WAIT_V(8); PG8_WAIT_L(0); PG8_BAR; PG8_MMA(1, 0, At, B0); PG8_MMA(1, 1, At, B1); PG8_BAR; PG8_SCHED;
            PG8_LDB(B0, 1, 0); PG8_LDB(B1, 1, 1); PG8_SCHED; PG8_LDA(At, 1, 0); PG8_STAGE_A(PG8_SA(0, 1), a2, 1);
            PG8_WAIT_V(8); PG8_WAIT_L(0); PG8_BAR; PG8_MMA(0, 0, At, B0); PG8_MMA(0, 1, At, B1); PG8_BAR; PG8_SCHED;
            PG8_LDA(At, 1, 1); PG8_STAGE(PG8_SB(1, 0), b3, voffB); PG8_STAGE(PG8_SB(1, 1), b3 + hstep, voffB); PG8_STAGE_A(PG8_SA(1, 0), a3, 0);
            PG8_WAIT_V(8); PG8_WAIT_L(0); PG8_BAR; PG8_MMA(1, 0, At, B0); PG8_MMA(1, 1, At, B1); PG8_BAR; PG8_SCHED;
            } else {
            PG8_LDB(B0, 0, 0); PG8_SCHED; PG8_LDA(At, 0, 0); PG8_STAGE_A(PG8_SA(1, 1), a1, 1); if constexpr (GATHER) { if (last && has_next) PG8_LOAD_GOFF(nxt.pm); }
            PG8_WAIT_L(8); PG8_BAR; PG8_WAIT_L(0); PG8_MMA(0, 0, At, B0); PG8_BAR; PG8_SCHED;
            PG8_LDB(B1, 0, 1); PG8_STAGE(PG8_SB(0, 0), b2, voffB);
            PG8_BAR; PG8_WAIT_L(0); PG8_MMA(0, 1, At, B1); PG8_BAR;
            PG8_LDA(At, 0, 1); PG8_STAGE_A(PG8_SA(0, 0), a2, 0);
            PG8_BAR; PG8_WAIT_L(0); PG8_MMA(1, 0, At, B0); PG8_BAR; PG8_SCHED;
            PG8_STAGE(PG8_SB(0, 1), b2 + hstep, voffB);
            PG8_WAIT_V(6); PG8_BAR; PG8_MMA(1, 1, At, B1); PG8_BAR;
            PG8_LDB(B0, 1, 0); PG8_SCHED; PG8_LDA(At, 1, 0); PG8_STAGE_A(PG8_SA(0, 1), a2, 1);
            PG8_WAIT_L(8); PG8_BAR; PG8_WAIT_L(0); PG8_MMA(0, 0, At, B0); PG8_BAR; PG8_SCHED;
            PG8_LDB(B1, 1, 1); PG8_STAGE(PG8_SB(1, 0), b3, voffB);
            PG8_BAR; PG8_WAIT_L(0); PG8_MMA(0, 1, At, B1); PG8_BAR;
            PG8_LDA(At, 1, 1); PG8_STAGE_A(PG8_SA(1, 0), a3, 0);
            PG8_BAR; PG8_WAIT_L(0); PG8_MMA(1, 0, At, B0); PG8_BAR; PG8_SCHED;
            PG8_STAGE(PG8_SB(1, 1), b3 + hstep, voffB);
            PG8_WAIT_V(6); PG8_BAR; PG8_MMA(1, 1, At, B1); PG8_BAR;
            }
            if constexpr (Epi::HOOK) { if (t == 2 || t == 8) E.hook(acc, cur, t, wr, wc, fr, fq); }
        }
        if constexpr (ALIGN_EPI) { if (wr == 0) PG8_BAR; }
        if constexpr (!Epi::AFTER_DRAIN) { E(acc, cur, wr, wc, fr, fq); S.done(cur); }
        if (!has_next) break;
#pragma unroll
        for (int a = 0; a < 2; ++a)
#pragma unroll
            for (int b = 0; b < 2; ++b)
#pragma unroll
                for (int m = 0; m < 4; ++m)
#pragma unroll
                    for (int n = 0; n < 2; ++n) acc[a][b][m][n] = (f32x4){0.f, 0.f, 0.f, 0.f};
        cur = nxt; cA = nA; cB = nB; ++ui;
        if constexpr (ALIGN_EPI) { if (wr == 1) PG8_BAR; }
    }
    PG8_WAIT_V(0);
    if constexpr (!ALIGN_EPI) { if (wr == 0) PG8_BAR; }
    PG8_BAR;
    if constexpr (Epi::AFTER_DRAIN) { E.fused(acc, cur, wr, wc, fr, fq, lds, wid, lane); S.done(cur); }
#undef PG8_SA
#undef PG8_SB
#undef PG8_STAGE
#undef PG8_LDA
#undef PG8_STAGE_A
#undef PG8_LOAD_GOFF
#undef PG8_LDB
#undef PG8_MMA
#undef PG8_WAIT_V
#undef PG8_WAIT_L
#undef PG8_BAR
#undef PG8_SCHED
}

}
__device__ __forceinline__ pg8::u32x4 pack8(const f32x4& a, const f32x4& b) { pg8::u32x4 w; w.x = pack2(a[0], a[1]); w.y = pack2(a[2], a[3]); w.z = pack2(b[0], b[1]); w.w = pack2(b[2], b[3]); return w; }
__device__ __forceinline__ void unpack8(const pg8::u32x4& w, f32x4& a, f32x4& b) {
    a[0] = __uint_as_float(w.x << 16); a[1] = __uint_as_float(w.x & 0xffff0000u); a[2] = __uint_as_float(w.y << 16); a[3] = __uint_as_float(w.y & 0xffff0000u);
    b[0] = __uint_as_float(w.z << 16); b[1] = __uint_as_float(w.z & 0xffff0000u); b[2] = __uint_as_float(w.w << 16); b[3] = __uint_as_float(w.w & 0xffff0000u); }


__device__ __forceinline__ void phase_gemm_in(ParamsC p, int l, unsigned char* smem) {
    const int tid = ltid(), lane = tid & 63, wid = tid >> 6, wm = wid >> 1, wn = wid & 1, q4 = (lane >> 4) * 4;
    const int nM = T_ALL / 128, nN = IN_COLS / 128;
    for (int tile = lbid(); tile < nM * nN; tile += gridDim.x) {
        const int tm = tile / nN, tn = tile % nN, m0 = tm * 128, n0 = tn * 128;
        f32x4 acc[2][4]; zero_acc(acc);
        RowsLinear ar{p->h + (size_t)m0 * 1024, 1024};
        gemm_core(smem, ar, p->wt_in + (size_t)n0 * 1024, 1024, 0, 1024, acc);
        const int cb = n0 + wn * 64;
#pragma unroll
        for (int mi = 0; mi < 2; ++mi) {
            const int t = m0 + wm * 32 + mi * 16 + (lane & 15);
            f32x4 v0 = acc[mi][0], v1 = acc[mi][1], v2 = acc[mi][2], v3 = acc[mi][3];
            if (cb >= 2560) {
                bf16_t* dst = p->uG + (size_t)t * UG_LD + (cb - 2560) + q4;
#pragma unroll
                for (int e = 0; e < 4; ++e) { v0[e] = 1.f / (1.f + __expf(-v0[e])); v1[e] = 1.f / (1.f + __expf(-v1[e])); v2[e] = 1.f / (1.f + __expf(-v2[e])); v3[e] = 1.f / (1.f + __expf(-v3[e])); }
                store4bf(dst, v0); store4bf(dst + 16, v1); store4bf(dst + 32, v2); store4bf(dst + 48, v3);
            } else {
                const bool isq = (cb >= 768 && cb < 1152) || (cb >= 1920 && cb < 2304);
                const bool rope = (cb >= 1920 && cb < 2432) && (t < T_LAT);
                if (rope) { const int pos = t & 8191, r = pos >> 6, cc = pos & 63;
#pragma unroll
                    for (int e = 0; e < 4; ++e) {
                        const float2 csr = *(const float2*)(p->ropet + (r * 16 + q4 + e) * 2), csc = *(const float2*)(p->ropet + (cc * 16 + q4 + e) * 2);
                        const float a1 = v0[e], a2 = v1[e]; v0[e] = a1 * csr.x - a2 * csr.y; v1[e] = a1 * csr.y + a2 * csr.x;
                        const float b1 = v2[e], b2 = v3[e]; v2[e] = b1 * csc.x - b2 * csc.y; v3[e] = b1 * csc.y + b2 * csc.x; } }
                if (isq) { v0 = v0 * 0.125f; v1 = v1 * 0.125f; v2 = v2 * 0.125f; v3 = v3 * 0.125f; }
                bf16_t* dst = p->uA + (size_t)t * UA_LD + cb + q4;
                store4bf(dst, v0); store4bf(dst + 16, v1); store4bf(dst + 32, v2); store4bf(dst + 48, v3);
            }
        }
    }
}

struct KmNA { int b, r, c, rs, cs; const float* rpb;
    __device__ __forceinline__ int tok(int kk) const { if (kk < 128) return b * SEQ + (rs + (kk >> 4)) * 64 + cs + (kk & 15); return T_LAT + b * CTXL + (kk - 128); }
    __device__ __forceinline__ float bias(int kk) const { if (kk < 128) return rpb[(rs + (kk >> 4) - r + 7) * 31 + (cs + (kk & 15) - c + 15)]; return 0.f; } };
struct KmSWA { int b, i;
    __device__ __forceinline__ int tok(int kk) const { if (kk < 257) { const int j = i - 128 + kk; return (j >= 0 && j < SEQ) ? b * SEQ + j : -1; } if (kk < 513) return T_LAT + b * CTXL + (kk - 257); return -1; }
    __device__ __forceinline__ float bias(int) const { return 0.f; } };
struct KmCtx { int b;
    __device__ __forceinline__ int tok(int kk) const { return T_LAT + b * CTXL + kk; }
    __device__ __forceinline__ float bias(int) const { return 0.f; } };

template <int NI, class KM>
__device__ __forceinline__ void attn_item(const bf16_t* uA, int tq, int qcol, int kcol, int vcol, const KM& km, bool has_sink, float sink, bf16_t* outp, int lane) {
    float q[64];
    {   const uint4* qp = (const uint4*)(uA + (size_t)tq * UA_LD + qcol);
#pragma unroll
        for (int c = 0; c < 8; ++c) { const uint4 v = qp[c];
            q[c * 8 + 0] = bf2f((bf16_t)(v.x & 0xffff)); q[c * 8 + 1] = bf2f((bf16_t)(v.x >> 16)); q[c * 8 + 2] = bf2f((bf16_t)(v.y & 0xffff)); q[c * 8 + 3] = bf2f((bf16_t)(v.y >> 16));
            q[c * 8 + 4] = bf2f((bf16_t)(v.z & 0xffff)); q[c * 8 + 5] = bf2f((bf16_t)(v.z >> 16)); q[c * 8 + 6] = bf2f((bf16_t)(v.w & 0xffff)); q[c * 8 + 7] = bf2f((bf16_t)(v.w >> 16)); } }
    float s[NI]; float mx = -3.0e38f;
#pragma unroll
    for (int i = 0; i < NI; ++i) { const int kk = i * 64 + lane; const int tk = km.tok(kk);
        float d = -3.0e38f;
        if (tk >= 0) { const uint4* kp = (const uint4*)(uA + (size_t)tk * UA_LD + kcol); d = 0.f;
#pragma unroll
            for (int c = 0; c < 8; ++c) { const uint4 v = kp[c];
                d += q[c * 8 + 0] * bf2f((bf16_t)(v.x & 0xffff)) + q[c * 8 + 1] * bf2f((bf16_t)(v.x >> 16)) + q[c * 8 + 2] * bf2f((bf16_t)(v.y & 0xffff)) + q[c * 8 + 3] * bf2f((bf16_t)(v.y >> 16))
                   + q[c * 8 + 4] * bf2f((bf16_t)(v.z & 0xffff)) + q[c * 8 + 5] * bf2f((bf16_t)(v.z >> 16)) + q[c * 8 + 6] * bf2f((bf16_t)(v.w & 0xffff)) + q[c * 8 + 7] * bf2f((bf16_t)(v.w >> 16)); }
            d += km.bias(kk); }
        s[i] = d; mx = fmaxf(mx, d); }
    mx = wave_max(mx); if (has_sink) mx = fmaxf(mx, sink);
    float sum = 0.f;
#pragma unroll
    for (int i = 0; i < NI; ++i) { const float pv = s[i] > -1.0e38f ? __expf(s[i] - mx) : 0.f; s[i] = pv; sum += pv; }
    sum = wave_sum(sum); if (has_sink) sum += __expf(sink - mx);
    const float inv = 1.0f / sum;
    float o = 0.f;
#pragma unroll
    for (int i = 0; i < NI; ++i) {
        for (int sl = 0; sl < 64; ++sl) { const int tk = km.tok(i * 64 + sl); const float pv = __shfl(s[i], sl);
            if (tk >= 0) o += pv * bf2f(uA[(size_t)tk * UA_LD + vcol + lane]); } }
    outp[lane] = f2bf(o * inv);
}

__device__ __forceinline__ void phase_mix(ParamsC p, int l) {
    const int tid = ltid(), lane = tid & 63, wid = tid >> 6;
    const bool need_ctx = l < DEPTH - 1;
    {   const int ntok = need_ctx ? T_ALL : T_LAT; const float* cw = p->conv_w + l * 3 * 256;
        for (int idx = lbid() * NTHR + tid; idx < ntok * 256; idx += gridDim.x * NTHR) { const int t = idx >> 8, c = idx & 255;
            int pos, len; if (t < T_LAT) { pos = t & 8191; len = SEQ; } else { pos = (t - T_LAT) & 255; len = CTXL; }
            const bf16_t* u = p->uA + (size_t)t * UA_LD + c;
            const float z1 = bf2f(u[512]) * bf2f(u[0]);
            const float z0 = pos > 0 ? bf2f(u[512 - UA_LD]) * bf2f(u[-UA_LD]) : 0.f;
            const float z2 = pos + 1 < len ? bf2f(u[512 + UA_LD]) * bf2f(u[UA_LD]) : 0.f;
            const float y = bf2f(u[256]) * (z0 * cw[c] + z1 * cw[256 + c] + z2 * cw[512 + c]);
            p->ycat[(size_t)t * 1024 + c] = f2bf(y); } }
    const int n_lat = T_LAT * 12, n_all = n_lat + (need_ctx ? T_CTX * 12 : 0);
    for (int it = lbid() * 8 + wid; it < n_all; it += gridDim.x * 8) {
        if (it < n_lat) { const int t = it / 12, hh = it % 12; const int b = t >> 13, pos = t & 8191;
            if (hh < 6) { KmNA km; km.b = b; km.r = pos >> 6; km.c = pos & 63; km.rs = min(max(km.r - 4, 0), 120); km.cs = min(max(km.c - 8, 0), 48); km.rpb = p->rpb + ((size_t)l * 6 + hh) * 15 * 31;
                attn_item<6>(p->uA, t, 768 + hh * 64, 1152 + hh * 64, 1536 + hh * 64, km, false, 0.f, p->ycat + (size_t)t * 1024 + 256 + hh * 64, lane); }
            else { const int hq = hh - 6, kh = hq / 3; KmSWA km; km.b = b; km.i = pos;
                attn_item<9>(p->uA, t, 1920 + hq * 64, 2304 + kh * 64, 2432 + kh * 64, km, true, p->sinks[l * 6 + hq], p->ycat + (size_t)t * 1024 + 640 + hq * 64, lane); }
        } else { const int it2 = it - n_lat; const int tc = it2 / 12, hh = it2 % 12; const int t = T_LAT + tc; KmCtx km; km.b = tc >> 8;
            if (hh < 6) attn_item<4>(p->uA, t, 768 + hh * 64, 1152 + hh * 64, 1536 + hh * 64, km, false, 0.f, p->ycat + (size_t)t * 1024 + 256 + hh * 64, lane);
            else { const int hq = hh - 6, kh = hq / 3; attn_item<4>(p->uA, t, 1920 + hq * 64, 2304 + kh * 64, 2432 + kh * 64, km, true, p->sinks[l * 6 + hq], p->ycat + (size_t)t * 1024 + 640 + hq * 64, lane); }
        }
    }
}


typedef float f32x16 __attribute__((ext_vector_type(16)));
typedef short s16x4 __attribute__((ext_vector_type(4)));
#define AT_STRIDE 144
#define AT_KBUF(b) ((b) * 9216)
#define AT_VBUF(b) (18432 + (b) * 9216)
#define AT_RPB 36864
#define LOG2E 1.4426950408889634f
#define AT_NEG (-1.0e30f)
#define AT_THR 16.0f

template <int MK>
__device__ __forceinline__ void attn_tile(const unsigned char* kt, const unsigned char* vlane, const bf16x8 (&qf)[4], f32x16 (&oacc)[2], float& m, float& lsum,
                                          const float* rpb_row, int relc0  , int lo0  , int lane) {
    const int n = lane & 31, hh = lane >> 5;
    f32x16 sc;
#pragma unroll
    for (int r = 0; r < 16; ++r) sc[r] = 0.f;
#pragma unroll
    for (int sp = 0; sp < 4; ++sp) { const bf16x8 kf = *(const bf16x8*)(kt + n * AT_STRIDE + sp * 32 + hh * 16); sc = __builtin_amdgcn_mfma_f32_32x32x16_bf16(kf, qf[sp], sc, 0, 0, 0); }
    float mx = AT_NEG;
#pragma unroll
    for (int r = 0; r < 16; ++r) { const int i = (r & 3) + 8 * (r >> 2) + 4 * hh; float v = sc[r];
        if (MK == 1) { const bool ok = (unsigned)(i - lo0) < 16u; const int ridx = ok ? (relc0 + i) : 0; v = ok ? (v + rpb_row[ridx]) : AT_NEG; }
        else if (MK == 2) v = (i >= n) ? v : AT_NEG;
        else if (MK == 3) v = (i <= n) ? v : AT_NEG;
        sc[r] = v; mx = fmaxf(mx, v); }
    if (__any(mx > m + AT_THR)) { mx = fmaxf(mx, __shfl_xor(mx, 32)); const float mn = fmaxf(m, mx); const float alpha = __builtin_amdgcn_exp2f(m - mn); lsum *= alpha; m = mn;
#pragma unroll
        for (int r = 0; r < 16; ++r) { oacc[0][r] *= alpha; oacc[1][r] *= alpha; } }
    float ps = 0.f;
#pragma unroll
    for (int r = 0; r < 16; ++r) { const float pv = __builtin_amdgcn_exp2f(sc[r] - m); sc[r] = pv; ps += pv; }
    lsum += ps;
    bf16x8 pf[2];
#pragma unroll
    for (int s2 = 0; s2 < 2; ++s2) { pg8::u32x4 w; w.x = pack2(sc[s2 * 8 + 0], sc[s2 * 8 + 1]); w.y = pack2(sc[s2 * 8 + 2], sc[s2 * 8 + 3]); w.z = pack2(sc[s2 * 8 + 4], sc[s2 * 8 + 5]); w.w = pack2(sc[s2 * 8 + 6], sc[s2 * 8 + 7]);
        pf[s2] = __builtin_bit_cast(bf16x8, w); }
#pragma unroll
    for (int c = 0; c < 2; ++c)
#pragma unroll
        for (int s2 = 0; s2 < 2; ++s2) {
            const s16x4 v0 = __builtin_amdgcn_ds_read_tr16_b64_v4i16((LAS s16x4*)(vlane + (16 * s2) * AT_STRIDE + 64 * c));
            const s16x4 v1 = __builtin_amdgcn_ds_read_tr16_b64_v4i16((LAS s16x4*)(vlane + (16 * s2 + 8) * AT_STRIDE + 64 * c));
            bf16x8 vf; vf[0] = v0[0]; vf[1] = v0[1]; vf[2] = v0[2]; vf[3] = v0[3]; vf[4] = v1[0]; vf[5] = v1[1]; vf[6] = v1[2]; vf[7] = v1[3];
            oacc[c] = __builtin_amdgcn_mfma_f32_32x32x16_bf16(vf, pf[s2], oacc[c], 0, 0, 0);
        }
}

template <int MODE>
__device__ __forceinline__ void attn_unit(ParamsC p, int l, int u, unsigned char* smem) {
    const int tid = ltid(), lane = tid & 63, wid = tid >> 6;
    int b, qcol, kcol, vcol, ocol, qtok; bool has_sink = false; float sinkv = 0.f;
    int nsteps, krlo = 0, r = 0, rs = 0, c = 0, cs = 0, q0 = 0, jwlo = 0;
    if (MODE == 0) { b = u / 192; const int rem = u % 192, h = rem / 32, rg = rem % 32; qcol = 768 + h * 64; kcol = 1152 + h * 64; vcol = 1536 + h * 64; ocol = 256 + h * 64;
        r = rg * 4 + (wid >> 1); rs = min(max(r - 4, 0), 120); c = 32 * (wid & 1) + (lane & 31); cs = min(max(c - 8, 0), 48);
        krlo = min(max(rg * 4 - 4, 0), 120); const int krhi = min(max(rg * 4 + 3 - 4, 0), 120) + 7; nsteps = 4 + (krhi - krlo + 1);
        qtok = b * SEQ + r * 64 + 32 * (wid & 1);
        for (int i = tid; i < 15 * 31; i += NTHR) ((float*)(smem + AT_RPB))[i] = p->rpb[((size_t)l * 6 + h) * 465 + i] * LOG2E;
    } else if (MODE == 1) { b = u / 192; const int rem = u % 192, hq = rem / 32, qb = rem % 32, kh = hq / 3; qcol = 1920 + hq * 64; kcol = 2304 + kh * 64; vcol = 2432 + kh * 64; ocol = 640 + hq * 64;
        q0 = qb * 256; jwlo = (q0 == 0) ? 2 : 0; const int jwhi = min(8, (SEQ - q0 + 128) / 64); nsteps = 4 + (jwhi - jwlo);
        qtok = b * SEQ + q0 + 32 * wid; has_sink = true; sinkv = p->sinks[l * 6 + hq];
    } else { b = u / 12; const int hh = u % 12;
        if (hh < 6) { qcol = 768 + hh * 64; kcol = 1152 + hh * 64; vcol = 1536 + hh * 64; ocol = 256 + hh * 64; }
        else { const int hq = hh - 6, kh = hq / 3; qcol = 1920 + hq * 64; kcol = 2304 + kh * 64; vcol = 2432 + kh * 64; ocol = 640 + hq * 64; has_sink = true; sinkv = p->sinks[l * 6 + hq]; }
        nsteps = 4; qtok = T_LAT + b * CTXL + 32 * wid;
    }
    const bf16_t* uA = p->uA;
    bf16x8 qf[4];
    {   const bf16_t* qp = uA + (size_t)(qtok + (lane & 31)) * UA_LD + qcol + (lane >> 5) * 8;
#pragma unroll
        for (int sp = 0; sp < 4; ++sp) qf[sp] = *(const bf16x8*)(qp + sp * 16); }
    f32x16 oacc[2];
#pragma unroll
    for (int r16 = 0; r16 < 16; ++r16) { oacc[0][r16] = 0.f; oacc[1][r16] = 0.f; }
    float m = has_sink ? sinkv * LOG2E : AT_NEG, lsum = (has_sink && lane < 32) ? 1.f : 0.f;
    const int skey = tid >> 3, sch = tid & 7; const int soff = skey * AT_STRIDE + sch * 16;
    auto chunk_tok = [&](int j) -> int {
        if (j < 4) return T_LAT + b * CTXL + 64 * j;
        if (MODE == 0) return b * SEQ + (krlo + (j - 4)) * 64;
        return b * SEQ + q0 - 128 + 64 * (jwlo + (j - 4)); };
    uint4 rk0, rv0, rk1, rv1;
#define AT_LOAD(RK, RV, jj) do { const bf16_t* src_ = uA + (size_t)(chunk_tok(jj) + skey) * UA_LD + sch * 8; RK = *(const uint4*)(src_ + kcol); RV = *(const uint4*)(src_ + vcol); } while (0)
#define AT_STORE(RK, RV, bb) do { *(uint4*)(smem + AT_KBUF(bb) + soff) = RK; *(uint4*)(smem + AT_VBUF(bb) + soff) = RV; } while (0)
    AT_LOAD(rk0, rv0, 0); AT_STORE(rk0, rv0, 0);
    if (1 < nsteps) AT_LOAD(rk1, rv1, 1);
    if (2 < nsteps) AT_LOAD(rk0, rv0, 2);
    __syncthreads();
    const int vl_off = (4 * (lane >> 5) + ((lane & 15) >> 2)) * AT_STRIDE + (16 * ((lane >> 4) & 1) + 4 * (lane & 3)) * 2;
    const float* rpb_s = (const float*)(smem + AT_RPB);
    for (int j = 0; j < nsteps; ++j) {
        const int buf = j & 1;
        if (j & 1) { if (j + 1 < nsteps) AT_STORE(rk0, rv0, 0); if (j + 3 < nsteps) AT_LOAD(rk0, rv0, j + 3); }
        else       { if (j + 1 < nsteps) AT_STORE(rk1, rv1, 1); if (j + 3 < nsteps) AT_LOAD(rk1, rv1, j + 3); }
        const unsigned char* kb = smem + AT_KBUF(buf); const unsigned char* vb = smem + AT_VBUF(buf) + vl_off;
        if (j < 4) {
            attn_tile<0>(kb, vb, qf, oacc, m, lsum, rpb_s, 0, 0, lane);
            attn_tile<0>(kb + 32 * AT_STRIDE, vb + 32 * AT_STRIDE, qf, oacc, m, lsum, rpb_s, 0, 0, lane);
        } else if (MODE == 0) {
            const int kr = krlo + (j - 4);
            if (kr >= rs && kr < rs + 8) { const float* rrow = rpb_s + (kr - r + 7) * 31;
                attn_tile<1>(kb, vb, qf, oacc, m, lsum, rrow, 0 - c + 15, cs, lane);
                attn_tile<1>(kb + 32 * AT_STRIDE, vb + 32 * AT_STRIDE, qf, oacc, m, lsum, rrow, 32 - c + 15, cs - 32, lane); }
        } else if (MODE == 1) {
            const int qp0 = q0 + 32 * wid;
#pragma unroll
            for (int tl = 0; tl < 2; ++tl) { const int kp0 = q0 - 128 + 64 * (jwlo + (j - 4)) + 32 * tl; const int d = kp0 - qp0;
                const unsigned char* kt = kb + tl * 32 * AT_STRIDE; const unsigned char* vt = vb + tl * 32 * AT_STRIDE;
                if (d == -128) attn_tile<2>(kt, vt, qf, oacc, m, lsum, rpb_s, 0, 0, lane);
                else if (d == 128) attn_tile<3>(kt, vt, qf, oacc, m, lsum, rpb_s, 0, 0, lane);
                else if (d > -128 && d < 128) attn_tile<0>(kt, vt, qf, oacc, m, lsum, rpb_s, 0, 0, lane); }
        }
        __syncthreads();
    }
    const float ltot = lsum + __shfl_xor(lsum, 32); const float inv = 1.0f / ltot;
    bf16_t* op = p->ycat + (size_t)(qtok + (lane & 31)) * 1024 + ocol + 4 * (lane >> 5);
#pragma unroll
    for (int cc = 0; cc < 2; ++cc)
#pragma unroll
        for (int g = 0; g < 4; ++g) { f32x4 v; v[0] = oacc[cc][4 * g] * inv; v[1] = oacc[cc][4 * g + 1] * inv; v[2] = oacc[cc][4 * g + 2] * inv; v[3] = oacc[cc][4 * g + 3] * inv;
            store4bf(op + 32 * cc + 8 * g, v); }
}


#define NA_TBL 36864
#define NA_TROW 48
#define NA_TLEAD 16
__device__ __forceinline__ void na_softmax8(f32x4& s0, f32x4& s1, float& m, float& lsum, f32x4 (&oacc)[4], bf16x8& pf) {
    float mx = fmaxf(fmaxf(fmaxf(s0[0], s0[1]), fmaxf(s0[2], s0[3])), fmaxf(fmaxf(s1[0], s1[1]), fmaxf(s1[2], s1[3])));
    if (__any(mx > m + AT_THR)) { mx = fmaxf(mx, __shfl_xor(mx, 16)); mx = fmaxf(mx, __shfl_xor(mx, 32)); const float mn = fmaxf(m, mx); const float alpha = __builtin_amdgcn_exp2f(m - mn); lsum *= alpha; m = mn;
#pragma unroll
        for (int db = 0; db < 4; ++db) oacc[db] = oacc[db] * alpha; }
#pragma unroll
    for (int e = 0; e < 4; ++e) { s0[e] = __builtin_amdgcn_exp2f(s0[e] - m); s1[e] = __builtin_amdgcn_exp2f(s1[e] - m); }
    lsum += (s0[0] + s0[1]) + (s0[2] + s0[3]) + (s1[0] + s1[1]) + (s1[2] + s1[3]);
    pg8::u32x4 w; w.x = pack2(s0[0], s0[1]); w.y = pack2(s0[2], s0[3]); w.z = pack2(s1[0], s1[1]); w.w = pack2(s1[2], s1[3]);
    pf = __builtin_bit_cast(bf16x8, w);
}
__device__ __forceinline__ void attn_unit_na(ParamsC p, int l, int u, unsigned char* smem) {
    const int tid = ltid(), lane = tid & 63, wid = tid >> 6, q16 = lane & 15, kg = lane >> 4;
    const int b = u / 192, rem = u % 192, h = rem / 32, rg = rem % 32;
    const int qcol = 768 + h * 64, kcol = 1152 + h * 64, vcol = 1536 + h * 64, ocol = 256 + h * 64;
    const int r = rg * 4 + (wid >> 1), qh = wid & 1, rs = min(max(r - 4, 0), 120);
    const int krlo = min(max(rg * 4 - 4, 0), 120), krhi = min(max(rg * 4 + 3 - 4, 0), 120) + 7, nsteps = 4 + (krhi - krlo + 1);
    const int qtok = b * SEQ + r * 64 + 32 * qh;
    const bf16_t* uA = p->uA;
    {   float* T = (float*)(smem + NA_TBL); const float* rp = p->rpb + ((size_t)l * 6 + h) * 465;
        for (int i = tid; i < NA_TLEAD + 16 * 15 * NA_TROW; i += NTHR) { float v = AT_NEG;
            if (i >= NA_TLEAD) { const int k = i - NA_TLEAD, j = k % NA_TROW, rr = (k / NA_TROW) % 15, dl = k / (NA_TROW * 15); if (j < 16) v = rp[rr * 31 + j + dl] * LOG2E; }
            T[i] = v; } }
    int kc0[2], tbase[2];
#pragma unroll
    for (int g2 = 0; g2 < 2; ++g2) { const int c = 32 * qh + 16 * g2 + q16, cs = min(max(c - 8, 0), 48), dl = cs - c + 15;
        kc0[g2] = (qh == 0) ? (g2 == 0 ? 0 : 8) : (g2 == 0 ? 24 : 32);
        tbase[g2] = NA_TLEAD + dl * (15 * NA_TROW) + (kc0[g2] - cs) + 4 * kg; }
    bf16x8 qf[2][2];
#pragma unroll
    for (int g2 = 0; g2 < 2; ++g2)
#pragma unroll
        for (int ds = 0; ds < 2; ++ds) qf[g2][ds] = *(const bf16x8*)(uA + (size_t)(qtok + 16 * g2 + q16) * UA_LD + qcol + ds * 32 + kg * 8);
    f32x4 oacc[2][4];
#pragma unroll
    for (int g2 = 0; g2 < 2; ++g2)
#pragma unroll
        for (int db = 0; db < 4; ++db) oacc[g2][db] = (f32x4){0.f, 0.f, 0.f, 0.f};
    float m[2] = {AT_NEG, AT_NEG}, lsum[2] = {0.f, 0.f};
    const int skey = tid >> 3, sch = tid & 7; const int soff = skey * AT_STRIDE + sch * 16;
    auto chunk_tok = [&](int j) -> int { return (j < 4) ? (T_LAT + b * CTXL + 64 * j) : (b * SEQ + (krlo + (j - 4)) * 64); };
    uint4 rk0, rv0, rk1, rv1;
    AT_LOAD(rk0, rv0, 0); AT_STORE(rk0, rv0, 0);
    if (1 < nsteps) AT_LOAD(rk1, rv1, 1);
    if (2 < nsteps) AT_LOAD(rk0, rv0, 2);
    __syncthreads();
    const int ka_off = q16 * AT_STRIDE + kg * 16;
    const int va_off = (4 * kg + (q16 >> 2)) * AT_STRIDE + (4 * (q16 & 3)) * 2;
    const float* T = (const float*)(smem + NA_TBL);
    for (int j = 0; j < nsteps; ++j) {
        const int buf = j & 1;
        { SUB_T0(1)
        if (j & 1) { if (j + 1 < nsteps) AT_STORE(rk0, rv0, 0); if (j + 3 < nsteps) AT_LOAD(rk0, rv0, j + 3); }
        else       { if (j + 1 < nsteps) AT_STORE(rk1, rv1, 1); if (j + 3 < nsteps) AT_LOAD(rk1, rv1, j + 3); }
        SUB_ACC(1) }
        const unsigned char* kb = smem + AT_KBUF(buf); const unsigned char* vb = smem + AT_VBUF(buf);
        if (j < 4) {
#pragma unroll
            for (int tp = 0; tp < 2; ++tp) {
                bf16x8 kf[2][2];
#pragma unroll
                for (int t = 0; t < 2; ++t)
#pragma unroll
                    for (int ds = 0; ds < 2; ++ds) kf[t][ds] = *(const bf16x8*)(kb + (32 * tp + 16 * t) * AT_STRIDE + ka_off + ds * 64);
                bf16x8 pf[2];
#pragma unroll
                for (int g2 = 0; g2 < 2; ++g2) { f32x4 s0 = (f32x4){0.f, 0.f, 0.f, 0.f}, s1 = s0;
                    s0 = __builtin_amdgcn_mfma_f32_16x16x32_bf16(kf[0][0], qf[g2][0], s0, 0, 0, 0); s0 = __builtin_amdgcn_mfma_f32_16x16x32_bf16(kf[0][1], qf[g2][1], s0, 0, 0, 0);
                    s1 = __builtin_amdgcn_mfma_f32_16x16x32_bf16(kf[1][0], qf[g2][0], s1, 0, 0, 0); s1 = __builtin_amdgcn_mfma_f32_16x16x32_bf16(kf[1][1], qf[g2][1], s1, 0, 0, 0);
                    na_softmax8(s0, s1, m[g2], lsum[g2], oacc[g2], pf[g2]); }
#pragma unroll
                for (int db = 0; db < 4; ++db) {
                    const s16x4 v0 = __builtin_amdgcn_ds_read_tr16_b64_v4i16((LAS s16x4*)(vb + (32 * tp) * AT_STRIDE + va_off + db * 32));
                    const s16x4 v1 = __builtin_amdgcn_ds_read_tr16_b64_v4i16((LAS s16x4*)(vb + (32 * tp + 16) * AT_STRIDE + va_off + db * 32));
                    bf16x8 vf; vf[0] = v0[0]; vf[1] = v0[1]; vf[2] = v0[2]; vf[3] = v0[3]; vf[4] = v1[0]; vf[5] = v1[1]; vf[6] = v1[2]; vf[7] = v1[3];
                    oacc[0][db] = __builtin_amdgcn_mfma_f32_16x16x32_bf16(vf, pf[0], oacc[0][db], 0, 0, 0); oacc[1][db] = __builtin_amdgcn_mfma_f32_16x16x32_bf16(vf, pf[1], oacc[1][db], 0, 0, 0); }
            }
        } else { const int kr = krlo + (j - 4);
            if (kr >= rs && kr < rs + 8) { const int trow = (kr - r + 7) * NA_TROW;
#pragma unroll
                for (int g2 = 0; g2 < 2; ++g2) { const unsigned char* kt = kb + kc0[g2] * AT_STRIDE; const unsigned char* vt = vb + kc0[g2] * AT_STRIDE;
                    f32x4 s0 = (f32x4){0.f, 0.f, 0.f, 0.f}, s1 = s0;
#pragma unroll
                    for (int ds = 0; ds < 2; ++ds) { const bf16x8 k0 = *(const bf16x8*)(kt + ka_off + ds * 64), k1 = *(const bf16x8*)(kt + 16 * AT_STRIDE + ka_off + ds * 64);
                        s0 = __builtin_amdgcn_mfma_f32_16x16x32_bf16(k0, qf[g2][ds], s0, 0, 0, 0); s1 = __builtin_amdgcn_mfma_f32_16x16x32_bf16(k1, qf[g2][ds], s1, 0, 0, 0); }
                    const float* tp_ = T + tbase[g2] + trow;
#pragma unroll
                    for (int e = 0; e < 4; ++e) { s0[e] += tp_[e]; s1[e] += tp_[16 + e]; }
                    bf16x8 pf; na_softmax8(s0, s1, m[g2], lsum[g2], oacc[g2], pf);
#pragma unroll
                    for (int db = 0; db < 4; ++db) {
                        const s16x4 v0 = __builtin_amdgcn_ds_read_tr16_b64_v4i16((LAS s16x4*)(vt + va_off + db * 32));
                        const s16x4 v1 = __builtin_amdgcn_ds_read_tr16_b64_v4i16((LAS s16x4*)(vt + 16 * AT_STRIDE + va_off + db * 32));
                        bf16x8 vf; vf[0] = v0[0]; vf[1] = v0[1]; vf[2] = v0[2]; vf[3] = v0[3]; vf[4] = v1[0]; vf[5] = v1[1]; vf[6] = v1[2]; vf[7] = v1[3];
                        oacc[g2][db] = __builtin_amdgcn_mfma_f32_16x16x32_bf16(vf, pf, oacc[g2][db], 0, 0, 0); } }
            }
        }
        { SUB_T0(2) __syncthreads(); SUB_ACC(2) }
    }
#pragma unroll
    for (int g2 = 0; g2 < 2; ++g2) { float lt = lsum[g2]; lt += __shfl_xor(lt, 16); lt += __shfl_xor(lt, 32); const float inv = 1.0f / lt;
        bf16_t* op = p->ycat + (size_t)(qtok + 16 * g2 + q16) * 1024 + ocol + 4 * kg;
#pragma unroll
        for (int db = 0; db < 4; ++db) store4bf(op + 16 * db, oacc[g2][db] * inv); }
}

__device__ __forceinline__ void phase_conv(ParamsC p, int l) {
    const int tid = ltid();
    const bool need_ctx = l < DEPTH - 1;
    {
        const int ntok = need_ctx ? T_ALL : T_LAT; const float* cw = p->conv_w + l * 3 * 256;
        for (int idx = lbid() * NTHR + tid; idx < ntok * 32; idx += gridDim.x * NTHR) { const int t = idx >> 5, c = (idx & 31) * 8;
            int pos, len; if (t < T_LAT) { pos = t & 8191; len = SEQ; } else { pos = (t - T_LAT) & 255; len = CTXL; }
            const bf16_t* u = p->uA + (size_t)t * UA_LD + c;
            const bool hp = pos > 0, hn = pos + 1 < len;
            const pg8::u32x4 zero4 = (pg8::u32x4){0u, 0u, 0u, 0u};
            const pg8::u32x4 h1 = *(const pg8::u32x4*)u, c1 = *(const pg8::u32x4*)(u + 512), b1 = *(const pg8::u32x4*)(u + 256);
            const pg8::u32x4 h0 = hp ? *(const pg8::u32x4*)(u - UA_LD) : zero4, c0 = hp ? *(const pg8::u32x4*)(u + 512 - UA_LD) : zero4;
            const pg8::u32x4 h2 = hn ? *(const pg8::u32x4*)(u + UA_LD) : zero4, c2 = hn ? *(const pg8::u32x4*)(u + 512 + UA_LD) : zero4;
            f32x4 w0a = *(const f32x4*)(cw + c), w0b = *(const f32x4*)(cw + c + 4), w1a = *(const f32x4*)(cw + 256 + c), w1b = *(const f32x4*)(cw + 256 + c + 4), w2a = *(const f32x4*)(cw + 512 + c), w2b = *(const f32x4*)(cw + 512 + c + 4);
            f32x4 ha, hb, ca, cb, ya, yb;
            unpack8(h0, ha, hb); unpack8(c0, ca, cb); ya = ha * ca * w0a; yb = hb * cb * w0b;
            unpack8(h1, ha, hb); unpack8(c1, ca, cb); ya += ha * ca * w1a; yb += hb * cb * w1b;
            unpack8(h2, ha, hb); unpack8(c2, ca, cb); ya += ha * ca * w2a; yb += hb * cb * w2b;
            unpack8(b1, ha, hb); ya = ya * ha; yb = yb * hb;
            *(pg8::u32x4*)(p->ycat + (size_t)t * 1024 + c) = pack8(ya, yb); } }
}
__device__ __forceinline__ void phase_na(ParamsC p, int l, unsigned char* smem) {
    for (int u = lbid(); u < 768; u += gridDim.x) attn_unit_na(p, l, u, smem);
}
__device__ __forceinline__ void phase_swa(ParamsC p, int l, unsigned char* smem) {
    for (int u = lbid(); u < 768; u += gridDim.x) attn_unit<1>(p, l, u, smem);
    if (l < DEPTH - 1) for (int u = lbid(); u < 48; u += gridDim.x) attn_unit<2>(p, l, u, smem);
}

__device__ __forceinline__ void phase_gemm_merge(ParamsC p, int l, unsigned char* smem) {
    const int tid = ltid(), lane = tid & 63, wid = tid >> 6, wm = wid >> 1, wn = wid & 1, q4 = (lane >> 4) * 4;
    const int ntok = (l < DEPTH - 1) ? T_ALL : T_LAT; const int nM = ntok / 128, nN = 8;
    for (int tile = lbid(); tile < nM * nN; tile += gridDim.x) {
        const int tm = tile / nN, tn = tile % nN, m0 = tm * 128, n0 = tn * 128;
        f32x4 macc[2][4]; zero_acc(macc);
        RowsLinear ar{p->ycat + (size_t)m0 * 1024, 1024};
#pragma unroll
        for (int seg = 0; seg < 3; ++seg) {
            const int k0 = seg == 0 ? 0 : (seg == 1 ? 256 : 640), k1 = seg == 0 ? 256 : (seg == 1 ? 640 : 1024);
            f32x4 acc[2][4]; zero_acc(acc);
            gemm_core(smem, ar, p->wt_br + (size_t)n0 * 1024, 1024, k0, k1, acc);
#pragma unroll
            for (int mi = 0; mi < 2; ++mi) { const int t = m0 + wm * 32 + mi * 16 + (lane & 15);
#pragma unroll
                for (int nj = 0; nj < 4; ++nj) { const uint2 g = *(const uint2*)(p->uG + (size_t)t * UG_LD + seg * 1024 + n0 + wn * 64 + nj * 16 + q4);
                    macc[mi][nj][0] += bf2f((bf16_t)(g.x & 0xffff)) * acc[mi][nj][0]; macc[mi][nj][1] += bf2f((bf16_t)(g.x >> 16)) * acc[mi][nj][1];
                    macc[mi][nj][2] += bf2f((bf16_t)(g.y & 0xffff)) * acc[mi][nj][2]; macc[mi][nj][3] += bf2f((bf16_t)(g.y >> 16)) * acc[mi][nj][3]; } }
        }
#pragma unroll
        for (int mi = 0; mi < 2; ++mi) { const int t = m0 + wm * 32 + mi * 16 + (lane & 15);
#pragma unroll
            for (int nj = 0; nj < 4; ++nj) store4bf(p->mbuf + (size_t)t * 1024 + n0 + wn * 64 + nj * 16 + q4, macc[mi][nj]); }
    }
}

__device__ __forceinline__ void phase_gemm_o(ParamsC p, int l, unsigned char* smem) {
    const int tid = ltid(), lane = tid & 63, wid = tid >> 6, wm = wid >> 1, wn = wid & 1, q4 = (lane >> 4) * 4;
    const int ntok = (l < DEPTH - 1) ? T_ALL : T_LAT; const int nM = ntok / 128, nN = 8;
    for (int tile = lbid(); tile < nM * nN; tile += gridDim.x) {
        const int tm = tile / nN, tn = tile % nN, m0 = tm * 128, n0 = tn * 128;
        f32x4 acc[2][4]; zero_acc(acc);
        RowsLinear ar{p->mbuf + (size_t)m0 * 1024, 1024};
        gemm_core(smem, ar, p->wt_o + (size_t)n0 * 1024, 1024, 0, 1024, acc);
#pragma unroll
        for (int mi = 0; mi < 2; ++mi) { const int t = m0 + wm * 32 + mi * 16 + (lane & 15); const float* gt = p->modv + (size_t)(l * 5 + tok_variant(t)) * 6144 + 2048;
#pragma unroll
            for (int nj = 0; nj < 4; ++nj) { const int c = n0 + wn * 64 + nj * 16 + q4; bf16_t* xp = p->xs + (size_t)t * 1024 + c; float4 xv = load4bf(xp); const float4 g = *(const float4*)(gt + c);
                xv.x += g.x * acc[mi][nj][0]; xv.y += g.y * acc[mi][nj][1]; xv.z += g.z * acc[mi][nj][2]; xv.w += g.w * acc[mi][nj][3]; { uint2 xo; xo.x = pack2(xv.x, xv.y); xo.y = pack2(xv.z, xv.w); *(uint2*)xp = xo; } } }
    }
}

#define RT_LD 1028
__device__ __forceinline__ void split8(const float (&x)[8], bf16x8& hi, bf16x8& lo) {
    pg8::u32x4 h, lw; float r[8];
    h.x = pack2(x[0], x[1]); h.y = pack2(x[2], x[3]); h.z = pack2(x[4], x[5]); h.w = pack2(x[6], x[7]);
    r[0] = x[0] - __uint_as_float(h.x << 16); r[1] = x[1] - __uint_as_float(h.x & 0xffff0000u); r[2] = x[2] - __uint_as_float(h.y << 16); r[3] = x[3] - __uint_as_float(h.y & 0xffff0000u);
    r[4] = x[4] - __uint_as_float(h.z << 16); r[5] = x[5] - __uint_as_float(h.z & 0xffff0000u); r[6] = x[6] - __uint_as_float(h.w << 16); r[7] = x[7] - __uint_as_float(h.w & 0xffff0000u);
    lw.x = pack2(r[0], r[1]); lw.y = pack2(r[2], r[3]); lw.z = pack2(r[4], r[5]); lw.w = pack2(r[6], r[7]);
    hi = __builtin_bit_cast(bf16x8, h); lo = __builtin_bit_cast(bf16x8, lw);
}
__device__ __forceinline__ void phase_router(ParamsC p, int l, float* smem) {
    const int tid = ltid(), lane = tid & 63, wid = tid >> 6;
    float* sh2 = smem;
    float* spart = smem + 16 * RT_LD;
    float* slg = spart + 8 * 16 * 48;
    int* bcnt = (int*)(slg + 16 * 36);
    if (tid < 32) bcnt[tid] = 0;
    const int ntok = (l < DEPTH - 1) ? T_ALL : T_LAT;
    const float* wre = p->w_re + (size_t)l * 1024 * 32; const float* wrg = p->w_rg + (size_t)l * 1024 * 4;
    bf16x8 bh[4][3], bl[4][3];
#pragma unroll
    for (int ks = 0; ks < 4; ++ks)
#pragma unroll
        for (int nt = 0; nt < 3; ++nt) { float w[8]; const int k0 = wid * 128 + ks * 32 + (lane >> 4) * 8, n = lane & 15;
#pragma unroll
            for (int j = 0; j < 8; ++j) w[j] = (nt < 2) ? wre[(size_t)(k0 + j) * 32 + nt * 16 + n] : (n < 4 ? wrg[(size_t)(k0 + j) * 4 + n] : 0.f);
            split8(w, bh[ks][nt], bl[ks][nt]); }
    float4 gf[4];
#pragma unroll
    for (int i = 0; i < 4; ++i) gf[i] = *(const float4*)(p->g_ffn + l * 1024 + i * 256 + lane * 4);
    const bf16_t* xs = p->xs; bf16_t* hout = p->h; const float* modv = p->modv + (size_t)l * 5 * 6144 + 3072;
    const int G = gridDim.x, ntb = ntok / 16;
    __syncthreads();
    for (int tb = lbid(); tb < ntb; tb += G) {
#pragma unroll
        for (int j = 0; j < 2; ++j) { const int tt = wid * 2 + j, t = tb * 16 + tt; const int v = tok_variant(t);
            float4 xv[4]; float ss = 0.f;
#pragma unroll
            for (int i = 0; i < 4; ++i) { xv[i] = load4bf(xs + (size_t)t * 1024 + i * 256 + lane * 4); ss += xv[i].x * xv[i].x + xv[i].y * xv[i].y + xv[i].z * xv[i].z + xv[i].w * xv[i].w; }
            ss = wave_sum(ss); const float rstd = rsqrtf(ss * (1.0f / 1024.0f) + 1e-6f);
            const float* mv = modv + (size_t)v * 6144;
#pragma unroll
            for (int i = 0; i < 4; ++i) { const int c = i * 256 + lane * 4;
                const float4 g = gf[i], sh = *(const float4*)(mv + c), sc = *(const float4*)(mv + 1024 + c);
                float4 o; o.x = xv[i].x * rstd * g.x * (1.f + sc.x) + sh.x; o.y = xv[i].y * rstd * g.y * (1.f + sc.y) + sh.y; o.z = xv[i].z * rstd * g.z * (1.f + sc.z) + sh.z; o.w = xv[i].w * rstd * g.w * (1.f + sc.w) + sh.w;
                *(float4*)(sh2 + tt * RT_LD + c) = o; uint2 ob; ob.x = pack2(o.x, o.y); ob.y = pack2(o.z, o.w); *(uint2*)(hout + (size_t)t * 1024 + c) = ob; } }
        __syncthreads();
        {   f32x4 c0 = (f32x4){0.f, 0.f, 0.f, 0.f}, c1 = c0, c2 = c0;
            const float* ap = sh2 + (lane & 15) * RT_LD + wid * 128 + (lane >> 4) * 8;
#pragma unroll
            for (int ks = 0; ks < 4; ++ks) { const float4 a0 = *(const float4*)(ap + ks * 32), a1 = *(const float4*)(ap + ks * 32 + 4);
                const float x8[8] = {a0.x, a0.y, a0.z, a0.w, a1.x, a1.y, a1.z, a1.w}; bf16x8 ah, al; split8(x8, ah, al);
                c0 = __builtin_amdgcn_mfma_f32_16x16x32_bf16(ah, bh[ks][0], c0, 0, 0, 0); c0 = __builtin_amdgcn_mfma_f32_16x16x32_bf16(ah, bl[ks][0], c0, 0, 0, 0); c0 = __builtin_amdgcn_mfma_f32_16x16x32_bf16(al, bh[ks][0], c0, 0, 0, 0);
                c1 = __builtin_amdgcn_mfma_f32_16x16x32_bf16(ah, bh[ks][1], c1, 0, 0, 0); c1 = __builtin_amdgcn_mfma_f32_16x16x32_bf16(ah, bl[ks][1], c1, 0, 0, 0); c1 = __builtin_amdgcn_mfma_f32_16x16x32_bf16(al, bh[ks][1], c1, 0, 0, 0);
                c2 = __builtin_amdgcn_mfma_f32_16x16x32_bf16(ah, bh[ks][2], c2, 0, 0, 0); c2 = __builtin_amdgcn_mfma_f32_16x16x32_bf16(ah, bl[ks][2], c2, 0, 0, 0); c2 = __builtin_amdgcn_mfma_f32_16x16x32_bf16(al, bh[ks][2], c2, 0, 0, 0); }
#pragma unroll
            for (int r = 0; r < 4; ++r) { float* sp = spart + (wid * 16 + 4 * (lane >> 4) + r) * 48 + (lane & 15); sp[0] = c0[r]; sp[16] = c1[r]; sp[32] = c2[r]; } }
        __syncthreads();
        {   const int tt = tid >> 5, j = tid & 31; float a = p->b_re[l * 32 + j];
#pragma unroll
            for (int w8 = 0; w8 < 8; ++w8) a += spart[(w8 * 16 + tt) * 48 + j];
            slg[tt * 36 + 4 + j] = a;
            if (tid < 64) { const int t2 = tid >> 2, j2 = tid & 3; float a2 = p->b_rg[l * 4 + j2];
#pragma unroll
                for (int w8 = 0; w8 < 8; ++w8) a2 += spart[(w8 * 16 + t2) * 48 + 32 + j2];
                slg[t2 * 36 + j2] = a2; } }
        __syncthreads();
        if (tid < 16) { const int t = tb * 16 + tid; const float* lg = slg + tid * 36;
            int gi = 0; float gm = lg[0];
#pragma unroll
            for (int j = 1; j < 4; ++j) if (lg[j] > gm) { gm = lg[j]; gi = j; }
            float den = 0.f;
#pragma unroll
            for (int j = 0; j < 4; ++j) den += __expf(lg[j] - gm);
            const float pg = __builtin_amdgcn_rcpf(den);
            const float* le = lg + 4 + gi * 8;
            int i1 = 0; float v1 = le[0];
#pragma unroll
            for (int j = 1; j < 8; ++j) if (le[j] > v1) { v1 = le[j]; i1 = j; }
            int i2 = -1; float v2 = -3.0e38f;
#pragma unroll
            for (int j = 0; j < 8; ++j) if (j != i1 && le[j] > v2) { v2 = le[j]; i2 = j; }
            const float e2 = __expf(v2 - v1); const float wa = __builtin_amdgcn_rcpf(1.0f + e2), wb = e2 * wa;
            const int ea = gi * 8 + i1, eb = gi * 8 + i2;
            p->eid[t * 2] = ea; p->eid[t * 2 + 1] = eb; p->ewt[t * 2] = pg * wa; p->ewt[t * 2 + 1] = pg * wb;
            p->epos[t * 2] = atomicAdd(bcnt + ea, 1); p->epos[t * 2 + 1] = atomicAdd(bcnt + eb, 1); }
        __syncthreads();
    }
    __syncthreads();
    if (tid < 32) p->cnt[lbid() * 32 + tid] = bcnt[tid];
}

__device__ __forceinline__ void phase_dispatch(ParamsC p, int l, int* smem) {
    const int tid = ltid(), lane = tid & 63, wid = tid >> 6;
    int* sfull = smem;
    int* spre = smem + 512;
    int* pstart = smem + 1024;
    int* boff = smem + 1024 + 64;
    const int G = gridDim.x;
    {   const int e = tid & 31, part = tid >> 5; int sf = 0, sp = 0;
        for (int bb = part; bb < G; bb += 16) { const int c = p->cnt[bb * 32 + e]; sf += c; sp += (bb < lbid()) ? c : 0; }
        sfull[part * 32 + e] = sf; spre[part * 32 + e] = sp; }
    __syncthreads();
    if (tid < 32) { int tf = 0, tp = 0; for (int q = 0; q < 16; ++q) { tf += sfull[q * 32 + tid]; tp += spre[q * 32 + tid]; } sfull[tid] = tf; spre[tid] = tp; }
    __syncthreads();
    if (tid == 0) { int acc = 0; for (int e = 0; e < 32; ++e) { pstart[e] = acc; acc += ((sfull[e] + 255) >> 8) << 8; } pstart[32] = acc; }
    __syncthreads();
    if (tid < 32) boff[tid] = pstart[tid] + spre[tid];
    if (lbid() == 0) { const int nb = pstart[32] >> 8;
        for (int rb = tid; rb < nb; rb += NTHR) { int e = 0; while (e < 31 && pstart[e + 1] <= rb * 256) ++e; p->blk_e[rb] = e; }
        if (tid == 0) p->nbu[0] = nb; }
    __syncthreads();
    const int ntok = (l < DEPTH - 1) ? T_ALL : T_LAT;
    for (int tb = lbid(); tb < ntok / 16; tb += G) {
#pragma unroll
        for (int j = 0; j < 4; ++j) { const int a = tb * 32 + wid * 4 + j; const int t = a >> 1; const int sl = boff[p->eid[a]] + p->epos[a];
            if (lane == 0) { p->slot[a] = sl; p->tokmap[sl] = t; } }
    }
    for (int e = lbid(); e < 32; e += G) { const int lo = pstart[e] + sfull[e], hi = pstart[e + 1]; for (int sl = lo + tid; sl < hi; sl += NTHR) p->tokmap[sl] = 0; }
}

__device__ __forceinline__ void phase_gemm_e1(ParamsC p, unsigned char* smem) {
    const int tid = ltid(), lane = tid & 63, wid = tid >> 6, wm = wid >> 1, wn = wid & 1, q4 = (lane >> 4) * 4;
    const int nb = p->nbu[0]; const int ntiles = nb * 2 * 4;
    for (int tile = lbid(); tile < ntiles; tile += gridDim.x) {
        const int rb = tile >> 2, tn = tile & 3, m0 = rb * 128, e = p->blk_e[rb >> 1];
        f32x4 acc[2][4]; zero_acc(acc);
        RowsLinear ar{p->xd + (size_t)m0 * 1024, 1024};
        gemm_core(smem, ar, p->wt_gu + ((size_t)e * 512 + tn * 128) * 1024, 1024, 0, 1024, acc);
        const int pg = tn * 2 + wn;
#pragma unroll
        for (int mi = 0; mi < 2; ++mi) { const int sl = m0 + wm * 32 + mi * 16 + (lane & 15);
#pragma unroll
            for (int nj = 0; nj < 2; ++nj) { f32x4 g = acc[mi][nj], u = acc[mi][nj + 2], o;
#pragma unroll
                for (int e4 = 0; e4 < 4; ++e4) o[e4] = g[e4] / (1.f + __expf(-g[e4])) * u[e4];
                store4bf(p->hid + (size_t)sl * 256 + pg * 32 + nj * 16 + q4, o); } }
    }
}
__device__ __forceinline__ void phase_gemm_e2(ParamsC p, unsigned char* smem) {
    const int tid = ltid(), lane = tid & 63, wid = tid >> 6, wm = wid >> 1, wn = wid & 1, q4 = (lane >> 4) * 4;
    const int nb = p->nbu[0]; const int ntiles = nb * 2 * 8;
    for (int tile = lbid(); tile < ntiles; tile += gridDim.x) {
        const int rb = tile >> 3, tn = tile & 7, m0 = rb * 128, n0 = tn * 128, e = p->blk_e[rb >> 1];
        f32x4 acc[2][4]; zero_acc(acc);
        RowsLinear ar{p->hid + (size_t)m0 * 256, 256};
        gemm_core(smem, ar, p->wt_d + ((size_t)e * 1024 + n0) * 256, 256, 0, 256, acc);
#pragma unroll
        for (int mi = 0; mi < 2; ++mi) { const int sl = m0 + wm * 32 + mi * 16 + (lane & 15);
#pragma unroll
            for (int nj = 0; nj < 4; ++nj) store4bf(p->Y + (size_t)sl * 1024 + n0 + wn * 64 + nj * 16 + q4, acc[mi][nj]); }
    }
}


struct EpiIn { static constexpr bool PERM = true, AFTER_DRAIN = false, HOOK = false;
    bf16_t* uA; bf16_t* uG; const float* ropet;
    __device__ __forceinline__ void operator()(const f32x4 (&acc)[2][2][4][2], const pg8::Unit& u, int wr, int wc, int fr, int fq) const {
        const int row0 = u.pm * 256 + wr * 64 + fr; const bool latent = u.pm < 128;
#pragma unroll
        for (int bj = 0; bj < 2; ++bj) {
            const int cb32 = u.pn * 256 + bj * 128 + wc * 32, c0 = cb32 + 8 * fq;
            if (cb32 >= 2560) {
#pragma unroll
                for (int ai = 0; ai < 2; ++ai)
#pragma unroll
                    for (int m = 0; m < 4; ++m) { const int t = row0 + ai * 128 + m * 16; f32x4 v0 = acc[ai][bj][m][0], v1 = acc[ai][bj][m][1];
#pragma unroll
                        for (int e = 0; e < 4; ++e) { v0[e] = __builtin_amdgcn_rcpf(1.f + __expf(-v0[e])); v1[e] = __builtin_amdgcn_rcpf(1.f + __expf(-v1[e])); }
                        const int gt_ = (u.pn - 10), wv_ = wr * 4 + wc;
                        *(pg8::u32x4*)(uG + ((((size_t)u.pm * 12 + gt_) * 8 + wv_) * 16 + (ai * 8 + m * 2 + bj)) * 512 + (fq * 16 + fr) * 8) = pack8(v0, v1); }
            } else {
                const bool isq = (cb32 >= 768 && cb32 < 1152) || (cb32 >= 1920 && cb32 < 2304);
                const bool rope = (cb32 >= 1920 && cb32 < 2432) && latent;
#pragma unroll
                for (int ai = 0; ai < 2; ++ai)
#pragma unroll
                    for (int m = 0; m < 4; ++m) { const int t = row0 + ai * 128 + m * 16; f32x4 v0 = acc[ai][bj][m][0], v1 = acc[ai][bj][m][1];
                        if (rope) { const int pos = t & 8191; const int posv = (wc & 1) ? (pos & 63) : (pos >> 6);
                            const float4* cs = (const float4*)(ropet + (posv * 16 + 8 * (fq & 1)) * 2);
                            const float4 c01 = cs[0], c23 = cs[1], c45 = cs[2], c67 = cs[3];
                            f32x4 p0, p1;
#pragma unroll
                            for (int e = 0; e < 4; ++e) { p0[e] = __shfl_xor(v0[e], 32); p1[e] = __shfl_xor(v1[e], 32); }
                            const float co0[4] = {c01.x, c01.z, c23.x, c23.z}, si0[4] = {c01.y, c01.w, c23.y, c23.w}, co1[4] = {c45.x, c45.z, c67.x, c67.z}, si1[4] = {c45.y, c45.w, c67.y, c67.w};
#pragma unroll
                            for (int e = 0; e < 4; ++e) {
                                if (fq < 2) { v0[e] = v0[e] * co0[e] - p0[e] * si0[e]; v1[e] = v1[e] * co1[e] - p1[e] * si1[e]; }
                                else { v0[e] = p0[e] * si0[e] + v0[e] * co0[e]; v1[e] = p1[e] * si1[e] + v1[e] * co1[e]; } } }
                        if (isq) { v0 = v0 * (0.125f * QLOG2E); v1 = v1 * (0.125f * QLOG2E); }
                        *(pg8::u32x4*)(uA + (size_t)t * UA_LD + c0) = pack8(v0, v1); }
            }
        }
    }
};

struct EpiMerge { static constexpr bool PERM = true, AFTER_DRAIN = false, HOOK = true;
    const bf16_t* uG; bf16_t* mo;
    __device__ __forceinline__ void hook(f32x4 (&acc)[2][2][4][2], const pg8::Unit& u, int t, int wr, int wc, int fr, int fq) const {
        int lo_ = (fq * 16 + fr) * 8; asm volatile("" : "+v"(lo_)); const int seg = (t == 2) ? 0 : 1;
        const bf16_t* gbase = uG + ((((size_t)u.pm * 12 + seg * 4 + u.pn) * 8 + (wr * 4 + wc)) * 16) * 512 + lo_;
#pragma unroll
        for (int ai = 0; ai < 2; ++ai) {
            pg8::u32x4 wn[4][2], wd[4][2];
#pragma unroll
            for (int m = 0; m < 4; ++m)
#pragma unroll
                for (int bj = 0; bj < 2; ++bj) { const bf16_t* gp = gbase + (ai * 8 + m * 2 + bj) * 512; wn[m][bj] = *(const pg8::u32x4*)gp; wd[m][bj] = *(const pg8::u32x4*)(gp + 4 * 65536); }
#pragma unroll
            for (int m = 0; m < 4; ++m)
#pragma unroll
                for (int bj = 0; bj < 2; ++bj) { f32x4 n0, n1, d0, d1; unpack8(wn[m][bj], n0, n1); unpack8(wd[m][bj], d0, d1);
#pragma unroll
                    for (int e = 0; e < 4; ++e) { acc[ai][bj][m][0][e] *= n0[e] * __builtin_amdgcn_rcpf(fmaxf(d0[e], 1e-20f)); acc[ai][bj][m][1][e] *= n1[e] * __builtin_amdgcn_rcpf(fmaxf(d1[e], 1e-20f)); } }
            asm volatile("" ::: "memory");
        }
    }
    __device__ __forceinline__ void operator()(const f32x4 (&acc)[2][2][4][2], const pg8::Unit& u, int wr, int wc, int fr, int fq) const {
        const int row0 = u.pm * 256 + wr * 64 + fr; const int c00 = u.pn * 256 + wc * 32 + 8 * fq;
#pragma unroll
        for (int ai = 0; ai < 2; ++ai) { pg8::u32x4 wg[4][2];
#pragma unroll
            for (int m = 0; m < 4; ++m)
#pragma unroll
                for (int bj = 0; bj < 2; ++bj) wg[m][bj] = *(const pg8::u32x4*)(uG + ((((size_t)u.pm * 12 + 8 + u.pn) * 8 + (wr * 4 + wc)) * 16 + (ai * 8 + m * 2 + bj)) * 512 + (fq * 16 + fr) * 8);
#pragma unroll
            for (int m = 0; m < 4; ++m)
#pragma unroll
                for (int bj = 0; bj < 2; ++bj) { f32x4 g0, g1; unpack8(wg[m][bj], g0, g1); f32x4 v0 = acc[ai][bj][m][0], v1 = acc[ai][bj][m][1];
#pragma unroll
                    for (int e = 0; e < 4; ++e) { v0[e] *= fmaxf(g0[e], 1e-20f); v1[e] *= fmaxf(g1[e], 1e-20f); }
                    *(pg8::u32x4*)(mo + (size_t)(row0 + ai * 128 + m * 16) * 1024 + c00 + bj * 128) = pack8(v0, v1); }
            asm volatile("" ::: "memory"); }
    }
};

struct EpiO { static constexpr bool PERM = true, AFTER_DRAIN = false, HOOK = false;
    bf16_t* xs; const float* modv_l;
    __device__ __forceinline__ void operator()(const f32x4 (&acc)[2][2][4][2], const pg8::Unit& u, int wr, int wc, int fr, int fq) const {
        const int row0 = u.pm * 256 + wr * 64 + fr; const int v = u.pm < 128 ? (u.pm >> 5) : 4; const float* gt = modv_l + (size_t)v * 6144 + 2048;
        const int col0 = u.pn * 256 + wc * 32 + 8 * fq;
        f32x4 gv[2][2];
#pragma unroll
        for (int bj = 0; bj < 2; ++bj)
#pragma unroll
            for (int n = 0; n < 2; ++n) gv[bj][n] = *(const f32x4*)(gt + col0 + bj * 128 + n * 4);
#pragma unroll
        for (int ai = 0; ai < 2; ++ai) { pg8::u32x4 xw[4][2];
#pragma unroll
            for (int m = 0; m < 4; ++m)
#pragma unroll
                for (int bj = 0; bj < 2; ++bj) xw[m][bj] = *(const pg8::u32x4*)(xs + (size_t)(row0 + ai * 128 + m * 16) * 1024 + col0 + bj * 128);
#pragma unroll
            for (int m = 0; m < 4; ++m)
#pragma unroll
                for (int bj = 0; bj < 2; ++bj) { f32x4 x0, x1; unpack8(xw[m][bj], x0, x1);
                    x0 = x0 + gv[bj][0] * acc[ai][bj][m][0]; x1 = x1 + gv[bj][1] * acc[ai][bj][m][1];
                    *(pg8::u32x4*)(xs + (size_t)(row0 + ai * 128 + m * 16) * 1024 + col0 + bj * 128) = pack8(x0, x1); }
            asm volatile("" ::: "memory"); }
    }
};

struct EpiE1 { static constexpr bool PERM = true, AFTER_DRAIN = false, HOOK = false;
    bf16_t* hid;
    __device__ __forceinline__ void operator()(const f32x4 (&acc)[2][2][4][2], const pg8::Unit& u, int wr, int wc, int fr, int fq) const {
        const int row0 = u.pm * 256 + wr * 64 + fr; const int c0 = (u.pn & 1) * 128 + wc * 32 + 8 * fq;
#pragma unroll
        for (int ai = 0; ai < 2; ++ai)
#pragma unroll
            for (int m = 0; m < 4; ++m) { f32x4 o0, o1;
#pragma unroll
                for (int e = 0; e < 4; ++e) { const float g0 = acc[ai][0][m][0][e], g1 = acc[ai][0][m][1][e];
                    o0[e] = g0 * __builtin_amdgcn_rcpf(1.f + __expf(-g0)) * acc[ai][1][m][0][e]; o1[e] = g1 * __builtin_amdgcn_rcpf(1.f + __expf(-g1)) * acc[ai][1][m][1][e]; }
                *(pg8::u32x4*)(hid + (size_t)(row0 + ai * 128 + m * 16) * 256 + c0) = pack8(o0, o1); }
    }
};

struct EpiE2 { static constexpr bool PERM = true, AFTER_DRAIN = false, HOOK = false;
    bf16_t* Y;
    __device__ __forceinline__ void operator()(const f32x4 (&acc)[2][2][4][2], const pg8::Unit& u, int wr, int wc, int fr, int fq) const {
        const int row0 = u.pm * 256 + wr * 64 + fr; const int c0 = (u.pn & 3) * 256 + wc * 32 + 8 * fq;
#pragma unroll
        for (int ai = 0; ai < 2; ++ai)
#pragma unroll
            for (int m = 0; m < 4; ++m)
#pragma unroll
                for (int bj = 0; bj < 2; ++bj) *(pg8::u32x4*)(Y + (size_t)(row0 + ai * 128 + m * 16) * 1024 + c0 + bj * 128) = pack8(acc[ai][bj][m][0], acc[ai][bj][m][1]);
    }
};

__device__ __forceinline__ void phase_pg_in(ParamsC p, int l, unsigned char* smem) {
    pg8::Gemm g{p->h, WSEL(wt_in, l), T_ALL, IN_COLS, 1024, nullptr}; pg8::StaticOrder S; S.init(T_ALL, IN_COLS, (int)gridDim.x, lbid());
    EpiIn E{p->uA, p->uG, p->ropet};
    pg8::gemm_phase<EpiIn, pg8::StaticOrder, true, true>((PG8_LAS unsigned char*)smem, g, S, E);
}
__device__ __forceinline__ void phase_pg_merge(ParamsC p, int l, unsigned char* smem) {
    const int M = (l < DEPTH - 1) ? T_ALL : T_LAT;
    pg8::Gemm g{p->ycat, WSEL(wt_br, l), M, 1024, 1024, nullptr}; pg8::StaticOrder S; S.init(M, 1024, (int)gridDim.x, lbid());
    EpiMerge E{p->uG, p->mbuf};
    pg8::gemm_phase<EpiMerge, pg8::StaticOrder, true, true>((PG8_LAS unsigned char*)smem, g, S, E);
    if (l < DEPTH - 1) { const int G = (int)gridDim.x, extra = (M / 256) * 4 - 2 * G, c = lbid(); const bool part = extra > 0 && extra < G;
        const int first = part ? c - extra : c, stride = part ? G - extra : G;
        if (first >= 0) phase_wconv(p, l + 1, (float*)smem, 0, WC_TOTAL / 2, first, stride); }
}
__device__ __forceinline__ void phase_pg_o(ParamsC p, int l, unsigned char* smem) {
    const int M = (l < DEPTH - 1) ? T_ALL : T_LAT;
    pg8::Gemm g{p->mbuf, WSEL(wt_o, l), M, 1024, 1024, nullptr}; pg8::StaticOrder S; S.init(M, 1024, (int)gridDim.x, lbid());
    EpiO E{p->xs, p->modv + (size_t)l * 5 * 6144};
    pg8::gemm_phase<EpiO, pg8::StaticOrder, true, true>((PG8_LAS unsigned char*)smem, g, S, E);
    if (l < DEPTH - 1) { const int G = (int)gridDim.x, extra = (M / 256) * 4 - 2 * G, c = lbid(); const bool part = extra > 0 && extra < G;
        const int first = part ? c - extra : c, stride = part ? G - extra : G;
        if (first >= 0) phase_wconv(p, l + 1, (float*)smem, WC_TOTAL / 2, WC_TOTAL, first, stride); }
}
__device__ __forceinline__ void phase_pg_e1(ParamsC p, int l, unsigned char* smem) {
    const int nb = p->nbu[0];
    pg8::Gemm g{p->h, WSEL(wt_gu, l), nb * 256, 512, 1024, p->tokmap}; pg8::GroupedOrder<2> S{p->blk_e, nb * 2, (int)gridDim.x, lbid()};
    EpiE1 E{p->hid};
    pg8::gemm_phase<EpiE1, pg8::GroupedOrder<2>, true, true, true>((PG8_LAS unsigned char*)smem, g, S, E);
}
__device__ __forceinline__ void phase_pg_e2(ParamsC p, int l, unsigned char* smem) {
    const int nb = p->nbu[0];
    pg8::Gemm g{p->hid, WSEL(wt_d, l), nb * 256, 1024, 256, nullptr}; pg8::GroupedOrder<4> S{p->blk_e, nb * 4, (int)gridDim.x, lbid()};
    EpiE2 E{p->Y};
    pg8::gemm_phase<EpiE2, pg8::GroupedOrder<4>, true, true>((PG8_LAS unsigned char*)smem, g, S, E);
}

#define XB_TMO      128
#define XB_XCNT(j)  (256  + 64 * (j))
#define XB_XSUB(j)  (1280 + 64 * (j))
#define XB_XGEN(j)  (2304 + 64 * (j))
#define XB_TOP      3328
#define XB_TOPGEN   3392
#define XCD_BAR_WORDS 3456
#define XB_SPIN_CAP (1u << 18)
__device__ __forceinline__ unsigned xb_ld(unsigned* p)              { return __hip_atomic_load(p, __ATOMIC_RELAXED, __HIP_MEMORY_SCOPE_AGENT); }
__device__ __forceinline__ unsigned xb_add(unsigned* p, unsigned v) { return __hip_atomic_fetch_add(p, v, __ATOMIC_RELAXED, __HIP_MEMORY_SCOPE_AGENT); }
__device__ __forceinline__ unsigned xb_xcc_id() { return (unsigned)__builtin_amdgcn_s_getreg((3 << 11) | 20) & 0xFu; }
#define XB_SPIN(cond, bar) do { unsigned _sp = 0; while (cond) { __builtin_amdgcn_s_sleep(1); \
    if ((++_sp & 255u) == 0u) { if (xb_ld(&(bar)[XB_TMO])) break; if (_sp > XB_SPIN_CAP) { atomicAdd(&(bar)[XB_TMO], 1u); break; } } } } while (0)
struct XcdBarrier { unsigned* bar; unsigned x; volatile LAS unsigned* st; };
__device__ __forceinline__ XcdBarrier xcd_barrier_post(unsigned* bar, volatile LAS unsigned* st) {
    XcdBarrier b; b.bar = bar; b.x = xb_xcc_id(); b.st = st;
    if (threadIdx.x == 0) (void)xb_add(&bar[XB_XCNT(b.x)], 1u);
    return b;
}
__device__ __forceinline__ void xcd_barrier_complete(unsigned* bar, unsigned x, unsigned& nloc, unsigned& nx) {
    const unsigned G = gridDim.x * gridDim.y * gridDim.z;
    unsigned sum, cnt, mine, sp = 0u;
    for (;;) {
        sum = 0u; cnt = 0u; mine = 0u;
#pragma unroll
        for (unsigned j = 0; j < 16; ++j) { const unsigned c = xb_ld(&bar[XB_XCNT(j)]); sum += c; cnt += (c > 0u) ? 1u : 0u; mine = (j == x) ? c : mine; }
        if (sum == G) break;
        __builtin_amdgcn_s_sleep(1);
        if ((++sp & 255u) == 0u) { if (xb_ld(&bar[XB_TMO])) break; if (sp > XB_SPIN_CAP) { atomicAdd(&bar[XB_TMO], 1u); break; } }
    }
    nloc = mine > 0u ? mine : 1u; nx = cnt > 0u ? cnt : 1u;
}
__device__ __forceinline__ void xcd_barrier(const XcdBarrier& b) {
    asm volatile("s_waitcnt vmcnt(0)" ::: "memory");
    __syncthreads();
    if (threadIdx.x == 0) {
        unsigned* bar = b.bar;
        __builtin_amdgcn_s_waitcnt(0);
        unsigned nloc = b.st[0], nx = b.st[1];
        if (nloc == 0u) { xcd_barrier_complete(bar, b.x, nloc, nx); b.st[0] = nloc; b.st[1] = nx; }
        const unsigned old = xb_add(&bar[XB_XSUB(b.x)], 1u);
        const unsigned gen = old / nloc;
        if (old + 1u == (gen + 1u) * nloc) {
            __builtin_amdgcn_fence(__ATOMIC_RELEASE, "agent");
            asm volatile("s_waitcnt vmcnt(0)" ::: "memory");
            const unsigned og = xb_add(&bar[XB_TOP], 1u);
            const unsigned tg = og / nx;
            if (og + 1u == (tg + 1u) * nx) xb_add(&bar[XB_TOPGEN], 1u);
            else XB_SPIN(xb_ld(&bar[XB_TOPGEN]) == tg, bar);
            __builtin_amdgcn_fence(__ATOMIC_ACQUIRE, "agent");
            xb_add(&bar[XB_XGEN(b.x)], 1u);
            asm volatile("s_waitcnt vmcnt(0)" ::: "memory");
        } else {
            XB_SPIN(xb_ld(&bar[XB_XGEN(b.x)]) == gen, bar);
            __builtin_amdgcn_fence(__ATOMIC_ACQUIRE, "agent");
            asm volatile("s_waitcnt vmcnt(0)" ::: "memory");
        }
    }
    __syncthreads();
}

#define SMEM_BYTES 131072
#ifndef PROBE_MASK
#define PROBE_MASK 0
#endif
#define PROBE_MULT 4
#define PH_BEGIN(id) do { if (PROBE_MASK & (1 << (id))) t0 = wall_clock64(); } while (0)
#define PH_END(id) do { if (PROBE_MASK & (1 << (id))) tacc += wall_clock64() - t0; } while (0)
__global__ void __launch_bounds__(NTHR, 2) k_mega(Params p_unused) {
    const ParamsC pk = (ParamsC)__builtin_amdgcn_kernarg_segment_ptr();
#define PP() ({ ParamsC q_ = pk; asm volatile("" : "+s"(q_) :: "memory"); q_; })
    extern __shared__ __attribute__((aligned(16))) unsigned char smem[];
    volatile LAS unsigned* xbw = (volatile LAS unsigned*)(smem + SMEM_BYTES);
    if (threadIdx.x == 0) { xbw[0] = 0u; xbw[1] = 0u; xbw[2] = 0u; xbw[3] = 0u; }
    __syncthreads();
    (void)xcd_barrier_post(PP()->bar, xbw);
    unsigned long long tacc = 0, t0 = 0;
#define GRID_BAR() do { XcdBarrier bar_; bar_.bar = PP()->bar; bar_.x = xb_xcc_id(); bar_.st = xbw; xcd_barrier(bar_); } while (0)
    PH_BEGIN(0); phase_mod(PP(), (float*)smem); phase_wconv(PP(), 0, (float*)smem, 0, WC_TOTAL, lbid(), (int)gridDim.x); GRID_BAR(); PH_END(0);
    for (int l = 0; l < DEPTH; ++l) {
        PH_BEGIN(1); phase_norm1(PP(), l); GRID_BAR(); PH_END(1);
        PH_BEGIN(2); phase_pg_in(PP(), l, smem); GRID_BAR(); PH_END(2);
        PH_BEGIN(3); PH_BEGIN(11); phase_conv(PP(), l); PH_END(11); PH_BEGIN(12); phase_na(PP(), l, smem); PH_END(12); PH_BEGIN(13); phase_swa(PP(), l, smem); PH_END(13); GRID_BAR(); PH_END(3);
        PH_BEGIN(4); phase_pg_merge(PP(), l, smem); GRID_BAR(); PH_END(4);
        PH_BEGIN(5); phase_pg_o(PP(), l, smem); GRID_BAR(); PH_END(5);
        PH_BEGIN(6); phase_router(PP(), l, (float*)smem); GRID_BAR(); PH_END(6);
        PH_BEGIN(7); phase_dispatch(PP(), l, (int*)smem); GRID_BAR(); PH_END(7);
        PH_BEGIN(8); phase_pg_e1(PP(), l, smem); GRID_BAR(); PH_END(8);
        PH_BEGIN(9); phase_pg_e2(PP(), l, smem); GRID_BAR(); PH_END(9);
    }
    PH_BEGIN(10); phase_norm1(PP(), DEPTH); PH_END(10);
    if (PROBE_SUB != 0 && threadIdx.x == 0) tacc += ((volatile LAS unsigned*)(smem + 131072 + 8))[0];
    if ((PROBE_MASK != 0 || PROBE_SUB != 0) && blockIdx.x == 0) { const unsigned long long te = wall_clock64(); while (wall_clock64() - te < tacc * PROBE_MULT) __builtin_amdgcn_s_sleep(8); }
}

extern "C" void kernel_launch(void* const* d_in, const int* in_sizes, int n_in, void* d_out, int out_size, void* d_ws, size_t ws_size, hipStream_t stream) {
    Params p{};
    p.x = (const float*)d_in[0]; p.c = (const float*)d_in[1]; p.ctx = (const float*)d_in[2]; p.c_ctx = (const float*)d_in[3]; p.w_mod = (const float*)d_in[4]; p.b_mod = (const float*)d_in[5];
    p.g_attn = (const float*)d_in[6]; p.g_ffn = (const float*)d_in[7]; p.w_in = (const float*)d_in[8]; p.conv_w = (const float*)d_in[9]; p.rpb = (const float*)d_in[10]; p.sinks = (const float*)d_in[11];
    p.w_branch = (const float*)d_in[12]; p.w_o = (const float*)d_in[13]; p.w_rg = (const float*)d_in[14]; p.b_rg = (const float*)d_in[15]; p.w_re = (const float*)d_in[16]; p.b_re = (const float*)d_in[17];
    p.w_eg = (const float*)d_in[18]; p.w_eu = (const float*)d_in[19]; p.w_ed = (const float*)d_in[20]; p.g_final = (const float*)d_in[21];
    p.out = (float*)d_out;
    unsigned char* w = (unsigned char*)d_ws; size_t off = 0;
    auto take = [&](size_t bytes) { unsigned char* r = w + off; off += (bytes + 255) & ~(size_t)255; return r; };
    p.bar = (unsigned*)take(16384); p.cnt = (int*)take(1024 * 32 * 4); p.blk_e = (int*)take(MAXBLK * 4); p.nbu = (int*)take(256);
    p.modv = (float*)take((size_t)DEPTH * 5 * 6144 * 4); p.ropet = (float*)take(128 * 16 * 2 * 4);
    p.eid = (int*)take((size_t)T_ALL * 2 * 4); p.epos = (int*)take((size_t)T_ALL * 2 * 4); p.ewt = (float*)take((size_t)T_ALL * 2 * 4); p.slot = (int*)take((size_t)T_ALL * 2 * 4); p.tokmap = (int*)take((size_t)MAXBLK * 256 * 4);
    p.xs = (bf16_t*)take((size_t)T_ALL * 1024 * 2);
    p.h = (bf16_t*)take((size_t)T_ALL * 1024 * 2);
    p.wt_in = (bf16_t*)take((size_t)IN_COLS * 1024 * 2); p.wt_br = (bf16_t*)take((size_t)1024 * 1024 * 2); p.wt_o = (bf16_t*)take((size_t)1024 * 1024 * 2);
    p.wt_gu = (bf16_t*)take((size_t)32 * 512 * 1024 * 2); p.wt_d = (bf16_t*)take((size_t)32 * 1024 * 256 * 2);
    {   unsigned char* o = (unsigned char*)d_out; size_t oo = 0;
        auto take_o = [&](size_t bytes) { unsigned char* r = o + oo; oo += (bytes + 255) & ~(size_t)255; return r; };
        p.wt_in1 = (bf16_t*)take_o((size_t)IN_COLS * 1024 * 2); p.wt_br1 = (bf16_t*)take_o((size_t)1024 * 1024 * 2); p.wt_o1 = (bf16_t*)take_o((size_t)1024 * 1024 * 2);
        p.wt_gu1 = (bf16_t*)take_o((size_t)32 * 512 * 1024 * 2); p.wt_d1 = (bf16_t*)take_o((size_t)32 * 1024 * 256 * 2);
        if (oo > (size_t)out_size * 4) return; }
    p.uA = (bf16_t*)take((size_t)T_ALL * UA_LD * 2); p.uG = (bf16_t*)take((size_t)T_ALL * UG_LD * 2); p.ycat = (bf16_t*)take((size_t)T_ALL * 1024 * 2);
    p.mbuf = p.uA; p.xd = p.uA; p.hid = p.ycat; p.Y = p.uG;
    if (off > ws_size) return;
    constexpr size_t kDynLds = SMEM_BYTES + 16;
    static int grid = 0;
    if (!grid) {
        (void)hipFuncSetAttribute((const void*)k_mega, hipFuncAttributeMaxDynamicSharedMemorySize, (int)kDynLds);
        int dev = 0, cus = 0, per_cu = 0;
        (void)hipGetDevice(&dev);
        (void)hipDeviceGetAttribute(&cus, hipDeviceAttributeMultiprocessorCount, dev);
        (void)hipOccupancyMaxActiveBlocksPerMultiprocessor(&per_cu, (const void*)k_mega, NTHR, kDynLds);
        grid = cus * (per_cu < 1 ? per_cu : 1);
        if (grid <= 0) grid = 0;
    }
    if (!grid) return;
    (void)hipMemsetAsync(p.bar, 0, XCD_BAR_WORDS * sizeof(unsigned), stream);
    hipLaunchKernelGGL(k_mega, dim3(grid), dim3(NTHR), kDynLds, stream, p);
}
```

```cpp
#include <hip/hip_runtime.h>
#include <stdint.h>

typedef unsigned short bf16_t;
typedef short bf16x8 __attribute__((ext_vector_type(8)));
typedef float f32x4 __attribute__((ext_vector_type(4)));

#define D_MODEL 1024
#define NB 4
#define SEQ 8192
#define DEPTH 4
#define CTXL 256
#define T_LAT 32768
#define T_CTX 1024
#define T_ALL 33792
#define UA_LD 2560
#define UG_LD 3072
#define IN_COLS 5632
#define MAXBLK 296
#define NTHR 512
#ifndef PROBE_SUB
#define PROBE_SUB 0
#endif
#define SUB_T0(id) unsigned long long st0_ = 0; if (PROBE_SUB == (id) && threadIdx.x == 0) st0_ = wall_clock64();
#define SUB_ACC(id) if (PROBE_SUB == (id) && threadIdx.x == 0) { volatile LAS unsigned* sw_ = (volatile LAS unsigned*)(smem + 131072 + 8); sw_[0] = sw_[0] + (unsigned)(wall_clock64() - st0_); }
#define QLOG2E 1.4426950408889634f
#ifndef PGM
#define PGM 31
#endif
#define LAS __attribute__((address_space(3)))

struct Params {
    const float *x, *c, *ctx, *c_ctx, *w_mod, *b_mod, *g_attn, *g_ffn, *w_in, *conv_w, *rpb, *sinks, *w_branch, *w_o, *w_rg, *b_rg, *w_re, *b_re, *w_eg, *w_eu, *w_ed, *g_final;
    float* out;
    unsigned* bar; int* cnt; int* blk_e; int* nbu;
    float* modv; float* ropet; bf16_t* xs;
    bf16_t *h, *wt_in, *wt_br, *wt_o, *wt_gu, *wt_d, *uA, *uG, *ycat, *mbuf, *xd, *hid, *Y;
    int* eid; int* epos; float* ewt; int* slot; int* tokmap;
    bf16_t *wt_in1, *wt_br1, *wt_o1, *wt_gu1, *wt_d1;
};
typedef const __attribute__((address_space(4))) Params* ParamsC;
#define WSEL(X, l) (((l) & 1) ? p->X##1 : p->X)

__device__ __forceinline__ int lbid() { int b = blockIdx.x; asm volatile("" : "+s"(b) :: "memory"); return b; }
__device__ __forceinline__ int ltid() { int t = threadIdx.x; asm volatile("" : "+v"(t) :: "memory"); return t; }
__device__ __forceinline__ bf16_t f2bf(float f) { unsigned u = __float_as_uint(f); u += 0x7FFFu + ((u >> 16) & 1u); return (bf16_t)(u >> 16); }
__device__ __forceinline__ float bf2f(bf16_t b) { return __uint_as_float(((unsigned)b) << 16); }
typedef float f32x2_t __attribute__((ext_vector_type(2)));
typedef __bf16 bf16x2_t __attribute__((ext_vector_type(2)));
__device__ __forceinline__ unsigned pack2(float a, float b) { const f32x2_t v = {a, b}; const bf16x2_t r = __builtin_convertvector(v, bf16x2_t); return __builtin_bit_cast(unsigned, r); }
__device__ __forceinline__ float4 load4bf(const bf16_t* p) { const uint2 w = *(const uint2*)p; float4 r; r.x = __uint_as_float(w.x << 16); r.y = __uint_as_float(w.x & 0xffff0000u); r.z = __uint_as_float(w.y << 16); r.w = __uint_as_float(w.y & 0xffff0000u); return r; }
__device__ __forceinline__ float wave_sum(float v) { for (int o = 32; o > 0; o >>= 1) v += __shfl_xor(v, o); return v; }
__device__ __forceinline__ float wave_max(float v) { for (int o = 32; o > 0; o >>= 1) v = fmaxf(v, __shfl_xor(v, o)); return v; }
__device__ __forceinline__ int tok_variant(int t) { return t < T_LAT ? (t >> 13) : 4; }

__device__ __forceinline__ void phase_mod(ParamsC p, float* smem) {
    const int tid = ltid(), lane = tid & 63, wid = tid >> 6;
    float* s_silu = smem;
    float* s_part = smem + 5 * 1024;
    for (int i = tid; i < 5 * 1024; i += NTHR) { const int v = i >> 10, k = i & 1023; const float cv = v < 4 ? p->c[v * 1024 + k] : p->c_ctx[k]; s_silu[i] = cv / (1.0f + expf(-cv)); }
    __syncthreads();
    for (int item = lbid(); item < DEPTH * 96; item += gridDim.x) {
        const int l = item / 96, cb = item % 96, col = cb * 64 + lane;
        const float* w = p->w_mod + (size_t)l * 1024 * 6144 + col;
        float a0 = 0.f, a1 = 0.f, a2 = 0.f, a3 = 0.f, a4 = 0.f;
#pragma unroll 8
        for (int kk = 0; kk < 128; ++kk) { const int k = wid * 128 + kk; const float wv = w[(size_t)k * 6144];
            a0 += s_silu[k] * wv; a1 += s_silu[1024 + k] * wv; a2 += s_silu[2048 + k] * wv; a3 += s_silu[3072 + k] * wv; a4 += s_silu[4096 + k] * wv; }
        s_part[(wid * 5 + 0) * 64 + lane] = a0; s_part[(wid * 5 + 1) * 64 + lane] = a1; s_part[(wid * 5 + 2) * 64 + lane] = a2; s_part[(wid * 5 + 3) * 64 + lane] = a3; s_part[(wid * 5 + 4) * 64 + lane] = a4;
        __syncthreads();
        if (tid < 320) { const int v = tid >> 6, ln = tid & 63; float s = p->b_mod[l * 6144 + cb * 64 + ln];
            for (int w8 = 0; w8 < 8; ++w8) s += s_part[(w8 * 5 + v) * 64 + ln];
            p->modv[(size_t)(l * 5 + v) * 6144 + cb * 64 + ln] = s; }
        __syncthreads();
    }
    if (lbid() < 4) { const int i = lbid() * NTHR + tid; const int pos = i >> 4, f = i & 15;
        const float inv = powf(10000.0f, -(float)f / 16.0f); const float ang = (float)pos * inv; p->ropet[i * 2] = cosf(ang); p->ropet[i * 2 + 1] = sinf(ang); }
}

#define GU_IG 128
struct WcTile { const float* src; bf16_t* dst; int ldN, ldK, kt, nt, kind, e; };
__device__ __forceinline__ WcTile wconv_decode(ParamsC p, int l, int it) {
    const int n1 = 16 * 88, n2 = 256, n3 = 256, n4 = 2048, n5 = 2048;
    WcTile w; w.kind = 0; w.e = 0; int i = it;
    if (i < n1) { w.src = p->w_in + (size_t)l * 1024 * IN_COLS; w.ldN = IN_COLS; w.dst = WSEL(wt_in, l); w.ldK = 1024; w.kt = i / 88; w.nt = i % 88; }
    else if ((i -= n1) < n2) { w.src = p->w_branch + (size_t)l * 1024 * 1024; w.ldN = 1024; w.dst = WSEL(wt_br, l); w.ldK = 1024; w.kt = i / 16; w.nt = i % 16; }
    else if ((i -= n2) < n3) { w.src = p->w_o + (size_t)l * 1024 * 1024; w.ldN = 1024; w.dst = WSEL(wt_o, l); w.ldK = 1024; w.kt = i / 16; w.nt = i % 16; }
    else if ((i -= n3) < n4) { w.e = i / 64; i %= 64; w.src = p->w_eg + ((size_t)l * 32 + w.e) * 1024 * 256; w.ldN = 256; w.dst = WSEL(wt_gu, l); w.ldK = 1024; w.kt = i / 4; w.nt = i % 4; w.kind = 1; }
    else if ((i -= n4) < n5) { w.e = i / 64; i %= 64; w.src = p->w_eu + ((size_t)l * 32 + w.e) * 1024 * 256; w.ldN = 256; w.dst = WSEL(wt_gu, l); w.ldK = 1024; w.kt = i / 4; w.nt = i % 4; w.kind = 2; }
    else { i -= n5; w.e = i / 64; i %= 64; w.src = p->w_ed + ((size_t)l * 32 + w.e) * 256 * 1024; w.ldN = 1024; w.dst = WSEL(wt_d, l) + (size_t)w.e * 1024 * 256; w.ldK = 256; w.kt = i / 16; w.nt = i % 16; }
    return w;
}
#define WC_TOTAL (16 * 88 + 256 + 256 + 2048 * 3)
__device__ __forceinline__ void phase_wconv(ParamsC p, int l, float* smem, int lo, int hi, int first, int stride) {
    const int tid = ltid();
    float* tile = smem;
    const int r = tid >> 4, c4 = tid & 15;
    int it = lo + first; if (it >= hi) return;
    WcTile w = wconv_decode(p, l, it);
    float4 v0 = *(const float4*)(w.src + (size_t)(w.kt * 64 + r) * w.ldN + w.nt * 64 + c4 * 4), v1 = *(const float4*)(w.src + (size_t)(w.kt * 64 + r + 32) * w.ldN + w.nt * 64 + c4 * 4);
    for (;;) {
        tile[r * 65 + c4 * 4 + 0] = v0.x; tile[r * 65 + c4 * 4 + 1] = v0.y; tile[r * 65 + c4 * 4 + 2] = v0.z; tile[r * 65 + c4 * 4 + 3] = v0.w;
        tile[(r + 32) * 65 + c4 * 4 + 0] = v1.x; tile[(r + 32) * 65 + c4 * 4 + 1] = v1.y; tile[(r + 32) * 65 + c4 * 4 + 2] = v1.z; tile[(r + 32) * 65 + c4 * 4 + 3] = v1.w;
        __syncthreads();
        const int nit = it + stride; WcTile wn = w;
        if (nit < hi) { wn = wconv_decode(p, l, nit);
            v0 = *(const float4*)(wn.src + (size_t)(wn.kt * 64 + r) * wn.ldN + wn.nt * 64 + c4 * 4); v1 = *(const float4*)(wn.src + (size_t)(wn.kt * 64 + r + 32) * wn.ldN + wn.nt * 64 + c4 * 4); }
        {   const int n = tid >> 3, kc = tid & 7; const int ncol = w.nt * 64 + n; int drow = ncol;
            if (w.kind) drow = w.e * 512 + (ncol / GU_IG) * (2 * GU_IG) + (w.kind == 2 ? GU_IG : 0) + (ncol % GU_IG);
            uint4 o; o.x = pack2(tile[(kc * 8 + 0) * 65 + n], tile[(kc * 8 + 1) * 65 + n]); o.y = pack2(tile[(kc * 8 + 2) * 65 + n], tile[(kc * 8 + 3) * 65 + n]);
            o.z = pack2(tile[(kc * 8 + 4) * 65 + n], tile[(kc * 8 + 5) * 65 + n]); o.w = pack2(tile[(kc * 8 + 6) * 65 + n], tile[(kc * 8 + 7) * 65 + n]);
            *(uint4*)(w.dst + (size_t)drow * w.ldK + w.kt * 64 + kc * 8) = o; }
        __syncthreads();
        if (nit >= hi) break;
        it = nit; w = wn;
    }
}

__device__ __forceinline__ void phase_norm1(ParamsC p, int l) {
    const int tid = ltid(), lane = tid & 63, wid = tid >> 6;
    const int ntok = (l == DEPTH) ? T_LAT : T_ALL;
    for (int t = lbid() * 8 + wid; t < ntok; t += gridDim.x * 8) {
        const int v = tok_variant(t);
        float4 xv[4];
        if (l == 0) {
            const float* src = t < T_LAT ? p->x + (size_t)t * 1024 : p->ctx + (size_t)(t - T_LAT) * 1024;
#pragma unroll
            for (int i = 0; i < 4; ++i) xv[i] = *(const float4*)(src + i * 256 + lane * 4);
        } else {
            const bf16_t* src = p->xs + (size_t)t * 1024;
#pragma unroll
            for (int i = 0; i < 4; ++i) xv[i] = load4bf(src + i * 256 + lane * 4);
            const bool had_moe = (l - 1 < DEPTH - 1) || t < T_LAT;
            if (had_moe) {
                const int s0 = p->slot[t * 2], s1 = p->slot[t * 2 + 1]; const float w0 = p->ewt[t * 2], w1 = p->ewt[t * 2 + 1];
                const float* gt = p->modv + (size_t)((l - 1) * 5 + v) * 6144 + 5120;
#pragma unroll
                for (int i = 0; i < 4; ++i) { const int c = i * 256 + lane * 4;
                    const uint2 y0 = *(const uint2*)(p->Y + (size_t)s0 * 1024 + c), y1 = *(const uint2*)(p->Y + (size_t)s1 * 1024 + c);
                    const float4 g = *(const float4*)(gt + c);
                    xv[i].x += g.x * (w0 * bf2f((bf16_t)(y0.x & 0xffff)) + w1 * bf2f((bf16_t)(y1.x & 0xffff)));
                    xv[i].y += g.y * (w0 * bf2f((bf16_t)(y0.x >> 16)) + w1 * bf2f((bf16_t)(y1.x >> 16)));
                    xv[i].z += g.z * (w0 * bf2f((bf16_t)(y0.y & 0xffff)) + w1 * bf2f((bf16_t)(y1.y & 0xffff)));
                    xv[i].w += g.w * (w0 * bf2f((bf16_t)(y0.y >> 16)) + w1 * bf2f((bf16_t)(y1.y >> 16))); }
            }
        }
        float ss = 0.f;
#pragma unroll
        for (int i = 0; i < 4; ++i) ss += xv[i].x * xv[i].x + xv[i].y * xv[i].y + xv[i].z * xv[i].z + xv[i].w * xv[i].w;
        ss = wave_sum(ss);
        const float rstd = rsqrtf(ss * (1.0f / 1024.0f) + 1e-6f);
        if (l == DEPTH) {
#pragma unroll
            for (int i = 0; i < 4; ++i) { const int c = i * 256 + lane * 4; const float4 g = *(const float4*)(p->g_final + c);
                float4 o; o.x = xv[i].x * rstd * g.x; o.y = xv[i].y * rstd * g.y; o.z = xv[i].z * rstd * g.z; o.w = xv[i].w * rstd * g.w;
                *(float4*)(p->out + (size_t)t * 1024 + c) = o; }
        } else {
            const float* mv = p->modv + (size_t)(l * 5 + v) * 6144;
#pragma unroll
            for (int i = 0; i < 4; ++i) { const int c = i * 256 + lane * 4;
                { uint2 xo; xo.x = pack2(xv[i].x, xv[i].y); xo.y = pack2(xv[i].z, xv[i].w); *(uint2*)(p->xs + (size_t)t * 1024 + c) = xo; }
                const float4 g = *(const float4*)(p->g_attn + l * 1024 + c), sh = *(const float4*)(mv + c), sc = *(const float4*)(mv + 1024 + c);
                uint2 o; o.x = pack2(xv[i].x * rstd * g.x * (1.f + sc.x) + sh.x, xv[i].y * rstd * g.y * (1.f + sc.y) + sh.y);
                o.y = pack2(xv[i].z * rstd * g.z * (1.f + sc.z) + sh.z, xv[i].w * rstd * g.w * (1.f + sc.w) + sh.w);
                *(uint2*)(p->h + (size_t)t * 1024 + c) = o; }
        }
    }
}

#define SG_STRIDE 144
#define SG_BOFF (128 * SG_STRIDE)
struct RowsLinear { const bf16_t* base; size_t ld; __device__ __forceinline__ const bf16_t* operator()(int r) const { return base + (size_t)r * ld; } };
template <class ARow>
__device__ __forceinline__ void gemm_core(unsigned char* smem, const ARow& arow, const bf16_t* Bt, size_t ldb, int k0, int k1, f32x4 (&acc)[2][4]) {
    const int tid = ltid(), lane = tid & 63, wid = tid >> 6, wm = wid >> 1, wn = wid & 1;
    const int row0 = tid >> 3, kc = tid & 7;
    const bf16_t* pa0 = arow(row0) + kc * 8; const bf16_t* pa1 = arow(row0 + 64) + kc * 8;
    const bf16_t* pb0 = Bt + (size_t)row0 * ldb + kc * 8; const bf16_t* pb1 = Bt + (size_t)(row0 + 64) * ldb + kc * 8;
    const int soff0 = row0 * SG_STRIDE + kc * 16, soff1 = soff0 + 64 * SG_STRIDE;
    uint4 ra0 = *(const uint4*)(pa0 + k0), ra1 = *(const uint4*)(pa1 + k0), rb0 = *(const uint4*)(pb0 + k0), rb1 = *(const uint4*)(pb1 + k0);
    const int fa = (wm * 32 + (lane & 15)) * SG_STRIDE + (lane >> 4) * 16, fb = SG_BOFF + (wn * 64 + (lane & 15)) * SG_STRIDE + (lane >> 4) * 16;
    for (int k = k0; k < k1; k += 64) {
        __syncthreads();
        *(uint4*)(smem + soff0) = ra0; *(uint4*)(smem + soff1) = ra1; *(uint4*)(smem + SG_BOFF + soff0) = rb0; *(uint4*)(smem + SG_BOFF + soff1) = rb1;
        __syncthreads();
        if (k + 64 < k1) { ra0 = *(const uint4*)(pa0 + k + 64); ra1 = *(const uint4*)(pa1 + k + 64); rb0 = *(const uint4*)(pb0 + k + 64); rb1 = *(const uint4*)(pb1 + k + 64); }
#pragma unroll
        for (int ks = 0; ks < 2; ++ks) {
            const bf16x8 af0 = *(const bf16x8*)(smem + fa + ks * 64), af1 = *(const bf16x8*)(smem + fa + 16 * SG_STRIDE + ks * 64);
            const bf16x8 b0 = *(const bf16x8*)(smem + fb + ks * 64), b1 = *(const bf16x8*)(smem + fb + 16 * SG_STRIDE + ks * 64);
            const bf16x8 b2 = *(const bf16x8*)(smem + fb + 32 * SG_STRIDE + ks * 64), b3 = *(const bf16x8*)(smem + fb + 48 * SG_STRIDE + ks * 64);
            acc[0][0] = __builtin_amdgcn_mfma_f32_16x16x32_bf16(b0, af0, acc[0][0], 0, 0, 0); acc[0][1] = __builtin_amdgcn_mfma_f32_16x16x32_bf16(b1, af0, acc[0][1], 0, 0, 0);
            acc[0][2] = __builtin_amdgcn_mfma_f32_16x16x32_bf16(b2, af0, acc[0][2], 0, 0, 0); acc[0][3] = __builtin_amdgcn_mfma_f32_16x16x32_bf16(b3, af0, acc[0][3], 0, 0, 0);
            acc[1][0] = __builtin_amdgcn_mfma_f32_16x16x32_bf16(b0, af1, acc[1][0], 0, 0, 0); acc[1][1] = __builtin_amdgcn_mfma_f32_16x16x32_bf16(b1, af1, acc[1][1], 0, 0, 0);
            acc[1][2] = __builtin_amdgcn_mfma_f32_16x16x32_bf16(b2, af1, acc[1][2], 0, 0, 0); acc[1][3] = __builtin_amdgcn_mfma_f32_16x16x32_bf16(b3, af1, acc[1][3], 0, 0, 0);
        }
    }
}
__device__ __forceinline__ void zero_acc(f32x4 (&acc)[2][4]) {
#pragma unroll
    for (int a = 0; a < 2; ++a)
#pragma unroll
        for (int b = 0; b < 4; ++b) acc[a][b] = (f32x4){0.f, 0.f, 0.f, 0.f};
}
__device__ __forceinline__ void store4bf(bf16_t* dst, f32x4 v) { uint2 o; o.x = pack2(v[0], v[1]); o.y = pack2(v[2], v[3]); *(uint2*)dst = o; }


namespace pg8 {
#define PG8_LAS __attribute__((address_space(3)))
typedef unsigned u32x4 __attribute__((ext_vector_type(4)));
constexpr int BM = 256, BK = 64, HALF = 128, HTB = HALF * BK * 2, STAGE_BYTES = 8 * HTB, NXCD = 8, WGM = 8;
__host__ __device__ __forceinline__ int lds_byte(int r, int c) { const int st = (r >> 4) * 2 + (c >> 5), rr = r & 15, cc = c & 31, ob = rr * 64 + cc * 2; return st * 1024 + (ob ^ (((ob >> 9) & 1) << 5)); }
__host__ __device__ __forceinline__ void stage_rc(int b, int& R, int& C) { const int st = b / 1024, sb = b % 1024, swz = sb ^ (((sb >> 9) & 1) << 5); R = (st >> 1) * 16 + swz / 64; C = (st & 1) * 32 + (swz % 64) / 2; }
__host__ __device__ __forceinline__ int perm32(int rho) { const int n = rho >> 4, i = rho & 15; return 8 * (i >> 2) + 4 * n + (i & 3); }
struct Unit { int pm, pn; };
struct Gemm { const bf16_t* A; const bf16_t* Bt; int M, N, K; const int* rowmap; };
struct StaticOrder {
    int nM, nN, nwg, G, c;
    __device__ void init(int M, int N, int G_, int c_) { nM = M / BM; nN = N / BM; nwg = nM * nN; G = G_; c = c_; }
    __device__ bool next(int i, Unit& u) const {
        const long L = (long)i * G + c; if (L >= nwg) return false;
        int wgid = (int)L; { const int q = nwg / NXCD, r = nwg % NXCD, xcd = wgid % NXCD, off = wgid / NXCD; wgid = (xcd < r ? xcd * (q + 1) : r * (q + 1) + (xcd - r) * q) + off; }
        const int nig = WGM * nN, gid = wgid / nig, fm = gid * WGM, gsz = (nM - fm) < WGM ? (nM - fm) : WGM;
        u.pm = fm + ((wgid % nig) % gsz); u.pn = (wgid % nig) / gsz; return true;
    }
    __device__ __forceinline__ void a_ready(const Unit&) const {}
    __device__ __forceinline__ void done(const Unit&) const {}
};
template <int NT> struct GroupedOrder {
    const int* blk_e; int nunits, G, c;
    __device__ bool next(int i, Unit& u) const { const long L = (long)i * G + c; if (L >= nunits) return false; const int rb = (int)L / NT; u.pm = rb; u.pn = blk_e[rb] * NT + (int)L % NT; return true; }
    __device__ __forceinline__ void a_ready(const Unit&) const {}
    __device__ __forceinline__ void done(const Unit&) const {}
};
template <class Epi, class Sched, bool ALIGN_EPI = false, bool SP2 = false, bool GATHER = false>
__device__ __forceinline__ void gemm_phase(PG8_LAS unsigned char* lds, const Gemm g, const Sched& S, const Epi& E) {
    const int tid = ltid(), wid = __builtin_amdgcn_readfirstlane(tid >> 6), lane = tid & 63, wr = wid >> 2, wc = wid & 3, fr = lane & 15, fq = lane >> 4;
    int K = g.K; asm volatile("" : "+s"(K)); const int nt = K / BK;
    unsigned voffA[2], voffB[2];
#pragma unroll
    for (int i = 0; i < 2; ++i) { int R, C; stage_rc(tid * 16 + i * 8192, R, C); const int Rb = Epi::PERM ? ((R & ~31) + perm32(R & 31)) : R;
        voffA[i] = (unsigned)(R * K + C) * 2u; voffB[i] = (unsigned)(Rb * K + C) * 2u; }
    const size_t kstep = (size_t)(BK * 2);
    const size_t hstep = (size_t)HALF * K * 2;
    const size_t tstep = 2 * hstep;
    const unsigned ldsw = (unsigned)wid * 1024u;
    const int aoff = lds_byte(wr * 64 + fr, fq * 8), boff = lds_byte(wc * 32 + fr, fq * 8);
#define PG8_SA(b, h) (((b) * 2 + (h)) * HTB)
#define PG8_SB(b, h) ((4 + (b) * 2 + (h)) * HTB)
#define PG8_STAGE(bufoff, gbase, voff) do { _Pragma("unroll") for (int _i = 0; _i < 2; ++_i) \
        __builtin_amdgcn_global_load_lds((const unsigned*)((const char*)(gbase) + (voff)[_i]), (PG8_LAS unsigned*)(lds + (bufoff) + ldsw + _i * 8192), 16, 0, 0); } while (0)
#define PG8_STAGE_A(bufoff, gptr, hf) do { if constexpr (GATHER) { _Pragma("unroll") for (int _i = 0; _i < 2; ++_i) \
        __builtin_amdgcn_global_load_lds((const unsigned*)((const char*)(gptr) + gC[hf][_i]), (PG8_LAS unsigned*)(lds + (bufoff) + ldsw + _i * 8192), 16, 0, 0); } \
        else { PG8_STAGE(bufoff, (gptr) + (hf) * hstep, voffA); } } while (0)
#define PG8_LOAD_GOFF(pm_) do { _Pragma("unroll") for (int _h = 0; _h < 2; ++_h) _Pragma("unroll") for (int _i = 0; _i < 2; ++_i) { int R_, C_; stage_rc(tid * 16 + _i * 8192, R_, C_); \
        gC[_h][_i] = (unsigned)(g.rowmap[(pm_) * 256 + _h * 128 + R_] * K + C_) * 2u; } } while (0)
#define PG8_LDA(dst, b, h) do { _Pragma("unroll") for (int m = 0; m < 4; ++m) _Pragma("unroll") for (int k = 0; k < 2; ++k) dst[m][k] = *(const PG8_LAS bf16x8*)(lds + PG8_SA(b, h) + aoff + m * 2048 + k * 1024); } while (0)
#define PG8_LDB(dst, b, h) do { _Pragma("unroll") for (int n = 0; n < 2; ++n) _Pragma("unroll") for (int k = 0; k < 2; ++k) dst[n][k] = *(const PG8_LAS bf16x8*)(lds + PG8_SB(b, h) + boff + n * 2048 + k * 1024); } while (0)
#define PG8_MMA(ai, bj, At, Bt) do { __builtin_amdgcn_s_setprio(1); _Pragma("unroll") for (int m = 0; m < 4; ++m) _Pragma("unroll") for (int n = 0; n < 2; ++n) _Pragma("unroll") for (int k = 0; k < 2; ++k) \
        acc[ai][bj][m][n] = __builtin_amdgcn_mfma_f32_16x16x32_bf16(Bt[n][k], At[m][k], acc[ai][bj][m][n], 0, 0, 0); __builtin_amdgcn_s_setprio(0); } while (0)
#define PG8_WAIT_V(n) asm volatile("s_waitcnt vmcnt(" #n ")" ::: "memory")
#define PG8_WAIT_L(n) asm volatile("s_waitcnt lgkmcnt(" #n ")" ::: "memory")
#define PG8_BAR __builtin_amdgcn_s_barrier()
#define PG8_SCHED __builtin_amdgcn_sched_barrier(0)
    Unit cur, nxt; int ui = 0;
    if (!S.next(0, cur)) return;
    f32x4 acc[2][2][4][2];
#pragma unroll
    for (int a = 0; a < 2; ++a)
#pragma unroll
        for (int b = 0; b < 2; ++b)
#pragma unroll
            for (int m = 0; m < 4; ++m)
#pragma unroll
                for (int n = 0; n < 2; ++n) acc[a][b][m][n] = (f32x4){0.f, 0.f, 0.f, 0.f};
    bf16x8 At[4][2], B0[2][2], B1[2][2];
    const char* cA = (const char*)g.A + (GATHER ? (size_t)0 : (size_t)cur.pm * tstep); const char* cB = (const char*)g.Bt + (size_t)cur.pn * tstep;
    unsigned gC[2][2] = {{0u, 0u}, {0u, 0u}};
    S.a_ready(cur);
    if constexpr (GATHER) PG8_LOAD_GOFF(cur.pm);
    if constexpr (SP2) {
        PG8_STAGE(PG8_SB(0, 0), cB, voffB); PG8_STAGE(PG8_SB(0, 1), cB + hstep, voffB); PG8_STAGE_A(PG8_SA(0, 0), cA, 0); PG8_STAGE_A(PG8_SA(0, 1), cA, 1);
        if (wr == 1) PG8_BAR;
        PG8_WAIT_V(2); PG8_BAR;
        PG8_STAGE(PG8_SB(1, 0), cB + kstep, voffB); PG8_STAGE_A(PG8_SA(1, 0), cA + kstep, 0); PG8_STAGE(PG8_SB(1, 1), cB + hstep + kstep, voffB);
        PG8_WAIT_V(6); PG8_BAR;
    } else {
        PG8_STAGE(PG8_SB(0, 0), cB, voffB); PG8_STAGE_A(PG8_SA(0, 0), cA, 0); PG8_STAGE(PG8_SB(0, 1), cB + hstep, voffB); PG8_STAGE_A(PG8_SA(0, 1), cA, 1);
        if (wr == 1) PG8_BAR;
        PG8_WAIT_V(4); PG8_BAR;
        PG8_STAGE(PG8_SB(1, 0), cB + kstep, voffB); PG8_STAGE_A(PG8_SA(1, 0), cA + kstep, 0); PG8_STAGE(PG8_SB(1, 1), cB + hstep + kstep, voffB);
        PG8_WAIT_V(6); PG8_BAR;
    }
    for (;;) {
        const bool has_next = S.next(ui + 1, nxt);
        const char* nA = (has_next && !GATHER) ? (const char*)g.A + (size_t)nxt.pm * tstep : cA; const char* nB = has_next ? (const char*)g.Bt + (size_t)nxt.pn * tstep : cB;
        for (int t = 0; t < nt; t += 2) {
            const bool last = (t == nt - 2);
            const char* a1 = cA + (size_t)(t + 1) * kstep;
            const char* a2 = last ? nA : cA + (size_t)(t + 2) * kstep; const char* b2 = last ? nB : cB + (size_t)(t + 2) * kstep;
            const char* a3 = a2 + kstep; const char* b3 = b2 + kstep;
            if (last && has_next) S.a_ready(nxt);
            if constexpr (SP2) {
            PG8_LDB(B0, 0, 0); PG8_LDB(B1, 0, 1); PG8_SCHED; PG8_LDA(At, 0, 0); PG8_STAGE_A(PG8_SA(1, 1), a1, 1); if constexpr (GATHER) { if (last && has_next) PG8_LOAD_GOFF(nxt.pm); }
            PG8_WAIT_V(8); PG8_WAIT_L(0); PG8_BAR; PG8_MMA(0, 0, At, B0); PG8_MMA(0, 1, At, B1); PG8_BAR; PG8_SCHED;
            PG8_LDA(At, 0, 1); PG8_STAGE(PG8_SB(0, 0), b2, voffB); PG8_STAGE(PG8_SB(0, 1), b2 + hstep, voffB); PG8_STAGE_A(PG8_SA(0, 0), a2, 0);
            PG8_WAIT_V(8); PG8_WAIT_L(0); PG8_BAR; PG8_MMA(1, 0, At, B0); PG8_MMA(1, 1, At, B1); PG8_BAR; PG8_SCHED;
            PG8_LDB(B0, 1, 0); PG8_LDB(B1, 1, 1); PG8_SCHED; PG8_LDA(At, 1, 0); PG8_STAGE_A(PG8_SA(0, 1), a2, 1);
            PG8_WAIT_V(8); PG8_WAIT_L(0); PG8_BAR; PG8_MMA(0, 0, At, B0); PG8_MMA(0, 1, At, B1); PG8_BAR; PG8_SCHED;
            PG8_LDA(At, 1, 1); PG8_STAGE(PG8_SB(1, 0), b3, voffB); PG8_STAGE(PG8_SB(1, 1), b3 + hstep, voffB); PG8_STAGE_A(PG8_SA(1, 0), a3, 0);
            PG8_WAIT_V(8); PG8_WAIT_L(0); PG8_BAR; PG8_MMA(1, 0, At, B0); PG8_MMA(1, 1, At, B1); PG8_BAR; PG8_SCHED;
            } else {
            PG8_LDB(B0, 0, 0); PG8_SCHED; PG8_LDA(At, 0, 0); PG8_STAGE_A(PG8_SA(1, 1), a1, 1); if constexpr (GATHER) { if (last && has_next) PG8_LOAD_GOFF(nxt.pm); }
            PG8_WAIT_L(8); PG8_BAR; PG8_WAIT_L(0); PG8_MMA(0, 0, At, B0); PG8_BAR; PG8_SCHED;
            PG8_LDB(B1, 0, 1); PG8_STAGE(PG8_SB(0, 0), b2, voffB);
            PG8_BAR; PG8_WAIT_L(0); PG8_MMA(0, 1, At, B1); PG8_BAR;
            PG8_LDA(At, 0, 1); PG8_STAGE_A(PG8_SA(0, 0), a2, 0);
            PG8_BAR; PG8_WAIT_L(0); PG8_MMA(1, 0, At, B0); PG8_BAR; PG8_SCHED;
            PG8_STAGE(PG8_SB(0, 1), b2 + hstep, voffB);
            PG8_WAIT_V(6); PG8_BAR; PG8_MMA(1, 1, At, B1); PG8_BAR;
            PG8_LDB(B0, 1, 0); PG8_SCHED; PG8_LDA(At, 1, 0); PG8_STAGE_A(PG8_SA(0, 1), a2, 1);
            PG8_WAIT_L(8); PG8_BAR; PG8_WAIT_L(0); PG8_MMA(0, 0, At, B0); PG8_BAR; PG8_SCHED;
            PG8_LDB(B1, 1, 1); PG8_STAGE(PG8_SB(1, 0), b3, voffB);
            PG8_BAR; PG8_WAIT_L(0); PG8_MMA(0, 1, At, B1); PG8_BAR;
            PG8_LDA(At, 1, 1); PG8_STAGE_A(PG8_SA(1, 0), a3, 0);
            PG8_BAR; PG8_WAIT_L(0); PG8_MMA(1, 0, At, B0); PG8_BAR; PG8_SCHED;
            PG8_STAGE(PG8_SB(1, 1), b3 + hstep, voffB);
            PG8_WAIT_V(6); PG8_BAR; PG8_MMA(1, 1, At, B1); PG8_BAR;
            }
            if constexpr (Epi::HOOK) { if (t == 2 || t == 8) E.hook(acc, cur, t, wr, wc, fr, fq); }
        }
        if constexpr (ALIGN_EPI) { if (wr == 0) PG8_BAR; }
        if constexpr (!Epi::AFTER_DRAIN) { E(acc, cur, wr, wc, fr, fq); S.done(cur); }
        if (!has_next) break;
#pragma unroll
        for (int a = 0; a < 2; ++a)
#pragma unroll
            for (int b = 0; b < 2; ++b)
#pragma unroll
                for (int m = 0; m < 4; ++m)
#pragma unroll
                    for (int n = 0; n < 2; ++n) acc[a][b][m][n] = (f32x4){0.f, 0.f, 0.f, 0.f};
        cur = nxt; cA = nA; cB = nB; ++ui;
        if constexpr (ALIGN_EPI) { if (wr == 1) PG8_BAR; }
    }
    PG8_WAIT_V(0);
    if constexpr (!ALIGN_EPI) { if (wr == 0) PG8_BAR; }
    PG8_BAR;
    if constexpr (Epi::AFTER_DRAIN) { E.fused(acc, cur, wr, wc, fr, fq, lds, wid, lane); S.done(cur); }
#undef PG8_SA
#undef PG8_SB
#undef PG8_STAGE
#undef PG8_LDA
#undef PG8_STAGE_A
#undef PG8_LOAD_GOFF
#undef PG8_LDB
#undef PG8_MMA
#undef PG8_WAIT_V
#undef PG8_WAIT_L
#undef PG8_BAR
#undef PG8_SCHED
}

}
__device__ __forceinline__ pg8::u32x4 pack8(const f32x4& a, const f32x4& b) { pg8::u32x4 w; w.x = pack2(a[0], a[1]); w.y = pack2(a[2], a[3]); w.z = pack2(b[0], b[1]); w.w = pack2(b[2], b[3]); return w; }
__device__ __forceinline__ void unpack8(const pg8::u32x4& w, f32x4& a, f32x4& b) {
    a[0] = __uint_as_float(w.x << 16); a[1] = __uint_as_float(w.x & 0xffff0000u); a[2] = __uint_as_float(w.y << 16); a[3] = __uint_as_float(w.y & 0xffff0000u);
    b[0] = __uint_as_float(w.z << 16); b[1] = __uint_as_float(w.z & 0xffff0000u); b[2] = __uint_as_float(w.w << 16); b[3] = __uint_as_float(w.w & 0xffff0000u); }


__device__ __forceinline__ void phase_gemm_in(ParamsC p, int l, unsigned char* smem) {
    const int tid = ltid(), lane = tid & 63, wid = tid >> 6, wm = wid >> 1, wn = wid & 1, q4 = (lane >> 4) * 4;
    const int nM = T_ALL / 128, nN = IN_COLS / 128;
    for (int tile = lbid(); tile < nM * nN; tile += gridDim.x) {
        const int tm = tile / nN, tn = tile % nN, m0 = tm * 128, n0 = tn * 128;
        f32x4 acc[2][4]; zero_acc(acc);
        RowsLinear ar{p->h + (size_t)m0 * 1024, 1024};
        gemm_core(smem, ar, p->wt_in + (size_t)n0 * 1024, 1024, 0, 1024, acc);
        const int cb = n0 + wn * 64;
#pragma unroll
        for (int mi = 0; mi < 2; ++mi) {
            const int t = m0 + wm * 32 + mi * 16 + (lane & 15);
            f32x4 v0 = acc[mi][0], v1 = acc[mi][1], v2 = acc[mi][2], v3 = acc[mi][3];
            if (cb >= 2560) {
                bf16_t* dst = p->uG + (size_t)t * UG_LD + (cb - 2560) + q4;
#pragma unroll
                for (int e = 0; e < 4; ++e) { v0[e] = 1.f / (1.f + __expf(-v0[e])); v1[e] = 1.f / (1.f + __expf(-v1[e])); v2[e] = 1.f / (1.f + __expf(-v2[e])); v3[e] = 1.f / (1.f + __expf(-v3[e])); }
                store4bf(dst, v0); store4bf(dst + 16, v1); store4bf(dst + 32, v2); store4bf(dst + 48, v3);
            } else {
                const bool isq = (cb >= 768 && cb < 1152) || (cb >= 1920 && cb < 2304);
                const bool rope = (cb >= 1920 && cb < 2432) && (t < T_LAT);
                if (rope) { const int pos = t & 8191, r = pos >> 6, cc = pos & 63;
#pragma unroll
                    for (int e = 0; e < 4; ++e) {
                        const float2 csr = *(const float2*)(p->ropet + (r * 16 + q4 + e) * 2), csc = *(const float2*)(p->ropet + (cc * 16 + q4 + e) * 2);
                        const float a1 = v0[e], a2 = v1[e]; v0[e] = a1 * csr.x - a2 * csr.y; v1[e] = a1 * csr.y + a2 * csr.x;
                        const float b1 = v2[e], b2 = v3[e]; v2[e] = b1 * csc.x - b2 * csc.y; v3[e] = b1 * csc.y + b2 * csc.x; } }
                if (isq) { v0 = v0 * 0.125f; v1 = v1 * 0.125f; v2 = v2 * 0.125f; v3 = v3 * 0.125f; }
                bf16_t* dst = p->uA + (size_t)t * UA_LD + cb + q4;
                store4bf(dst, v0); store4bf(dst + 16, v1); store4bf(dst + 32, v2); store4bf(dst + 48, v3);
            }
        }
    }
}

struct KmNA { int b, r, c, rs, cs; const float* rpb;
    __device__ __forceinline__ int tok(int kk) const { if (kk < 128) return b * SEQ + (rs + (kk >> 4)) * 64 + cs + (kk & 15); return T_LAT + b * CTXL + (kk - 128); }
    __device__ __forceinline__ float bias(int kk) const { if (kk < 128) return rpb[(rs + (kk >> 4) - r + 7) * 31 + (cs + (kk & 15) - c + 15)]; return 0.f; } };
struct KmSWA { int b, i;
    __device__ __forceinline__ int tok(int kk) const { if (kk < 257) { const int j = i - 128 + kk; return (j >= 0 && j < SEQ) ? b * SEQ + j : -1; } if (kk < 513) return T_LAT + b * CTXL + (kk - 257); return -1; }
    __device__ __forceinline__ float bias(int) const { return 0.f; } };
struct KmCtx { int b;
    __device__ __forceinline__ int tok(int kk) const { return T_LAT + b * CTXL + kk; }
    __device__ __forceinline__ float bias(int) const { return 0.f; } };

template <int NI, class KM>
__device__ __forceinline__ void attn_item(const bf16_t* uA, int tq, int qcol, int kcol, int vcol, const KM& km, bool has_sink, float sink, bf16_t* outp, int lane) {
    float q[64];
    {   const uint4* qp = (const uint4*)(uA + (size_t)tq * UA_LD + qcol);
#pragma unroll
        for (int c = 0; c < 8; ++c) { const uint4 v = qp[c];
            q[c * 8 + 0] = bf2f((bf16_t)(v.x & 0xffff)); q[c * 8 + 1] = bf2f((bf16_t)(v.x >> 16)); q[c * 8 + 2] = bf2f((bf16_t)(v.y & 0xffff)); q[c * 8 + 3] = bf2f((bf16_t)(v.y >> 16));
            q[c * 8 + 4] = bf2f((bf16_t)(v.z & 0xffff)); q[c * 8 + 5] = bf2f((bf16_t)(v.z >> 16)); q[c * 8 + 6] = bf2f((bf16_t)(v.w & 0xffff)); q[c * 8 + 7] = bf2f((bf16_t)(v.w >> 16)); } }
    float s[NI]; float mx = -3.0e38f;
#pragma unroll
    for (int i = 0; i < NI; ++i) { const int kk = i * 64 + lane; const int tk = km.tok(kk);
        float d = -3.0e38f;
        if (tk >= 0) { const uint4* kp = (const uint4*)(uA + (size_t)tk * UA_LD + kcol); d = 0.f;
#pragma unroll
            for (int c = 0; c < 8; ++c) { const uint4 v = kp[c];
                d += q[c * 8 + 0] * bf2f((bf16_t)(v.x & 0xffff)) + q[c * 8 + 1] * bf2f((bf16_t)(v.x >> 16)) + q[c * 8 + 2] * bf2f((bf16_t)(v.y & 0xffff)) + q[c * 8 + 3] * bf2f((bf16_t)(v.y >> 16))
                   + q[c * 8 + 4] * bf2f((bf16_t)(v.z & 0xffff)) + q[c * 8 + 5] * bf2f((bf16_t)(v.z >> 16)) + q[c * 8 + 6] * bf2f((bf16_t)(v.w & 0xffff)) + q[c * 8 + 7] * bf2f((bf16_t)(v.w >> 16)); }
            d += km.bias(kk); }
        s[i] = d; mx = fmaxf(mx, d); }
    mx = wave_max(mx); if (has_sink) mx = fmaxf(mx, sink);
    float sum = 0.f;
#pragma unroll
    for (int i = 0; i < NI; ++i) { const float pv = s[i] > -1.0e38f ? __expf(s[i] - mx) : 0.f; s[i] = pv; sum += pv; }
    sum = wave_sum(sum); if (has_sink) sum += __expf(sink - mx);
    const float inv = 1.0f / sum;
    float o = 0.f;
#pragma unroll
    for (int i = 0; i < NI; ++i) {
        for (int sl = 0; sl < 64; ++sl) { const int tk = km.tok(i * 64 + sl); const float pv = __shfl(s[i], sl);
            if (tk >= 0) o += pv * bf2f(uA[(size_t)tk * UA_LD + vcol + lane]); } }
    outp[lane] = f2bf(o * inv);
}

__device__ __forceinline__ void phase_mix(ParamsC p, int l) {
    const int tid = ltid(), lane = tid & 63, wid = tid >> 6;
    const bool need_ctx = l < DEPTH - 1;
    {   const int ntok = need_ctx ? T_ALL : T_LAT; const float* cw = p->conv_w + l * 3 * 256;
        for (int idx = lbid() * NTHR + tid; idx < ntok * 256; idx += gridDim.x * NTHR) { const int t = idx >> 8, c = idx & 255;
            int pos, len; if (t < T_LAT) { pos = t & 8191; len = SEQ; } else { pos = (t - T_LAT) & 255; len = CTXL; }
            const bf16_t* u = p->uA + (size_t)t * UA_LD + c;
            const float z1 = bf2f(u[512]) * bf2f(u[0]);
            const float z0 = pos > 0 ? bf2f(u[512 - UA_LD]) * bf2f(u[-UA_LD]) : 0.f;
            const float z2 = pos + 1 < len ? bf2f(u[512 + UA_LD]) * bf2f(u[UA_LD]) : 0.f;
            const float y = bf2f(u[256]) * (z0 * cw[c] + z1 * cw[256 + c] + z2 * cw[512 + c]);
            p->ycat[(size_t)t * 1024 + c] = f2bf(y); } }
    const int n_lat = T_LAT * 12, n_all = n_lat + (need_ctx ? T_CTX * 12 : 0);
    for (int it = lbid() * 8 + wid; it < n_all; it += gridDim.x * 8) {
        if (it < n_lat) { const int t = it / 12, hh = it % 12; const int b = t >> 13, pos = t & 8191;
            if (hh < 6) { KmNA km; km.b = b; km.r = pos >> 6; km.c = pos & 63; km.rs = min(max(km.r - 4, 0), 120); km.cs = min(max(km.c - 8, 0), 48); km.rpb = p->rpb + ((size_t)l * 6 + hh) * 15 * 31;
                attn_item<6>(p->uA, t, 768 + hh * 64, 1152 + hh * 64, 1536 + hh * 64, km, false, 0.f, p->ycat + (size_t)t * 1024 + 256 + hh * 64, lane); }
            else { const int hq = hh - 6, kh = hq / 3; KmSWA km; km.b = b; km.i = pos;
                attn_item<9>(p->uA, t, 1920 + hq * 64, 2304 + kh * 64, 2432 + kh * 64, km, true, p->sinks[l * 6 + hq], p->ycat + (size_t)t * 1024 + 640 + hq * 64, lane); }
        } else { const int it2 = it - n_lat; const int tc = it2 / 12, hh = it2 % 12; const int t = T_LAT + tc; KmCtx km; km.b = tc >> 8;
            if (hh < 6) attn_item<4>(p->uA, t, 768 + hh * 64, 1152 + hh * 64, 1536 + hh * 64, km, false, 0.f, p->ycat + (size_t)t * 1024 + 256 + hh * 64, lane);
            else { const int hq = hh - 6, kh = hq / 3; attn_item<4>(p->uA, t, 1920 + hq * 64, 2304 + kh * 64, 2432 + kh * 64, km, true, p->sinks[l * 6 + hq], p->ycat + (size_t)t * 1024 + 640 + hq * 64, lane); }
        }
    }
}


typedef float f32x16 __attribute__((ext_vector_type(16)));
typedef short s16x4 __attribute__((ext_vector_type(4)));
#define AT_STRIDE 144
#define AT_KBUF(b) ((b) * 18432)
#define AT_VBUF(b) (36864 + (b) * 18432)
#define LOG2E 1.4426950408889634f
#define AT_NEG (-1.0e30f)
#define AT_THR 16.0f

__device__ __forceinline__ void attn_tile(const unsigned char* kt, const unsigned char* vlane, const bf16x8 (&qf)[4], f32x16 (&oacc)[2], float& m, float& lsum, int mk, int lane) {
    const int n = lane & 31, hh = lane >> 5;
    f32x16 sc;
#pragma unroll
    for (int r = 0; r < 16; ++r) sc[r] = 0.f;
#pragma unroll
    for (int sp = 0; sp < 4; ++sp) { const bf16x8 kf = *(const bf16x8*)(kt + n * AT_STRIDE + sp * 32 + hh * 16); sc = __builtin_amdgcn_mfma_f32_32x32x16_bf16(kf, qf[sp], sc, 0, 0, 0); }
    if (mk != 0) {
#pragma unroll
        for (int r = 0; r < 16; ++r) { const int i = (r & 3) + 8 * (r >> 2) + 4 * hh; const bool ok = (mk == 2) ? (i >= n) : (i <= n); sc[r] = ok ? sc[r] : AT_NEG; } }
    float mx = AT_NEG;
#pragma unroll
    for (int r = 0; r < 16; ++r) mx = fmaxf(mx, sc[r]);
    float mn = m;
    if (__any(mx > m + AT_THR)) { mx = fmaxf(mx, __shfl_xor(mx, 32)); mn = fmaxf(m, mx); }
    {   const float alpha = __builtin_amdgcn_exp2f(m - mn); lsum *= alpha; m = mn;
#pragma unroll
        for (int r = 0; r < 16; ++r) { oacc[0][r] *= alpha; oacc[1][r] *= alpha; } }
    float ps = 0.f;
#pragma unroll
    for (int r = 0; r < 16; ++r) { const float pv = __builtin_amdgcn_exp2f(sc[r] - m); sc[r] = pv; ps += pv; }
    lsum += ps;
    bf16x8 pf[2];
#pragma unroll
    for (int s2 = 0; s2 < 2; ++s2) { pg8::u32x4 w; w.x = pack2(sc[s2 * 8 + 0], sc[s2 * 8 + 1]); w.y = pack2(sc[s2 * 8 + 2], sc[s2 * 8 + 3]); w.z = pack2(sc[s2 * 8 + 4], sc[s2 * 8 + 5]); w.w = pack2(sc[s2 * 8 + 6], sc[s2 * 8 + 7]);
        pf[s2] = __builtin_bit_cast(bf16x8, w); }
#pragma unroll
    for (int c = 0; c < 2; ++c)
#pragma unroll
        for (int s2 = 0; s2 < 2; ++s2) {
            const s16x4 v0 = __builtin_amdgcn_ds_read_tr16_b64_v4i16((LAS s16x4*)(vlane + (16 * s2) * AT_STRIDE + 64 * c));
            const s16x4 v1 = __builtin_amdgcn_ds_read_tr16_b64_v4i16((LAS s16x4*)(vlane + (16 * s2 + 8) * AT_STRIDE + 64 * c));
            bf16x8 vf; vf[0] = v0[0]; vf[1] = v0[1]; vf[2] = v0[2]; vf[3] = v0[3]; vf[4] = v1[0]; vf[5] = v1[1]; vf[6] = v1[2]; vf[7] = v1[3];
            oacc[c] = __builtin_amdgcn_mfma_f32_32x32x16_bf16(vf, pf[s2], oacc[c], 0, 0, 0);
        }
}

#define AT_LOAD(...) AT_LOAD_(__VA_ARGS__)
#define AT_STORE(...) AT_STORE_(__VA_ARGS__)
#define AT_LOAD_(K0, V0, K1, V1, tok0) do { const bf16_t* src_ = uA + (size_t)((tok0) + skey) * UA_LD + sch * 8; K0 = *(const uint4*)(src_ + kcol); V0 = *(const uint4*)(src_ + vcol); \
        K1 = *(const uint4*)(src_ + 64 * UA_LD + kcol); V1 = *(const uint4*)(src_ + 64 * UA_LD + vcol); } while (0)
#define AT_STORE_(K0, V0, K1, V1, bb) do { *(uint4*)(smem + AT_KBUF(bb) + soff) = K0; *(uint4*)(smem + AT_VBUF(bb) + soff) = V0; \
        *(uint4*)(smem + AT_KBUF(bb) + soff + 64 * AT_STRIDE) = K1; *(uint4*)(smem + AT_VBUF(bb) + soff + 64 * AT_STRIDE) = V1; } while (0)
#define AT_S0 ak0, av0, ak1, av1
#define AT_S1 bk0, bv0, bk1, bv1
template <int MODE>
__device__ __forceinline__ void attn_unit(ParamsC p, int l, int u, unsigned char* smem) {
    const int tid = ltid(), lane = tid & 63, wid = tid >> 6;
    int b, qcol, kcol, vcol, ocol, qtok; bool has_sink = false; float sinkv = 0.f;
    int nsteps, q0 = 0, jwlo = 0;
    if (MODE == 1) { b = u / 192; const int rem = u % 192, hq = rem / 32, qb = rem % 32, kh = hq / 3; qcol = 1920 + hq * 64; kcol = 2304 + kh * 64; vcol = 2432 + kh * 64; ocol = 640 + hq * 64;
        q0 = qb * 256; jwlo = (q0 == 0) ? 1 : 0; const int jwhi = min(4, (SEQ - q0 + 128) / 128); nsteps = 2 + (jwhi - jwlo);
        qtok = b * SEQ + q0 + 32 * wid; has_sink = true; sinkv = p->sinks[l * 6 + hq];
    } else { b = u / 12; const int hh = u % 12;
        if (hh < 6) { qcol = 768 + hh * 64; kcol = 1152 + hh * 64; vcol = 1536 + hh * 64; ocol = 256 + hh * 64; }
        else { const int hq = hh - 6, kh = hq / 3; qcol = 1920 + hq * 64; kcol = 2304 + kh * 64; vcol = 2432 + kh * 64; ocol = 640 + hq * 64; has_sink = true; sinkv = p->sinks[l * 6 + hq]; }
        nsteps = 2; qtok = T_LAT + b * CTXL + 32 * wid;
    }
    const bf16_t* uA = p->uA;
    bf16x8 qf[4];
    {   const bf16_t* qp = uA + (size_t)(qtok + (lane & 31)) * UA_LD + qcol + (lane >> 5) * 8;
#pragma unroll
        for (int sp = 0; sp < 4; ++sp) qf[sp] = *(const bf16x8*)(qp + sp * 16); }
    f32x16 oacc[2];
#pragma unroll
    for (int r16 = 0; r16 < 16; ++r16) { oacc[0][r16] = 0.f; oacc[1][r16] = 0.f; }
    float m = has_sink ? sinkv * LOG2E : AT_NEG, lsum = (has_sink && lane < 32) ? 1.f : 0.f;
    const int skey = tid >> 3, sch = tid & 7; const int soff = skey * AT_STRIDE + sch * 16;
    auto chunk_tok = [&](int j) -> int { return (j < 2) ? (T_LAT + b * CTXL + 128 * j) : (b * SEQ + q0 - 128 + 128 * (jwlo + (j - 2))); };
    uint4 ak0, av0, ak1, av1, bk0, bv0, bk1, bv1;
    AT_LOAD(AT_S0, chunk_tok(0)); AT_STORE(AT_S0, 0);
    if (1 < nsteps) AT_LOAD(AT_S1, chunk_tok(1));
    if (2 < nsteps) AT_LOAD(AT_S0, chunk_tok(2));
    __syncthreads();
    const int vl_off = (4 * (lane >> 5) + ((lane & 15) >> 2)) * AT_STRIDE + (16 * ((lane >> 4) & 1) + 4 * (lane & 3)) * 2;
    for (int j = 0; j < nsteps; ++j) {
        const int buf = j & 1;
        if (j & 1) { if (j + 1 < nsteps) AT_STORE(AT_S0, 0); if (j + 3 < nsteps) AT_LOAD(AT_S0, chunk_tok(j + 3)); }
        else       { if (j + 1 < nsteps) AT_STORE(AT_S1, 1); if (j + 3 < nsteps) AT_LOAD(AT_S1, chunk_tok(j + 3)); }
        const unsigned char* kb = smem + AT_KBUF(buf); const unsigned char* vb = smem + AT_VBUF(buf) + vl_off;
#pragma unroll 2
        for (int tl = 0; tl < 4; ++tl) {
            bool act = true; int mk = 0;
            if (MODE == 1 && j >= 2) { const int d = (-128 + 128 * (jwlo + (j - 2)) + 32 * tl) - 32 * wid; act = (d >= -128 && d <= 128); mk = (d == -128) ? 2 : ((d == 128) ? 3 : 0); }
            if (act) attn_tile(kb + tl * 32 * AT_STRIDE, vb + tl * 32 * AT_STRIDE, qf, oacc, m, lsum, mk, lane); }
        __syncthreads();
    }
    const float ltot = lsum + __shfl_xor(lsum, 32); const float inv = 1.0f / ltot;
    bf16_t* op = p->ycat + (size_t)(qtok + (lane & 31)) * 1024 + ocol + 4 * (lane >> 5);
#pragma unroll
    for (int cc = 0; cc < 2; ++cc)
#pragma unroll
        for (int g = 0; g < 4; ++g) { f32x4 v; v[0] = oacc[cc][4 * g] * inv; v[1] = oacc[cc][4 * g + 1] * inv; v[2] = oacc[cc][4 * g + 2] * inv; v[3] = oacc[cc][4 * g + 3] * inv;
            store4bf(op + 32 * cc + 8 * g, v); }
}

#define NA_TBL 73728
#define NA_TROW 48
#define NA_TLEAD 16
__device__ __forceinline__ void na_softmax8(f32x4& s0, f32x4& s1, float& m, float& lsum, f32x4 (&oacc)[4], bf16x8& pf) {
    float mx = fmaxf(fmaxf(fmaxf(s0[0], s0[1]), fmaxf(s0[2], s0[3])), fmaxf(fmaxf(s1[0], s1[1]), fmaxf(s1[2], s1[3])));
    float mn = m;
    if (__any(mx > m + AT_THR)) { mx = fmaxf(mx, __shfl_xor(mx, 16)); mx = fmaxf(mx, __shfl_xor(mx, 32)); mn = fmaxf(m, mx); }
    {   const float alpha = __builtin_amdgcn_exp2f(m - mn); lsum *= alpha; m = mn;
#pragma unroll
        for (int db = 0; db < 4; ++db) oacc[db] = oacc[db] * alpha; }
#pragma unroll
    for (int e = 0; e < 4; ++e) { s0[e] = __builtin_amdgcn_exp2f(s0[e] - m); s1[e] = __builtin_amdgcn_exp2f(s1[e] - m); }
    lsum += (s0[0] + s0[1]) + (s0[2] + s0[3]) + (s1[0] + s1[1]) + (s1[2] + s1[3]);
    pg8::u32x4 w; w.x = pack2(s0[0], s0[1]); w.y = pack2(s0[2], s0[3]); w.z = pack2(s1[0], s1[1]); w.w = pack2(s1[2], s1[3]);
    pf = __builtin_bit_cast(bf16x8, w);
}
__device__ __forceinline__ void attn_unit_na(ParamsC p, int l, int u, unsigned char* smem) {
    const int tid = ltid(), lane = tid & 63, wid = tid >> 6, q16 = lane & 15, kg = lane >> 4;
    const int b = u / 192, rem = u % 192, h = rem / 32, rg = rem % 32;
    const int qcol = 768 + h * 64, kcol = 1152 + h * 64, vcol = 1536 + h * 64, ocol = 256 + h * 64;
    const int r = rg * 4 + (wid >> 1), qh = wid & 1, rs = min(max(r - 4, 0), 120);
    const int krlo = min(max(rg * 4 - 4, 0), 120), krhi = min(max(rg * 4 + 3 - 4, 0), 120) + 7, nsteps = 2 + (krhi - krlo + 2) / 2;
    const int qtok = b * SEQ + r * 64 + 32 * qh;
    const bf16_t* uA = p->uA;
    {   float* T = (float*)(smem + NA_TBL); const float* rp = p->rpb + ((size_t)l * 6 + h) * 465;
        for (int i = tid; i < NA_TLEAD + 16 * 15 * NA_TROW; i += NTHR) { float v = AT_NEG;
            if (i >= NA_TLEAD) { const int k = i - NA_TLEAD, j = k % NA_TROW, rr = (k / NA_TROW) % 15, dl = k / (NA_TROW * 15); if (j < 16) v = rp[rr * 31 + j + dl] * LOG2E; }
            T[i] = v; } }
    int kc0[2], tbase[2];
#pragma unroll
    for (int g2 = 0; g2 < 2; ++g2) { const int c = 32 * qh + 16 * g2 + q16, cs = min(max(c - 8, 0), 48), dl = cs - c + 15;
        kc0[g2] = (qh == 0) ? (g2 == 0 ? 0 : 8) : (g2 == 0 ? 24 : 32);
        tbase[g2] = NA_TLEAD + dl * (15 * NA_TROW) + (kc0[g2] - cs) + 4 * kg; }
    bf16x8 qf[2][2];
#pragma unroll
    for (int g2 = 0; g2 < 2; ++g2)
#pragma unroll
        for (int ds = 0; ds < 2; ++ds) qf[g2][ds] = *(const bf16x8*)(uA + (size_t)(qtok + 16 * g2 + q16) * UA_LD + qcol + ds * 32 + kg * 8);
    f32x4 oacc[2][4];
#pragma unroll
    for (int g2 = 0; g2 < 2; ++g2)
#pragma unroll
        for (int db = 0; db < 4; ++db) oacc[g2][db] = (f32x4){0.f, 0.f, 0.f, 0.f};
    float m[2] = {AT_NEG, AT_NEG}, lsum[2] = {0.f, 0.f};
    const int skey = tid >> 3, sch = tid & 7; const int soff = skey * AT_STRIDE + sch * 16;
    auto chunk_tok = [&](int j) -> int { return (j < 2) ? (T_LAT + b * CTXL + 128 * j) : (b * SEQ + (krlo + 2 * (j - 2)) * 64); };
    uint4 ak0, av0, ak1, av1, bk0, bv0, bk1, bv1;
    AT_LOAD(AT_S0, chunk_tok(0)); AT_STORE(AT_S0, 0);
    if (1 < nsteps) AT_LOAD(AT_S1, chunk_tok(1));
    if (2 < nsteps) AT_LOAD(AT_S0, chunk_tok(2));
    __syncthreads();
    const int ka_off = q16 * AT_STRIDE + kg * 16;
    const int va_off = (4 * kg + (q16 >> 2)) * AT_STRIDE + (4 * (q16 & 3)) * 2;
    const float* T = (const float*)(smem + NA_TBL);
    for (int j = 0; j < nsteps; ++j) {
        const int buf = j & 1;
        if (j & 1) { if (j + 1 < nsteps) AT_STORE(AT_S0, 0); if (j + 3 < nsteps) AT_LOAD(AT_S0, chunk_tok(j + 3)); }
        else       { if (j + 1 < nsteps) AT_STORE(AT_S1, 1); if (j + 3 < nsteps) AT_LOAD(AT_S1, chunk_tok(j + 3)); }
        const unsigned char* kb = smem + AT_KBUF(buf); const unsigned char* vb = smem + AT_VBUF(buf);
        if (j < 2) {
#pragma unroll
            for (int tp = 0; tp < 4; ++tp) {
                bf16x8 kf[2][2];
#pragma unroll
                for (int t = 0; t < 2; ++t)
#pragma unroll
                    for (int ds = 0; ds < 2; ++ds) kf[t][ds] = *(const bf16x8*)(kb + (32 * tp + 16 * t) * AT_STRIDE + ka_off + ds * 64);
                bf16x8 pf[2];
#pragma unroll
                for (int g2 = 0; g2 < 2; ++g2) { f32x4 s0 = (f32x4){0.f, 0.f, 0.f, 0.f}, s1 = s0;
                    s0 = __builtin_amdgcn_mfma_f32_16x16x32_bf16(kf[0][0], qf[g2][0], s0, 0, 0, 0); s0 = __builtin_amdgcn_mfma_f32_16x16x32_bf16(kf[0][1], qf[g2][1], s0, 0, 0, 0);
                    s1 = __builtin_amdgcn_mfma_f32_16x16x32_bf16(kf[1][0], qf[g2][0], s1, 0, 0, 0); s1 = __builtin_amdgcn_mfma_f32_16x16x32_bf16(kf[1][1], qf[g2][1], s1, 0, 0, 0);
                    na_softmax8(s0, s1, m[g2], lsum[g2], oacc[g2], pf[g2]); }
#pragma unroll
                for (int db = 0; db < 4; ++db) {
                    const s16x4 v0 = __builtin_amdgcn_ds_read_tr16_b64_v4i16((LAS s16x4*)(vb + (32 * tp) * AT_STRIDE + va_off + db * 32));
                    const s16x4 v1 = __builtin_amdgcn_ds_read_tr16_b64_v4i16((LAS s16x4*)(vb + (32 * tp + 16) * AT_STRIDE + va_off + db * 32));
                    bf16x8 vf; vf[0] = v0[0]; vf[1] = v0[1]; vf[2] = v0[2]; vf[3] = v0[3]; vf[4] = v1[0]; vf[5] = v1[1]; vf[6] = v1[2]; vf[7] = v1[3];
                    oacc[0][db] = __builtin_amdgcn_mfma_f32_16x16x32_bf16(vf, pf[0], oacc[0][db], 0, 0, 0); oacc[1][db] = __builtin_amdgcn_mfma_f32_16x16x32_bf16(vf, pf[1], oacc[1][db], 0, 0, 0); }
            }
        } else {
#pragma unroll
          for (int rr = 0; rr < 2; ++rr) { const int kr = krlo + 2 * (j - 2) + rr;
            if (kr >= rs && kr < rs + 8) { const int trow = (kr - r + 7) * NA_TROW;
#pragma unroll
                for (int g2 = 0; g2 < 2; ++g2) { const unsigned char* kt = kb + (rr * 64 + kc0[g2]) * AT_STRIDE; const unsigned char* vt = vb + (rr * 64 + kc0[g2]) * AT_STRIDE;
                    f32x4 s0 = (f32x4){0.f, 0.f, 0.f, 0.f}, s1 = s0;
#pragma unroll
                    for (int ds = 0; ds < 2; ++ds) { const bf16x8 k0 = *(const bf16x8*)(kt + ka_off + ds * 64), k1 = *(const bf16x8*)(kt + 16 * AT_STRIDE + ka_off + ds * 64);
                        s0 = __builtin_amdgcn_mfma_f32_16x16x32_bf16(k0, qf[g2][ds], s0, 0, 0, 0); s1 = __builtin_amdgcn_mfma_f32_16x16x32_bf16(k1, qf[g2][ds], s1, 0, 0, 0); }
                    const float* tp_ = T + tbase[g2] + trow;
#pragma unroll
                    for (int e = 0; e < 4; ++e) { s0[e] += tp_[e]; s1[e] += tp_[16 + e]; }
                    bf16x8 pf; na_softmax8(s0, s1, m[g2], lsum[g2], oacc[g2], pf);
#pragma unroll
                    for (int db = 0; db < 4; ++db) {
                        const s16x4 v0 = __builtin_amdgcn_ds_read_tr16_b64_v4i16((LAS s16x4*)(vt + va_off + db * 32));
                        const s16x4 v1 = __builtin_amdgcn_ds_read_tr16_b64_v4i16((LAS s16x4*)(vt + 16 * AT_STRIDE + va_off + db * 32));
                        bf16x8 vf; vf[0] = v0[0]; vf[1] = v0[1]; vf[2] = v0[2]; vf[3] = v0[3]; vf[4] = v1[0]; vf[5] = v1[1]; vf[6] = v1[2]; vf[7] = v1[3];
                        oacc[g2][db] = __builtin_amdgcn_mfma_f32_16x16x32_bf16(vf, pf, oacc[g2][db], 0, 0, 0); } }
            } }
        }
        __syncthreads();
    }
#pragma unroll
    for (int g2 = 0; g2 < 2; ++g2) { float lt = lsum[g2]; lt += __shfl_xor(lt, 16); lt += __shfl_xor(lt, 32); const float inv = 1.0f / lt;
        bf16_t* op = p->ycat + (size_t)(qtok + 16 * g2 + q16) * 1024 + ocol + 4 * kg;
#pragma unroll
        for (int db = 0; db < 4; ++db) store4bf(op + 16 * db, oacc[g2][db] * inv); }
}

__device__ __forceinline__ void phase_conv(ParamsC p, int l) {
    const int tid = ltid();
    const bool need_ctx = l < DEPTH - 1;
    {
        const int ntok = need_ctx ? T_ALL : T_LAT; const float* cw = p->conv_w + l * 3 * 256;
        for (int idx = lbid() * NTHR + tid; idx < ntok * 32; idx += gridDim.x * NTHR) { const int t = idx >> 5, c = (idx & 31) * 8;
            int pos, len; if (t < T_LAT) { pos = t & 8191; len = SEQ; } else { pos = (t - T_LAT) & 255; len = CTXL; }
            const bf16_t* u = p->uA + (size_t)t * UA_LD + c;
            const bool hp = pos > 0, hn = pos + 1 < len;
            const pg8::u32x4 zero4 = (pg8::u32x4){0u, 0u, 0u, 0u};
            const pg8::u32x4 h1 = *(const pg8::u32x4*)u, c1 = *(const pg8::u32x4*)(u + 512), b1 = *(const pg8::u32x4*)(u + 256);
            const pg8::u32x4 h0 = hp ? *(const pg8::u32x4*)(u - UA_LD) : zero4, c0 = hp ? *(const pg8::u32x4*)(u + 512 - UA_LD) : zero4;
            const pg8::u32x4 h2 = hn ? *(const pg8::u32x4*)(u + UA_LD) : zero4, c2 = hn ? *(const pg8::u32x4*)(u + 512 + UA_LD) : zero4;
            f32x4 w0a = *(const f32x4*)(cw + c), w0b = *(const f32x4*)(cw + c + 4), w1a = *(const f32x4*)(cw + 256 + c), w1b = *(const f32x4*)(cw + 256 + c + 4), w2a = *(const f32x4*)(cw + 512 + c), w2b = *(const f32x4*)(cw + 512 + c + 4);
            f32x4 ha, hb, ca, cb, ya, yb;
            unpack8(h0, ha, hb); unpack8(c0, ca, cb); ya = ha * ca * w0a; yb = hb * cb * w0b;
            unpack8(h1, ha, hb); unpack8(c1, ca, cb); ya += ha * ca * w1a; yb += hb * cb * w1b;
            unpack8(h2, ha, hb); unpack8(c2, ca, cb); ya += ha * ca * w2a; yb += hb * cb * w2b;
            unpack8(b1, ha, hb); ya = ya * ha; yb = yb * hb;
            *(pg8::u32x4*)(p->ycat + (size_t)t * 1024 + c) = pack8(ya, yb); } }
}
__device__ __forceinline__ void phase_na(ParamsC p, int l, unsigned char* smem) {
    for (int u = lbid(); u < 768; u += gridDim.x) attn_unit_na(p, l, u, smem);
}
__device__ __forceinline__ void phase_swa(ParamsC p, int l, unsigned char* smem) {
    for (int u = lbid(); u < 768; u += gridDim.x) attn_unit<1>(p, l, u, smem);
    if (l < DEPTH - 1) for (int u = lbid(); u < 48; u += gridDim.x) attn_unit<2>(p, l, u, smem);
}

__device__ __forceinline__ void phase_gemm_merge(ParamsC p, int l, unsigned char* smem) {
    const int tid = ltid(), lane = tid & 63, wid = tid >> 6, wm = wid >> 1, wn = wid & 1, q4 = (lane >> 4) * 4;
    const int ntok = (l < DEPTH - 1) ? T_ALL : T_LAT; const int nM = ntok / 128, nN = 8;
    for (int tile = lbid(); tile < nM * nN; tile += gridDim.x) {
        const int tm = tile / nN, tn = tile % nN, m0 = tm * 128, n0 = tn * 128;
        f32x4 macc[2][4]; zero_acc(macc);
        RowsLinear ar{p->ycat + (size_t)m0 * 1024, 1024};
#pragma unroll
        for (int seg = 0; seg < 3; ++seg) {
            const int k0 = seg == 0 ? 0 : (seg == 1 ? 256 : 640), k1 = seg == 0 ? 256 : (seg == 1 ? 640 : 1024);
            f32x4 acc[2][4]; zero_acc(acc);
            gemm_core(smem, ar, p->wt_br + (size_t)n0 * 1024, 1024, k0, k1, acc);
#pragma unroll
            for (int mi = 0; mi < 2; ++mi) { const int t = m0 + wm * 32 + mi * 16 + (lane & 15);
#pragma unroll
                for (int nj = 0; nj < 4; ++nj) { const uint2 g = *(const uint2*)(p->uG + (size_t)t * UG_LD + seg * 1024 + n0 + wn * 64 + nj * 16 + q4);
                    macc[mi][nj][0] += bf2f((bf16_t)(g.x & 0xffff)) * acc[mi][nj][0]; macc[mi][nj][1] += bf2f((bf16_t)(g.x >> 16)) * acc[mi][nj][1];
                    macc[mi][nj][2] += bf2f((bf16_t)(g.y & 0xffff)) * acc[mi][nj][2]; macc[mi][nj][3] += bf2f((bf16_t)(g.y >> 16)) * acc[mi][nj][3]; } }
        }
#pragma unroll
        for (int mi = 0; mi < 2; ++mi) { const int t = m0 + wm * 32 + mi * 16 + (lane & 15);
#pragma unroll
            for (int nj = 0; nj < 4; ++nj) store4bf(p->mbuf + (size_t)t * 1024 + n0 + wn * 64 + nj * 16 + q4, macc[mi][nj]); }
    }
}

__device__ __forceinline__ void phase_gemm_o(ParamsC p, int l, unsigned char* smem) {
    const int tid = ltid(), lane = tid & 63, wid = tid >> 6, wm = wid >> 1, wn = wid & 1, q4 = (lane >> 4) * 4;
    const int ntok = (l < DEPTH - 1) ? T_ALL : T_LAT; const int nM = ntok / 128, nN = 8;
    for (int tile = lbid(); tile < nM * nN; tile += gridDim.x) {
        const int tm = tile / nN, tn = tile % nN, m0 = tm * 128, n0 = tn * 128;
        f32x4 acc[2][4]; zero_acc(acc);
        RowsLinear ar{p->mbuf + (size_t)m0 * 1024, 1024};
        gemm_core(smem, ar, p->wt_o + (size_t)n0 * 1024, 1024, 0, 1024, acc);
#pragma unroll
        for (int mi = 0; mi < 2; ++mi) { const int t = m0 + wm * 32 + mi * 16 + (lane & 15); const float* gt = p->modv + (size_t)(l * 5 + tok_variant(t)) * 6144 + 2048;
#pragma unroll
            for (int nj = 0; nj < 4; ++nj) { const int c = n0 + wn * 64 + nj * 16 + q4; bf16_t* xp = p->xs + (size_t)t * 1024 + c; float4 xv = load4bf(xp); const float4 g = *(const float4*)(gt + c);
                xv.x += g.x * acc[mi][nj][0]; xv.y += g.y * acc[mi][nj][1]; xv.z += g.z * acc[mi][nj][2]; xv.w += g.w * acc[mi][nj][3]; { uint2 xo; xo.x = pack2(xv.x, xv.y); xo.y = pack2(xv.z, xv.w); *(uint2*)xp = xo; } } }
    }
}

#define RT_LD 1028
__device__ __forceinline__ void split8(const float (&x)[8], bf16x8& hi, bf16x8& lo) {
    pg8::u32x4 h, lw; float r[8];
    h.x = pack2(x[0], x[1]); h.y = pack2(x[2], x[3]); h.z = pack2(x[4], x[5]); h.w = pack2(x[6], x[7]);
    r[0] = x[0] - __uint_as_float(h.x << 16); r[1] = x[1] - __uint_as_float(h.x & 0xffff0000u); r[2] = x[2] - __uint_as_float(h.y << 16); r[3] = x[3] - __uint_as_float(h.y & 0xffff0000u);
    r[4] = x[4] - __uint_as_float(h.z << 16); r[5] = x[5] - __uint_as_float(h.z & 0xffff0000u); r[6] = x[6] - __uint_as_float(h.w << 16); r[7] = x[7] - __uint_as_float(h.w & 0xffff0000u);
    lw.x = pack2(r[0], r[1]); lw.y = pack2(r[2], r[3]); lw.z = pack2(r[4], r[5]); lw.w = pack2(r[6], r[7]);
    hi = __builtin_bit_cast(bf16x8, h); lo = __builtin_bit_cast(bf16x8, lw);
}
__device__ __forceinline__ void phase_router(ParamsC p, int l, float* smem) {
    const int tid = ltid(), lane = tid & 63, wid = tid >> 6;
    float* sh2 = smem;
    float* spart = smem + 16 * RT_LD;
    float* slg = spart + 8 * 16 * 48;
    int* bcnt = (int*)(slg + 16 * 36);
    if (tid < 32) bcnt[tid] = 0;
    const int ntok = (l < DEPTH - 1) ? T_ALL : T_LAT;
    const float* wre = p->w_re + (size_t)l * 1024 * 32; const float* wrg = p->w_rg + (size_t)l * 1024 * 4;
    bf16x8 bh[4][3], bl[4][3];
#pragma unroll
    for (int ks = 0; ks < 4; ++ks)
#pragma unroll
        for (int nt = 0; nt < 3; ++nt) { float w[8]; const int k0 = wid * 128 + ks * 32 + (lane >> 4) * 8, n = lane & 15;
#pragma unroll
            for (int j = 0; j < 8; ++j) w[j] = (nt < 2) ? wre[(size_t)(k0 + j) * 32 + nt * 16 + n] : (n < 4 ? wrg[(size_t)(k0 + j) * 4 + n] : 0.f);
            split8(w, bh[ks][nt], bl[ks][nt]); }
    float4 gf[4];
#pragma unroll
    for (int i = 0; i < 4; ++i) gf[i] = *(const float4*)(p->g_ffn + l * 1024 + i * 256 + lane * 4);
    const bf16_t* xs = p->xs; bf16_t* hout = p->h; const float* modv = p->modv + (size_t)l * 5 * 6144 + 3072;
    const int G = gridDim.x, ntb = ntok / 16;
    __syncthreads();
    for (int tb = lbid(); tb < ntb; tb += G) {
#pragma unroll
        for (int j = 0; j < 2; ++j) { const int tt = wid * 2 + j, t = tb * 16 + tt; const int v = tok_variant(t);
            float4 xv[4]; float ss = 0.f;
#pragma unroll
            for (int i = 0; i < 4; ++i) { xv[i] = load4bf(xs + (size_t)t * 1024 + i * 256 + lane * 4); ss += xv[i].x * xv[i].x + xv[i].y * xv[i].y + xv[i].z * xv[i].z + xv[i].w * xv[i].w; }
            ss = wave_sum(ss); const float rstd = rsqrtf(ss * (1.0f / 1024.0f) + 1e-6f);
            const float* mv = modv + (size_t)v * 6144;
#pragma unroll
            for (int i = 0; i < 4; ++i) { const int c = i * 256 + lane * 4;
                const float4 g = gf[i], sh = *(const float4*)(mv + c), sc = *(const float4*)(mv + 1024 + c);
                float4 o; o.x = xv[i].x * rstd * g.x * (1.f + sc.x) + sh.x; o.y = xv[i].y * rstd * g.y * (1.f + sc.y) + sh.y; o.z = xv[i].z * rstd * g.z * (1.f + sc.z) + sh.z; o.w = xv[i].w * rstd * g.w * (1.f + sc.w) + sh.w;
                *(float4*)(sh2 + tt * RT_LD + c) = o; uint2 ob; ob.x = pack2(o.x, o.y); ob.y = pack2(o.z, o.w); *(uint2*)(hout + (size_t)t * 1024 + c) = ob; } }
        __syncthreads();
        {   f32x4 c0 = (f32x4){0.f, 0.f, 0.f, 0.f}, c1 = c0, c2 = c0;
            const float* ap = sh2 + (lane & 15) * RT_LD + wid * 128 + (lane >> 4) * 8;
#pragma unroll
            for (int ks = 0; ks < 4; ++ks) { const float4 a0 = *(const float4*)(ap + ks * 32), a1 = *(const float4*)(ap + ks * 32 + 4);
                const float x8[8] = {a0.x, a0.y, a0.z, a0.w, a1.x, a1.y, a1.z, a1.w}; bf16x8 ah, al; split8(x8, ah, al);
                c0 = __builtin_amdgcn_mfma_f32_16x16x32_bf16(ah, bh[ks][0], c0, 0, 0, 0); c0 = __builtin_amdgcn_mfma_f32_16x16x32_bf16(ah, bl[ks][0], c0, 0, 0, 0); c0 = __builtin_amdgcn_mfma_f32_16x16x32_bf16(al, bh[ks][0], c0, 0, 0, 0);
                c1 = __builtin_amdgcn_mfma_f32_16x16x32_bf16(ah, bh[ks][1], c1, 0, 0, 0); c1 = __builtin_amdgcn_mfma_f32_16x16x32_bf16(ah, bl[ks][1], c1, 0, 0, 0); c1 = __builtin_amdgcn_mfma_f32_16x16x32_bf16(al, bh[ks][1], c1, 0, 0, 0);
                c2 = __builtin_amdgcn_mfma_f32_16x16x32_bf16(ah, bh[ks][2], c2, 0, 0, 0); c2 = __builtin_amdgcn_mfma_f32_16x16x32_bf16(ah, bl[ks][2], c2, 0, 0, 0); c2 = __builtin_amdgcn_mfma_f32_16x16x32_bf16(al, bh[ks][2], c2, 0, 0, 0); }
#pragma unroll
            for (int r = 0; r < 4; ++r) { float* sp = spart + (wid * 16 + 4 * (lane >> 4) + r) * 48 + (lane & 15); sp[0] = c0[r]; sp[16] = c1[r]; sp[32] = c2[r]; } }
        __syncthreads();
        {   const int tt = tid >> 5, j = tid & 31; float a = p->b_re[l * 32 + j];
#pragma unroll
            for (int w8 = 0; w8 < 8; ++w8) a += spart[(w8 * 16 + tt) * 48 + j];
            slg[tt * 36 + 4 + j] = a;
            if (tid < 64) { const int t2 = tid >> 2, j2 = tid & 3; float a2 = p->b_rg[l * 4 + j2];
#pragma unroll
                for (int w8 = 0; w8 < 8; ++w8) a2 += spart[(w8 * 16 + t2) * 48 + 32 + j2];
                slg[t2 * 36 + j2] = a2; } }
        __syncthreads();
        if (tid < 16) { const int t = tb * 16 + tid; const float* lg = slg + tid * 36;
            int gi = 0; float gm = lg[0];
#pragma unroll
            for (int j = 1; j < 4; ++j) if (lg[j] > gm) { gm = lg[j]; gi = j; }
            float den = 0.f;
#pragma unroll
            for (int j = 0; j < 4; ++j) den += __expf(lg[j] - gm);
            const float pg = __builtin_amdgcn_rcpf(den);
            const float* le = lg + 4 + gi * 8;
            int i1 = 0; float v1 = le[0];
#pragma unroll
            for (int j = 1; j < 8; ++j) if (le[j] > v1) { v1 = le[j]; i1 = j; }
            int i2 = -1; float v2 = -3.0e38f;
#pragma unroll
            for (int j = 0; j < 8; ++j) if (j != i1 && le[j] > v2) { v2 = le[j]; i2 = j; }
            const float e2 = __expf(v2 - v1); const float wa = __builtin_amdgcn_rcpf(1.0f + e2), wb = e2 * wa;
            const int ea = gi * 8 + i1, eb = gi * 8 + i2;
            p->eid[t * 2] = ea; p->eid[t * 2 + 1] = eb; p->ewt[t * 2] = pg * wa; p->ewt[t * 2 + 1] = pg * wb;
            p->epos[t * 2] = atomicAdd(bcnt + ea, 1); p->epos[t * 2 + 1] = atomicAdd(bcnt + eb, 1); }
        __syncthreads();
    }
    __syncthreads();
    if (tid < 32) p->cnt[lbid() * 32 + tid] = bcnt[tid];
}

__device__ __forceinline__ void phase_dispatch(ParamsC p, int l, int* smem) {
    const int tid = ltid(), lane = tid & 63, wid = tid >> 6;
    int* sfull = smem;
    int* spre = smem + 512;
    int* pstart = smem + 1024;
    int* boff = smem + 1024 + 64;
    const int G = gridDim.x;
    {   const int e = tid & 31, part = tid >> 5; int sf = 0, sp = 0;
        for (int bb = part; bb < G; bb += 16) { const int c = p->cnt[bb * 32 + e]; sf += c; sp += (bb < lbid()) ? c : 0; }
        sfull[part * 32 + e] = sf; spre[part * 32 + e] = sp; }
    __syncthreads();
    if (tid < 32) { int tf = 0, tp = 0; for (int q = 0; q < 16; ++q) { tf += sfull[q * 32 + tid]; tp += spre[q * 32 + tid]; } sfull[tid] = tf; spre[tid] = tp; }
    __syncthreads();
    if (tid == 0) { int acc = 0; for (int e = 0; e < 32; ++e) { pstart[e] = acc; acc += ((sfull[e] + 255) >> 8) << 8; } pstart[32] = acc; }
    __syncthreads();
    if (tid < 32) boff[tid] = pstart[tid] + spre[tid];
    if (lbid() == 0) { const int nb = pstart[32] >> 8;
        for (int rb = tid; rb < nb; rb += NTHR) { int e = 0; while (e < 31 && pstart[e + 1] <= rb * 256) ++e; p->blk_e[rb] = e; }
        if (tid == 0) p->nbu[0] = nb; }
    __syncthreads();
    const int ntok = (l < DEPTH - 1) ? T_ALL : T_LAT;
    for (int tb = lbid(); tb < ntok / 16; tb += G) {
#pragma unroll
        for (int j = 0; j < 4; ++j) { const int a = tb * 32 + wid * 4 + j; const int t = a >> 1; const int sl = boff[p->eid[a]] + p->epos[a];
            if (lane == 0) { p->slot[a] = sl; p->tokmap[sl] = t; } }
    }
    for (int e = lbid(); e < 32; e += G) { const int lo = pstart[e] + sfull[e], hi = pstart[e + 1]; for (int sl = lo + tid; sl < hi; sl += NTHR) p->tokmap[sl] = 0; }
}

__device__ __forceinline__ void phase_gemm_e1(ParamsC p, unsigned char* smem) {
    const int tid = ltid(), lane = tid & 63, wid = tid >> 6, wm = wid >> 1, wn = wid & 1, q4 = (lane >> 4) * 4;
    const int nb = p->nbu[0]; const int ntiles = nb * 2 * 4;
    for (int tile = lbid(); tile < ntiles; tile += gridDim.x) {
        const int rb = tile >> 2, tn = tile & 3, m0 = rb * 128, e = p->blk_e[rb >> 1];
        f32x4 acc[2][4]; zero_acc(acc);
        RowsLinear ar{p->xd + (size_t)m0 * 1024, 1024};
        gemm_core(smem, ar, p->wt_gu + ((size_t)e * 512 + tn * 128) * 1024, 1024, 0, 1024, acc);
        const int pg = tn * 2 + wn;
#pragma unroll
        for (int mi = 0; mi < 2; ++mi) { const int sl = m0 + wm * 32 + mi * 16 + (lane & 15);
#pragma unroll
            for (int nj = 0; nj < 2; ++nj) { f32x4 g = acc[mi][nj], u = acc[mi][nj + 2], o;
#pragma unroll
                for (int e4 = 0; e4 < 4; ++e4) o[e4] = g[e4] / (1.f + __expf(-g[e4])) * u[e4];
                store4bf(p->hid + (size_t)sl * 256 + pg * 32 + nj * 16 + q4, o); } }
    }
}
__device__ __forceinline__ void phase_gemm_e2(ParamsC p, unsigned char* smem) {
    const int tid = ltid(), lane = tid & 63, wid = tid >> 6, wm = wid >> 1, wn = wid & 1, q4 = (lane >> 4) * 4;
    const int nb = p->nbu[0]; const int ntiles = nb * 2 * 8;
    for (int tile = lbid(); tile < ntiles; tile += gridDim.x) {
        const int rb = tile >> 3, tn = tile & 7, m0 = rb * 128, n0 = tn * 128, e = p->blk_e[rb >> 1];
        f32x4 acc[2][4]; zero_acc(acc);
        RowsLinear ar{p->hid + (size_t)m0 * 256, 256};
        gemm_core(smem, ar, p->wt_d + ((size_t)e * 1024 + n0) * 256, 256, 0, 256, acc);
#pragma unroll
        for (int mi = 0; mi < 2; ++mi) { const int sl = m0 + wm * 32 + mi * 16 + (lane & 15);
#pragma unroll
            for (int nj = 0; nj < 4; ++nj) store4bf(p->Y + (size_t)sl * 1024 + n0 + wn * 64 + nj * 16 + q4, acc[mi][nj]); }
    }
}


struct EpiIn { static constexpr bool PERM = true, AFTER_DRAIN = false, HOOK = false;
    bf16_t* uA; bf16_t* uG; const float* ropet;
    __device__ __forceinline__ void operator()(const f32x4 (&acc)[2][2][4][2], const pg8::Unit& u, int wr, int wc, int fr, int fq) const {
        const int row0 = u.pm * 256 + wr * 64 + fr; const bool latent = u.pm < 128;
#pragma unroll
        for (int bj = 0; bj < 2; ++bj) {
            const int cb32 = u.pn * 256 + bj * 128 + wc * 32, c0 = cb32 + 8 * fq;
            if (cb32 >= 2560) {
#pragma unroll
                for (int ai = 0; ai < 2; ++ai)
#pragma unroll
                    for (int m = 0; m < 4; ++m) { const int t = row0 + ai * 128 + m * 16; f32x4 v0 = acc[ai][bj][m][0], v1 = acc[ai][bj][m][1];
#pragma unroll
                        for (int e = 0; e < 4; ++e) { v0[e] = __builtin_amdgcn_rcpf(1.f + __expf(-v0[e])); v1[e] = __builtin_amdgcn_rcpf(1.f + __expf(-v1[e])); }
                        const int gt_ = (u.pn - 10), wv_ = wr * 4 + wc;
                        *(pg8::u32x4*)(uG + ((((size_t)u.pm * 12 + gt_) * 8 + wv_) * 16 + (ai * 8 + m * 2 + bj)) * 512 + (fq * 16 + fr) * 8) = pack8(v0, v1); }
            } else {
                const bool isq = (cb32 >= 768 && cb32 < 1152) || (cb32 >= 1920 && cb32 < 2304);
                const bool rope = (cb32 >= 1920 && cb32 < 2432) && latent;
#pragma unroll
                for (int ai = 0; ai < 2; ++ai)
#pragma unroll
                    for (int m = 0; m < 4; ++m) { const int t = row0 + ai * 128 + m * 16; f32x4 v0 = acc[ai][bj][m][0], v1 = acc[ai][bj][m][1];
                        if (rope) { const int pos = t & 8191; const int posv = (wc & 1) ? (pos & 63) : (pos >> 6);
                            const float4* cs = (const float4*)(ropet + (posv * 16 + 8 * (fq & 1)) * 2);
                            const float4 c01 = cs[0], c23 = cs[1], c45 = cs[2], c67 = cs[3];
                            f32x4 p0, p1;
#pragma unroll
                            for (int e = 0; e < 4; ++e) { p0[e] = __shfl_xor(v0[e], 32); p1[e] = __shfl_xor(v1[e], 32); }
                            const float co0[4] = {c01.x, c01.z, c23.x, c23.z}, si0[4] = {c01.y, c01.w, c23.y, c23.w}, co1[4] = {c45.x, c45.z, c67.x, c67.z}, si1[4] = {c45.y, c45.w, c67.y, c67.w};
#pragma unroll
                            for (int e = 0; e < 4; ++e) {
                                if (fq < 2) { v0[e] = v0[e] * co0[e] - p0[e] * si0[e]; v1[e] = v1[e] * co1[e] - p1[e] * si1[e]; }
                                else { v0[e] = p0[e] * si0[e] + v0[e] * co0[e]; v1[e] = p1[e] * si1[e] + v1[e] * co1[e]; } } }
                        if (isq) { v0 = v0 * (0.125f * QLOG2E); v1 = v1 * (0.125f * QLOG2E); }
                        *(pg8::u32x4*)(uA + (size_t)t * UA_LD + c0) = pack8(v0, v1); }
            }
        }
    }
};

struct EpiMerge { static constexpr bool PERM = true, AFTER_DRAIN = false, HOOK = true;
    const bf16_t* uG; bf16_t* mo;
    __device__ __forceinline__ void hook(f32x4 (&acc)[2][2][4][2], const pg8::Unit& u, int t, int wr, int wc, int fr, int fq) const {
        int lo_ = (fq * 16 + fr) * 8; asm volatile("" : "+v"(lo_)); const int seg = (t == 2) ? 0 : 1;
        const bf16_t* gbase = uG + ((((size_t)u.pm * 12 + seg * 4 + u.pn) * 8 + (wr * 4 + wc)) * 16) * 512 + lo_;
#pragma unroll
        for (int ai = 0; ai < 2; ++ai) {
            pg8::u32x4 wn[4][2], wd[4][2];
#pragma unroll
            for (int m = 0; m < 4; ++m)
#pragma unroll
                for (int bj = 0; bj < 2; ++bj) { const bf16_t* gp = gbase + (ai * 8 + m * 2 + bj) * 512; wn[m][bj] = *(const pg8::u32x4*)gp; wd[m][bj] = *(const pg8::u32x4*)(gp + 4 * 65536); }
#pragma unroll
            for (int m = 0; m < 4; ++m)
#pragma unroll
                for (int bj = 0; bj < 2; ++bj) { f32x4 n0, n1, d0, d1; unpack8(wn[m][bj], n0, n1); unpack8(wd[m][bj], d0, d1);
#pragma unroll
                    for (int e = 0; e < 4; ++e) { acc[ai][bj][m][0][e] *= n0[e] * __builtin_amdgcn_rcpf(fmaxf(d0[e], 1e-20f)); acc[ai][bj][m][1][e] *= n1[e] * __builtin_amdgcn_rcpf(fmaxf(d1[e], 1e-20f)); } }
            asm volatile("" ::: "memory");
        }
    }
    __device__ __forceinline__ void operator()(const f32x4 (&acc)[2][2][4][2], const pg8::Unit& u, int wr, int wc, int fr, int fq) const {
        const int row0 = u.pm * 256 + wr * 64 + fr; const int c00 = u.pn * 256 + wc * 32 + 8 * fq;
#pragma unroll
        for (int ai = 0; ai < 2; ++ai) { pg8::u32x4 wg[4][2];
#pragma unroll
            for (int m = 0; m < 4; ++m)
#pragma unroll
                for (int bj = 0; bj < 2; ++bj) wg[m][bj] = *(const pg8::u32x4*)(uG + ((((size_t)u.pm * 12 + 8 + u.pn) * 8 + (wr * 4 + wc)) * 16 + (ai * 8 + m * 2 + bj)) * 512 + (fq * 16 + fr) * 8);
#pragma unroll
            for (int m = 0; m < 4; ++m)
#pragma unroll
                for (int bj = 0; bj < 2; ++bj) { f32x4 g0, g1; unpack8(wg[m][bj], g0, g1); f32x4 v0 = acc[ai][bj][m][0], v1 = acc[ai][bj][m][1];
#pragma unroll
                    for (int e = 0; e < 4; ++e) { v0[e] *= fmaxf(g0[e], 1e-20f); v1[e] *= fmaxf(g1[e], 1e-20f); }
                    *(pg8::u32x4*)(mo + (size_t)(row0 + ai * 128 + m * 16) * 1024 + c00 + bj * 128) = pack8(v0, v1); }
            asm volatile("" ::: "memory"); }
    }
};

struct EpiO { static constexpr bool PERM = true, AFTER_DRAIN = false, HOOK = false;
    bf16_t* xs; const float* modv_l;
    __device__ __forceinline__ void operator()(const f32x4 (&acc)[2][2][4][2], const pg8::Unit& u, int wr, int wc, int fr, int fq) const {
        const int row0 = u.pm * 256 + wr * 64 + fr; const int v = u.pm < 128 ? (u.pm >> 5) : 4; const float* gt = modv_l + (size_t)v * 6144 + 2048;
        const int col0 = u.pn * 256 + wc * 32 + 8 * fq;
        f32x4 gv[2][2];
#pragma unroll
        for (int bj = 0; bj < 2; ++bj)
#pragma unroll
            for (int n = 0; n < 2; ++n) gv[bj][n] = *(const f32x4*)(gt + col0 + bj * 128 + n * 4);
#pragma unroll
        for (int ai = 0; ai < 2; ++ai) { pg8::u32x4 xw[4][2];
#pragma unroll
            for (int m = 0; m < 4; ++m)
#pragma unroll
                for (int bj = 0; bj < 2; ++bj) xw[m][bj] = *(const pg8::u32x4*)(xs + (size_t)(row0 + ai * 128 + m * 16) * 1024 + col0 + bj * 128);
#pragma unroll
            for (int m = 0; m < 4; ++m)
#pragma unroll
                for (int bj = 0; bj < 2; ++bj) { f32x4 x0, x1; unpack8(xw[m][bj], x0, x1);
                    x0 = x0 + gv[bj][0] * acc[ai][bj][m][0]; x1 = x1 + gv[bj][1] * acc[ai][bj][m][1];
                    *(pg8::u32x4*)(xs + (size_t)(row0 + ai * 128 + m * 16) * 1024 + col0 + bj * 128) = pack8(x0, x1); }
            asm volatile("" ::: "memory"); }
    }
};

struct EpiE1 { static constexpr bool PERM = true, AFTER_DRAIN = false, HOOK = false;
    bf16_t* hid;
    __device__ __forceinline__ void operator()(const f32x4 (&acc)[2][2][4][2], const pg8::Unit& u, int wr, int wc, int fr, int fq) const {
        const int row0 = u.pm * 256 + wr * 64 + fr; const int c0 = (u.pn & 1) * 128 + wc * 32 + 8 * fq;
#pragma unroll
        for (int ai = 0; ai < 2; ++ai)
#pragma unroll
            for (int m = 0; m < 4; ++m) { f32x4 o0, o1;
#pragma unroll
                for (int e = 0; e < 4; ++e) { const float g0 = acc[ai][0][m][0][e], g1 = acc[ai][0][m][1][e];
                    o0[e] = g0 * __builtin_amdgcn_rcpf(1.f + __expf(-g0)) * acc[ai][1][m][0][e]; o1[e] = g1 * __builtin_amdgcn_rcpf(1.f + __expf(-g1)) * acc[ai][1][m][1][e]; }
                *(pg8::u32x4*)(hid + (size_t)(row0 + ai * 128 + m * 16) * 256 + c0) = pack8(o0, o1); }
    }
};

struct EpiE2 { static constexpr bool PERM = true, AFTER_DRAIN = false, HOOK = false;
    bf16_t* Y;
    __device__ __forceinline__ void operator()(const f32x4 (&acc)[2][2][4][2], const pg8::Unit& u, int wr, int wc, int fr, int fq) const {
        const int row0 = u.pm * 256 + wr * 64 + fr; const int c0 = (u.pn & 3) * 256 + wc * 32 + 8 * fq;
#pragma unroll
        for (int ai = 0; ai < 2; ++ai)
#pragma unroll
            for (int m = 0; m < 4; ++m)
#pragma unroll
                for (int bj = 0; bj < 2; ++bj) *(pg8::u32x4*)(Y + (size_t)(row0 + ai * 128 + m * 16) * 1024 + c0 + bj * 128) = pack8(acc[ai][bj][m][0], acc[ai][bj][m][1]);
    }
};

__device__ __forceinline__ void phase_pg_in(ParamsC p, int l, unsigned char* smem) {
    pg8::Gemm g{p->h, WSEL(wt_in, l), T_ALL, IN_COLS, 1024, nullptr}; pg8::StaticOrder S; S.init(T_ALL, IN_COLS, (int)gridDim.x, lbid());
    EpiIn E{p->uA, p->uG, p->ropet};
    pg8::gemm_phase<EpiIn, pg8::StaticOrder, true, true>((PG8_LAS unsigned char*)smem, g, S, E);
}
__device__ __forceinline__ void phase_pg_merge(ParamsC p, int l, unsigned char* smem) {
    const int M = (l < DEPTH - 1) ? T_ALL : T_LAT;
    pg8::Gemm g{p->ycat, WSEL(wt_br, l), M, 1024, 1024, nullptr}; pg8::StaticOrder S; S.init(M, 1024, (int)gridDim.x, lbid());
    EpiMerge E{p->uG, p->mbuf};
    pg8::gemm_phase<EpiMerge, pg8::StaticOrder, true, true>((PG8_LAS unsigned char*)smem, g, S, E);
    if (l < DEPTH - 1) { const int G = (int)gridDim.x, extra = (M / 256) * 4 - 2 * G, c = lbid(); const bool part = extra > 0 && extra < G;
        const int first = part ? c - extra : c, stride = part ? G - extra : G;
        if (first >= 0) phase_wconv(p, l + 1, (float*)smem, 0, WC_TOTAL / 2, first, stride); }
}
__device__ __forceinline__ void phase_pg_o(ParamsC p, int l, unsigned char* smem) {
    const int M = (l < DEPTH - 1) ? T_ALL : T_LAT;
    pg8::Gemm g{p->mbuf, WSEL(wt_o, l), M, 1024, 1024, nullptr}; pg8::StaticOrder S; S.init(M, 1024, (int)gridDim.x, lbid());
    EpiO E{p->xs, p->modv + (size_t)l * 5 * 6144};
    pg8::gemm_phase<EpiO, pg8::StaticOrder, true, true>((PG8_LAS unsigned char*)smem, g, S, E);
    if (l < DEPTH - 1) { const int G = (int)gridDim.x, extra = (M / 256) * 4 - 2 * G, c = lbid(); const bool part = extra > 0 && extra < G;
        const int first = part ? c - extra : c, stride = part ? G - extra : G;
        if (first >= 0) phase_wconv(p, l + 1, (float*)smem, WC_TOTAL / 2, WC_TOTAL, first, stride); }
}
__device__ __forceinline__ void phase_pg_e1(ParamsC p, int l, unsigned char* smem) {
    const int nb = p->nbu[0];
    pg8::Gemm g{p->h, WSEL(wt_gu, l), nb * 256, 512, 1024, p->tokmap}; pg8::GroupedOrder<2> S{p->blk_e, nb * 2, (int)gridDim.x, lbid()};
    EpiE1 E{p->hid};
    pg8::gemm_phase<EpiE1, pg8::GroupedOrder<2>, true, true, true>((PG8_LAS unsigned char*)smem, g, S, E);
}
__device__ __forceinline__ void phase_pg_e2(ParamsC p, int l, unsigned char* smem) {
    const int nb = p->nbu[0];
    pg8::Gemm g{p->hid, WSEL(wt_d, l), nb * 256, 1024, 256, nullptr}; pg8::GroupedOrder<4> S{p->blk_e, nb * 4, (int)gridDim.x, lbid()};
    EpiE2 E{p->Y};
    pg8::gemm_phase<EpiE2, pg8::GroupedOrder<4>, true, true>((PG8_LAS unsigned char*)smem, g, S, E);
}

#define XB_TMO      128
#define XB_XCNT(j)  (256  + 64 * (j))
#define XB_XSUB(j)  (1280 + 64 * (j))
#define XB_XGEN(j)  (2304 + 64 * (j))
#define XB_TOP      3328
#define XB_TOPGEN   3392
#define XCD_BAR_WORDS 3456
#define XB_SPIN_CAP (1u << 18)
__device__ __forceinline__ unsigned xb_ld(unsigned* p)              { return __hip_atomic_load(p, __ATOMIC_RELAXED, __HIP_MEMORY_SCOPE_AGENT); }
__device__ __forceinline__ unsigned xb_add(unsigned* p, unsigned v) { return __hip_atomic_fetch_add(p, v, __ATOMIC_RELAXED, __HIP_MEMORY_SCOPE_AGENT); }
__device__ __forceinline__ unsigned xb_xcc_id() { return (unsigned)__builtin_amdgcn_s_getreg((3 << 11) | 20) & 0xFu; }
#define XB_SPIN(cond, bar) do { unsigned _sp = 0; while (cond) { __builtin_amdgcn_s_sleep(1); \
    if ((++_sp & 255u) == 0u) { if (xb_ld(&(bar)[XB_TMO])) break; if (_sp > XB_SPIN_CAP) { atomicAdd(&(bar)[XB_TMO], 1u); break; } } } } while (0)
struct XcdBarrier { unsigned* bar; unsigned x; volatile LAS unsigned* st; };
__device__ __forceinline__ XcdBarrier xcd_barrier_post(unsigned* bar, volatile LAS unsigned* st) {
    XcdBarrier b; b.bar = bar; b.x = xb_xcc_id(); b.st = st;
    if (threadIdx.x == 0) (void)xb_add(&bar[XB_XCNT(b.x)], 1u);
    return b;
}
__device__ __forceinline__ void xcd_barrier_complete(unsigned* bar, unsigned x, unsigned& nloc, unsigned& nx) {
    const unsigned G = gridDim.x * gridDim.y * gridDim.z;
    unsigned sum, cnt, mine, sp = 0u;
    for (;;) {
        sum = 0u; cnt = 0u; mine = 0u;
#pragma unroll
        for (unsigned j = 0; j < 16; ++j) { const unsigned c = xb_ld(&bar[XB_XCNT(j)]); sum += c; cnt += (c > 0u) ? 1u : 0u; mine = (j == x) ? c : mine; }
        if (sum == G) break;
        __builtin_amdgcn_s_sleep(1);
        if ((++sp & 255u) == 0u) { if (xb_ld(&bar[XB_TMO])) break; if (sp > XB_SPIN_CAP) { atomicAdd(&bar[XB_TMO], 1u); break; } }
    }
    nloc = mine > 0u ? mine : 1u; nx = cnt > 0u ? cnt : 1u;
}
__device__ __forceinline__ void xcd_barrier(const XcdBarrier& b) {
    asm volatile("s_waitcnt vmcnt(0)" ::: "memory");
    __syncthreads();
    if (threadIdx.x == 0) {
        unsigned* bar = b.bar;
        __builtin_amdgcn_s_waitcnt(0);
        unsigned nloc = b.st[0], nx = b.st[1];
        if (nloc == 0u) { xcd_barrier_complete(bar, b.x, nloc, nx); b.st[0] = nloc; b.st[1] = nx; }
        const unsigned old = xb_add(&bar[XB_XSUB(b.x)], 1u);
        const unsigned gen = old / nloc;
        if (old + 1u == (gen + 1u) * nloc) {
            __builtin_amdgcn_fence(__ATOMIC_RELEASE, "agent");
            asm volatile("s_waitcnt vmcnt(0)" ::: "memory");
            const unsigned og = xb_add(&bar[XB_TOP], 1u);
            const unsigned tg = og / nx;
            if (og + 1u == (tg + 1u) * nx) xb_add(&bar[XB_TOPGEN], 1u);
            else XB_SPIN(xb_ld(&bar[XB_TOPGEN]) == tg, bar);
            __builtin_amdgcn_fence(__ATOMIC_ACQUIRE, "agent");
            xb_add(&bar[XB_XGEN(b.x)], 1u);
            asm volatile("s_waitcnt vmcnt(0)" ::: "memory");
        } else {
            XB_SPIN(xb_ld(&bar[XB_XGEN(b.x)]) == gen, bar);
            __builtin_amdgcn_fence(__ATOMIC_ACQUIRE, "agent");
            asm volatile("s_waitcnt vmcnt(0)" ::: "memory");
        }
    }
    __syncthreads();
}

#define SMEM_BYTES 131072
#ifndef PROBE_MASK
#define PROBE_MASK 0
#endif
#define PROBE_MULT 4
#define PH_BEGIN(id) do { if (PROBE_MASK & (1 << (id))) t0 = wall_clock64(); } while (0)
#define PH_END(id) do { if (PROBE_MASK & (1 << (id))) tacc += wall_clock64() - t0; } while (0)
__global__ void __launch_bounds__(NTHR, 2) k_mega(Params p_unused) {
    const ParamsC pk = (ParamsC)__builtin_amdgcn_kernarg_segment_ptr();
#define PP() ({ ParamsC q_ = pk; asm volatile("" : "+s"(q_) :: "memory"); q_; })
    extern __shared__ __attribute__((aligned(16))) unsigned char smem[];
    volatile LAS unsigned* xbw = (volatile LAS unsigned*)(smem + SMEM_BYTES);
    if (threadIdx.x == 0) { xbw[0] = 0u; xbw[1] = 0u; xbw[2] = 0u; xbw[3] = 0u; }
    __syncthreads();
    (void)xcd_barrier_post(PP()->bar, xbw);
    unsigned long long tacc = 0, t0 = 0;
#define GRID_BAR() do { unsigned long long tb0_ = 0; if (PROBE_MASK & (1 << 14)) tb0_ = wall_clock64(); XcdBarrier bar_; bar_.bar = PP()->bar; bar_.x = xb_xcc_id(); bar_.st = xbw; xcd_barrier(bar_); if (PROBE_MASK & (1 << 14)) tacc += wall_clock64() - tb0_; } while (0)
    PH_BEGIN(0); phase_mod(PP(), (float*)smem); phase_wconv(PP(), 0, (float*)smem, 0, WC_TOTAL, lbid(), (int)gridDim.x); GRID_BAR(); PH_END(0);
    for (int l = 0; l < DEPTH; ++l) {
        PH_BEGIN(1); phase_norm1(PP(), l); GRID_BAR(); PH_END(1);
        PH_BEGIN(2); phase_pg_in(PP(), l, smem); GRID_BAR(); PH_END(2);
        PH_BEGIN(3); PH_BEGIN(11); phase_conv(PP(), l); PH_END(11); PH_BEGIN(12); phase_na(PP(), l, smem); PH_END(12); PH_BEGIN(13); phase_swa(PP(), l, smem); PH_END(13); GRID_BAR(); PH_END(3);
        PH_BEGIN(4); phase_pg_merge(PP(), l, smem); GRID_BAR(); PH_END(4);
        PH_BEGIN(5); phase_pg_o(PP(), l, smem); GRID_BAR(); PH_END(5);
        PH_BEGIN(6); phase_router(PP(), l, (float*)smem); GRID_BAR(); PH_END(6);
        PH_BEGIN(7); phase_dispatch(PP(), l, (int*)smem); GRID_BAR(); PH_END(7);
        PH_BEGIN(8); phase_pg_e1(PP(), l, smem); GRID_BAR(); PH_END(8);
        PH_BEGIN(9); phase_pg_e2(PP(), l, smem); GRID_BAR(); PH_END(9);
    }
    PH_BEGIN(10); phase_norm1(PP(), DEPTH); PH_END(10);
    if (PROBE_SUB != 0 && threadIdx.x == 0) tacc += ((volatile LAS unsigned*)(smem + 131072 + 8))[0];
    if ((PROBE_MASK != 0 || PROBE_SUB != 0) && blockIdx.x == 0) { const unsigned long long te = wall_clock64(); while (wall_clock64() - te < tacc * PROBE_MULT) __builtin_amdgcn_s_sleep(8); }
}

extern "C" void kernel_launch(void* const* d_in, const int* in_sizes, int n_in, void* d_out, int out_size, void* d_ws, size_t ws_size, hipStream_t stream) {
    Params p{};
    p.x = (const float*)d_in[0]; p.c = (const float*)d_in[1]; p.ctx = (const float*)d_in[2]; p.c_ctx = (const float*)d_in[3]; p.w_mod = (const float*)d_in[4]; p.b_mod = (const float*)d_in[5];
    p.g_attn = (const float*)d_in[6]; p.g_ffn = (const float*)d_in[7]; p.w_in = (const float*)d_in[8]; p.conv_w = (const float*)d_in[9]; p.rpb = (const float*)d_in[10]; p.sinks = (const float*)d_in[11];
    p.w_branch = (const float*)d_in[12]; p.w_o = (const float*)d_in[13]; p.w_rg = (const float*)d_in[14]; p.b_rg = (const float*)d_in[15]; p.w_re = (const float*)d_in[16]; p.b_re = (const float*)d_in[17];
    p.w_eg = (const float*)d_in[18]; p.w_eu = (const float*)d_in[19]; p.w_ed = (const float*)d_in[20]; p.g_final = (const float*)d_in[21];
    p.out = (float*)d_out;
    unsigned char* w = (unsigned char*)d_ws; size_t off = 0;
    auto take = [&](size_t bytes) { unsigned char* r = w + off; off += (bytes + 255) & ~(size_t)255; return r; };
    p.bar = (unsigned*)take(16384); p.cnt = (int*)take(1024 * 32 * 4); p.blk_e = (int*)take(MAXBLK * 4); p.nbu = (int*)take(256);
    p.modv = (float*)take((size_t)DEPTH * 5 * 6144 * 4); p.ropet = (float*)take(128 * 16 * 2 * 4);
    p.eid = (int*)take((size_t)T_ALL * 2 * 4); p.epos = (int*)take((size_t)T_ALL * 2 * 4); p.ewt = (float*)take((size_t)T_ALL * 2 * 4); p.slot = (int*)take((size_t)T_ALL * 2 * 4); p.tokmap = (int*)take((size_t)MAXBLK * 256 * 4);
    p.xs = (bf16_t*)take((size_t)T_ALL * 1024 * 2);
    p.h = (bf16_t*)take((size_t)T_ALL * 1024 * 2);
    p.wt_in = (bf16_t*)take((size_t)IN_COLS * 1024 * 2); p.wt_br = (bf16_t*)take((size_t)1024 * 1024 * 2); p.wt_o = (bf16_t*)take((size_t)1024 * 1024 * 2);
    p.wt_gu = (bf16_t*)take((size_t)32 * 512 * 1024 * 2); p.wt_d = (bf16_t*)take((size_t)32 * 1024 * 256 * 2);
    {   unsigned char* o = (unsigned char*)d_out; size_t oo = 0;
        auto take_o = [&](size_t bytes) { unsigned char* r = o + oo; oo += (bytes + 255) & ~(size_t)255; return r; };
        p.wt_in1 = (bf16_t*)take_o((size_t)IN_COLS * 1024 * 2); p.wt_br1 = (bf16_t*)take_o((size_t)1024 * 1024 * 2); p.wt_o1 = (bf16_t*)take_o((size_t)1024 * 1024 * 2);
        p.wt_gu1 = (bf16_t*)take_o((size_t)32 * 512 * 1024 * 2); p.wt_d1 = (bf16_t*)take_o((size_t)32 * 1024 * 256 * 2);
        if (oo > (size_t)out_size * 4) return; }
    p.uA = (bf16_t*)take((size_t)T_ALL * UA_LD * 2); p.uG = (bf16_t*)take((size_t)T_ALL * UG_LD * 2); p.ycat = (bf16_t*)take((size_t)T_ALL * 1024 * 2);
    p.mbuf = p.uA; p.xd = p.uA; p.hid = p.ycat; p.Y = p.uG;
    if (off > ws_size) return;
    constexpr size_t kDynLds = SMEM_BYTES + 16;
    static int grid = 0;
    if (!grid) {
        (void)hipFuncSetAttribute((const void*)k_mega, hipFuncAttributeMaxDynamicSharedMemorySize, (int)kDynLds);
        int dev = 0, cus = 0, per_cu = 0;
        (void)hipGetDevice(&dev);
        (void)hipDeviceGetAttribute(&cus, hipDeviceAttributeMultiprocessorCount, dev);
        (void)hipOccupancyMaxActiveBlocksPerMultiprocessor(&per_cu, (const void*)k_mega, NTHR, kDynLds);
        grid = cus * (per_cu < 1 ? per_cu : 1);
        if (grid <= 0) grid = 0;
    }
    if (!grid) return;
    (void)hipMemsetAsync(p.bar, 0, XCD_BAR_WORDS * sizeof(unsigned), stream);
    hipLaunchKernelGGL(k_mega, dim3(grid), dim3(NTHR), kDynLds, stream, p);
}
```

```cpp
#include <hip/hip_runtime.h>
#include <stdint.h>

typedef unsigned short bf16_t;
typedef short bf16x8 __attribute__((ext_vector_type(8)));
typedef float f32x4 __attribute__((ext_vector_type(4)));

#define D_MODEL 1024
#define NB 4
#define SEQ 8192
#define DEPTH 4
#define CTXL 256
#define T_LAT 32768
#define T_CTX 1024
#define T_ALL 33792
#define UA_LD 2560
#define UG_LD 3072
#define IN_COLS 5632
#define MAXBLK 296
#define NTHR 512
#ifndef PROBE_SUB
#define PROBE_SUB 0
#endif
#define SUB_T0(id) unsigned long long st0_ = 0; if (PROBE_SUB == (id) && threadIdx.x == 0) st0_ = wall_clock64();
#define SUB_ACC(id) if (PROBE_SUB == (id) && threadIdx.x == 0) { volatile LAS unsigned* sw_ = (volatile LAS unsigned*)(smem + 131072 + 8); sw_[0] = sw_[0] + (unsigned)(wall_clock64() - st0_); }
#define QLOG2E 1.4426950408889634f
#define LAS __attribute__((address_space(3)))

struct Params {
    const float *x, *c, *ctx, *c_ctx, *w_mod, *b_mod, *g_attn, *g_ffn, *w_in, *conv_w, *rpb, *sinks, *w_branch, *w_o, *w_rg, *b_rg, *w_re, *b_re, *w_eg, *w_eu, *w_ed, *g_final;
    float* out;
    unsigned* bar; int* cnt; int* blk_e; int* nbu;
    float* modv; float* ropet; bf16_t* xs;
    bf16_t *h, *wt_in, *wt_br, *wt_o, *wt_gu, *wt_d, *uA, *uG, *ycat, *mbuf, *xd, *hid, *Y;
    int* eid; int* epos; float* ewt; int* slot; int* tokmap;
    bf16_t *wt_in1, *wt_br1, *wt_o1, *wt_gu1, *wt_d1;
};
typedef const __attribute__((address_space(4))) Params* ParamsC;
#define WSEL(X, l) (((l) & 1) ? p->X##1 : p->X)

__device__ __forceinline__ int lbid() { int b = blockIdx.x; asm volatile("" : "+s"(b) :: "memory"); return b; }
__device__ __forceinline__ int ltid() { int t = threadIdx.x; asm volatile("" : "+v"(t) :: "memory"); return t; }
__device__ __forceinline__ bf16_t f2bf(float f) { unsigned u = __float_as_uint(f); u += 0x7FFFu + ((u >> 16) & 1u); return (bf16_t)(u >> 16); }
__device__ __forceinline__ float bf2f(bf16_t b) { return __uint_as_float(((unsigned)b) << 16); }
typedef float f32x2_t __attribute__((ext_vector_type(2)));
typedef __bf16 bf16x2_t __attribute__((ext_vector_type(2)));
__device__ __forceinline__ unsigned pack2(float a, float b) { const f32x2_t v = {a, b}; const bf16x2_t r = __builtin_convertvector(v, bf16x2_t); return __builtin_bit_cast(unsigned, r); }
__device__ __forceinline__ float4 load4bf(const bf16_t* p) { const uint2 w = *(const uint2*)p; float4 r; r.x = __uint_as_float(w.x << 16); r.y = __uint_as_float(w.x & 0xffff0000u); r.z = __uint_as_float(w.y << 16); r.w = __uint_as_float(w.y & 0xffff0000u); return r; }
__device__ __forceinline__ float wave_sum(float v) { for (int o = 32; o > 0; o >>= 1) v += __shfl_xor(v, o); return v; }
__device__ __forceinline__ float wave_max(float v) { for (int o = 32; o > 0; o >>= 1) v = fmaxf(v, __shfl_xor(v, o)); return v; }
__device__ __forceinline__ int tok_variant(int t) { return t < T_LAT ? (t >> 13) : 4; }

__device__ __forceinline__ void phase_mod(ParamsC p, float* smem) {
    const int tid = ltid(), lane = tid & 63, wid = tid >> 6;
    float* s_silu = smem;
    float* s_part = smem + 5 * 1024;
    for (int i = tid; i < 5 * 1024; i += NTHR) { const int v = i >> 10, k = i & 1023; const float cv = v < 4 ? p->c[v * 1024 + k] : p->c_ctx[k]; s_silu[i] = cv / (1.0f + expf(-cv)); }
    __syncthreads();
    for (int item = lbid(); item < DEPTH * 96; item += gridDim.x) {
        const int l = item / 96, cb = item % 96, col = cb * 64 + lane;
        const float* w = p->w_mod + (size_t)l * 1024 * 6144 + col;
        float a0 = 0.f, a1 = 0.f, a2 = 0.f, a3 = 0.f, a4 = 0.f;
#pragma unroll 8
        for (int kk = 0; kk < 128; ++kk) { const int k = wid * 128 + kk; const float wv = w[(size_t)k * 6144];
            a0 += s_silu[k] * wv; a1 += s_silu[1024 + k] * wv; a2 += s_silu[2048 + k] * wv; a3 += s_silu[3072 + k] * wv; a4 += s_silu[4096 + k] * wv; }
        s_part[(wid * 5 + 0) * 64 + lane] = a0; s_part[(wid * 5 + 1) * 64 + lane] = a1; s_part[(wid * 5 + 2) * 64 + lane] = a2; s_part[(wid * 5 + 3) * 64 + lane] = a3; s_part[(wid * 5 + 4) * 64 + lane] = a4;
        __syncthreads();
        if (tid < 320) { const int v = tid >> 6, ln = tid & 63; float s = p->b_mod[l * 6144 + cb * 64 + ln];
            for (int w8 = 0; w8 < 8; ++w8) s += s_part[(w8 * 5 + v) * 64 + ln];
            p->modv[(size_t)(l * 5 + v) * 6144 + cb * 64 + ln] = s; }
        __syncthreads();
    }
    if (lbid() < 4) { const int i = lbid() * NTHR + tid; const int pos = i >> 4, f = i & 15;
        const float inv = powf(10000.0f, -(float)f / 16.0f); const float ang = (float)pos * inv; p->ropet[i * 2] = cosf(ang); p->ropet[i * 2 + 1] = sinf(ang); }
}

#define GU_IG 128
struct WcTile { const float* src; bf16_t* dst; int ldN, ldK, kt, nt, kind, e; };
__device__ __forceinline__ WcTile wconv_decode(ParamsC p, int l, int it) {
    const int n1 = 16 * 88, n2 = 256, n3 = 256, n4 = 2048, n5 = 2048;
    WcTile w; w.kind = 0; w.e = 0; int i = it;
    if (i < n1) { w.src = p->w_in + (size_t)l * 1024 * IN_COLS; w.ldN = IN_COLS; w.dst = WSEL(wt_in, l); w.ldK = 1024; w.kt = i / 88; w.nt = i % 88; }
    else if ((i -= n1) < n2) { w.src = p->w_branch + (size_t)l * 1024 * 1024; w.ldN = 1024; w.dst = WSEL(wt_br, l); w.ldK = 1024; w.kt = i / 16; w.nt = i % 16; }
    else if ((i -= n2) < n3) { w.src = p->w_o + (size_t)l * 1024 * 1024; w.ldN = 1024; w.dst = WSEL(wt_o, l); w.ldK = 1024; w.kt = i / 16; w.nt = i % 16; }
    else if ((i -= n3) < n4) { w.e = i / 64; i %= 64; w.src = p->w_eg + ((size_t)l * 32 + w.e) * 1024 * 256; w.ldN = 256; w.dst = WSEL(wt_gu, l); w.ldK = 1024; w.kt = i / 4; w.nt = i % 4; w.kind = 1; }
    else if ((i -= n4) < n5) { w.e = i / 64; i %= 64; w.src = p->w_eu + ((size_t)l * 32 + w.e) * 1024 * 256; w.ldN = 256; w.dst = WSEL(wt_gu, l); w.ldK = 1024; w.kt = i / 4; w.nt = i % 4; w.kind = 2; }
    else { i -= n5; w.e = i / 64; i %= 64; w.src = p->w_ed + ((size_t)l * 32 + w.e) * 256 * 1024; w.ldN = 1024; w.dst = WSEL(wt_d, l) + (size_t)w.e * 1024 * 256; w.ldK = 256; w.kt = i / 16; w.nt = i % 16; }
    return w;
}
#define WC_TOTAL (16 * 88 + 256 + 256 + 2048 * 3)
__device__ __forceinline__ void phase_wconv(ParamsC p, int l, float* smem, int lo, int hi, int first, int stride) {
    const int tid = ltid();
    float* tile = smem;
    const int r = tid >> 4, c4 = tid & 15;
    int it = lo + first; if (it >= hi) return;
    WcTile w = wconv_decode(p, l, it);
    float4 v0 = *(const float4*)(w.src + (size_t)(w.kt * 64 + r) * w.ldN + w.nt * 64 + c4 * 4), v1 = *(const float4*)(w.src + (size_t)(w.kt * 64 + r + 32) * w.ldN + w.nt * 64 + c4 * 4);
    for (;;) {
        tile[r * 65 + c4 * 4 + 0] = v0.x; tile[r * 65 + c4 * 4 + 1] = v0.y; tile[r * 65 + c4 * 4 + 2] = v0.z; tile[r * 65 + c4 * 4 + 3] = v0.w;
        tile[(r + 32) * 65 + c4 * 4 + 0] = v1.x; tile[(r + 32) * 65 + c4 * 4 + 1] = v1.y; tile[(r + 32) * 65 + c4 * 4 + 2] = v1.z; tile[(r + 32) * 65 + c4 * 4 + 3] = v1.w;
        __syncthreads();
        const int nit = it + stride; WcTile wn = w;
        if (nit < hi) { wn = wconv_decode(p, l, nit);
            v0 = *(const float4*)(wn.src + (size_t)(wn.kt * 64 + r) * wn.ldN + wn.nt * 64 + c4 * 4); v1 = *(const float4*)(wn.src + (size_t)(wn.kt * 64 + r + 32) * wn.ldN + wn.nt * 64 + c4 * 4); }
        {   const int n = tid >> 3, kc = tid & 7; const int ncol = w.nt * 64 + n; int drow = ncol;
            if (w.kind) drow = w.e * 512 + (ncol / GU_IG) * (2 * GU_IG) + (w.kind == 2 ? GU_IG : 0) + (ncol % GU_IG);
            uint4 o; o.x = pack2(tile[(kc * 8 + 0) * 65 + n], tile[(kc * 8 + 1) * 65 + n]); o.y = pack2(tile[(kc * 8 + 2) * 65 + n], tile[(kc * 8 + 3) * 65 + n]);
            o.z = pack2(tile[(kc * 8 + 4) * 65 + n], tile[(kc * 8 + 5) * 65 + n]); o.w = pack2(tile[(kc * 8 + 6) * 65 + n], tile[(kc * 8 + 7) * 65 + n]);
            *(uint4*)(w.dst + (size_t)drow * w.ldK + w.kt * 64 + kc * 8) = o; }
        __syncthreads();
        if (nit >= hi) break;
        it = nit; w = wn;
    }
}

__device__ __forceinline__ void phase_norm1(ParamsC p, int l) {
    const int tid = ltid(), lane = tid & 63, wid = tid >> 6;
    const int ntok = (l == DEPTH) ? T_LAT : T_ALL;
    for (int t = lbid() * 8 + wid; t < ntok; t += gridDim.x * 8) {
        const int v = tok_variant(t);
        float4 xv[4];
        if (l == 0) {
            const float* src = t < T_LAT ? p->x + (size_t)t * 1024 : p->ctx + (size_t)(t - T_LAT) * 1024;
#pragma unroll
            for (int i = 0; i < 4; ++i) xv[i] = *(const float4*)(src + i * 256 + lane * 4);
        } else {
            const bf16_t* src = p->xs + (size_t)t * 1024;
#pragma unroll
            for (int i = 0; i < 4; ++i) xv[i] = load4bf(src + i * 256 + lane * 4);
            const bool had_moe = (l - 1 < DEPTH - 1) || t < T_LAT;
            if (had_moe) {
                const int s0 = p->slot[t * 2], s1 = p->slot[t * 2 + 1]; const float w0 = p->ewt[t * 2], w1 = p->ewt[t * 2 + 1];
                const float* gt = p->modv + (size_t)((l - 1) * 5 + v) * 6144 + 5120;
#pragma unroll
                for (int i = 0; i < 4; ++i) { const int c = i * 256 + lane * 4;
                    const uint2 y0 = *(const uint2*)(p->Y + (size_t)s0 * 1024 + c), y1 = *(const uint2*)(p->Y + (size_t)s1 * 1024 + c);
                    const float4 g = *(const float4*)(gt + c);
                    xv[i].x += g.x * (w0 * bf2f((bf16_t)(y0.x & 0xffff)) + w1 * bf2f((bf16_t)(y1.x & 0xffff)));
                    xv[i].y += g.y * (w0 * bf2f((bf16_t)(y0.x >> 16)) + w1 * bf2f((bf16_t)(y1.x >> 16)));
                    xv[i].z += g.z * (w0 * bf2f((bf16_t)(y0.y & 0xffff)) + w1 * bf2f((bf16_t)(y1.y & 0xffff)));
                    xv[i].w += g.w * (w0 * bf2f((bf16_t)(y0.y >> 16)) + w1 * bf2f((bf16_t)(y1.y >> 16))); }
            }
        }
        float ss = 0.f;
#pragma unroll
        for (int i = 0; i < 4; ++i) ss += xv[i].x * xv[i].x + xv[i].y * xv[i].y + xv[i].z * xv[i].z + xv[i].w * xv[i].w;
        ss = wave_sum(ss);
        const float rstd = rsqrtf(ss * (1.0f / 1024.0f) + 1e-6f);
        if (l == DEPTH) {
#pragma unroll
            for (int i = 0; i < 4; ++i) { const int c = i * 256 + lane * 4; const float4 g = *(const float4*)(p->g_final + c);
                float4 o; o.x = xv[i].x * rstd * g.x; o.y = xv[i].y * rstd * g.y; o.z = xv[i].z * rstd * g.z; o.w = xv[i].w * rstd * g.w;
                *(float4*)(p->out + (size_t)t * 1024 + c) = o; }
        } else {
            const float* mv = p->modv + (size_t)(l * 5 + v) * 6144;
#pragma unroll
            for (int i = 0; i < 4; ++i) { const int c = i * 256 + lane * 4;
                { uint2 xo; xo.x = pack2(xv[i].x, xv[i].y); xo.y = pack2(xv[i].z, xv[i].w); *(uint2*)(p->xs + (size_t)t * 1024 + c) = xo; }
                const float4 g = *(const float4*)(p->g_attn + l * 1024 + c), sh = *(const float4*)(mv + c), sc = *(const float4*)(mv + 1024 + c);
                uint2 o; o.x = pack2(xv[i].x * rstd * g.x * (1.f + sc.x) + sh.x, xv[i].y * rstd * g.y * (1.f + sc.y) + sh.y);
                o.y = pack2(xv[i].z * rstd * g.z * (1.f + sc.z) + sh.z, xv[i].w * rstd * g.w * (1.f + sc.w) + sh.w);
                *(uint2*)(p->h + (size_t)t * 1024 + c) = o; }
        }
    }
}

__device__ __forceinline__ void store4bf(bf16_t* dst, f32x4 v) { uint2 o; o.x = pack2(v[0], v[1]); o.y = pack2(v[2], v[3]); *(uint2*)dst = o; }


namespace pg8 {
#define PG8_LAS __attribute__((address_space(3)))
typedef unsigned u32x4 __attribute__((ext_vector_type(4)));
constexpr int BM = 256, BK = 64, HALF = 128, HTB = HALF * BK * 2, STAGE_BYTES = 8 * HTB, NXCD = 8, WGM = 8;
__host__ __device__ __forceinline__ int lds_byte(int r, int c) { const int st = (r >> 4) * 2 + (c >> 5), rr = r & 15, cc = c & 31, ob = rr * 64 + cc * 2; return st * 1024 + (ob ^ (((ob >> 9) & 1) << 5)); }
__host__ __device__ __forceinline__ void stage_rc(int b, int& R, int& C) { const int st = b / 1024, sb = b % 1024, swz = sb ^ (((sb >> 9) & 1) << 5); R = (st >> 1) * 16 + swz / 64; C = (st & 1) * 32 + (swz % 64) / 2; }
__host__ __device__ __forceinline__ int perm32(int rho) { const int n = rho >> 4, i = rho & 15; return 8 * (i >> 2) + 4 * n + (i & 3); }
struct Unit { int pm, pn; };
struct Gemm { const bf16_t* A; const bf16_t* Bt; int M, N, K; const int* rowmap; };
struct StaticOrder {
    int nM, nN, nwg, G, c;
    __device__ void init(int M, int N, int G_, int c_) { nM = M / BM; nN = N / BM; nwg = nM * nN; G = G_; c = c_; }
    __device__ bool next(int i, Unit& u) const {
        const long L = (long)i * G + c; if (L >= nwg) return false;
        int wgid = (int)L; { const int q = nwg / NXCD, r = nwg % NXCD, xcd = wgid % NXCD, off = wgid / NXCD; wgid = (xcd < r ? xcd * (q + 1) : r * (q + 1) + (xcd - r) * q) + off; }
        const int nig = WGM * nN, gid = wgid / nig, fm = gid * WGM, gsz = (nM - fm) < WGM ? (nM - fm) : WGM;
        u.pm = fm + ((wgid % nig) % gsz); u.pn = (wgid % nig) / gsz; return true;
    }
    __device__ __forceinline__ void a_ready(const Unit&) const {}
    __device__ __forceinline__ void done(const Unit&) const {}
};
template <int NT> struct GroupedOrder {
    const int* blk_e; int nunits, G, c;
    __device__ bool next(int i, Unit& u) const { const long L = (long)i * G + c; if (L >= nunits) return false; const int rb = (int)L / NT; u.pm = rb; u.pn = blk_e[rb] * NT + (int)L % NT; return true; }
    __device__ __forceinline__ void a_ready(const Unit&) const {}
    __device__ __forceinline__ void done(const Unit&) const {}
};
template <class Epi, class Sched, bool ALIGN_EPI = false, bool SP2 = false, bool GATHER = false>
__device__ __forceinline__ void gemm_phase(PG8_LAS unsigned char* lds, const Gemm g, const Sched& S, const Epi& E) {
    const int tid = ltid(), wid = __builtin_amdgcn_readfirstlane(tid >> 6), lane = tid & 63, wr = wid >> 2, wc = wid & 3, fr = lane & 15, fq = lane >> 4;
    int K = g.K; asm volatile("" : "+s"(K)); const int nt = K / BK;
    unsigned voffA[2], voffB[2];
#pragma unroll
    for (int i = 0; i < 2; ++i) { int R, C; stage_rc(tid * 16 + i * 8192, R, C); const int Rb = Epi::PERM ? ((R & ~31) + perm32(R & 31)) : R;
        voffA[i] = (unsigned)(R * K + C) * 2u; voffB[i] = (unsigned)(Rb * K + C) * 2u; }
    const size_t kstep = (size_t)(BK * 2);
    const size_t hstep = (size_t)HALF * K * 2;
    const size_t tstep = 2 * hstep;
    const unsigned ldsw = (unsigned)wid * 1024u;
    const int aoff = lds_byte(wr * 64 + fr, fq * 8), boff = lds_byte(wc * 32 + fr, fq * 8);
#define PG8_SA(b, h) (((b) * 2 + (h)) * HTB)
#define PG8_SB(b, h) ((4 + (b) * 2 + (h)) * HTB)
#define PG8_STAGE(bufoff, gbase, voff) do { _Pragma("unroll") for (int _i = 0; _i < 2; ++_i) \
        __builtin_amdgcn_global_load_lds((const unsigned*)((const char*)(gbase) + (voff)[_i]), (PG8_LAS unsigned*)(lds + (bufoff) + ldsw + _i * 8192), 16, 0, 0); } while (0)
#define PG8_STAGE_A(bufoff, gptr, hf) do { if constexpr (GATHER) { _Pragma("unroll") for (int _i = 0; _i < 2; ++_i) \
        __builtin_amdgcn_global_load_lds((const unsigned*)((const char*)(gptr) + gC[hf][_i]), (PG8_LAS unsigned*)(lds + (bufoff) + ldsw + _i * 8192), 16, 0, 0); } \
        else { PG8_STAGE(bufoff, (gptr) + (hf) * hstep, voffA); } } while (0)
#define PG8_LOAD_GOFF(pm_) do { _Pragma("unroll") for (int _h = 0; _h < 2; ++_h) _Pragma("unroll") for (int _i = 0; _i < 2; ++_i) { int R_, C_; stage_rc(tid * 16 + _i * 8192, R_, C_); \
        gC[_h][_i] = (unsigned)(g.rowmap[(pm_) * 256 + _h * 128 + R_] * K + C_) * 2u; } } while (0)
#define PG8_LDA(dst, b, h) do { _Pragma("unroll") for (int m = 0; m < 4; ++m) _Pragma("unroll") for (int k = 0; k < 2; ++k) dst[m][k] = *(const PG8_LAS bf16x8*)(lds + PG8_SA(b, h) + aoff + m * 2048 + k * 1024); } while (0)
#define PG8_LDB(dst, b, h) do { _Pragma("unroll") for (int n = 0; n < 2; ++n) _Pragma("unroll") for (int k = 0; k < 2; ++k) dst[n][k] = *(const PG8_LAS bf16x8*)(lds + PG8_SB(b, h) + boff + n * 2048 + k * 1024); } while (0)
#define PG8_MMA(ai, bj, At, Bt) do { __builtin_amdgcn_s_setprio(1); _Pragma("unroll") for (int m = 0; m < 4; ++m) _Pragma("unroll") for (int n = 0; n < 2; ++n) _Pragma("unroll") for (int k = 0; k < 2; ++k) \
        acc[ai][bj][m][n] = __builtin_amdgcn_mfma_f32_16x16x32_bf16(Bt[n][k], At[m][k], acc[ai][bj][m][n], 0, 0, 0); __builtin_amdgcn_s_setprio(0); } while (0)
#define PG8_WAIT_V(n) asm volatile("s_waitcnt vmcnt(" #n ")" ::: "memory")
#define PG8_WAIT_L(n) asm volatile("s_waitcnt lgkmcnt(" #n ")" ::: "memory")
#define PG8_BAR __builtin_amdgcn_s_barrier()
#define PG8_SCHED __builtin_amdgcn_sched_barrier(0)
    Unit cur, nxt; int ui = 0;
    if (!S.next(0, cur)) return;
    f32x4 acc[2][2][4][2];
#pragma unroll
    for (int a = 0; a < 2; ++a)
#pragma unroll
        for (int b = 0; b < 2; ++b)
#pragma unroll
            for (int m = 0; m < 4; ++m)
#pragma unroll
                for (int n = 0; n < 2; ++n) acc[a][b][m][n] = (f32x4){0.f, 0.f, 0.f, 0.f};
    bf16x8 At[4][2], B0[2][2], B1[2][2];
    const char* cA = (const char*)g.A + (GATHER ? (size_t)0 : (size_t)cur.pm * tstep); const char* cB = (const char*)g.Bt + (size_t)cur.pn * tstep;
    unsigned gC[2][2] = {{0u, 0u}, {0u, 0u}};
    S.a_ready(cur);
    if constexpr (GATHER) PG8_LOAD_GOFF(cur.pm);
    if constexpr (SP2) {
        PG8_STAGE(PG8_SB(0, 0), cB, voffB); PG8_STAGE(PG8_SB(0, 1), cB + hstep, voffB); PG8_STAGE_A(PG8_SA(0, 0), cA, 0); PG8_STAGE_A(PG8_SA(0, 1), cA, 1);
        if (wr == 1) PG8_BAR;
        PG8_WAIT_V(2); PG8_BAR;
        PG8_STAGE(PG8_SB(1, 0), cB + kstep, voffB); PG8_STAGE_A(PG8_SA(1, 0), cA + kstep, 0); PG8_STAGE(PG8_SB(1, 1), cB + hstep + kstep, voffB);
        PG8_WAIT_V(6); PG8_BAR;
    } else {
        PG8_STAGE(PG8_SB(0, 0), cB, voffB); PG8_STAGE_A(PG8_SA(0, 0), cA, 0); PG8_STAGE(PG8_SB(0, 1), cB + hstep, voffB); PG8_STAGE_A(PG8_SA(0, 1), cA, 1);
        if (wr == 1) PG8_BAR;
        PG8_WAIT_V(4); PG8_BAR;
        PG8_STAGE(PG8_SB(1, 0), cB + kstep, voffB); PG8_STAGE_A(PG8_SA(1, 0), cA + kstep, 0); PG8_STAGE(PG8_SB(1, 1), cB + hstep + kstep, voffB);
        PG8_WAIT_V(6); PG8_BAR;
    }
    for (;;) {
        const bool has_next = S.next(ui + 1, nxt);
        const char* nA = (has_next && !GATHER) ? (const char*)g.A + (size_t)nxt.pm * tstep : cA; const char* nB = has_next ? (const char*)g.Bt + (size_t)nxt.pn * tstep : cB;
        for (int t = 0; t < nt; t += 2) {
            const bool last = (t == nt - 2);
            const char* a1 = cA + (size_t)(t + 1) * kstep;
            const char* a2 = last ? nA : cA + (size_t)(t + 2) * kstep; const char* b2 = last ? nB : cB + (size_t)(t + 2) * kstep;
            const char* a3 = a2 + kstep; const char* b3 = b2 + kstep;
            if (last && has_next) S.a_ready(nxt);
            if constexpr (SP2) {
            PG8_LDB(B0, 0, 0); PG8_LDB(B1, 0, 1); PG8_SCHED; PG8_LDA(At, 0, 0); PG8_STAGE_A(PG8_SA(1, 1), a1, 1); if constexpr (GATHER) { if (last && has_next) PG8_LOAD_GOFF(nxt.pm); }
            PG8_WAIT_V(8); PG8_WAIT_L(0); PG8_BAR; PG8_MMA(0, 0, At, B0); PG8_MMA(0, 1, At, B1); PG8_BAR; PG8_SCHED;
            PG8_LDA(At, 0, 1); PG8_STAGE(PG8_SB(0, 0), b2, voffB); PG8_STAGE(PG8_SB(0, 1), b2 + hstep, voffB); PG8_STAGE_A(PG8_SA(0, 0), a2, 0);
            PG8_WAIT_V(8); PG8_WAIT_L(0); PG8_BAR; PG8_MMA(1, 0, At, B0); PG8_MMA(1, 1, At, B1); PG8_BAR; PG8_SCHED;
            PG8_LDB(B0, 1, 0); PG8_LDB(B1, 1, 1); PG8_SCHED; PG8_LDA(At, 1, 0); PG8_STAGE_A(PG8_SA(0, 1), a2, 1);
            PG8_WAIT_V(8); PG8_WAIT_L(0); PG8_BAR; PG8_MMA(0, 0, At, B0); PG8_MMA(0, 1, At, B1); PG8_BAR; PG8_SCHED;
            PG8_LDA(At, 1, 1); PG8_STAGE(PG8_SB(1, 0), b3, voffB); PG8_STAGE(PG8_SB(1, 1), b3 + hstep, voffB); PG8_STAGE_A(PG8_SA(1, 0), a3, 0);
            PG8_WAIT_V(8); PG8_WAIT_L(0); PG8_BAR; PG8_MMA(1, 0, At, B0); PG8_MMA(1, 1, At, B1); PG8_BAR; PG8_SCHED;
            } else {
            PG8_LDB(B0, 0, 0); PG8_SCHED; PG8_LDA(At, 0, 0); PG8_STAGE_A(PG8_SA(1, 1), a1, 1); if constexpr (GATHER) { if (last && has_next) PG8_LOAD_GOFF(nxt.pm); }
            PG8_WAIT_L(8); PG8_BAR; PG8_WAIT_L(0); PG8_MMA(0, 0, At, B0); PG8_BAR; PG8_SCHED;
            PG8_LDB(B1, 0, 1); PG8_STAGE(PG8_SB(0, 0), b2, voffB);
            PG8_BAR; PG8_WAIT_L(0); PG8_MMA(0, 1, At, B1); PG8_BAR;
            PG8_LDA(At, 0, 1); PG8_STAGE_A(PG8_SA(0, 0), a2, 0);
            PG8_BAR; PG8_WAIT_L(0); PG8_MMA(1, 0, At, B0); PG8_BAR; PG8_SCHED;
            PG8_STAGE(PG8_SB(0, 1), b2 + hstep, voffB);
            PG8_WAIT_V(6); PG8_BAR; PG8_MMA(1, 1, At, B1); PG8_BAR;
            PG8_LDB(B0, 1, 0); PG8_SCHED; PG8_LDA(At, 1, 0); PG8_STAGE_A(PG8_SA(0, 1), a2, 1);
            PG8_WAIT_L(8); PG8_BAR; PG8_WAIT_L(0); PG8_MMA(0, 0, At, B0); PG8_BAR; PG8_SCHED;
            PG8_LDB(B1, 1, 1); PG8_STAGE(PG8_SB(1, 0), b3, voffB);
            PG8_BAR; PG8_WAIT_L(0); PG8_MMA(0, 1, At, B1); PG8_BAR;
            PG8_LDA(At, 1, 1); PG8_STAGE_A(PG8_SA(1, 0), a3, 0);
            PG8_BAR; PG8_WAIT_L(0); PG8_MMA(1, 0, At, B0); PG8_BAR; PG8_SCHED;
            PG8_STAGE(PG8_SB(1, 1), b3 + hstep, voffB);
            PG8_WAIT_V(6); PG8_BAR; PG8_MMA(1, 1, At, B1); PG8_BAR;
            }
            if constexpr (Epi::HOOK) { if (t == 2 || t == 8) E.hook(acc, cur, t, wr, wc, fr, fq); }
        }
        if constexpr (ALIGN_EPI) { if (wr == 0) PG8_BAR; }
        if constexpr (!Epi::AFTER_DRAIN) { E(acc, cur, wr, wc, fr, fq); S.done(cur); }
        if (!has_next) break;
#pragma unroll
        for (int a = 0; a < 2; ++a)
#pragma unroll
            for (int b = 0; b < 2; ++b)
#pragma unroll
                for (int m = 0; m < 4; ++m)
#pragma unroll
                    for (int n = 0; n < 2; ++n) acc[a][b][m][n] = (f32x4){0.f, 0.f, 0.f, 0.f};
        cur = nxt; cA = nA; cB = nB; ++ui;
        if constexpr (ALIGN_EPI) { if (wr == 1) PG8_BAR; }
    }
    PG8_WAIT_V(0);
    if constexpr (!ALIGN_EPI) { if (wr == 0) PG8_BAR; }
    PG8_BAR;
    if constexpr (Epi::AFTER_DRAIN) { E.fused(acc, cur, wr, wc, fr, fq, lds, wid, lane); S.done(cur); }
#undef PG8_SA
#undef PG8_SB
#undef PG8_STAGE
#undef PG8_LDA
#undef PG8_STAGE_A
#undef PG8_LOAD_GOFF
#undef PG8_LDB
#undef PG8_MMA
#undef PG8_WAIT_V
#undef PG8_WAIT_L
#undef PG8_BAR
#undef PG8_SCHED
}

}
__device__ __forceinline__ pg8::u32x4 pack8(const f32x4& a, const f32x4& b) { pg8::u32x4 w; w.x = pack2(a[0], a[1]); w.y = pack2(a[2], a[3]); w.z = pack2(b[0], b[1]); w.w = pack2(b[2], b[3]); return w; }
__device__ __forceinline__ void unpack8(const pg8::u32x4& w, f32x4& a, f32x4& b) {
    a[0] = __uint_as_float(w.x << 16); a[1] = __uint_as_float(w.x & 0xffff0000u); a[2] = __uint_as_float(w.y << 16); a[3] = __uint_as_float(w.y & 0xffff0000u);
    b[0] = __uint_as_float(w.z << 16); b[1] = __uint_as_float(w.z & 0xffff0000u); b[2] = __uint_as_float(w.w << 16); b[3] = __uint_as_float(w.w & 0xffff0000u); }


typedef float f32x16 __attribute__((ext_vector_type(16)));
typedef short s16x4 __attribute__((ext_vector_type(4)));
#define AT_STRIDE 144
#define AT_KBUF(b) ((b) * 18432)
#define AT_VBUF(b) (36864 + (b) * 18432)
#define LOG2E 1.4426950408889634f
#define AT_NEG (-1.0e30f)
#define AT_THR 16.0f

__device__ __forceinline__ void attn_tile(const unsigned char* kt, const unsigned char* vlane, const bf16x8 (&qf)[4], f32x16 (&oacc)[2], float& m, float& lsum, int mk, int lane) {
    const int n = lane & 31, hh = lane >> 5;
    f32x16 sc;
#pragma unroll
    for (int r = 0; r < 16; ++r) sc[r] = 0.f;
#pragma unroll
    for (int sp = 0; sp < 4; ++sp) { const bf16x8 kf = *(const bf16x8*)(kt + n * AT_STRIDE + sp * 32 + hh * 16); sc = __builtin_amdgcn_mfma_f32_32x32x16_bf16(kf, qf[sp], sc, 0, 0, 0); }
    if (mk != 0) {
#pragma unroll
        for (int r = 0; r < 16; ++r) { const int i = (r & 3) + 8 * (r >> 2) + 4 * hh; const bool ok = (mk == 2) ? (i >= n) : (i <= n); sc[r] = ok ? sc[r] : AT_NEG; } }
    float mx = AT_NEG;
#pragma unroll
    for (int r = 0; r < 16; ++r) mx = fmaxf(mx, sc[r]);
    float mn = m;
    if (__any(mx > m + AT_THR)) { mx = fmaxf(mx, __shfl_xor(mx, 32)); mn = fmaxf(m, mx); }
    {   const float alpha = __builtin_amdgcn_exp2f(m - mn); lsum *= alpha; m = mn;
#pragma unroll
        for (int r = 0; r < 16; ++r) { oacc[0][r] *= alpha; oacc[1][r] *= alpha; } }
    float ps = 0.f;
#pragma unroll
    for (int r = 0; r < 16; ++r) { const float pv = __builtin_amdgcn_exp2f(sc[r] - m); sc[r] = pv; ps += pv; }
    lsum += ps;
    bf16x8 pf[2];
#pragma unroll
    for (int s2 = 0; s2 < 2; ++s2) { pg8::u32x4 w; w.x = pack2(sc[s2 * 8 + 0], sc[s2 * 8 + 1]); w.y = pack2(sc[s2 * 8 + 2], sc[s2 * 8 + 3]); w.z = pack2(sc[s2 * 8 + 4], sc[s2 * 8 + 5]); w.w = pack2(sc[s2 * 8 + 6], sc[s2 * 8 + 7]);
        pf[s2] = __builtin_bit_cast(bf16x8, w); }
#pragma unroll
    for (int c = 0; c < 2; ++c)
#pragma unroll
        for (int s2 = 0; s2 < 2; ++s2) {
            const s16x4 v0 = __builtin_amdgcn_ds_read_tr16_b64_v4i16((LAS s16x4*)(vlane + (16 * s2) * AT_STRIDE + 64 * c));
            const s16x4 v1 = __builtin_amdgcn_ds_read_tr16_b64_v4i16((LAS s16x4*)(vlane + (16 * s2 + 8) * AT_STRIDE + 64 * c));
            bf16x8 vf; vf[0] = v0[0]; vf[1] = v0[1]; vf[2] = v0[2]; vf[3] = v0[3]; vf[4] = v1[0]; vf[5] = v1[1]; vf[6] = v1[2]; vf[7] = v1[3];
            oacc[c] = __builtin_amdgcn_mfma_f32_32x32x16_bf16(vf, pf[s2], oacc[c], 0, 0, 0);
        }
}

#define AT_LOAD(...) AT_LOAD_(__VA_ARGS__)
#define AT_STORE(...) AT_STORE_(__VA_ARGS__)
#define AT_LOAD_(K0, V0, K1, V1, tok0) do { const bf16_t* src_ = uA + (size_t)((tok0) + skey) * UA_LD + sch * 8; K0 = *(const uint4*)(src_ + kcol); V0 = *(const uint4*)(src_ + vcol); \
        K1 = *(const uint4*)(src_ + 64 * UA_LD + kcol); V1 = *(const uint4*)(src_ + 64 * UA_LD + vcol); } while (0)
#define AT_STORE_(K0, V0, K1, V1, bb) do { *(uint4*)(smem + AT_KBUF(bb) + soff) = K0; *(uint4*)(smem + AT_VBUF(bb) + soff) = V0; \
        *(uint4*)(smem + AT_KBUF(bb) + soff + 64 * AT_STRIDE) = K1; *(uint4*)(smem + AT_VBUF(bb) + soff + 64 * AT_STRIDE) = V1; } while (0)
#define AT_S0 ak0, av0, ak1, av1
#define AT_S1 bk0, bv0, bk1, bv1
template <int MODE>
__device__ __forceinline__ void attn_unit(ParamsC p, int l, int u, unsigned char* smem) {
    const int tid = ltid(), lane = tid & 63, wid = tid >> 6;
    int b, qcol, kcol, vcol, ocol, qtok; bool has_sink = false; float sinkv = 0.f;
    int nsteps, q0 = 0, jwlo = 0;
    if (MODE == 1) { b = u / 192; const int rem = u % 192, hq = rem / 32, qb = rem % 32, kh = hq / 3; qcol = 1920 + hq * 64; kcol = 2304 + kh * 64; vcol = 2432 + kh * 64; ocol = 640 + hq * 64;
        q0 = qb * 256; jwlo = (q0 == 0) ? 1 : 0; const int jwhi = min(4, (SEQ - q0 + 128) / 128); nsteps = 2 + (jwhi - jwlo);
        qtok = b * SEQ + q0 + 32 * wid; has_sink = true; sinkv = p->sinks[l * 6 + hq];
    } else { b = u / 12; const int hh = u % 12;
        if (hh < 6) { qcol = 768 + hh * 64; kcol = 1152 + hh * 64; vcol = 1536 + hh * 64; ocol = 256 + hh * 64; }
        else { const int hq = hh - 6, kh = hq / 3; qcol = 1920 + hq * 64; kcol = 2304 + kh * 64; vcol = 2432 + kh * 64; ocol = 640 + hq * 64; has_sink = true; sinkv = p->sinks[l * 6 + hq]; }
        nsteps = 2; qtok = T_LAT + b * CTXL + 32 * wid;
    }
    const bf16_t* uA = p->uA;
    bf16x8 qf[4];
    {   const bf16_t* qp = uA + (size_t)(qtok + (lane & 31)) * UA_LD + qcol + (lane >> 5) * 8;
#pragma unroll
        for (int sp = 0; sp < 4; ++sp) qf[sp] = *(const bf16x8*)(qp + sp * 16); }
    f32x16 oacc[2];
#pragma unroll
    for (int r16 = 0; r16 < 16; ++r16) { oacc[0][r16] = 0.f; oacc[1][r16] = 0.f; }
    float m = has_sink ? sinkv * LOG2E : AT_NEG, lsum = (has_sink && lane < 32) ? 1.f : 0.f;
    const int skey = tid >> 3, sch = tid & 7; const int soff = skey * AT_STRIDE + sch * 16;
    auto chunk_tok = [&](int j) -> int { return (j < 2) ? (T_LAT + b * CTXL + 128 * j) : (b * SEQ + q0 - 128 + 128 * (jwlo + (j - 2))); };
    uint4 ak0, av0, ak1, av1, bk0, bv0, bk1, bv1;
    AT_LOAD(AT_S0, chunk_tok(0)); AT_STORE(AT_S0, 0);
    if (1 < nsteps) AT_LOAD(AT_S1, chunk_tok(1));
    if (2 < nsteps) AT_LOAD(AT_S0, chunk_tok(2));
    __syncthreads();
    const int vl_off = (4 * (lane >> 5) + ((lane & 15) >> 2)) * AT_STRIDE + (16 * ((lane >> 4) & 1) + 4 * (lane & 3)) * 2;
    for (int j = 0; j < nsteps; ++j) {
        const int buf = j & 1;
        if (j & 1) { if (j + 1 < nsteps) AT_STORE(AT_S0, 0); if (j + 3 < nsteps) AT_LOAD(AT_S0, chunk_tok(j + 3)); }
        else       { if (j + 1 < nsteps) AT_STORE(AT_S1, 1); if (j + 3 < nsteps) AT_LOAD(AT_S1, chunk_tok(j + 3)); }
        const unsigned char* kb = smem + AT_KBUF(buf); const unsigned char* vb = smem + AT_VBUF(buf) + vl_off;
#pragma unroll 2
        for (int tl = 0; tl < 4; ++tl) {
            bool act = true; int mk = 0;
            if (MODE == 1 && j >= 2) { const int d = (-128 + 128 * (jwlo + (j - 2)) + 32 * tl) - 32 * wid; act = (d >= -128 && d <= 128); mk = (d == -128) ? 2 : ((d == 128) ? 3 : 0); }
            if (act) attn_tile(kb + tl * 32 * AT_STRIDE, vb + tl * 32 * AT_STRIDE, qf, oacc, m, lsum, mk, lane); }
        __syncthreads();
    }
    const float ltot = lsum + __shfl_xor(lsum, 32); const float inv = 1.0f / ltot;
    bf16_t* op = p->ycat + (size_t)(qtok + (lane & 31)) * 1024 + ocol + 4 * (lane >> 5);
#pragma unroll
    for (int cc = 0; cc < 2; ++cc)
#pragma unroll
        for (int g = 0; g < 4; ++g) { f32x4 v; v[0] = oacc[cc][4 * g] * inv; v[1] = oacc[cc][4 * g + 1] * inv; v[2] = oacc[cc][4 * g + 2] * inv; v[3] = oacc[cc][4 * g + 3] * inv;
            store4bf(op + 32 * cc + 8 * g, v); }
}

#define NA_TBL 73728
#define NA_TROW 48
#define NA_TLEAD 16
__device__ __forceinline__ void na_softmax8(f32x4& s0, f32x4& s1, float& m, float& lsum, f32x4 (&oacc)[4], bf16x8& pf) {
    float mx = fmaxf(fmaxf(fmaxf(s0[0], s0[1]), fmaxf(s0[2], s0[3])), fmaxf(fmaxf(s1[0], s1[1]), fmaxf(s1[2], s1[3])));
    float mn = m;
    if (__any(mx > m + AT_THR)) { mx = fmaxf(mx, __shfl_xor(mx, 16)); mx = fmaxf(mx, __shfl_xor(mx, 32)); mn = fmaxf(m, mx); }
    {   const float alpha = __builtin_amdgcn_exp2f(m - mn); lsum *= alpha; m = mn;
#pragma unroll
        for (int db = 0; db < 4; ++db) oacc[db] = oacc[db] * alpha; }
#pragma unroll
    for (int e = 0; e < 4; ++e) { s0[e] = __builtin_amdgcn_exp2f(s0[e] - m); s1[e] = __builtin_amdgcn_exp2f(s1[e] - m); }
    lsum += (s0[0] + s0[1]) + (s0[2] + s0[3]) + (s1[0] + s1[1]) + (s1[2] + s1[3]);
    pg8::u32x4 w; w.x = pack2(s0[0], s0[1]); w.y = pack2(s0[2], s0[3]); w.z = pack2(s1[0], s1[1]); w.w = pack2(s1[2], s1[3]);
    pf = __builtin_bit_cast(bf16x8, w);
}
__device__ __forceinline__ void attn_unit_na(ParamsC p, int l, int u, unsigned char* smem) {
    const int tid = ltid(), lane = tid & 63, wid = tid >> 6, q16 = lane & 15, kg = lane >> 4;
    const int b = u / 192, rem = u % 192, h = rem / 32, rg = rem % 32;
    const int qcol = 768 + h * 64, kcol = 1152 + h * 64, vcol = 1536 + h * 64, ocol = 256 + h * 64;
    const int r = rg * 4 + (wid >> 1), qh = wid & 1, rs = min(max(r - 4, 0), 120);
    const int krlo = min(max(rg * 4 - 4, 0), 120), krhi = min(max(rg * 4 + 3 - 4, 0), 120) + 7, nsteps = 2 + (krhi - krlo + 2) / 2;
    const int qtok = b * SEQ + r * 64 + 32 * qh;
    const bf16_t* uA = p->uA;
    {   float* T = (float*)(smem + NA_TBL); const float* rp = p->rpb + ((size_t)l * 6 + h) * 465;
        for (int i = tid; i < NA_TLEAD + 16 * 15 * NA_TROW; i += NTHR) { float v = AT_NEG;
            if (i >= NA_TLEAD) { const int k = i - NA_TLEAD, j = k % NA_TROW, rr = (k / NA_TROW) % 15, dl = k / (NA_TROW * 15); if (j < 16) v = rp[rr * 31 + j + dl] * LOG2E; }
            T[i] = v; } }
    int kc0[2], tbase[2];
#pragma unroll
    for (int g2 = 0; g2 < 2; ++g2) { const int c = 32 * qh + 16 * g2 + q16, cs = min(max(c - 8, 0), 48), dl = cs - c + 15;
        kc0[g2] = (qh == 0) ? (g2 == 0 ? 0 : 8) : (g2 == 0 ? 24 : 32);
        tbase[g2] = NA_TLEAD + dl * (15 * NA_TROW) + (kc0[g2] - cs) + 4 * kg; }
    bf16x8 qf[2][2];
#pragma unroll
    for (int g2 = 0; g2 < 2; ++g2)
#pragma unroll
        for (int ds = 0; ds < 2; ++ds) qf[g2][ds] = *(const bf16x8*)(uA + (size_t)(qtok + 16 * g2 + q16) * UA_LD + qcol + ds * 32 + kg * 8);
    f32x4 oacc[2][4];
#pragma unroll
    for (int g2 = 0; g2 < 2; ++g2)
#pragma unroll
        for (int db = 0; db < 4; ++db) oacc[g2][db] = (f32x4){0.f, 0.f, 0.f, 0.f};
    float m[2] = {AT_NEG, AT_NEG}, lsum[2] = {0.f, 0.f};
    const int skey = tid >> 3, sch = tid & 7; const int soff = skey * AT_STRIDE + sch * 16;
    auto chunk_tok = [&](int j) -> int { return (j < 2) ? (T_LAT + b * CTXL + 128 * j) : (b * SEQ + (krlo + 2 * (j - 2)) * 64); };
    uint4 ak0, av0, ak1, av1, bk0, bv0, bk1, bv1;
    AT_LOAD(AT_S0, chunk_tok(0)); AT_STORE(AT_S0, 0);
    if (1 < nsteps) AT_LOAD(AT_S1, chunk_tok(1));
    if (2 < nsteps) AT_LOAD(AT_S0, chunk_tok(2));
    __syncthreads();
    const int ka_off = q16 * AT_STRIDE + kg * 16;
    const int va_off = (4 * kg + (q16 >> 2)) * AT_STRIDE + (4 * (q16 & 3)) * 2;
    const float* T = (const float*)(smem + NA_TBL);
    for (int j = 0; j < nsteps; ++j) {
        const int buf = j & 1;
        if (j & 1) { if (j + 1 < nsteps) AT_STORE(AT_S0, 0); if (j + 3 < nsteps) AT_LOAD(AT_S0, chunk_tok(j + 3)); }
        else       { if (j + 1 < nsteps) AT_STORE(AT_S1, 1); if (j + 3 < nsteps) AT_LOAD(AT_S1, chunk_tok(j + 3)); }
        const unsigned char* kb = smem + AT_KBUF(buf); const unsigned char* vb = smem + AT_VBUF(buf);
        if (j < 2) {
#pragma unroll
            for (int tp = 0; tp < 4; ++tp) {
                bf16x8 kf[2][2];
#pragma unroll
                for (int t = 0; t < 2; ++t)
#pragma unroll
                    for (int ds = 0; ds < 2; ++ds) kf[t][ds] = *(const bf16x8*)(kb + (32 * tp + 16 * t) * AT_STRIDE + ka_off + ds * 64);
                bf16x8 pf[2];
#pragma unroll
                for (int g2 = 0; g2 < 2; ++g2) { f32x4 s0 = (f32x4){0.f, 0.f, 0.f, 0.f}, s1 = s0;
                    s0 = __builtin_amdgcn_mfma_f32_16x16x32_bf16(kf[0][0], qf[g2][0], s0, 0, 0, 0); s0 = __builtin_amdgcn_mfma_f32_16x16x32_bf16(kf[0][1], qf[g2][1], s0, 0, 0, 0);
                    s1 = __builtin_amdgcn_mfma_f32_16x16x32_bf16(kf[1][0], qf[g2][0], s1, 0, 0, 0); s1 = __builtin_amdgcn_mfma_f32_16x16x32_bf16(kf[1][1], qf[g2][1], s1, 0, 0, 0);
                    na_softmax8(s0, s1, m[g2], lsum[g2], oacc[g2], pf[g2]); }
#pragma unroll
                for (int db = 0; db < 4; ++db) {
                    const s16x4 v0 = __builtin_amdgcn_ds_read_tr16_b64_v4i16((LAS s16x4*)(vb + (32 * tp) * AT_STRIDE + va_off + db * 32));
                    const s16x4 v1 = __builtin_amdgcn_ds_read_tr16_b64_v4i16((LAS s16x4*)(vb + (32 * tp + 16) * AT_STRIDE + va_off + db * 32));
                    bf16x8 vf; vf[0] = v0[0]; vf[1] = v0[1]; vf[2] = v0[2]; vf[3] = v0[3]; vf[4] = v1[0]; vf[5] = v1[1]; vf[6] = v1[2]; vf[7] = v1[3];
                    oacc[0][db] = __builtin_amdgcn_mfma_f32_16x16x32_bf16(vf, pf[0], oacc[0][db], 0, 0, 0); oacc[1][db] = __builtin_amdgcn_mfma_f32_16x16x32_bf16(vf, pf[1], oacc[1][db], 0, 0, 0); }
            }
        } else {
#pragma unroll
          for (int rr = 0; rr < 2; ++rr) { const int kr = krlo + 2 * (j - 2) + rr;
            if (kr >= rs && kr < rs + 8) { const int trow = (kr - r + 7) * NA_TROW;
#pragma unroll
                for (int g2 = 0; g2 < 2; ++g2) { const unsigned char* kt = kb + (rr * 64 + kc0[g2]) * AT_STRIDE; const unsigned char* vt = vb + (rr * 64 + kc0[g2]) * AT_STRIDE;
                    f32x4 s0 = (f32x4){0.f, 0.f, 0.f, 0.f}, s1 = s0;
#pragma unroll
                    for (int ds = 0; ds < 2; ++ds) { const bf16x8 k0 = *(const bf16x8*)(kt + ka_off + ds * 64), k1 = *(const bf16x8*)(kt + 16 * AT_STRIDE + ka_off + ds * 64);
                        s0 = __builtin_amdgcn_mfma_f32_16x16x32_bf16(k0, qf[g2][ds], s0, 0, 0, 0); s1 = __builtin_amdgcn_mfma_f32_16x16x32_bf16(k1, qf[g2][ds], s1, 0, 0, 0); }
                    const float* tp_ = T + tbase[g2] + trow;
#pragma unroll
                    for (int e = 0; e < 4; ++e) { s0[e] += tp_[e]; s1[e] += tp_[16 + e]; }
                    bf16x8 pf; na_softmax8(s0, s1, m[g2], lsum[g2], oacc[g2], pf);
#pragma unroll
                    for (int db = 0; db < 4; ++db) {
                        const s16x4 v0 = __builtin_amdgcn_ds_read_tr16_b64_v4i16((LAS s16x4*)(vt + va_off + db * 32));
                        const s16x4 v1 = __builtin_amdgcn_ds_read_tr16_b64_v4i16((LAS s16x4*)(vt + 16 * AT_STRIDE + va_off + db * 32));
                        bf16x8 vf; vf[0] = v0[0]; vf[1] = v0[1]; vf[2] = v0[2]; vf[3] = v0[3]; vf[4] = v1[0]; vf[5] = v1[1]; vf[6] = v1[2]; vf[7] = v1[3];
                        oacc[g2][db] = __builtin_amdgcn_mfma_f32_16x16x32_bf16(vf, pf, oacc[g2][db], 0, 0, 0); } }
            } }
        }
        __syncthreads();
    }
#pragma unroll
    for (int g2 = 0; g2 < 2; ++g2) { float lt = lsum[g2]; lt += __shfl_xor(lt, 16); lt += __shfl_xor(lt, 32); const float inv = 1.0f / lt;
        bf16_t* op = p->ycat + (size_t)(qtok + 16 * g2 + q16) * 1024 + ocol + 4 * kg;
#pragma unroll
        for (int db = 0; db < 4; ++db) store4bf(op + 16 * db, oacc[g2][db] * inv); }
}

__device__ __forceinline__ void phase_conv(ParamsC p, int l) {
    const int tid = ltid();
    const bool need_ctx = l < DEPTH - 1;
    {
        const int ntok = need_ctx ? T_ALL : T_LAT; const float* cw = p->conv_w + l * 3 * 256;
        for (int idx = lbid() * NTHR + tid; idx < ntok * 32; idx += gridDim.x * NTHR) { const int t = idx >> 5, c = (idx & 31) * 8;
            int pos, len; if (t < T_LAT) { pos = t & 8191; len = SEQ; } else { pos = (t - T_LAT) & 255; len = CTXL; }
            const bf16_t* u = p->uA + (size_t)t * UA_LD + c;
            const bool hp = pos > 0, hn = pos + 1 < len;
            const pg8::u32x4 zero4 = (pg8::u32x4){0u, 0u, 0u, 0u};
            const pg8::u32x4 h1 = *(const pg8::u32x4*)u, c1 = *(const pg8::u32x4*)(u + 512), b1 = *(const pg8::u32x4*)(u + 256);
            const pg8::u32x4 h0 = hp ? *(const pg8::u32x4*)(u - UA_LD) : zero4, c0 = hp ? *(const pg8::u32x4*)(u + 512 - UA_LD) : zero4;
            const pg8::u32x4 h2 = hn ? *(const pg8::u32x4*)(u + UA_LD) : zero4, c2 = hn ? *(const pg8::u32x4*)(u + 512 + UA_LD) : zero4;
            f32x4 w0a = *(const f32x4*)(cw + c), w0b = *(const f32x4*)(cw + c + 4), w1a = *(const f32x4*)(cw + 256 + c), w1b = *(const f32x4*)(cw + 256 + c + 4), w2a = *(const f32x4*)(cw + 512 + c), w2b = *(const f32x4*)(cw + 512 + c + 4);
            f32x4 ha, hb, ca, cb, ya, yb;
            unpack8(h0, ha, hb); unpack8(c0, ca, cb); ya = ha * ca * w0a; yb = hb * cb * w0b;
            unpack8(h1, ha, hb); unpack8(c1, ca, cb); ya += ha * ca * w1a; yb += hb * cb * w1b;
            unpack8(h2, ha, hb); unpack8(c2, ca, cb); ya += ha * ca * w2a; yb += hb * cb * w2b;
            unpack8(b1, ha, hb); ya = ya * ha; yb = yb * hb;
            *(pg8::u32x4*)(p->ycat + (size_t)t * 1024 + c) = pack8(ya, yb); } }
}
__device__ __forceinline__ void phase_na(ParamsC p, int l, unsigned char* smem) {
    for (int u = lbid(); u < 768; u += gridDim.x) attn_unit_na(p, l, u, smem);
}
__device__ __forceinline__ void phase_swa(ParamsC p, int l, unsigned char* smem) {
    for (int u = lbid(); u < 768; u += gridDim.x) attn_unit<1>(p, l, u, smem);
    if (l < DEPTH - 1) for (int u = lbid(); u < 48; u += gridDim.x) attn_unit<2>(p, l, u, smem);
}

#define RT_LD 1028
__device__ __forceinline__ void split8(const float (&x)[8], bf16x8& hi, bf16x8& lo) {
    pg8::u32x4 h, lw; float r[8];
    h.x = pack2(x[0], x[1]); h.y = pack2(x[2], x[3]); h.z = pack2(x[4], x[5]); h.w = pack2(x[6], x[7]);
    r[0] = x[0] - __uint_as_float(h.x << 16); r[1] = x[1] - __uint_as_float(h.x & 0xffff0000u); r[2] = x[2] - __uint_as_float(h.y << 16); r[3] = x[3] - __uint_as_float(h.y & 0xffff0000u);
    r[4] = x[4] - __uint_as_float(h.z << 16); r[5] = x[5] - __uint_as_float(h.z & 0xffff0000u); r[6] = x[6] - __uint_as_float(h.w << 16); r[7] = x[7] - __uint_as_float(h.w & 0xffff0000u);
    lw.x = pack2(r[0], r[1]); lw.y = pack2(r[2], r[3]); lw.z = pack2(r[4], r[5]); lw.w = pack2(r[6], r[7]);
    hi = __builtin_bit_cast(bf16x8, h); lo = __builtin_bit_cast(bf16x8, lw);
}
__device__ __forceinline__ void phase_router(ParamsC p, int l, float* smem) {
    const int tid = ltid(), lane = tid & 63, wid = tid >> 6;
    float* sh2 = smem;
    float* spart = smem + 16 * RT_LD;
    float* slg = spart + 8 * 16 * 48;
    int* bcnt = (int*)(slg + 16 * 36);
    if (tid < 32) bcnt[tid] = 0;
    const int ntok = (l < DEPTH - 1) ? T_ALL : T_LAT;
    const float* wre = p->w_re + (size_t)l * 1024 * 32; const float* wrg = p->w_rg + (size_t)l * 1024 * 4;
    bf16x8 bh[4][3], bl[4][3];
#pragma unroll
    for (int ks = 0; ks < 4; ++ks)
#pragma unroll
        for (int nt = 0; nt < 3; ++nt) { float w[8]; const int k0 = wid * 128 + ks * 32 + (lane >> 4) * 8, n = lane & 15;
#pragma unroll
            for (int j = 0; j < 8; ++j) w[j] = (nt < 2) ? wre[(size_t)(k0 + j) * 32 + nt * 16 + n] : (n < 4 ? wrg[(size_t)(k0 + j) * 4 + n] : 0.f);
            split8(w, bh[ks][nt], bl[ks][nt]); }
    float4 gf[4];
#pragma unroll
    for (int i = 0; i < 4; ++i) gf[i] = *(const float4*)(p->g_ffn + l * 1024 + i * 256 + lane * 4);
    const bf16_t* xs = p->xs; bf16_t* hout = p->h; const float* modv = p->modv + (size_t)l * 5 * 6144 + 3072;
    const int G = gridDim.x, ntb = ntok / 16;
    __syncthreads();
    for (int tb = lbid(); tb < ntb; tb += G) {
#pragma unroll
        for (int j = 0; j < 2; ++j) { const int tt = wid * 2 + j, t = tb * 16 + tt; const int v = tok_variant(t);
            float4 xv[4]; float ss = 0.f;
#pragma unroll
            for (int i = 0; i < 4; ++i) { xv[i] = load4bf(xs + (size_t)t * 1024 + i * 256 + lane * 4); ss += xv[i].x * xv[i].x + xv[i].y * xv[i].y + xv[i].z * xv[i].z + xv[i].w * xv[i].w; }
            ss = wave_sum(ss); const float rstd = rsqrtf(ss * (1.0f / 1024.0f) + 1e-6f);
            const float* mv = modv + (size_t)v * 6144;
#pragma unroll
            for (int i = 0; i < 4; ++i) { const int c = i * 256 + lane * 4;
                const float4 g = gf[i], sh = *(const float4*)(mv + c), sc = *(const float4*)(mv + 1024 + c);
                float4 o; o.x = xv[i].x * rstd * g.x * (1.f + sc.x) + sh.x; o.y = xv[i].y * rstd * g.y * (1.f + sc.y) + sh.y; o.z = xv[i].z * rstd * g.z * (1.f + sc.z) + sh.z; o.w = xv[i].w * rstd * g.w * (1.f + sc.w) + sh.w;
                *(float4*)(sh2 + tt * RT_LD + c) = o; uint2 ob; ob.x = pack2(o.x, o.y); ob.y = pack2(o.z, o.w); *(uint2*)(hout + (size_t)t * 1024 + c) = ob; } }
        __syncthreads();
        {   f32x4 c0 = (f32x4){0.f, 0.f, 0.f, 0.f}, c1 = c0, c2 = c0;
            const float* ap = sh2 + (lane & 15) * RT_LD + wid * 128 + (lane >> 4) * 8;
#pragma unroll
            for (int ks = 0; ks < 4; ++ks) { const float4 a0 = *(const float4*)(ap + ks * 32), a1 = *(const float4*)(ap + ks * 32 + 4);
                const float x8[8] = {a0.x, a0.y, a0.z, a0.w, a1.x, a1.y, a1.z, a1.w}; bf16x8 ah, al; split8(x8, ah, al);
                c0 = __builtin_amdgcn_mfma_f32_16x16x32_bf16(ah, bh[ks][0], c0, 0, 0, 0); c0 = __builtin_amdgcn_mfma_f32_16x16x32_bf16(ah, bl[ks][0], c0, 0, 0, 0); c0 = __builtin_amdgcn_mfma_f32_16x16x32_bf16(al, bh[ks][0], c0, 0, 0, 0);
                c1 = __builtin_amdgcn_mfma_f32_16x16x32_bf16(ah, bh[ks][1], c1, 0, 0, 0); c1 = __builtin_amdgcn_mfma_f32_16x16x32_bf16(ah, bl[ks][1], c1, 0, 0, 0); c1 = __builtin_amdgcn_mfma_f32_16x16x32_bf16(al, bh[ks][1], c1, 0, 0, 0);
                c2 = __builtin_amdgcn_mfma_f32_16x16x32_bf16(ah, bh[ks][2], c2, 0, 0, 0); c2 = __builtin_amdgcn_mfma_f32_16x16x32_bf16(ah, bl[ks][2], c2, 0, 0, 0); c2 = __builtin_amdgcn_mfma_f32_16x16x32_bf16(al, bh[ks][2], c2, 0, 0, 0); }
#pragma unroll
            for (int r = 0; r < 4; ++r) { float* sp = spart + (wid * 16 + 4 * (lane >> 4) + r) * 48 + (lane & 15); sp[0] = c0[r]; sp[16] = c1[r]; sp[32] = c2[r]; } }
        __syncthreads();
        {   const int tt = tid >> 5, j = tid & 31; float a = p->b_re[l * 32 + j];
#pragma unroll
            for (int w8 = 0; w8 < 8; ++w8) a += spart[(w8 * 16 + tt) * 48 + j];
            slg[tt * 36 + 4 + j] = a;
            if (tid < 64) { const int t2 = tid >> 2, j2 = tid & 3; float a2 = p->b_rg[l * 4 + j2];
#pragma unroll
                for (int w8 = 0; w8 < 8; ++w8) a2 += spart[(w8 * 16 + t2) * 48 + 32 + j2];
                slg[t2 * 36 + j2] = a2; } }
        __syncthreads();
        if (tid < 16) { const int t = tb * 16 + tid; const float* lg = slg + tid * 36;
            int gi = 0; float gm = lg[0];
#pragma unroll
            for (int j = 1; j < 4; ++j) if (lg[j] > gm) { gm = lg[j]; gi = j; }
            float den = 0.f;
#pragma unroll
            for (int j = 0; j < 4; ++j) den += __expf(lg[j] - gm);
            const float pg = __builtin_amdgcn_rcpf(den);
            const float* le = lg + 4 + gi * 8;
            int i1 = 0; float v1 = le[0];
#pragma unroll
            for (int j = 1; j < 8; ++j) if (le[j] > v1) { v1 = le[j]; i1 = j; }
            int i2 = -1; float v2 = -3.0e38f;
#pragma unroll
            for (int j = 0; j < 8; ++j) if (j != i1 && le[j] > v2) { v2 = le[j]; i2 = j; }
            const float e2 = __expf(v2 - v1); const float wa = __builtin_amdgcn_rcpf(1.0f + e2), wb = e2 * wa;
            const int ea = gi * 8 + i1, eb = gi * 8 + i2;
            p->eid[t * 2] = ea; p->eid[t * 2 + 1] = eb; p->ewt[t * 2] = pg * wa; p->ewt[t * 2 + 1] = pg * wb;
            p->epos[t * 2] = atomicAdd(bcnt + ea, 1); p->epos[t * 2 + 1] = atomicAdd(bcnt + eb, 1); }
        __syncthreads();
    }
    __syncthreads();
    if (tid < 32) p->cnt[lbid() * 32 + tid] = bcnt[tid];
}

__device__ __forceinline__ void phase_dispatch(ParamsC p, int l, int* smem) {
    const int tid = ltid(), lane = tid & 63, wid = tid >> 6;
    int* sfull = smem;
    int* spre = smem + 512;
    int* pstart = smem + 1024;
    int* boff = smem + 1024 + 64;
    const int G = gridDim.x;
    {   const int e = tid & 31, part = tid >> 5; int sf = 0, sp = 0;
        for (int bb = part; bb < G; bb += 16) { const int c = p->cnt[bb * 32 + e]; sf += c; sp += (bb < lbid()) ? c : 0; }
        sfull[part * 32 + e] = sf; spre[part * 32 + e] = sp; }
    __syncthreads();
    if (tid < 32) { int tf = 0, tp = 0; for (int q = 0; q < 16; ++q) { tf += sfull[q * 32 + tid]; tp += spre[q * 32 + tid]; } sfull[tid] = tf; spre[tid] = tp; }
    __syncthreads();
    if (tid == 0) { int acc = 0; for (int e = 0; e < 32; ++e) { pstart[e] = acc; acc += ((sfull[e] + 255) >> 8) << 8; } pstart[32] = acc; }
    __syncthreads();
    if (tid < 32) boff[tid] = pstart[tid] + spre[tid];
    if (lbid() == 0) { const int nb = pstart[32] >> 8;
        for (int rb = tid; rb < nb; rb += NTHR) { int e = 0; while (e < 31 && pstart[e + 1] <= rb * 256) ++e; p->blk_e[rb] = e; }
        if (tid == 0) p->nbu[0] = nb; }
    __syncthreads();
    const int ntok = (l < DEPTH - 1) ? T_ALL : T_LAT;
    {
        const int bid = lbid(), ntb = ntok / 16, nmine = (ntb - bid + G - 1) / G;
        for (int i = tid; i < nmine * 32; i += NTHR) { const int a = (bid + (i >> 5) * G) * 32 + (i & 31); const int sl = boff[p->eid[a]] + p->epos[a]; p->slot[a] = sl; p->tokmap[sl] = a >> 1; } }
    for (int e = lbid(); e < 32; e += G) { const int lo = pstart[e] + sfull[e], hi = pstart[e + 1]; for (int sl = lo + tid; sl < hi; sl += NTHR) p->tokmap[sl] = 0; }
}

struct EpiIn { static constexpr bool PERM = true, AFTER_DRAIN = false, HOOK = false;
    bf16_t* uA; bf16_t* uG; const float* ropet;
    __device__ __forceinline__ void operator()(const f32x4 (&acc)[2][2][4][2], const pg8::Unit& u, int wr, int wc, int fr, int fq) const {
        const int row0 = u.pm * 256 + wr * 64 + fr; const bool latent = u.pm < 128;
#pragma unroll
        for (int bj = 0; bj < 2; ++bj) {
            const int cb32 = u.pn * 256 + bj * 128 + wc * 32, c0 = cb32 + 8 * fq;
            if (cb32 >= 2560) {
#pragma unroll
                for (int ai = 0; ai < 2; ++ai)
#pragma unroll
                    for (int m = 0; m < 4; ++m) { const int t = row0 + ai * 128 + m * 16; f32x4 v0 = acc[ai][bj][m][0], v1 = acc[ai][bj][m][1];
#pragma unroll
                        for (int e = 0; e < 4; ++e) { v0[e] = __builtin_amdgcn_rcpf(1.f + __expf(-v0[e])); v1[e] = __builtin_amdgcn_rcpf(1.f + __expf(-v1[e])); }
                        const int gt_ = (u.pn - 10), wv_ = wr * 4 + wc;
                        *(pg8::u32x4*)(uG + ((((size_t)u.pm * 12 + gt_) * 8 + wv_) * 16 + (ai * 8 + m * 2 + bj)) * 512 + (fq * 16 + fr) * 8) = pack8(v0, v1); }
            } else {
                const bool isq = (cb32 >= 768 && cb32 < 1152) || (cb32 >= 1920 && cb32 < 2304);
                const bool rope = (cb32 >= 1920 && cb32 < 2432) && latent;
#pragma unroll
                for (int ai = 0; ai < 2; ++ai)
#pragma unroll
                    for (int m = 0; m < 4; ++m) { const int t = row0 + ai * 128 + m * 16; f32x4 v0 = acc[ai][bj][m][0], v1 = acc[ai][bj][m][1];
                        if (rope) { const int pos = t & 8191; const int posv = (wc & 1) ? (pos & 63) : (pos >> 6);
                            const float4* cs = (const float4*)(ropet + (posv * 16 + 8 * (fq & 1)) * 2);
                            const float4 c01 = cs[0], c23 = cs[1], c45 = cs[2], c67 = cs[3];
                            f32x4 p0, p1;
#pragma unroll
                            for (int e = 0; e < 4; ++e) { p0[e] = __shfl_xor(v0[e], 32); p1[e] = __shfl_xor(v1[e], 32); }
                            const float co0[4] = {c01.x, c01.z, c23.x, c23.z}, si0[4] = {c01.y, c01.w, c23.y, c23.w}, co1[4] = {c45.x, c45.z, c67.x, c67.z}, si1[4] = {c45.y, c45.w, c67.y, c67.w};
#pragma unroll
                            for (int e = 0; e < 4; ++e) {
                                if (fq < 2) { v0[e] = v0[e] * co0[e] - p0[e] * si0[e]; v1[e] = v1[e] * co1[e] - p1[e] * si1[e]; }
                                else { v0[e] = p0[e] * si0[e] + v0[e] * co0[e]; v1[e] = p1[e] * si1[e] + v1[e] * co1[e]; } } }
                        if (isq) { v0 = v0 * (0.125f * QLOG2E); v1 = v1 * (0.125f * QLOG2E); }
                        *(pg8::u32x4*)(uA + (size_t)t * UA_LD + c0) = pack8(v0, v1); }
            }
        }
    }
};

struct EpiMerge { static constexpr bool PERM = true, AFTER_DRAIN = false, HOOK = true;
    const bf16_t* uG; bf16_t* mo;
    __device__ __forceinline__ void hook(f32x4 (&acc)[2][2][4][2], const pg8::Unit& u, int t, int wr, int wc, int fr, int fq) const {
        int lo_ = (fq * 16 + fr) * 8; asm volatile("" : "+v"(lo_)); const int seg = (t == 2) ? 0 : 1;
        const bf16_t* gbase = uG + ((((size_t)u.pm * 12 + seg * 4 + u.pn) * 8 + (wr * 4 + wc)) * 16) * 512 + lo_;
#pragma unroll
        for (int ai = 0; ai < 2; ++ai) {
            pg8::u32x4 wn[4][2], wd[4][2];
#pragma unroll
            for (int m = 0; m < 4; ++m)
#pragma unroll
                for (int bj = 0; bj < 2; ++bj) { const bf16_t* gp = gbase + (ai * 8 + m * 2 + bj) * 512; wn[m][bj] = *(const pg8::u32x4*)gp; wd[m][bj] = *(const pg8::u32x4*)(gp + 4 * 65536); }
#pragma unroll
            for (int m = 0; m < 4; ++m)
#pragma unroll
                for (int bj = 0; bj < 2; ++bj) { f32x4 n0, n1, d0, d1; unpack8(wn[m][bj], n0, n1); unpack8(wd[m][bj], d0, d1);
#pragma unroll
                    for (int e = 0; e < 4; ++e) { acc[ai][bj][m][0][e] *= n0[e] * __builtin_amdgcn_rcpf(fmaxf(d0[e], 1e-20f)); acc[ai][bj][m][1][e] *= n1[e] * __builtin_amdgcn_rcpf(fmaxf(d1[e], 1e-20f)); } }
            asm volatile("" ::: "memory");
        }
    }
    __device__ __forceinline__ void operator()(const f32x4 (&acc)[2][2][4][2], const pg8::Unit& u, int wr, int wc, int fr, int fq) const {
        const int row0 = u.pm * 256 + wr * 64 + fr; const int c00 = u.pn * 256 + wc * 32 + 8 * fq;
#pragma unroll
        for (int ai = 0; ai < 2; ++ai) { pg8::u32x4 wg[4][2];
#pragma unroll
            for (int m = 0; m < 4; ++m)
#pragma unroll
                for (int bj = 0; bj < 2; ++bj) wg[m][bj] = *(const pg8::u32x4*)(uG + ((((size_t)u.pm * 12 + 8 + u.pn) * 8 + (wr * 4 + wc)) * 16 + (ai * 8 + m * 2 + bj)) * 512 + (fq * 16 + fr) * 8);
#pragma unroll
            for (int m = 0; m < 4; ++m)
#pragma unroll
                for (int bj = 0; bj < 2; ++bj) { f32x4 g0, g1; unpack8(wg[m][bj], g0, g1); f32x4 v0 = acc[ai][bj][m][0], v1 = acc[ai][bj][m][1];
#pragma unroll
                    for (int e = 0; e < 4; ++e) { v0[e] *= fmaxf(g0[e], 1e-20f); v1[e] *= fmaxf(g1[e], 1e-20f); }
                    *(pg8::u32x4*)(mo + (size_t)(row0 + ai * 128 + m * 16) * 1024 + c00 + bj * 128) = pack8(v0, v1); }
            asm volatile("" ::: "memory"); }
    }
};

struct EpiO { static constexpr bool PERM = true, AFTER_DRAIN = false, HOOK = false;
    bf16_t* xs; const float* modv_l;
    __device__ __forceinline__ void operator()(const f32x4 (&acc)[2][2][4][2], const pg8::Unit& u, int wr, int wc, int fr, int fq) const {
        const int row0 = u.pm * 256 + wr * 64 + fr; const int v = u.pm < 128 ? (u.pm >> 5) : 4; const float* gt = modv_l + (size_t)v * 6144 + 2048;
        const int col0 = u.pn * 256 + wc * 32 + 8 * fq;
        f32x4 gv[2][2];
#pragma unroll
        for (int bj = 0; bj < 2; ++bj)
#pragma unroll
            for (int n = 0; n < 2; ++n) gv[bj][n] = *(const f32x4*)(gt + col0 + bj * 128 + n * 4);
#pragma unroll
        for (int ai = 0; ai < 2; ++ai) { pg8::u32x4 xw[4][2];
#pragma unroll
            for (int m = 0; m < 4; ++m)
#pragma unroll
                for (int bj = 0; bj < 2; ++bj) xw[m][bj] = *(const pg8::u32x4*)(xs + (size_t)(row0 + ai * 128 + m * 16) * 1024 + col0 + bj * 128);
#pragma unroll
            for (int m = 0; m < 4; ++m)
#pragma unroll
                for (int bj = 0; bj < 2; ++bj) { f32x4 x0, x1; unpack8(xw[m][bj], x0, x1);
                    x0 = x0 + gv[bj][0] * acc[ai][bj][m][0]; x1 = x1 + gv[bj][1] * acc[ai][bj][m][1];
                    *(pg8::u32x4*)(xs + (size_t)(row0 + ai * 128 + m * 16) * 1024 + col0 + bj * 128) = pack8(x0, x1); }
            asm volatile("" ::: "memory"); }
    }
};

struct EpiE1 { static constexpr bool PERM = true, AFTER_DRAIN = false, HOOK = false;
    bf16_t* hid;
    __device__ __forceinline__ void operator()(const f32x4 (&acc)[2][2][4][2], const pg8::Unit& u, int wr, int wc, int fr, int fq) const {
        const int row0 = u.pm * 256 + wr * 64 + fr; const int c0 = (u.pn & 1) * 128 + wc * 32 + 8 * fq;
#pragma unroll
        for (int ai = 0; ai < 2; ++ai)
#pragma unroll
            for (int m = 0; m < 4; ++m) { f32x4 o0, o1;
#pragma unroll
                for (int e = 0; e < 4; ++e) { const float g0 = acc[ai][0][m][0][e], g1 = acc[ai][0][m][1][e];
                    o0[e] = g0 * __builtin_amdgcn_rcpf(1.f + __expf(-g0)) * acc[ai][1][m][0][e]; o1[e] = g1 * __builtin_amdgcn_rcpf(1.f + __expf(-g1)) * acc[ai][1][m][1][e]; }
                *(pg8::u32x4*)(hid + (size_t)(row0 + ai * 128 + m * 16) * 256 + c0) = pack8(o0, o1); }
    }
};

struct EpiE2 { static constexpr bool PERM = true, AFTER_DRAIN = false, HOOK = false;
    bf16_t* Y;
    __device__ __forceinline__ void operator()(const f32x4 (&acc)[2][2][4][2], const pg8::Unit& u, int wr, int wc, int fr, int fq) const {
        const int row0 = u.pm * 256 + wr * 64 + fr; const int c0 = (u.pn & 3) * 256 + wc * 32 + 8 * fq;
#pragma unroll
        for (int ai = 0; ai < 2; ++ai)
#pragma unroll
            for (int m = 0; m < 4; ++m)
#pragma unroll
                for (int bj = 0; bj < 2; ++bj) *(pg8::u32x4*)(Y + (size_t)(row0 + ai * 128 + m * 16) * 1024 + c0 + bj * 128) = pack8(acc[ai][bj][m][0], acc[ai][bj][m][1]);
    }
};

__device__ __forceinline__ void phase_pg_in(ParamsC p, int l, unsigned char* smem) {
    pg8::Gemm g{p->h, WSEL(wt_in, l), T_ALL, IN_COLS, 1024, nullptr}; pg8::StaticOrder S; S.init(T_ALL, IN_COLS, (int)gridDim.x, lbid());
    EpiIn E{p->uA, p->uG, p->ropet};
    pg8::gemm_phase<EpiIn, pg8::StaticOrder, true, true>((PG8_LAS unsigned char*)smem, g, S, E);
}
__device__ __forceinline__ void phase_pg_merge(ParamsC p, int l, unsigned char* smem) {
    const int M = (l < DEPTH - 1) ? T_ALL : T_LAT;
    pg8::Gemm g{p->ycat, WSEL(wt_br, l), M, 1024, 1024, nullptr}; pg8::StaticOrder S; S.init(M, 1024, (int)gridDim.x, lbid());
    EpiMerge E{p->uG, p->mbuf};
    pg8::gemm_phase<EpiMerge, pg8::StaticOrder, true, true>((PG8_LAS unsigned char*)smem, g, S, E);
    if (l < DEPTH - 1) { const int G = (int)gridDim.x, extra = (M / 256) * 4 - 2 * G, c = lbid(); const bool part = extra > 0 && extra < G;
        const int first = part ? c - extra : c, stride = part ? G - extra : G;
        if (first >= 0) phase_wconv(p, l + 1, (float*)smem, 0, WC_TOTAL / 2, first, stride); }
}
__device__ __forceinline__ void phase_pg_o(ParamsC p, int l, unsigned char* smem) {
    const int M = (l < DEPTH - 1) ? T_ALL : T_LAT;
    pg8::Gemm g{p->mbuf, WSEL(wt_o, l), M, 1024, 1024, nullptr}; pg8::StaticOrder S; S.init(M, 1024, (int)gridDim.x, lbid());
    EpiO E{p->xs, p->modv + (size_t)l * 5 * 6144};
    pg8::gemm_phase<EpiO, pg8::StaticOrder, true, true>((PG8_LAS unsigned char*)smem, g, S, E);
    if (l < DEPTH - 1) { const int G = (int)gridDim.x, extra = (M / 256) * 4 - 2 * G, c = lbid(); const bool part = extra > 0 && extra < G;
        const int first = part ? c - extra : c, stride = part ? G - extra : G;
        if (first >= 0) phase_wconv(p, l + 1, (float*)smem, WC_TOTAL / 2, WC_TOTAL, first, stride); }
}
__device__ __forceinline__ void phase_pg_e1(ParamsC p, int l, unsigned char* smem) {
    const int nb = p->nbu[0];
    pg8::Gemm g{p->h, WSEL(wt_gu, l), nb * 256, 512, 1024, p->tokmap}; pg8::GroupedOrder<2> S{p->blk_e, nb * 2, (int)gridDim.x, lbid()};
    EpiE1 E{p->hid};
    pg8::gemm_phase<EpiE1, pg8::GroupedOrder<2>, true, true, true>((PG8_LAS unsigned char*)smem, g, S, E);
}
__device__ __forceinline__ void phase_pg_e2(ParamsC p, int l, unsigned char* smem) {
    const int nb = p->nbu[0];
    pg8::Gemm g{p->hid, WSEL(wt_d, l), nb * 256, 1024, 256, nullptr}; pg8::GroupedOrder<4> S{p->blk_e, nb * 4, (int)gridDim.x, lbid()};
    EpiE2 E{p->Y};
    pg8::gemm_phase<EpiE2, pg8::GroupedOrder<4>, true, true>((PG8_LAS unsigned char*)smem, g, S, E);
}

#define XB_TMO      128
#define XB_XCNT(j)  (256  + 64 * (j))
#define XB_XSUB(j)  (1280 + 64 * (j))
#define XB_XGEN(j)  (2304 + 64 * (j))
#define XB_TOP      3328
#define XB_TOPGEN   3392
#define XCD_BAR_WORDS 3456
#define XB_SPIN_CAP (1u << 18)
__device__ __forceinline__ unsigned xb_ld(unsigned* p)              { return __hip_atomic_load(p, __ATOMIC_RELAXED, __HIP_MEMORY_SCOPE_AGENT); }
__device__ __forceinline__ unsigned xb_add(unsigned* p, unsigned v) { return __hip_atomic_fetch_add(p, v, __ATOMIC_RELAXED, __HIP_MEMORY_SCOPE_AGENT); }
__device__ __forceinline__ unsigned xb_xcc_id() { return (unsigned)__builtin_amdgcn_s_getreg((3 << 11) | 20) & 0xFu; }
#define XB_SPIN(cond, bar) do { unsigned _sp = 0; while (cond) { __builtin_amdgcn_s_sleep(1); \
    if ((++_sp & 255u) == 0u) { if (xb_ld(&(bar)[XB_TMO])) break; if (_sp > XB_SPIN_CAP) { atomicAdd(&(bar)[XB_TMO], 1u); break; } } } } while (0)
struct XcdBarrier { unsigned* bar; unsigned x; volatile LAS unsigned* st; };
__device__ __forceinline__ XcdBarrier xcd_barrier_post(unsigned* bar, volatile LAS unsigned* st) {
    XcdBarrier b; b.bar = bar; b.x = xb_xcc_id(); b.st = st;
    if (threadIdx.x == 0) (void)xb_add(&bar[XB_XCNT(b.x)], 1u);
    return b;
}
__device__ __forceinline__ void xcd_barrier_complete(unsigned* bar, unsigned x, unsigned& nloc, unsigned& nx) {
    const unsigned G = gridDim.x * gridDim.y * gridDim.z;
    unsigned sum, cnt, mine, sp = 0u;
    for (;;) {
        sum = 0u; cnt = 0u; mine = 0u;
#pragma unroll
        for (unsigned j = 0; j < 16; ++j) { const unsigned c = xb_ld(&bar[XB_XCNT(j)]); sum += c; cnt += (c > 0u) ? 1u : 0u; mine = (j == x) ? c : mine; }
        if (sum == G) break;
        __builtin_amdgcn_s_sleep(1);
        if ((++sp & 255u) == 0u) { if (xb_ld(&bar[XB_TMO])) break; if (sp > XB_SPIN_CAP) { atomicAdd(&bar[XB_TMO], 1u); break; } }
    }
    nloc = mine > 0u ? mine : 1u; nx = cnt > 0u ? cnt : 1u;
}
__device__ __forceinline__ void xcd_barrier(const XcdBarrier& b) {
    asm volatile("s_waitcnt vmcnt(0)" ::: "memory");
    __syncthreads();
    if (threadIdx.x == 0) {
        unsigned* bar = b.bar;
        __builtin_amdgcn_s_waitcnt(0);
        unsigned nloc = b.st[0], nx = b.st[1];
        if (nloc == 0u) { xcd_barrier_complete(bar, b.x, nloc, nx); b.st[0] = nloc; b.st[1] = nx; }
        const unsigned old = xb_add(&bar[XB_XSUB(b.x)], 1u);
        const unsigned gen = old / nloc;
        if (old + 1u == (gen + 1u) * nloc) {
            __builtin_amdgcn_fence(__ATOMIC_RELEASE, "agent");
            asm volatile("s_waitcnt vmcnt(0)" ::: "memory");
            const unsigned og = xb_add(&bar[XB_TOP], 1u);
            const unsigned tg = og / nx;
            if (og + 1u == (tg + 1u) * nx) xb_add(&bar[XB_TOPGEN], 1u);
            else XB_SPIN(xb_ld(&bar[XB_TOPGEN]) == tg, bar);
            __builtin_amdgcn_fence(__ATOMIC_ACQUIRE, "agent");
            xb_add(&bar[XB_XGEN(b.x)], 1u);
            asm volatile("s_waitcnt vmcnt(0)" ::: "memory");
        } else {
            XB_SPIN(xb_ld(&bar[XB_XGEN(b.x)]) == gen, bar);
            __builtin_amdgcn_fence(__ATOMIC_ACQUIRE, "agent");
            asm volatile("s_waitcnt vmcnt(0)" ::: "memory");
        }
    }
    __syncthreads();
}

#define SMEM_BYTES 131072
#ifndef PROBE_MASK
#define PROBE_MASK 0
#endif
#define PROBE_MULT 4
#define PH_BEGIN(id) do { if (PROBE_MASK & (1 << (id))) t0 = wall_clock64(); } while (0)
#define PH_END(id) do { if (PROBE_MASK & (1 << (id))) tacc += wall_clock64() - t0; } while (0)
__global__ void __launch_bounds__(NTHR, 2) k_mega(Params p_unused) {
    const ParamsC pk = (ParamsC)__builtin_amdgcn_kernarg_segment_ptr();
#define PP() ({ ParamsC q_ = pk; asm volatile("" : "+s"(q_) :: "memory"); q_; })
    extern __shared__ __attribute__((aligned(16))) unsigned char smem[];
    volatile LAS unsigned* xbw = (volatile LAS unsigned*)(smem + SMEM_BYTES);
    if (threadIdx.x == 0) { xbw[0] = 0u; xbw[1] = 0u; xbw[2] = 0u; xbw[3] = 0u; }
    __syncthreads();
    (void)xcd_barrier_post(PP()->bar, xbw);
    unsigned long long tacc = 0, t0 = 0;
#define GRID_BAR() do { unsigned long long tb0_ = 0; if (PROBE_MASK & (1 << 14)) tb0_ = wall_clock64(); XcdBarrier bar_; bar_.bar = PP()->bar; bar_.x = xb_xcc_id(); bar_.st = xbw; xcd_barrier(bar_); if (PROBE_MASK & (1 << 14)) tacc += wall_clock64() - tb0_; } while (0)
    PH_BEGIN(0); phase_mod(PP(), (float*)smem); phase_wconv(PP(), 0, (float*)smem, 0, WC_TOTAL, lbid(), (int)gridDim.x); GRID_BAR(); PH_END(0);
    for (int l = 0; l < DEPTH; ++l) {
        PH_BEGIN(1); phase_norm1(PP(), l); GRID_BAR(); PH_END(1);
        PH_BEGIN(2); phase_pg_in(PP(), l, smem); GRID_BAR(); PH_END(2);
        PH_BEGIN(3); PH_BEGIN(11); phase_conv(PP(), l); PH_END(11); PH_BEGIN(12); phase_na(PP(), l, smem); PH_END(12); PH_BEGIN(13); phase_swa(PP(), l, smem); PH_END(13); GRID_BAR(); PH_END(3);
        PH_BEGIN(4); phase_pg_merge(PP(), l, smem); GRID_BAR(); PH_END(4);
        PH_BEGIN(5); phase_pg_o(PP(), l, smem); GRID_BAR(); PH_END(5);
        PH_BEGIN(6); phase_router(PP(), l, (float*)smem); GRID_BAR(); PH_END(6);
        PH_BEGIN(7); phase_dispatch(PP(), l, (int*)smem); GRID_BAR(); PH_END(7);
        PH_BEGIN(8); phase_pg_e1(PP(), l, smem); GRID_BAR(); PH_END(8);
        PH_BEGIN(9); phase_pg_e2(PP(), l, smem); GRID_BAR(); PH_END(9);
    }
    PH_BEGIN(10); phase_norm1(PP(), DEPTH); PH_END(10);
    if (PROBE_SUB != 0 && threadIdx.x == 0) tacc += ((volatile LAS unsigned*)(smem + 131072 + 8))[0];
    if ((PROBE_MASK != 0 || PROBE_SUB != 0) && blockIdx.x == 0) { const unsigned long long te = wall_clock64(); while (wall_clock64() - te < tacc * PROBE_MULT) __builtin_amdgcn_s_sleep(8); }
}

extern "C" void kernel_launch(void* const* d_in, const int* in_sizes, int n_in, void* d_out, int out_size, void* d_ws, size_t ws_size, hipStream_t stream) {
    Params p{};
    p.x = (const float*)d_in[0]; p.c = (const float*)d_in[1]; p.ctx = (const float*)d_in[2]; p.c_ctx = (const float*)d_in[3]; p.w_mod = (const float*)d_in[4]; p.b_mod = (const float*)d_in[5];
    p.g_attn = (const float*)d_in[6]; p.g_ffn = (const float*)d_in[7]; p.w_in = (const float*)d_in[8]; p.conv_w = (const float*)d_in[9]; p.rpb = (const float*)d_in[10]; p.sinks = (const float*)d_in[11];
    p.w_branch = (const float*)d_in[12]; p.w_o = (const float*)d_in[13]; p.w_rg = (const float*)d_in[14]; p.b_rg = (const float*)d_in[15]; p.w_re = (const float*)d_in[16]; p.b_re = (const float*)d_in[17];
    p.w_eg = (const float*)d_in[18]; p.w_eu = (const float*)d_in[19]; p.w_ed = (const float*)d_in[20]; p.g_final = (const float*)d_in[21];
    p.out = (float*)d_out;
    unsigned char* w = (unsigned char*)d_ws; size_t off = 0;
    auto take = [&](size_t bytes) { unsigned char* r = w + off; off += (bytes + 255) & ~(size_t)255; return r; };
    p.bar = (unsigned*)take(16384); p.cnt = (int*)take(1024 * 32 * 4); p.blk_e = (int*)take(MAXBLK * 4); p.nbu = (int*)take(256);
    p.modv = (float*)take((size_t)DEPTH * 5 * 6144 * 4); p.ropet = (float*)take(128 * 16 * 2 * 4);
    p.eid = (int*)take((size_t)T_ALL * 2 * 4); p.epos = (int*)take((size_t)T_ALL * 2 * 4); p.ewt = (float*)take((size_t)T_ALL * 2 * 4); p.slot = (int*)take((size_t)T_ALL * 2 * 4); p.tokmap = (int*)take((size_t)MAXBLK * 256 * 4);
    p.xs = (bf16_t*)take((size_t)T_ALL * 1024 * 2);
    p.h = (bf16_t*)take((size_t)T_ALL * 1024 * 2);
    p.wt_in = (bf16_t*)take((size_t)IN_COLS * 1024 * 2); p.wt_br = (bf16_t*)take((size_t)1024 * 1024 * 2); p.wt_o = (bf16_t*)take((size_t)1024 * 1024 * 2);
    p.wt_gu = (bf16_t*)take((size_t)32 * 512 * 1024 * 2); p.wt_d = (bf16_t*)take((size_t)32 * 1024 * 256 * 2);
    {   unsigned char* o = (unsigned char*)d_out; size_t oo = 0;
        auto take_o = [&](size_t bytes) { unsigned char* r = o + oo; oo += (bytes + 255) & ~(size_t)255; return r; };
        p.wt_in1 = (bf16_t*)take_o((size_t)IN_COLS * 1024 * 2); p.wt_br1 = (bf16_t*)take_o((size_t)1024 * 1024 * 2); p.wt_o1 = (bf16_t*)take_o((size_t)1024 * 1024 * 2);
        p.wt_gu1 = (bf16_t*)take_o((size_t)32 * 512 * 1024 * 2); p.wt_d1 = (bf16_t*)take_o((size_t)32 * 1024 * 256 * 2);
        if (oo > (size_t)out_size * 4) return; }
    p.uA = (bf16_t*)take((size_t)T_ALL * UA_LD * 2); p.uG = (bf16_t*)take((size_t)T_ALL * UG_LD * 2); p.ycat = (bf16_t*)take((size_t)T_ALL * 1024 * 2);
    p.mbuf = p.uA; p.xd = p.uA; p.hid = p.ycat; p.Y = p.uG;
    if (off > ws_size) return;
    constexpr size_t kDynLds = SMEM_BYTES + 16;
    static int grid = 0;
    if (!grid) {
        (void)hipFuncSetAttribute((const void*)k_mega, hipFuncAttributeMaxDynamicSharedMemorySize, (int)kDynLds);
        int dev = 0, cus = 0, per_cu = 0;
        (void)hipGetDevice(&dev);
        (void)hipDeviceGetAttribute(&cus, hipDeviceAttributeMultiprocessorCount, dev);
        (void)hipOccupancyMaxActiveBlocksPerMultiprocessor(&per_cu, (const void*)k_mega, NTHR, kDynLds);
        grid = cus * (per_cu < 1 ? per_cu : 1);
        if (grid <= 0) grid = 0;
    }
    if (!grid) return;
    (void)hipMemsetAsync(p.bar, 0, XCD_BAR_WORDS * sizeof(unsigned), stream);
    hipLaunchKernelGGL(k_mega, dim3(grid), dim3(NTHR), kDynLds, stream, p);
}
```
